# Optimizing an MI355X kernel written in HIP

```python
import jax, jax.numpy as jnp
from jax import lax
import numpy as np

D_MODEL = 1024
BATCH = 2
SEQ = 8192
DEPTH = 4
DEC_BATCH = 128
DEC_SEQ = 1
PAST_LEN = 2048
PAGE_SIZE = 128

N_A_LAYERS = DEPTH // 2
N_B_LAYERS = DEPTH - N_A_LAYERS
D_FF = 2816
GMLP_EXPAND = 6
D_V = GMLP_EXPAND * D_MODEL // 2
CHUNK = 128
N_GROUPS_A = 8
CG = D_V // N_GROUPS_A
N_HEADS = 16
HEAD_DIM = D_MODEL // N_HEADS
N_KV = 4
HPG = N_HEADS // N_KV
CMP_LEN = 32
CMP_STRIDE = 16
CMP_HID = 256
SEL_BLOCK = 64
N_SEL = 16
WINDOW = 512
Q_BLOCK = 128
N_CACHE_SLOTS = 4
N_KV_PROJ = 6
EPS = 1e-6
NEG = -1e30
FORCE_BONUS = 1e4

kernel_name = 'yoco_gmlp_nsa_macaron_step'


def rms_norm(x, g):
    xf = x.astype(jnp.float32)
    y = xf * lax.rsqrt(jnp.mean(xf * xf, axis=-1, keepdims=True) + EPS)
    return (y * g.astype(jnp.float32)).astype(x.dtype)


def layer_norm(x, g, b):
    xf = x.astype(jnp.float32)
    mu = jnp.mean(xf, axis=-1, keepdims=True)
    var = jnp.mean(jnp.square(xf - mu), axis=-1, keepdims=True)
    return ((xf - mu) * lax.rsqrt(var + EPS) * g + b).astype(x.dtype)


def modulate(h, shift, scale):
    return h * (1 + scale[:, None, :]) + shift[:, None, :]


def ada_norm(x, g, m):
    return modulate(rms_norm(x, g), m[:, 0], m[:, 1])


def swiglu(h, w_gate, w_up, w_down):
    return (jax.nn.silu(h @ w_gate) * (h @ w_up)) @ w_down


def pad_seq(a, mult):
    p = (-a.shape[1]) % mult
    return jnp.pad(a, ((0, 0), (0, p)) + ((0, 0),) * (a.ndim - 2))


def alibi_slopes():
    h = jnp.arange(1, N_HEADS + 1, dtype=jnp.float32)
    return jnp.exp2(-8.0 * h / N_HEADS).reshape(N_KV, HPG)


def masked_softmax(s, mask):
    s = jnp.where(mask, s, NEG)
    p = jax.nn.softmax(s, axis=-1)
    return jnp.where(mask, p, 0.0)


def gmlp_mix(h, w_uv, ln_g, ln_b, w_sp, b_sp, w_out):
    B, T, _ = h.shape
    z = jax.nn.gelu(h @ w_uv)
    u, v = z[..., :D_V], z[..., D_V:]
    v = layer_norm(v, ln_g, ln_b)
    L = min(T, CHUNK)
    Tp = -(-T // L) * L
    vp = jnp.pad(v, ((0, 0), (0, Tp - T), (0, 0))).reshape(B, Tp // L, L, N_GROUPS_A, CG)
    w = jnp.where(jnp.tril(jnp.ones((L, L), bool)), w_sp[:, :L, :L], 0.0)
    s = jnp.einsum('gts,bnsgc->bntgc', w, vp) + b_sp[:, :L].T[None, None, :, :, None]
    s = s.reshape(B, Tp, D_V)[:, :T]
    return (u * s) @ w_out, v


def compress(k, w1, w2, pe):
    B, T = k.shape[:2]
    r_n = CMP_LEN // CMP_STRIDE
    n_chunk = T // CMP_STRIDE
    nc = n_chunk - r_n + 1
    chunks = k[:, :n_chunk * CMP_STRIDE].reshape(B, n_chunk, CMP_STRIDE, N_KV, HEAD_DIM)
    w1r = w1.reshape(r_n, CMP_STRIDE, HEAD_DIM, CMP_HID)
    hid = jnp.einsum('ld,ldh->h', pe, w1.reshape(CMP_LEN, HEAD_DIM, CMP_HID))
    for r in range(r_n):
        hid = hid + jnp.einsum('bnsgd,sdh->bngh', chunks[:, r:r + nc], w1r[r])
    out = jax.nn.gelu(hid) @ w2
    cpos = jnp.arange(nc) * CMP_STRIDE + CMP_LEN - 1
    return out, cpos


def nsa_core(q, gates, qpos, kc, vc, cpos, ks, vs, kw, vw, wpos):
    f32 = jnp.float32
    B = q.shape[0]
    sl = alibi_slopes()[None, :, :, None, None]
    d_c = (qpos[:, None] - cpos[None, :]).astype(f32)
    s_c = jnp.einsum('btghd,bngd->bghtn', q, kc).astype(f32) - sl * d_c
    p_c = masked_softmax(s_c, d_c >= 0)
    o_c = jnp.einsum('bghtn,bngd->btghd', p_c.astype(vc.dtype), vc)
    nc = kc.shape[1]
    ns = ks.shape[1] // SEL_BLOCK
    c_start = jnp.arange(nc)[:, None] * CMP_STRIDE
    s_start = jnp.arange(ns)[None, :] * SEL_BLOCK
    cover = ((c_start < s_start + SEL_BLOCK) & (c_start + CMP_LEN > s_start)).astype(f32)
    imp = jnp.einsum('bghtn,nj->bgtj', p_c, cover)
    q_blk = (qpos // SEL_BLOCK)[:, None]
    blk = jnp.arange(ns)[None, :]
    forced = (blk == 0) | (blk == q_blk) | (blk == q_blk - 1)
    imp = jnp.where(blk <= q_blk, imp + jnp.where(forced, FORCE_BONUS, 0.0), NEG)
    top_s, top_i = lax.top_k(imp, min(N_SEL, ns))
    bi = jnp.arange(B)[:, None, None, None]
    gi = jnp.arange(N_KV)[None, :, None, None]
    ks_b = ks.reshape(B, ns, SEL_BLOCK, N_KV, HEAD_DIM).transpose(0, 3, 1, 2, 4)
    vs_b = vs.reshape(B, ns, SEL_BLOCK, N_KV, HEAD_DIM).transpose(0, 3, 1, 2, 4)
    k_sel = ks_b[bi, gi, top_i]
    v_sel = vs_b[bi, gi, top_i]
    kpos = top_i[..., None] * SEL_BLOCK + jnp.arange(SEL_BLOCK)
    d_s = (qpos[None, None, :, None, None] - kpos).astype(f32)[:, :, None]
    m_s = (top_s > NEG / 2)[:, :, None, :, :, None] & (d_s >= 0)
    s_s = jnp.einsum('btghd,bgtjsd->bghtjs', q, k_sel).astype(f32) - sl[..., None] * d_s
    sh = s_s.shape
    p_s = masked_softmax(s_s.reshape(sh[:4] + (-1,)), m_s.reshape(m_s.shape[:4] + (-1,))).reshape(sh)
    o_s = jnp.einsum('bghtjs,bgtjsd->btghd', p_s.astype(v_sel.dtype), v_sel)
    d_w = (qpos[:, None] - wpos[None, :]).astype(f32)
    m_w = (d_w >= 0) & (d_w <= WINDOW) & (wpos[None, :] >= 0)
    s_w = jnp.einsum('btghd,blgd->bghtl', q, kw).astype(f32) - sl * d_w
    p_w = masked_softmax(s_w, m_w)
    o_w = jnp.einsum('bghtl,blgd->btghd', p_w.astype(vw.dtype), vw)
    return gates[..., 0:1] * o_c + gates[..., 1:2] * o_s + gates[..., 2:3] * o_w


def prompt_ctx(kv, cmp_w1, cmp_w2, cmp_pe):
    T = kv.shape[1]
    kc, cpos = compress(kv[:, :, 0], cmp_w1[0], cmp_w2[0], cmp_pe[0])
    vc, _ = compress(kv[:, :, 1], cmp_w1[1], cmp_w2[1], cmp_pe[1])
    ks = pad_seq(kv[:, :, 2], SEL_BLOCK)
    vs = pad_seq(kv[:, :, 3], SEL_BLOCK)
    win = jnp.pad(kv[:, :, 4:6], ((0, 0), (WINDOW, 0), (0, 0), (0, 0), (0, 0)))
    ctx = (kc, vc, cpos, ks, vs, win)
    new_state = (kv[:, :, :N_CACHE_SLOTS], kv[:, T - min(WINDOW, T):, 4:6])
    return ctx, new_state


def prompt_attend(q, gates, ctx):
    kc, vc, cpos, ks, vs, win = ctx
    B, T = q.shape[:2]
    qb = min(Q_BLOCK, T)
    nb = T // qb
    qs = q.reshape(B, nb, qb, N_KV, HPG, HEAD_DIM).swapaxes(0, 1)
    gs = gates.reshape(B, nb, qb, N_KV, HPG, 3).swapaxes(0, 1)

    def block(args):
        i, q_i, g_i = args
        start = i * qb
        w_i = lax.dynamic_slice_in_dim(win, start, WINDOW + qb, axis=1)
        qpos = start + jnp.arange(qb)
        wpos = start - WINDOW + jnp.arange(WINDOW + qb)
        return nsa_core(q_i, g_i, qpos, kc, vc, cpos, ks, vs, w_i[:, :, 0], w_i[:, :, 1], wpos)

    out = lax.map(block, (jnp.arange(nb), qs, gs))
    return out.swapaxes(0, 1).reshape(B, T, N_KV, HPG, HEAD_DIM)


def make_sample_ctx(cache_kv, page_table, state_win_kv):
    def ctx_fn(kv, cmp_w1, cmp_w2, cmp_pe):
        B, S = kv.shape[:2]
        past_len = page_table.shape[1] * PAGE_SIZE
        past = cache_kv[page_table].reshape(B, past_len, N_CACHE_SLOTS, N_KV, HEAD_DIM)
        full = jnp.concatenate([past, kv[:, :, :N_CACHE_SLOTS]], axis=1)
        kc, cpos = compress(full[:, :, 0], cmp_w1[0], cmp_w2[0], cmp_pe[0])
        vc, _ = compress(full[:, :, 1], cmp_w1[1], cmp_w2[1], cmp_pe[1])
        ks = pad_seq(full[:, :, 2], SEL_BLOCK)
        vs = pad_seq(full[:, :, 3], SEL_BLOCK)
        buf = state_win_kv.shape[1]
        win = jnp.concatenate([state_win_kv, kv[:, :, 4:6]], axis=1)
        wpos = past_len - buf + jnp.arange(buf + S)
        qpos = past_len + jnp.arange(S)
        ctx = (kc, vc, cpos, ks, vs, win, wpos, qpos)
        new_state = (kv[:, :, :N_CACHE_SLOTS], win[:, S:])
        return ctx, new_state
    return ctx_fn


def sample_attend(q, gates, ctx):
    kc, vc, cpos, ks, vs, win, wpos, qpos = ctx
    return nsa_core(q, gates, qpos, kc, vc, cpos, ks, vs, win[:, :, 0], win[:, :, 1], wpos)


def trunk(x, c, ctx_fn, attend_fn, ada_w, ada_b, norm_g, ffn_w_gate, ffn_w_up, ffn_w_down,
          gmlp_w_uv, gmlp_ln_g, gmlp_ln_b, gmlp_w_sp, gmlp_b_sp, gmlp_w_out,
          nsa_w_qg, nsa_w_o, kv_norm_g, kv_ada_w, kv_ada_b, kv_w,
          cmp_w1, cmp_w2, cmp_pe, final_g, final_ada_w, final_ada_b):
    B, T, _ = x.shape
    sc = jax.nn.silu(c)
    v_rows = []
    ctx = None
    kv_state = None
    for l in range(DEPTH):
        if l == N_A_LAYERS:
            kv_mod = (sc @ kv_ada_w + kv_ada_b).reshape(B, 2, D_MODEL)
            h_kv = modulate(rms_norm(x, kv_norm_g), kv_mod[:, 0], kv_mod[:, 1])
            kv = (h_kv @ kv_w).reshape(B, T, N_KV_PROJ, N_KV, HEAD_DIM)
            ctx, kv_state = ctx_fn(kv, cmp_w1, cmp_w2, cmp_pe)
        mod = (sc @ ada_w[l] + ada_b[l]).reshape(B, 3, 3, D_MODEL)
        h = ada_norm(x, norm_g[l, 0], mod[:, 0])
        x = x + 0.5 * mod[:, 0, 2, None, :] * swiglu(h, ffn_w_gate[l, 0], ffn_w_up[l, 0], ffn_w_down[l, 0])
        h = ada_norm(x, norm_g[l, 1], mod[:, 1])
        if l < N_A_LAYERS:
            y, v = gmlp_mix(h, gmlp_w_uv[l], gmlp_ln_g[l], gmlp_ln_b[l], gmlp_w_sp[l], gmlp_b_sp[l], gmlp_w_out[l])
            v_rows.append(v)
        else:
            j = l - N_A_LAYERS
            qg = h @ nsa_w_qg[j]
            q = qg[..., :N_HEADS * HEAD_DIM].reshape(B, T, N_KV, HPG, HEAD_DIM) * HEAD_DIM ** -0.5
            gates = jax.nn.sigmoid(qg[..., N_HEADS * HEAD_DIM:].reshape(B, T, N_KV, HPG, 3))
            y = attend_fn(q, gates, ctx).reshape(B, T, N_HEADS * HEAD_DIM) @ nsa_w_o[j]
        x = x + mod[:, 1, 2, None, :] * y
        h = ada_norm(x, norm_g[l, 2], mod[:, 2])
        x = x + 0.5 * mod[:, 2, 2, None, :] * swiglu(h, ffn_w_gate[l, 1], ffn_w_up[l, 1], ffn_w_down[l, 1])
    fmod = (sc @ final_ada_w + final_ada_b).reshape(B, 2, D_MODEL)
    y = modulate(rms_norm(x, final_g), fmod[:, 0], fmod[:, 1])
    return y, v_rows, kv_state


def setup_inputs(seed: int = 0) -> dict:
    key = jax.random.key(seed)
    ks = jax.random.split(key, 32)

    def nrm(k, shape, scale):
        return jax.random.normal(k, shape, jnp.float32) * scale

    D = D_MODEL
    n_pages = PAST_LEN // PAGE_SIZE
    n_used = DEC_BATCH * n_pages
    n_pool = n_used + max(1, n_used // 4)
    win_buf = min(WINDOW, PAST_LEN)
    page_table = jax.random.permutation(ks[4], n_pool)[:n_used].reshape(DEC_BATCH, n_pages).astype(jnp.int32)
    return {
        'x_prompt': nrm(ks[0], (BATCH, SEQ, D), 1.0),
        'x_sample': nrm(ks[1], (DEC_BATCH, DEC_SEQ, D), 1.0),
        'cache_kv': nrm(ks[2], (n_pool, PAGE_SIZE, N_CACHE_SLOTS, N_KV, HEAD_DIM), 1.0),
        'state_win_kv': nrm(ks[3], (DEC_BATCH, win_buf, 2, N_KV, HEAD_DIM), 1.0),
        'page_table': page_table,
        'c_prompt': nrm(ks[5], (BATCH, D), 1.0),
        'c_sample': nrm(ks[6], (DEC_BATCH, D), 1.0),
        'ada_w': nrm(ks[7], (DEPTH, D, 9 * D), 0.5 * D ** -0.5),
        'ada_b': nrm(ks[8], (DEPTH, 9 * D), 0.01),
        'norm_g': 1.0 + nrm(ks[9], (DEPTH, 3, D), 0.05),
        'ffn_w_gate': nrm(ks[10], (DEPTH, 2, D, D_FF), D ** -0.5),
        'ffn_w_up': nrm(ks[11], (DEPTH, 2, D, D_FF), D ** -0.5),
        'ffn_w_down': nrm(ks[12], (DEPTH, 2, D_FF, D), D_FF ** -0.5),
        'gmlp_w_uv': nrm(ks[13], (N_A_LAYERS, D, 2 * D_V), D ** -0.5),
        'gmlp_ln_g': 1.0 + nrm(ks[14], (N_A_LAYERS, D_V), 0.05),
        'gmlp_ln_b': nrm(ks[15], (N_A_LAYERS, D_V), 0.02),
        'gmlp_w_sp': nrm(ks[16], (N_A_LAYERS, N_GROUPS_A, CHUNK, CHUNK), CHUNK ** -0.5),
        'gmlp_b_sp': 1.0 + nrm(ks[17], (N_A_LAYERS, N_GROUPS_A, CHUNK), 0.1),
        'gmlp_w_out': nrm(ks[18], (N_A_LAYERS, D_V, D), D_V ** -0.5),
        'nsa_w_qg': nrm(ks[19], (N_B_LAYERS, D, N_HEADS * HEAD_DIM + 3 * N_HEADS), D ** -0.5),
        'nsa_w_o': nrm(ks[20], (N_B_LAYERS, N_HEADS * HEAD_DIM, D), (N_HEADS * HEAD_DIM) ** -0.5),
        'kv_norm_g': 1.0 + nrm(ks[21], (D,), 0.05),
        'kv_ada_w': nrm(ks[22], (D, 2 * D), 0.5 * D ** -0.5),
        'kv_ada_b': nrm(ks[23], (2 * D,), 0.01),
        'kv_w': nrm(ks[24], (D, N_KV_PROJ * N_KV * HEAD_DIM), D ** -0.5),
        'cmp_w1': nrm(ks[25], (2, CMP_LEN * HEAD_DIM, CMP_HID), (CMP_LEN * HEAD_DIM) ** -0.5),
        'cmp_w2': nrm(ks[26], (2, CMP_HID, HEAD_DIM), CMP_HID ** -0.5),
        'cmp_pe': nrm(ks[27], (2, CMP_LEN, HEAD_DIM), 0.5),
        'final_g': 1.0 + nrm(ks[28], (D,), 0.05),
        'final_ada_w': nrm(ks[29], (D, 2 * D), 0.5 * D ** -0.5),
        'final_ada_b': nrm(ks[30], (2 * D,), 0.01),
    }


def reference(x_prompt, x_sample, cache_kv, state_win_kv, page_table, c_prompt, c_sample,
              ada_w, ada_b, norm_g, ffn_w_gate, ffn_w_up, ffn_w_down,
              gmlp_w_uv, gmlp_ln_g, gmlp_ln_b, gmlp_w_sp, gmlp_b_sp, gmlp_w_out,
              nsa_w_qg, nsa_w_o, kv_norm_g, kv_ada_w, kv_ada_b, kv_w,
              cmp_w1, cmp_w2, cmp_pe, final_g, final_ada_w, final_ada_b):
    weights = (ada_w, ada_b, norm_g, ffn_w_gate, ffn_w_up, ffn_w_down,
               gmlp_w_uv, gmlp_ln_g, gmlp_ln_b, gmlp_w_sp, gmlp_b_sp, gmlp_w_out,
               nsa_w_qg, nsa_w_o, kv_norm_g, kv_ada_w, kv_ada_b, kv_w,
               cmp_w1, cmp_w2, cmp_pe, final_g, final_ada_w, final_ada_b)
    y_prompt, _, p_state = trunk(x_prompt, c_prompt, prompt_ctx, prompt_attend, *weights)
    kv_prompt, win_prompt = p_state
    sample_ctx = make_sample_ctx(cache_kv, page_table, state_win_kv)
    y_sample, v_rows_s, s_state = trunk(x_sample, c_sample, sample_ctx, sample_attend, *weights)
    kv_sample, win_sample = s_state
    gmlp_v_sample = jnp.stack(v_rows_s)
    return (y_prompt, y_sample, kv_prompt, kv_sample, win_prompt, win_sample, gmlp_v_sample)
```

```cpp
#include <hip/hip_runtime.h>
#include <cstdio>
#include <cstdint>
#include <cmath>
namespace pg8 {
#define PG8_LAS __attribute__((address_space(3)))
typedef unsigned short bf16_t;
typedef short bf16x8 __attribute__((ext_vector_type(8)));
typedef float f32x4 __attribute__((ext_vector_type(4)));
typedef unsigned u32x4 __attribute__((ext_vector_type(4)));
constexpr int BM = 256, BK = 64, HALF = 128, HTB = HALF * BK * 2  , STAGE_BYTES = 8 * HTB, NXCD = 8, WGM = 8;

__host__ __device__ __forceinline__ int lds_byte(int r, int c) { const int st = (r >> 4) * 2 + (c >> 5), rr = r & 15, cc = c & 31, ob = rr * 64 + cc * 2; return st * 1024 + (ob ^ (((ob >> 9) & 1) << 5)); }
__host__ __device__ __forceinline__ void stage_rc(int b, int& R, int& C) { const int st = b / 1024, sb = b % 1024, swz = sb ^ (((sb >> 9) & 1) << 5); R = (st >> 1) * 16 + swz / 64; C = (st & 1) * 32 + (swz % 64) / 2; }
__host__ __device__ __forceinline__ int perm32(int rho) { const int n = rho >> 4, i = rho & 15; return 8 * (i >> 2) + 4 * n + (i & 3); }

struct Unit { int pm, pn; };
struct Gemm { const bf16_t* A; const bf16_t* Bt; int M, N, K; };

struct StaticOrder {
    int nM, nN, nwg, G, c;
    __host__ __device__ void init(int M, int N, int G_, int c_) { nM = M / BM; nN = N / BM; nwg = nM * nN; G = G_; c = c_; }
    __host__ __device__ bool next(int i, Unit& u) const {
        const long L = (long)i * G + c; if (L >= nwg) return false;
        int wgid = (int)L; { const int q = nwg / NXCD, r = nwg % NXCD, xcd = wgid % NXCD, off = wgid / NXCD; wgid = (xcd < r ? xcd * (q + 1) : r * (q + 1) + (xcd - r) * q) + off; }
        const int nig = WGM * nN, gid = wgid / nig, fm = gid * WGM, gsz = (nM - fm) < WGM ? (nM - fm) : WGM;
        u.pm = fm + ((wgid % nig) % gsz); u.pn = (wgid % nig) / gsz; return true;
    }
    __device__ __forceinline__ void a_ready(const Unit&) const {}
    __device__ __forceinline__ void done(const Unit&) const {}
};

__device__ __forceinline__ unsigned cvt_pk_bf16(float lo, float hi) { unsigned r; asm volatile("v_cvt_pk_bf16_f32 %0, %1, %2" : "=v"(r) : "v"(lo), "v"(hi)); return r; }
typedef float f32x2 __attribute__((ext_vector_type(2)));
template <class Epi, class Sched, bool ALIGN_EPI = false, bool SP2 = false>
__device__ __forceinline__ void gemm_phase(PG8_LAS unsigned char* lds, const Gemm g, const Sched& S, const Epi& E) {
    int tid_raw = threadIdx.x; asm volatile("" : "+v"(tid_raw));
    const int tid = tid_raw, wid = __builtin_amdgcn_readfirstlane(tid >> 6), lane = tid & 63, wr = wid >> 2, wc = wid & 3, fr = lane & 15, fq = lane >> 4;
    const int K = g.K, nt = K / BK;
    unsigned voffA[2], voffB[2];
#pragma unroll
    for (int i = 0; i < 2; ++i) { int R, C; stage_rc(tid * 16 + i * 8192, R, C); const int Rb = Epi::PERM ? ((R & ~31) + perm32(R & 31)) : R;
        voffA[i] = (unsigned)(R * K + C) * 2u; voffB[i] = (unsigned)(Rb * K + C) * 2u; }
    const size_t kstep = (size_t)(BK * 2);
    const size_t hstep = (size_t)HALF * K * 2;
    const size_t tstep = 2 * hstep;
    const unsigned ldsw = (unsigned)wid * 1024u;
    const int aoff = lds_byte(wr * 64 + fr, fq * 8), boff = lds_byte(wc * 32 + fr, fq * 8);
#define PG8_SA(b, h) (((b) * 2 + (h)) * HTB)
#define PG8_SB(b, h) ((4 + (b) * 2 + (h)) * HTB)
#define PG8_STAGE(bufoff, gbase, voff) do { _Pragma("unroll") for (int _i = 0; _i < 2; ++_i) \
        __builtin_amdgcn_global_load_lds((const unsigned*)((const char*)(gbase) + (voff)[_i]), (PG8_LAS unsigned*)(lds + (bufoff) + ldsw + _i * 8192), 16, 0, 0); } while (0)
#define PG8_LDA(dst, b, h) do { _Pragma("unroll") for (int m = 0; m < 4; ++m) _Pragma("unroll") for (int k = 0; k < 2; ++k) dst[m][k] = *(const PG8_LAS bf16x8*)(lds + PG8_SA(b, h) + aoff + m * 2048 + k * 1024); } while (0)
#define PG8_LDB(dst, b, h) do { _Pragma("unroll") for (int n = 0; n < 2; ++n) _Pragma("unroll") for (int k = 0; k < 2; ++k) dst[n][k] = *(const PG8_LAS bf16x8*)(lds + PG8_SB(b, h) + boff + n * 2048 + k * 1024); } while (0)
#define PG8_MMA(ai, bj, At, Bt) do { __builtin_amdgcn_s_setprio(1); _Pragma("unroll") for (int m = 0; m < 4; ++m) _Pragma("unroll") for (int n = 0; n < 2; ++n) _Pragma("unroll") for (int k = 0; k < 2; ++k) \
        acc[ai][bj][m][n] = __builtin_amdgcn_mfma_f32_16x16x32_bf16(Bt[n][k], At[m][k], acc[ai][bj][m][n], 0, 0, 0); __builtin_amdgcn_s_setprio(0); } while (0)
#define PG8_WAIT_V(n) asm volatile("s_waitcnt vmcnt(" #n ")" ::: "memory")
#define PG8_WAIT_L(n) asm volatile("s_waitcnt lgkmcnt(" #n ")" ::: "memory")
#define PG8_BAR __builtin_amdgcn_s_barrier()
#define PG8_SCHED __builtin_amdgcn_sched_barrier(0)
    Unit cur, nxt; int ui = 0;
    if (!S.next(0, cur)) return;
    f32x4 acc[2][2][4][2];
#pragma unroll
    for (int a = 0; a < 2; ++a)
#pragma unroll
        for (int b = 0; b < 2; ++b)
#pragma unroll
            for (int m = 0; m < 4; ++m)
#pragma unroll
                for (int n = 0; n < 2; ++n) acc[a][b][m][n] = (f32x4){0.f, 0.f, 0.f, 0.f};
    bf16x8 At[4][2], B0[2][2], B1[2][2];
    const char* cA = (const char*)g.A + (size_t)cur.pm * tstep; const char* cB = (const char*)g.Bt + (size_t)cur.pn * tstep;
    S.a_ready(cur);
    if constexpr (SP2) {
        PG8_STAGE(PG8_SB(0, 0), cB, voffB); PG8_STAGE(PG8_SB(0, 1), cB + hstep, voffB); PG8_STAGE(PG8_SA(0, 0), cA, voffA); PG8_STAGE(PG8_SA(0, 1), cA + hstep, voffA);
        if (wr == 1) PG8_BAR;
        PG8_WAIT_V(2); PG8_BAR;
        PG8_STAGE(PG8_SB(1, 0), cB + kstep, voffB); PG8_STAGE(PG8_SA(1, 0), cA + kstep, voffA); PG8_STAGE(PG8_SB(1, 1), cB + hstep + kstep, voffB);
        PG8_WAIT_V(6); PG8_BAR;
    } else {
        PG8_STAGE(PG8_SB(0, 0), cB, voffB); PG8_STAGE(PG8_SA(0, 0), cA, voffA); PG8_STAGE(PG8_SB(0, 1), cB + hstep, voffB); PG8_STAGE(PG8_SA(0, 1), cA + hstep, voffA);
        if (wr == 1) PG8_BAR;
        PG8_WAIT_V(4); PG8_BAR;
        PG8_STAGE(PG8_SB(1, 0), cB + kstep, voffB); PG8_STAGE(PG8_SA(1, 0), cA + kstep, voffA); PG8_STAGE(PG8_SB(1, 1), cB + hstep + kstep, voffB);
        PG8_WAIT_V(6); PG8_BAR;
    }
    for (;;) {
        const bool has_next = S.next(ui + 1, nxt);
        const char* nA = has_next ? (const char*)g.A + (size_t)nxt.pm * tstep : cA; const char* nB = has_next ? (const char*)g.Bt + (size_t)nxt.pn * tstep : cB;
        for (int t = 0; t < nt; t += 2) {
            const bool last = (t == nt - 2);
            const char* a1 = cA + (size_t)(t + 1) * kstep;
            const char* a2 = last ? nA : cA + (size_t)(t + 2) * kstep; const char* b2 = last ? nB : cB + (size_t)(t + 2) * kstep;
            const char* a3 = a2 + kstep; const char* b3 = b2 + kstep;
            if (last && has_next) S.a_ready(nxt);
            if constexpr (SP2) {
            PG8_LDB(B0, 0, 0); PG8_LDB(B1, 0, 1); PG8_SCHED; PG8_LDA(At, 0, 0); PG8_STAGE(PG8_SA(1, 1), a1 + hstep, voffA);
            PG8_WAIT_V(8); PG8_WAIT_L(0); PG8_BAR; PG8_MMA(0, 0, At, B0); PG8_MMA(0, 1, At, B1); PG8_BAR; PG8_SCHED;
            PG8_LDA(At, 0, 1); PG8_STAGE(PG8_SB(0, 0), b2, voffB); PG8_STAGE(PG8_SB(0, 1), b2 + hstep, voffB); PG8_STAGE(PG8_SA(0, 0), a2, voffA);
            PG8_WAIT_V(8); PG8_WAIT_L(0); PG8_BAR; PG8_MMA(1, 0, At, B0); PG8_MMA(1, 1, At, B1); PG8_BAR; PG8_SCHED;
            PG8_LDB(B0, 1, 0); PG8_LDB(B1, 1, 1); PG8_SCHED; PG8_LDA(At, 1, 0); PG8_STAGE(PG8_SA(0, 1), a2 + hstep, voffA);
            PG8_WAIT_V(8); PG8_WAIT_L(0); PG8_BAR; PG8_MMA(0, 0, At, B0); PG8_MMA(0, 1, At, B1); PG8_BAR; PG8_SCHED;
            PG8_LDA(At, 1, 1); PG8_STAGE(PG8_SB(1, 0), b3, voffB); PG8_STAGE(PG8_SB(1, 1), b3 + hstep, voffB); PG8_STAGE(PG8_SA(1, 0), a3, voffA);
            PG8_WAIT_V(8); PG8_WAIT_L(0); PG8_BAR; PG8_MMA(1, 0, At, B0); PG8_MMA(1, 1, At, B1); PG8_BAR; PG8_SCHED;
            } else {
            PG8_LDB(B0, 0, 0); PG8_SCHED; PG8_LDA(At, 0, 0); PG8_STAGE(PG8_SA(1, 1), a1 + hstep, voffA);
            PG8_WAIT_L(8); PG8_BAR; PG8_WAIT_L(0); PG8_MMA(0, 0, At, B0); PG8_BAR; PG8_SCHED;
            PG8_LDB(B1, 0, 1); PG8_STAGE(PG8_SB(0, 0), b2, voffB);
            PG8_BAR; PG8_WAIT_L(0); PG8_MMA(0, 1, At, B1); PG8_BAR;
            PG8_LDA(At, 0, 1); PG8_STAGE(PG8_SA(0, 0), a2, voffA);
            PG8_BAR; PG8_WAIT_L(0); PG8_MMA(1, 0, At, B0); PG8_BAR; PG8_SCHED;
            PG8_STAGE(PG8_SB(0, 1), b2 + hstep, voffB);
            PG8_WAIT_V(6); PG8_BAR; PG8_MMA(1, 1, At, B1); PG8_BAR;
            PG8_LDB(B0, 1, 0); PG8_SCHED; PG8_LDA(At, 1, 0); PG8_STAGE(PG8_SA(0, 1), a2 + hstep, voffA);
            PG8_WAIT_L(8); PG8_BAR; PG8_WAIT_L(0); PG8_MMA(0, 0, At, B0); PG8_BAR; PG8_SCHED;
            PG8_LDB(B1, 1, 1); PG8_STAGE(PG8_SB(1, 0), b3, voffB);
            PG8_BAR; PG8_WAIT_L(0); PG8_MMA(0, 1, At, B1); PG8_BAR;
            PG8_LDA(At, 1, 1); PG8_STAGE(PG8_SA(1, 0), a3, voffA);
            PG8_BAR; PG8_WAIT_L(0); PG8_MMA(1, 0, At, B0); PG8_BAR; PG8_SCHED;
            PG8_STAGE(PG8_SB(1, 1), b3 + hstep, voffB);
            PG8_WAIT_V(6); PG8_BAR; PG8_MMA(1, 1, At, B1); PG8_BAR;
            }
        }
        if constexpr (ALIGN_EPI) { if (wr == 0) PG8_BAR; }
        if constexpr (!Epi::AFTER_DRAIN) { E(acc, cur, wr, wc, fr, fq); S.done(cur); }
        if (!has_next) break;
#pragma unroll
        for (int a = 0; a < 2; ++a)
#pragma unroll
            for (int b = 0; b < 2; ++b)
#pragma unroll
                for (int m = 0; m < 4; ++m)
#pragma unroll
                    for (int n = 0; n < 2; ++n) acc[a][b][m][n] = (f32x4){0.f, 0.f, 0.f, 0.f};
        cur = nxt; cA = nA; cB = nB; ++ui;
        if constexpr (ALIGN_EPI) { if (wr == 1) PG8_BAR; }
    }
    PG8_WAIT_V(0);
    if constexpr (!ALIGN_EPI) { if (wr == 0) PG8_BAR; }
    PG8_BAR;
    if constexpr (Epi::AFTER_DRAIN) { E.fused(acc, cur, wr, wc, fr, fq, lds, wid, lane); S.done(cur); }
#undef PG8_SA
#undef PG8_SB
#undef PG8_STAGE
#undef PG8_LDA
#undef PG8_LDB
#undef PG8_MMA
#undef PG8_WAIT_V
#undef PG8_WAIT_L
#undef PG8_BAR
#undef PG8_SCHED
}
}
#define LAS __attribute__((address_space(3)))
#define XB_TMO      128
#define XB_XCNT(j)  (256  + 64 * (j))
#define XB_XSUB(j)  (1280 + 64 * (j))
#define XB_XGEN(j)  (2304 + 64 * (j))
#define XB_TOP      3328
#define XB_TOPGEN   3392
#define XCD_BAR_WORDS 3456
#define XB_SPIN_CAP (1u << 18)

__device__ __forceinline__ unsigned xb_ld(unsigned* p)              { return __hip_atomic_load(p, __ATOMIC_RELAXED, __HIP_MEMORY_SCOPE_AGENT); }
__device__ __forceinline__ unsigned xb_add(unsigned* p, unsigned v) { return __hip_atomic_fetch_add(p, v, __ATOMIC_RELAXED, __HIP_MEMORY_SCOPE_AGENT); }
__device__ __forceinline__ unsigned xb_xcc_id() { return (unsigned)__builtin_amdgcn_s_getreg((3 << 11) | 20) & 0xFu; }
#define XB_SPIN(cond, bar) do { unsigned _sp = 0; while (cond) { __builtin_amdgcn_s_sleep(1); \
    if ((++_sp & 255u) == 0u) { if (xb_ld(&(bar)[XB_TMO])) break; if (_sp > XB_SPIN_CAP) { atomicAdd(&(bar)[XB_TMO], 1u); break; } } } } while (0)

struct XcdBarrier {
    unsigned* bar; unsigned x;
    volatile LAS unsigned* st;
};

__device__ __forceinline__ XcdBarrier xcd_barrier_post(unsigned* bar, volatile LAS unsigned* st) {
    XcdBarrier b; b.bar = bar; b.x = xb_xcc_id(); b.st = st;
    if (threadIdx.x == 0) (void)xb_add(&bar[XB_XCNT(b.x)], 1u);
    return b;
}
__device__ __forceinline__ void xcd_barrier_complete(unsigned* bar, unsigned x, unsigned& nloc, unsigned& nx) {
    const unsigned G = gridDim.x * gridDim.y * gridDim.z;
    unsigned sum, cnt, mine, sp = 0u;
    for (;;) {
        sum = 0u; cnt = 0u; mine = 0u;
#pragma unroll
        for (unsigned j = 0; j < 16; ++j) { const unsigned c = xb_ld(&bar[XB_XCNT(j)]); sum += c; cnt += (c > 0u) ? 1u : 0u; mine = (j == x) ? c : mine; }
        if (sum == G) break;
        __builtin_amdgcn_s_sleep(1);
        if ((++sp & 255u) == 0u) { if (xb_ld(&bar[XB_TMO])) break; if (sp > XB_SPIN_CAP) { atomicAdd(&bar[XB_TMO], 1u); break; } }
    }
    nloc = mine > 0u ? mine : 1u; nx = cnt > 0u ? cnt : 1u;
}

__device__ __forceinline__ void xcd_barrier(const XcdBarrier& b) {
    asm volatile("s_waitcnt vmcnt(0)" ::: "memory");
    __syncthreads();
    if (threadIdx.x == 0) {
        unsigned* bar = b.bar;
        __builtin_amdgcn_s_waitcnt(0);
        unsigned nloc = b.st[0], nx = b.st[1];
        if (nloc == 0u) { xcd_barrier_complete(bar, b.x, nloc, nx); b.st[0] = nloc; b.st[1] = nx; }
        const unsigned old = xb_add(&bar[XB_XSUB(b.x)], 1u);
        const unsigned gen = old / nloc;
        if (old + 1u == (gen + 1u) * nloc) {
            __builtin_amdgcn_fence(__ATOMIC_RELEASE, "agent");
            asm volatile("s_waitcnt vmcnt(0)" ::: "memory");
            const unsigned og = xb_add(&bar[XB_TOP], 1u);
            const unsigned tg = og / nx;
            if (og + 1u == (tg + 1u) * nx) xb_add(&bar[XB_TOPGEN], 1u);
            else XB_SPIN(xb_ld(&bar[XB_TOPGEN]) == tg, bar);
            __builtin_amdgcn_fence(__ATOMIC_ACQUIRE, "agent");
            xb_add(&bar[XB_XGEN(b.x)], 1u);
            asm volatile("s_waitcnt vmcnt(0)" ::: "memory");
        } else {
            XB_SPIN(xb_ld(&bar[XB_XGEN(b.x)]) == gen, bar);
            __builtin_amdgcn_fence(__ATOMIC_ACQUIRE, "agent");
            asm volatile("s_waitcnt vmcnt(0)" ::: "memory");
        }
    }
    __syncthreads();
}

constexpr int DM = 1024, SEQ = 8192, MP = 16384, MS = 128, MR = MP + MS, RT = 16640;
constexpr int DFF = 2816, DV = 3072, NGA = 8, CGW = 384, NQG = 1280, NKVP = 1536;
constexpr int NMOD = 40960;
constexpr int MODKV = 36864, MODFIN = 38912;
constexpr int NPAGES = 16, PAST = 2048;
constexpr float LOG2E = 1.4426950408889634f;
#ifndef ONE_LAUNCH
#define ONE_LAUNCH 1
#endif

constexpr size_t OY_P = 0, OY_S = 16777216, OKV_P = 16908288, OKV_S = 33685504, OWIN_P = 33816576, OWIN_S = 34340864, OGV = 67895296, OUT_TOTAL = 68681728;

constexpr size_t al(size_t x) { return (x + 0xFFFFFull) & ~0xFFFFFull; }
constexpr size_t WS_CTL = 0, CTL_ZERO_BYTES = 2u << 20;
constexpr size_t WS_WMOD = al(CTL_ZERO_BYTES);
constexpr size_t WS_WGU = al(WS_WMOD + (size_t)NMOD * DM * 2);
constexpr size_t WS_WDN = al(WS_WGU + (size_t)8 * 5632 * DM * 2);
constexpr size_t WS_WUV = al(WS_WDN + (size_t)8 * DM * DFF * 2);
constexpr size_t WS_WOUT = al(WS_WUV + (size_t)2 * 6144 * DM * 2);
constexpr size_t WS_WQG = al(WS_WOUT + (size_t)2 * DM * DV * 2);
constexpr size_t WS_WO = al(WS_WQG + (size_t)2 * NQG * DM * 2);
constexpr size_t WS_WKV = al(WS_WO + (size_t)2 * DM * DM * 2);
constexpr size_t WS_WC1 = al(WS_WKV + (size_t)NKVP * DM * 2);
constexpr size_t WS_WC2 = al(WS_WC1 + (size_t)2 * 512 * 1024 * 2);
constexpr size_t WS_WSP = al(WS_WC2 + (size_t)2 * 64 * 256 * 2);
constexpr size_t WS_CBIAS = al(WS_WSP + (size_t)2 * 8 * 128 * 128 * 2);
constexpr size_t WS_X = al(WS_CBIAS + 4096);
constexpr size_t WS_H = al(WS_X + (size_t)RT * DM * 2);
constexpr size_t WS_HID = al(WS_H + (size_t)RT * DM * 2);
constexpr size_t WS_Z = al(WS_HID + (size_t)RT * DFF * 2);
constexpr size_t WS_VT = al(WS_Z + (size_t)RT * 6144 * 2);
constexpr size_t WS_P = al(WS_VT + (size_t)128 * DV * 128 * 2);
constexpr size_t WS_Q = al(WS_P + (size_t)RT * DV * 2);
constexpr size_t WS_GATES = al(WS_Q + (size_t)RT * DM * 2);
constexpr size_t WS_O = al(WS_GATES + (size_t)RT * 48 * 4);
constexpr size_t KVB = (size_t)8 * SEQ * 64 * 2;
constexpr size_t WS_KCIN = al(WS_O + (size_t)RT * DM * 2);
constexpr size_t WS_VCIN = WS_KCIN + KVB, WS_SK = WS_VCIN + KVB, WS_SVT = WS_SK + KVB, WS_WK = WS_SVT + KVB, WS_WVT = WS_WK + KVB;
constexpr size_t WS_MOD = al(WS_WVT + KVB);
constexpr size_t WS_SC = al(WS_MOD + (size_t)256 * NMOD * 4);
constexpr size_t WS_TK = al(WS_SC + (size_t)256 * DM * 2);
constexpr size_t WS_TV = al(WS_TK + (size_t)4096 * 512 * 2);
constexpr size_t WS_KC = al(WS_TV + (size_t)4096 * 512 * 2);
constexpr size_t WS_VCT = al(WS_KC + (size_t)8 * 512 * 64 * 2);
constexpr size_t WS_ACMP = al(WS_VCT + (size_t)8 * 64 * 512 * 2);
constexpr size_t WS_TS = al(WS_ACMP + (size_t)2 * 65536 * 1024 * 2);
constexpr size_t WS_KCS = al(WS_TS + (size_t)2 * 65536 * 512 * 2);
constexpr size_t WS_VCS = al(WS_KCS + (size_t)512 * 128 * 64 * 4);
constexpr size_t WS_OACC = al(WS_VCS + (size_t)512 * 128 * 64 * 4);
constexpr size_t WS_HKV = al(WS_OACC + (size_t)MP * DM * 4);
constexpr size_t WS_SHB = al(WS_HKV + (size_t)RT * DM * 2);
constexpr size_t WS_B2 = al(WS_SHB + (size_t)13 * 256 * 1024 * 2);
constexpr size_t WS_NG = al(WS_B2 + (size_t)13 * 256 * 6144 * 4);
constexpr size_t WS_SSP = al(WS_NG + (size_t)13 * 1024 * 4);
constexpr size_t WS_SSPS = al(WS_SSP + (size_t)11 * MP * 16 * 4);
constexpr size_t WS_END = al(WS_SSPS + (size_t)11 * MS * 32 * 4);

constexpr int CW_BAR = 4096, CW_QUEUE = 8192, CW_SS = 32768, CW_VS = CW_SS + 11 * 16640;
static_assert((size_t)(CW_VS + 2 * 16640 * 2) * 4 <= CTL_ZERO_BYTES, "SS / VS accumulators inside the memset region");

constexpr int RING_BYTES = 131072, LDSCTL_OFF = RING_BYTES, MISC_OFF = LDSCTL_OFF + 320, LDS_BYTES = 147456;
constexpr int NWAVES = 8;

#define GAS __attribute__((address_space(1)))
typedef unsigned short bf16;
typedef unsigned v4u __attribute__((ext_vector_type(4)));
typedef unsigned v2u __attribute__((ext_vector_type(2)));
typedef float f32x4 __attribute__((ext_vector_type(4)));
typedef short bf16x8 __attribute__((ext_vector_type(8)));
typedef short bf16x4 __attribute__((ext_vector_type(4)));
typedef float f32x2 __attribute__((ext_vector_type(2)));
typedef _Float16 f16x4 __attribute__((ext_vector_type(4)));
typedef _Float16 f16x8 __attribute__((ext_vector_type(8)));
typedef _Float16 f16;

__device__ __forceinline__ float bf2f(unsigned b) { return __uint_as_float(b << 16); }
__device__ __forceinline__ float bflo(unsigned w) { return __uint_as_float(w << 16); }
__device__ __forceinline__ float bfhi(unsigned w) { return __uint_as_float(w & 0xffff0000u); }
__device__ __forceinline__ unsigned pk2(float lo, float hi) { return pg8::cvt_pk_bf16(lo, hi); }
__device__ __forceinline__ float frcp(float x) { return __builtin_amdgcn_rcpf(x); }
__device__ __forceinline__ float fexp2(float x) { return __builtin_amdgcn_exp2f(x); }
__device__ __forceinline__ float sigmoid_f(float x) { return frcp(1.f + fexp2(-LOG2E * x)); }
__device__ __forceinline__ float silu_f(float x) { return x * sigmoid_f(x); }
__device__ __forceinline__ float gelu_tanh_f(float x) { const float u = x + 0.044715f * x * x * x; return x * frcp(1.f + fexp2(-2.302208198f * u)); }
__device__ __forceinline__ int row_b(int r) { return r < SEQ ? 0 : (r < MP ? 1 : 2 + ((r - MP) < MS ? (r - MP) : (MS - 1))); }
__device__ __forceinline__ float wave_sum(float v) {
#pragma unroll
    for (int o = 1; o < 64; o <<= 1) v += __shfl_xor(v, o);
    return v;
}
__device__ __forceinline__ v4u pack8(const f32x4 a, const f32x4 b) { v4u w; w.x = pk2(a[0], a[1]); w.y = pk2(a[2], a[3]); w.z = pk2(b[0], b[1]); w.w = pk2(b[2], b[3]); return w; }
__device__ __forceinline__ void unpack8(const v4u w, float (&f)[8]) { f[0] = bflo(w.x); f[1] = bfhi(w.x); f[2] = bflo(w.y); f[3] = bfhi(w.y); f[4] = bflo(w.z); f[5] = bfhi(w.z); f[6] = bflo(w.w); f[7] = bfhi(w.w); }

template <class F> struct Epi8 {
    static constexpr bool PERM = true, AFTER_DRAIN = false; F f;
    __device__ __forceinline__ void operator()(const pg8::f32x4 (&acc)[2][2][4][2], const pg8::Unit& u, int wr, int wc, int fr, int fq) const {
        const int row0 = u.pm * pg8::BM + wr * 64 + fr, col0 = u.pn * pg8::BM + wc * 32 + 8 * fq;
        typename F::Pre pre; f.prep(pre, row0, col0, false);
#pragma unroll
        for (int ai = 0; ai < 2; ++ai)
#pragma unroll
            for (int mh = 0; mh < 2; ++mh) {
                typename F::Ld ld[2][2];
#pragma unroll
                for (int m2 = 0; m2 < 2; ++m2)
#pragma unroll
                    for (int bj = 0; bj < 2; ++bj) f.fetch(ld[m2][bj], row0 + ai * pg8::HALF + (2 * mh + m2) * 16, col0 + bj * pg8::HALF);
#pragma unroll
                for (int m2 = 0; m2 < 2; ++m2) { const int m = 2 * mh + m2, row = row0 + ai * pg8::HALF + m * 16;
                    f32x2 part = (f32x2){0.f, 0.f};
#pragma unroll
                    for (int bj = 0; bj < 2; ++bj) part = part + f(pre, ld[m2][bj], ai * 4 + m, bj, row, col0 + bj * pg8::HALF, acc[ai][bj][m][0], acc[ai][bj][m][1]);
                    f.row_done(row, part, fq); }
            }
    }
};
struct NoLd {};
struct NoPre {};
struct NormPre { float rs[8]; f32x4 b[2][2]; };
struct NormIn { unsigned char* ws; int ssi, inst, on;
    __device__ __forceinline__ void prep(NormPre& p, int row0, int col0, bool skinny) const {
        if (!on) return;
        const float* SS = (const float*)(ws + WS_CTL) + CW_SS + (size_t)ssi * RT; const float* b = (const float*)(ws + WS_B2) + ((size_t)inst * 256 + row_b(row0)) * 6144 + col0;
        if (skinny) { p.rs[0] = SS[row0]; p.b[0][0] = *(const f32x4*)b; p.b[0][1] = *(const f32x4*)(b + 4); p.rs[0] = __builtin_amdgcn_rsqf(p.rs[0] * (1.0f / DM) + 1e-6f); }
        else {
#pragma unroll
            for (int i = 0; i < 8; ++i) p.rs[i] = SS[row0 + (i >> 2) * 128 + (i & 3) * 16];
#pragma unroll
            for (int bj = 0; bj < 2; ++bj) { p.b[bj][0] = *(const f32x4*)(b + 128 * bj); p.b[bj][1] = *(const f32x4*)(b + 128 * bj + 4); }
#pragma unroll
            for (int i = 0; i < 8; ++i) p.rs[i] = __builtin_amdgcn_rsqf(p.rs[i] * (1.0f / DM) + 1e-6f);
        }
    }
    __device__ __forceinline__ void apply(const NormPre& p, int ri, int bj, f32x4& v0, f32x4& v1) const { if (on) { v0 = v0 * p.rs[ri] + p.b[bj][0]; v1 = v1 * p.rs[ri] + p.b[bj][1]; } }
};
struct FSwiglu {
    typedef NormPre Pre; typedef NoLd Ld; __device__ __forceinline__ void fetch(Ld&, int, int) const {} bf16* HID; NormIn ni;
    __device__ __forceinline__ void prep(Pre& p, int row0, int col0, bool sk) const { ni.prep(p, row0, col0, sk); }
    __device__ __forceinline__ f32x2 operator()(const Pre& p, const Ld&, int ri, int bj, int row, int col0, f32x4 g, f32x4 u) const {
        ni.apply(p, ri, bj, g, u);
        v2u w; w.x = pk2(silu_f(g[0]) * u[0], silu_f(g[1]) * u[1]); w.y = pk2(silu_f(g[2]) * u[2], silu_f(g[3]) * u[3]);
        *(v2u*)(HID + (size_t)row * DFF + (col0 >> 1)) = w; return (f32x2){0.f, 0.f};
    }
    __device__ __forceinline__ void row_done(int, f32x2, int) const {}
};
struct ResidPre { f32x4 gate[2][2], hm[2][2]; };
struct FResid {
    typedef ResidPre Pre; struct Ld { f32x4 x0, x1; };
    unsigned char* ws; int gcol; float coef; int n1, sc1, n2, sc2, ssi;
    __device__ __forceinline__ void fetch(Ld& d, int row, int col0) const { const f16x8 h = *(const f16x8*)((const f16*)(ws + WS_X) + (size_t)row * DM + col0); const f16x4 lo = __builtin_shufflevector(h, h, 0, 1, 2, 3), hi = __builtin_shufflevector(h, h, 4, 5, 6, 7);
        d.x0 = __builtin_convertvector(lo, f32x4); d.x1 = __builtin_convertvector(hi, f32x4); }
    __device__ __forceinline__ void prep(Pre& p, int row0, int col0, bool skinny) const {
        const float* mrow = (const float*)(ws + WS_MOD) + (size_t)row_b(row0) * NMOD + col0;
#pragma unroll
        for (int bj = 0; bj < 2; ++bj) { if (skinny && bj) break;
            p.gate[bj][0] = *(const f32x4*)(mrow + gcol + 128 * bj) * coef; p.gate[bj][1] = *(const f32x4*)(mrow + gcol + 128 * bj + 4) * coef;
            if (n1 >= 0) { const float* g1 = (const float*)(ws + WS_NG) + n1 * DM + col0 + 128 * bj;
                p.hm[bj][0] = *(const f32x4*)g1 * (*(const f32x4*)(mrow + sc1 + 128 * bj) + 1.0f); p.hm[bj][1] = *(const f32x4*)(g1 + 4) * (*(const f32x4*)(mrow + sc1 + 128 * bj + 4) + 1.0f); } }
    }
    __device__ __forceinline__ f32x2 operator()(const Pre& p, const Ld& d, int ri, int bj, int row, int col0, f32x4 v0, f32x4 v1) const {
        const f32x4 x0 = d.x0 + p.gate[bj][0] * v0, x1 = d.x1 + p.gate[bj][1] * v1;
        { const f16x4 lo = __builtin_convertvector(x0, f16x4), hi = __builtin_convertvector(x1, f16x4); *(f16x8*)((f16*)(ws + WS_X) + (size_t)row * DM + col0) = __builtin_shufflevector(lo, hi, 0, 1, 2, 3, 4, 5, 6, 7); }
        if (n1 >= 0) *(v4u*)((bf16*)(ws + WS_H) + (size_t)row * DM + col0) = pack8(x0 * p.hm[bj][0], x1 * p.hm[bj][1]);
        if (n2 >= 0) { const float* mrow = (const float*)(ws + WS_MOD) + (size_t)row_b(row) * NMOD + col0; const float* g2 = (const float*)(ws + WS_NG) + n2 * DM + col0;
            const f32x4 a0 = *(const f32x4*)g2, a1 = *(const f32x4*)(g2 + 4), s0 = *(const f32x4*)(mrow + sc2), s1 = *(const f32x4*)(mrow + sc2 + 4);
            *(v4u*)((bf16*)(ws + WS_HKV) + (size_t)row * DM + col0) = pack8(x0 * a0 * (s0 + 1.0f), x1 * a1 * (s1 + 1.0f)); }
        return (f32x2){((x0[0] * x0[0] + x0[1] * x0[1]) + (x0[2] * x0[2] + x0[3] * x0[3])) + ((x1[0] * x1[0] + x1[1] * x1[1]) + (x1[2] * x1[2] + x1[3] * x1[3])), 0.f};
    }
    __device__ __forceinline__ void row_done(int row, f32x2 part2, int fq) const {
        float part = part2[0];
        if (ssi >= 0) { part += __shfl_xor(part, 16); part += __shfl_xor(part, 32); if (fq == 0) atomicAdd((float*)(ws + WS_CTL) + CW_SS + (size_t)ssi * RT + row, part); }
    }
};
struct FGelu {
    typedef NormPre Pre; typedef NoLd Ld; __device__ __forceinline__ void fetch(Ld&, int, int) const {} bf16* Z; NormIn ni; float* VS;
    __device__ __forceinline__ void prep(Pre& p, int row0, int col0, bool sk) const { ni.prep(p, row0, col0, sk); }
    __device__ __forceinline__ f32x2 operator()(const Pre& p, const Ld&, int ri, int bj, int row, int col0, f32x4 v0, f32x4 v1) const {
        ni.apply(p, ri, bj, v0, v1);
        f32x4 a, b;
#pragma unroll
        for (int i = 0; i < 4; ++i) { a[i] = gelu_tanh_f(v0[i]); b[i] = gelu_tanh_f(v1[i]); }
        *(v4u*)(Z + (size_t)row * 6144 + col0) = pack8(a, b);
        if (col0 < DV) return (f32x2){0.f, 0.f};
        const f32x4 s = a + b, q = a * a + b * b; return (f32x2){(s[0] + s[1]) + (s[2] + s[3]), (q[0] + q[1]) + (q[2] + q[3])};
    }
    __device__ __forceinline__ void row_done(int row, f32x2 part, int fq) const {
        float s = part[0], q = part[1];
        s += __shfl_xor(s, 16); s += __shfl_xor(s, 32); q += __shfl_xor(q, 16); q += __shfl_xor(q, 32);
        if (fq == 0 && q != 0.f) { atomicAdd(VS + 2 * (size_t)row, s); atomicAdd(VS + 2 * (size_t)row + 1, q); }
    }
};
struct FQg {
    typedef NormPre Pre; typedef NoLd Ld; __device__ __forceinline__ void fetch(Ld&, int, int) const {} bf16* Q; float* GATES; NormIn ni;
    __device__ __forceinline__ void prep(Pre& p, int row0, int col0, bool sk) const { ni.prep(p, row0, col0, sk); }
    __device__ __forceinline__ f32x2 operator()(const Pre& p, const Ld&, int ri, int bj, int row, int col0, f32x4 v0, f32x4 v1) const {
        ni.apply(p, ri, bj, v0, v1);
        if (col0 < DM) { *(v4u*)(Q + (size_t)row * DM + col0) = pack8(v0 * (0.125f * LOG2E), v1 * (0.125f * LOG2E)); }
        else if (col0 < DM + 48) { f32x4 a, b;
#pragma unroll
            for (int i = 0; i < 4; ++i) { a[i] = sigmoid_f(v0[i]); b[i] = sigmoid_f(v1[i]); }
            float* gp = GATES + (size_t)row * 48 + (col0 - DM); *(f32x4*)gp = a; *(f32x4*)(gp + 4) = b; }
        return (f32x2){0.f, 0.f};
    }
    __device__ __forceinline__ void row_done(int, f32x2, int) const {}
};
struct FKv {
    typedef NormPre Pre; typedef NoLd Ld; __device__ __forceinline__ void fetch(Ld&, int, int) const {} float* out; bf16 *KCIN; NormIn ni;
    __device__ __forceinline__ void prep(Pre& p, int row0, int col0, bool sk) const { ni.prep(p, row0, col0, sk); }
    __device__ __forceinline__ f32x2 operator()(const Pre& p, const Ld&, int ri, int bj, int row, int col0, f32x4 v0, f32x4 v1) const {
        ni.apply(p, ri, bj, v0, v1);
        const int slot = col0 >> 8, g = (col0 >> 6) & 3, d0 = col0 & 63;
        if (row < MP) {
            const int b = row >> 13, t = row & (SEQ - 1);
            if (slot < 4) { float* q = out + OKV_P + (size_t)row * DM + col0; *(f32x4*)q = v0; *(f32x4*)(q + 4) = v1; }
            else if (t >= SEQ - 512) { float* q = out + OWIN_P + ((size_t)(b * 512 + (t - (SEQ - 512))) * 2 + (slot - 4)) * 256 + g * 64 + d0; *(f32x4*)q = v0; *(f32x4*)(q + 4) = v1; }
            const int bg = b * 4 + g;
            if (slot == 3 || slot == 5) {
                bf16* base = KCIN + (size_t)slot * (KVB / 2) + (((size_t)bg * (SEQ / 32) + (t >> 5)) * 64 + d0) * 32 + (t & 31);
#pragma unroll
                for (int i = 0; i < 4; ++i) { base[i * 32] = (bf16)(pk2(v0[i], 0.f) & 0xffffu); base[(i + 4) * 32] = (bf16)(pk2(v1[i], 0.f) & 0xffffu); }
            } else {
                bf16* base = KCIN + (size_t)slot * (KVB / 2) + ((size_t)bg * SEQ + t) * 64 + d0;
                *(v4u*)base = pack8(v0, v1);
            }
        } else {
            const int bs = row - MP;
            if (slot < 4) { float* q = out + OKV_S + (size_t)bs * DM + col0; *(f32x4*)q = v0; *(f32x4*)(q + 4) = v1; }
            else { float* q = out + OWIN_S + ((size_t)bs * 512 + 511) * 512 + (slot - 4) * 256 + g * 64 + d0; *(f32x4*)q = v0; *(f32x4*)(q + 4) = v1; }
        }
        return (f32x2){0.f, 0.f};
    }
    __device__ __forceinline__ void row_done(int, f32x2, int) const {}
};
constexpr int SH_NINST = 13;
struct FMod {
    typedef NoPre Pre; typedef NoLd Ld; __device__ __forceinline__ void fetch(Ld&, int, int) const {} float* MOD; const float *b0, *b1, *b2; bf16* SHB;
    __device__ __forceinline__ void prep(Pre&, int, int, bool) const {}
    __device__ __forceinline__ f32x2 operator()(const Pre&, const Ld&, int, int, int row, int col0, f32x4 v0, f32x4 v1) const {
        const float* bp = col0 < MODKV ? b0 + col0 : (col0 < MODFIN ? b1 + (col0 - MODKV) : b2 + (col0 - MODFIN));
        v0 = v0 + *(const f32x4*)bp; v1 = v1 + *(const f32x4*)(bp + 4);
        float* p = MOD + (size_t)row * NMOD + col0; *(f32x4*)p = v0; *(f32x4*)(p + 4) = v1;
        int inst = -1, k = 0;
        if (col0 < MODKV) { const int l = col0 / 9216, r = col0 - l * 9216, sub = r / 3072, rr = r - sub * 3072; if (rr < DM) { inst = l * 3 + sub; k = rr; } }
        else if (col0 < MODKV + DM) { inst = 12; k = col0 - MODKV; }
        if (inst >= 0) *(v4u*)(SHB + ((size_t)inst * 256 + row) * DM + k) = pack8(v0, v1);
        return (f32x2){0.f, 0.f};
    }
    __device__ __forceinline__ void row_done(int, f32x2, int) const {}
};
struct FBf16 {
    typedef NoPre Pre; typedef NoLd Ld; __device__ __forceinline__ void fetch(Ld&, int, int) const {} bf16* T; int ld;
    __device__ __forceinline__ void prep(Pre&, int, int, bool) const {}
    __device__ __forceinline__ f32x2 operator()(const Pre&, const Ld&, int, int, int row, int col0, f32x4 v0, f32x4 v1) const { *(v4u*)(T + (size_t)row * ld + col0) = pack8(v0, v1); return (f32x2){0.f, 0.f}; }
    __device__ __forceinline__ void row_done(int, f32x2, int) const {}
};
constexpr int TILEB = 256 * 1024 * 2;
constexpr int PN_UV = (int)((WS_WUV - WS_WGU) / TILEB), PN_QG = (int)((WS_WQG - WS_WGU) / TILEB), PN_KV = (int)((WS_WKV - WS_WGU) / TILEB);
static_assert((WS_WUV - WS_WGU) % TILEB == 0 && (WS_WQG - WS_WGU) % TILEB == 0 && (WS_WKV - WS_WGU) % TILEB == 0, "weight copies on 256-row tile boundaries");
struct ShiftOrder {
    int G, c;
    __device__ __forceinline__ bool next(int i, pg8::Unit& u) const {
        const int L = i * G + c; if (L >= 240) return false;
        if (L < 176) { const int f = L / 22, t = L - f * 22; u.pm = (f >> 1) * 3 + 2 * (f & 1); u.pn = f * 22 + t; }
        else if (L < 224) { const int q = L - 176, l = q / 24, t = q - l * 24; u.pm = l * 3 + 1; u.pn = PN_UV + l * 24 + t; }
        else if (L < 234) { const int q = L - 224, j = q / 5, t = q - j * 5; u.pm = (2 + j) * 3 + 1; u.pn = PN_QG + j * 5 + t; }
        else { u.pm = 12; u.pn = PN_KV + (L - 234); }
        return true;
    }
    __device__ __forceinline__ void a_ready(const pg8::Unit&) const {}
    __device__ __forceinline__ void done(const pg8::Unit&) const {}
};
struct FB2 {
    typedef NoPre Pre; typedef NoLd Ld; __device__ __forceinline__ void fetch(Ld&, int, int) const {} float* B2;
    __device__ __forceinline__ void prep(Pre&, int, int, bool) const {}
    __device__ __forceinline__ f32x2 operator()(const Pre&, const Ld&, int, int, int row, int col0, f32x4 v0, f32x4 v1) const {
        const int inst = row >> 8, b = row & 255, pn = col0 >> 8;
        int t;
        if (pn < 176) t = pn % 22; else if (pn < PN_QG) t = (pn - PN_UV) % 24; else if (pn < PN_KV) t = (pn - PN_QG) % 5; else t = pn - PN_KV;
        float* p = B2 + ((size_t)inst * 256 + b) * 6144 + t * 256 + (col0 & 255); *(f32x4*)p = v0; *(f32x4*)(p + 4) = v1; return (f32x2){0.f, 0.f};
    }
    __device__ __forceinline__ void row_done(int, f32x2, int) const {}
};

template <class F> __device__ __forceinline__ void run_gemm(LAS unsigned char* lds, const bf16* A, const bf16* Bt, int M, int N, int K, const F& f, int rot = 0) {
    int cblk = ((int)blockIdx.x + rot) % (int)gridDim.x; asm volatile("" : "+s"(cblk));
    pg8::Gemm g{A, Bt, M, N, K}; pg8::StaticOrder S; S.init(M, N, (int)gridDim.x, cblk);
    Epi8<F> E{f};
    pg8::gemm_phase<Epi8<F>, pg8::StaticOrder, true, true>(lds, g, S, E);
}

template <class F> __device__ __forceinline__ void skinny_gemm(LAS unsigned char* lds, const bf16* A, const bf16* Bt, int ncol32, int K, int rem, const F& f) {
    int tid_raw = threadIdx.x; asm volatile("" : "+v"(tid_raw));
    const int lane = tid_raw & 63, wave = __builtin_amdgcn_readfirstlane(tid_raw >> 6), fr = lane & 15, fq = lane >> 4;
    const int kper = K >> 3, nsteps = kper >> 5, nunits = 2 * ncol32;
    int cblk = (int)blockIdx.x; asm volatile("" : "+s"(cblk));
    const int nl = (int)gridDim.x - rem;
    LAS f32x4* red = (LAS f32x4*)lds;
    if (cblk < rem) return;
    for (int u = cblk - rem; u < nunits; u += nl) {
        const int n0 = 32 * (u >> 1), r0 = MP + 64 * (u & 1);
        f32x4 acc[4][2];
#pragma unroll
        for (int rt = 0; rt < 4; ++rt) { acc[rt][0] = (f32x4){0.f, 0.f, 0.f, 0.f}; acc[rt][1] = (f32x4){0.f, 0.f, 0.f, 0.f}; }
        const bf16* bp = Bt + (size_t)(n0 + 8 * (fr >> 2) + (fr & 3)) * K + wave * kper + 8 * fq;
        const bf16* ap = A + (size_t)(r0 + fr) * K + wave * kper + 8 * fq;
#pragma unroll 1
        for (int ks0 = 0; ks0 < nsteps; ks0 += 6) {
            bf16x8 bb[6][2], aa[6][4];
#pragma unroll
            for (int s = 0; s < 6; ++s) { const int ks = (ks0 + s < nsteps) ? ks0 + s : nsteps - 1;
                bb[s][0] = *(const bf16x8*)(bp + 32 * ks); bb[s][1] = *(const bf16x8*)(bp + (size_t)4 * K + 32 * ks);
#pragma unroll
                for (int rt = 0; rt < 4; ++rt) aa[s][rt] = *(const bf16x8*)(ap + (size_t)(16 * rt) * K + 32 * ks); }
#pragma unroll
            for (int s = 0; s < 6; ++s) if (ks0 + s < nsteps) {
#pragma unroll
                for (int rt = 0; rt < 4; ++rt) { acc[rt][0] = __builtin_amdgcn_mfma_f32_16x16x32_bf16(bb[s][0], aa[s][rt], acc[rt][0], 0, 0, 0); acc[rt][1] = __builtin_amdgcn_mfma_f32_16x16x32_bf16(bb[s][1], aa[s][rt], acc[rt][1], 0, 0, 0); } }
        }
#pragma unroll
        for (int rt = 0; rt < 4; ++rt) { red[((wave * 4 + rt) * 2 + 0) * 64 + lane] = acc[rt][0]; red[((wave * 4 + rt) * 2 + 1) * 64 + lane] = acc[rt][1]; }
        __syncthreads();
        if (wave < 4) {
            f32x4 s0 = (f32x4){0.f, 0.f, 0.f, 0.f}, s1 = (f32x4){0.f, 0.f, 0.f, 0.f};
#pragma unroll
            for (int w2 = 0; w2 < 8; ++w2) { s0 = s0 + red[((w2 * 4 + wave) * 2 + 0) * 64 + lane]; s1 = s1 + red[((w2 * 4 + wave) * 2 + 1) * 64 + lane]; }
            const int row = r0 + 16 * wave + fr;
            typename F::Pre pre; typename F::Ld ld; f.fetch(ld, row, n0 + 8 * fq); f.prep(pre, row, n0 + 8 * fq, true); const f32x2 part = f(pre, ld, 0, 0, row, n0 + 8 * fq, s0, s1); f.row_done(row, part, fq);
        }
        __syncthreads();
    }
}
template <class F> __device__ __forceinline__ void run_gemm2(LAS unsigned char* lds, const bf16* A, const bf16* Bt, int N, int Nreal, int K, const F& f, int rot = 0, int rem = -1) {
    run_gemm(lds, A, Bt, MP, N, K, f, rot);
    skinny_gemm(lds, A, Bt, (Nreal + 31) >> 5, K, rem >= 0 ? rem : ((MP / 256) * (N / 256)) % (int)gridDim.x, f);
}

template <bool FINAL>
__device__ __forceinline__ void norm_phase(const f16* X, const float* gvec, const float* MOD, int shift_col, int scale_col, bf16* H, float* out, int gw, int NGW, int lane) {
    for (int r = gw; r < MR; r += NGW) {
        const f16x4* xr = (const f16x4*)(X + (size_t)r * DM) + lane;
        f32x4 v[4]; float ss = 0.f;
#pragma unroll
        for (int j = 0; j < 4; ++j) { v[j] = __builtin_convertvector(xr[64 * j], f32x4); ss += (v[j][0] * v[j][0] + v[j][1] * v[j][1]) + (v[j][2] * v[j][2] + v[j][3] * v[j][3]); }
        ss = wave_sum(ss);
        const float rstd = 1.0f / sqrtf(ss * (1.0f / DM) + 1e-6f);
        const float* mrow = MOD + (size_t)row_b(r) * NMOD;
#pragma unroll
        for (int j = 0; j < 4; ++j) { const int c = 4 * lane + 256 * j;
            const f32x4 gv = *(const f32x4*)(gvec + c), sh = *(const f32x4*)(mrow + shift_col + c), sc = *(const f32x4*)(mrow + scale_col + c);
            const f32x4 y = (v[j] * rstd) * gv * (sc + 1.0f) + sh;
            if (FINAL) { float* o = (r < MP) ? out + OY_P + (size_t)r * DM + c : out + OY_S + (size_t)(r - MP) * DM + c; *(f32x4*)o = y; }
            else { v2u w; w.x = pk2(y[0], y[1]); w.y = pk2(y[2], y[3]); *(v2u*)(H + (size_t)r * DM + c) = w; }
        }
    }
}

__device__ __forceinline__ void transpose_item(const float* W, int N, int ldw, bf16* WT, int ldt, int mode, int row_off, LAS float* scr, int item, int lane) {
    const int nblk = (N + 31) >> 5, kb = item / nblk, nb = item - kb * nblk, k0 = 64 * kb, n0 = 32 * nb;
    const int nn = n0 + (lane & 31); const bool okn = nn < N;
    float tv[32];
#pragma unroll
    for (int i = 0; i < 32; ++i) { const int kk = 2 * i + (lane >> 5); tv[i] = okn ? __builtin_nontemporal_load(W + (size_t)(k0 + kk) * ldw + nn) : 0.f; }
#pragma unroll
    for (int i = 0; i < 32; ++i) { const int kk = 2 * i + (lane >> 5); scr[kk * 33 + (lane & 31)] = tv[i]; }
    asm volatile("s_waitcnt lgkmcnt(0)" ::: "memory");
    const int c = lane & 7;
#pragma unroll
    for (int j = 0; j < 4; ++j) { const int n = (lane >> 3) + 8 * j; const LAS float* s = scr + (8 * c) * 33 + n;
        v4u o; o.x = pk2(s[0 * 33], s[1 * 33]); o.y = pk2(s[2 * 33], s[3 * 33]); o.z = pk2(s[4 * 33], s[5 * 33]); o.w = pk2(s[6 * 33], s[7 * 33]);
        const int ng = n0 + n;
        const int drow = mode == 0 ? row_off + ng : (8 * (ng >> 2) + (ng & 3) + (mode == 2 ? 4 : 0));
        if (ng < N) *(v4u*)(WT + (size_t)drow * ldt + k0 + 8 * c) = o; }
    asm volatile("s_waitcnt lgkmcnt(0)" ::: "memory");
}
struct TDesc { const float* src; int K, N, ldw; bf16* dst; int ldt, mode, row_off; };
struct Ptrs {
    const float *x_prompt, *x_sample, *cache_kv, *state_win; const int* page_table; const float *c_prompt, *c_sample, *ada_w, *ada_b, *norm_g, *w_gate, *w_up, *w_down,
        *w_uv, *ln_g, *ln_b, *w_sp, *b_sp, *w_out, *w_qg, *w_o, *kv_norm_g, *kv_ada_w, *kv_ada_b, *kv_w, *cmp_w1, *cmp_w2, *cmp_pe, *final_g, *final_ada_w, *final_ada_b;
    float* out; unsigned char* ws;
};
#define WSP(T, off) ((T*)(P.ws + (off)))
typedef const __attribute__((address_space(4))) unsigned long long* kptr_t;
__device__ __forceinline__ void load_ptrs(Ptrs& P) {
    kptr_t k = (kptr_t)__builtin_amdgcn_kernarg_segment_ptr();
    asm volatile("" : "+s"(k));
    P.x_prompt = (const float*)(GAS const float*)k[0]; P.x_sample = (const float*)(GAS const float*)k[1]; P.cache_kv = (const float*)(GAS const float*)k[2]; P.state_win = (const float*)(GAS const float*)k[3];
    P.page_table = (const int*)(GAS const int*)k[4]; P.c_prompt = (const float*)(GAS const float*)k[5]; P.c_sample = (const float*)(GAS const float*)k[6]; P.ada_w = (const float*)(GAS const float*)k[7];
    P.ada_b = (const float*)(GAS const float*)k[8]; P.norm_g = (const float*)(GAS const float*)k[9]; P.w_gate = (const float*)(GAS const float*)k[10]; P.w_up = (const float*)(GAS const float*)k[11];
    P.w_down = (const float*)(GAS const float*)k[12]; P.w_uv = (const float*)(GAS const float*)k[13]; P.ln_g = (const float*)(GAS const float*)k[14]; P.ln_b = (const float*)(GAS const float*)k[15];
    P.w_sp = (const float*)(GAS const float*)k[16]; P.b_sp = (const float*)(GAS const float*)k[17]; P.w_out = (const float*)(GAS const float*)k[18]; P.w_qg = (const float*)(GAS const float*)k[19];
    P.w_o = (const float*)(GAS const float*)k[20]; P.kv_norm_g = (const float*)(GAS const float*)k[21]; P.kv_ada_w = (const float*)(GAS const float*)k[22]; P.kv_ada_b = (const float*)(GAS const float*)k[23];
    P.kv_w = (const float*)(GAS const float*)k[24]; P.cmp_w1 = (const float*)(GAS const float*)k[25]; P.cmp_w2 = (const float*)(GAS const float*)k[26]; P.cmp_pe = (const float*)(GAS const float*)k[27];
    P.final_g = (const float*)(GAS const float*)k[28]; P.final_ada_w = (const float*)(GAS const float*)k[29]; P.final_ada_b = (const float*)(GAS const float*)k[30];
    P.out = (float*)(GAS float*)k[31]; P.ws = (unsigned char*)(GAS unsigned char*)k[32];
}
__device__ __forceinline__ void get_tdesc(const Ptrs& P, int id, TDesc& d) {
    d.mode = 0; d.row_off = 0; d.K = 1024; d.ldt = 1024;
    if (id < 4) { d.src = P.ada_w + (size_t)id * 1024 * 9216; d.N = 9216; d.dst = WSP(bf16, WS_WMOD); d.row_off = id * 9216; }
    else if (id == 4) { d.src = P.kv_ada_w; d.N = 2048; d.dst = WSP(bf16, WS_WMOD); d.row_off = MODKV; }
    else if (id == 5) { d.src = P.final_ada_w; d.N = 2048; d.dst = WSP(bf16, WS_WMOD); d.row_off = MODFIN; }
    else if (id < 14) { const int i = id - 6; d.src = P.w_gate + (size_t)i * 1024 * DFF; d.N = DFF; d.dst = WSP(bf16, WS_WGU) + (size_t)i * 5632 * 1024; d.mode = 1; }
    else if (id < 22) { const int i = id - 14; d.src = P.w_up + (size_t)i * 1024 * DFF; d.N = DFF; d.dst = WSP(bf16, WS_WGU) + (size_t)i * 5632 * 1024; d.mode = 2; }
    else if (id < 30) { const int i = id - 22; d.src = P.w_down + (size_t)i * DFF * 1024; d.K = DFF; d.N = 1024; d.dst = WSP(bf16, WS_WDN) + (size_t)i * 1024 * DFF; d.ldt = DFF; }
    else if (id < 32) { const int i = id - 30; d.src = P.w_uv + (size_t)i * 1024 * 6144; d.N = 6144; d.dst = WSP(bf16, WS_WUV) + (size_t)i * 6144 * 1024; }
    else if (id < 34) { const int i = id - 32; d.src = P.w_out + (size_t)i * DV * 1024; d.K = DV; d.N = 1024; d.dst = WSP(bf16, WS_WOUT) + (size_t)i * 1024 * DV; d.ldt = DV; }
    else if (id < 36) { const int i = id - 34; d.src = P.w_qg + (size_t)i * 1024 * 1072; d.N = 1072; d.dst = WSP(bf16, WS_WQG) + (size_t)i * NQG * 1024; }
    else if (id < 38) { const int i = id - 36; d.src = P.w_o + (size_t)i * 1024 * 1024; d.N = 1024; d.dst = WSP(bf16, WS_WO) + (size_t)i * 1024 * 1024; }
    else if (id == 38) { d.src = P.kv_w; d.N = NKVP; d.dst = WSP(bf16, WS_WKV); }
    else if (id < 43) { const int i = id - 39, kv = i >> 1, r = i & 1; d.src = P.cmp_w1 + (size_t)kv * 2048 * 256 + (size_t)r * 1024 * 256; d.N = 256; d.dst = WSP(bf16, WS_WC1) + (size_t)kv * 512 * 1024; d.row_off = r * 256; }
    else { const int kv = id - 43; d.src = P.cmp_w2 + (size_t)kv * 256 * 64; d.K = 256; d.N = 64; d.dst = WSP(bf16, WS_WC2) + (size_t)kv * 64 * 256; d.ldt = 256; }
    d.ldw = d.N;
}
constexpr int N_TMAT = 45;

__device__ __forceinline__ void prologue_phase(const Ptrs& P, LAS unsigned char* lds, int gw, int NGW, int wave, int lane, int tid) {
    if (blockIdx.x < 8) {
        const int kv = blockIdx.x >> 2, hb = blockIdx.x & 3; const float* pe = P.cmp_pe + kv * 2048; const float* w1 = P.cmp_w1 + (size_t)kv * 2048 * 256 + hb * 64 + lane;
        float acc = 0.f;
#pragma unroll 8
        for (int k = wave * 256; k < wave * 256 + 256; ++k) acc += pe[k] * w1[(size_t)k * 256];
        LAS float* red = (LAS float*)lds;
        red[wave * 64 + lane] = acc;
        __syncthreads();
        if (wave == 0) { float s = 0.f;
#pragma unroll
            for (int w = 0; w < 8; ++w) s += red[w * 64 + lane];
            WSP(float, WS_CBIAS)[kv * 256 + hb * 64 + lane] = s; }
        __syncthreads();
    }
    { LAS float* scr = (LAS float*)(lds + wave * 16384); int off = 0;
      for (int id = 0; id < N_TMAT; ++id) { TDesc d; get_tdesc(P, id, d);
          const int nitems = (d.K >> 6) * ((d.N + 31) >> 5);
          for (int it = (gw + NGW - (off % NGW)) % NGW; it < nitems; it += NGW) transpose_item(d.src, d.N, d.ldw, d.dst, d.ldt, d.mode, d.row_off, scr, it, lane);
          off += nitems; } }
    for (int r = gw; r < RT; r += NGW) { f16x4* xo = (f16x4*)(WSP(f16, WS_X) + (size_t)r * DM) + lane;
        const f32x4* xi = r < MP ? (const f32x4*)(P.x_prompt + (size_t)r * DM) + lane : (const f32x4*)(P.x_sample + (size_t)((r < MR ? r : MR - 1) - MP) * DM) + lane;
#pragma unroll
        for (int j = 0; j < 4; ++j) { f32x4 v = xi[64 * j]; if (r >= MR) v = (f32x4){0.f, 0.f, 0.f, 0.f}; xo[64 * j] = __builtin_convertvector(v, f16x4); } }
    for (int r = gw; r < 256; r += NGW) { const float* ci = r < 2 ? P.c_prompt + (size_t)r * DM : P.c_sample + (size_t)((r < 130 ? r : 129) - 2) * DM;
#pragma unroll
        for (int j = 0; j < 4; ++j) { const int c = 4 * lane + 256 * j; f32x4 v = *(const f32x4*)(ci + c); v2u w; w.x = pk2(silu_f(v[0]), silu_f(v[1])); w.y = pk2(silu_f(v[2]), silu_f(v[3])); if (r >= 130) { w.x = 0u; w.y = 0u; }
            *(v2u*)(WSP(bf16, WS_SC) + (size_t)r * DM + c) = w; } }
    for (int it0 = gw * 8; it0 < MS * PAST; it0 += NGW * 8) { const int bs = it0 >> 11, pos0 = it0 & (PAST - 1); const int page = P.page_table[bs * NPAGES + (pos0 >> 7)];
        const float* src = P.cache_kv + ((size_t)page * 128 + (pos0 & 127)) * 1024 + 8 * lane;
        f32x4 a[8], b[8];
#pragma unroll
        for (int q = 0; q < 8; ++q) { a[q] = __builtin_nontemporal_load((const f32x4*)(src + (size_t)q * 1024)); b[q] = __builtin_nontemporal_load((const f32x4*)(src + (size_t)q * 1024 + 4)); }
        const int slot = lane >> 5, g = (lane >> 3) & 3, d0 = (lane & 7) * 8;
        bf16* dst = WSP(bf16, WS_ACMP) + (size_t)slot * 65536 * 1024 + ((size_t)(bs * 4 + g) * 128 + (pos0 >> 4)) * 1024 + (pos0 & 15) * 64 + d0;
#pragma unroll
        for (int q = 0; q < 8; ++q) *(v4u*)(dst + q * 64) = pack8(a[q], b[q]); }
    for (int i = gw * 64 + lane; i < 13 * DM; i += NGW * 64) WSP(float, WS_NG)[i] = i < 12 * DM ? P.norm_g[i] : P.kv_norm_g[i - 12 * DM];
    for (int i = gw * 64 + lane; i < 2 * 8 * 128 * 128; i += NGW * 64) { const int t = (i >> 7) & 127, s = i & 127; WSP(bf16, WS_WSP)[i] = (bf16)(pk2(s <= t ? P.w_sp[i] : 0.f, 0.f) & 0xffffu); }
    for (int it = gw; it < MS * 64; it += NGW) { const int bs = it >> 6, j0 = (it & 63) * 8;
        const float* src = P.state_win + ((size_t)bs * 512 + j0 + 1) * 512 + 4 * lane; float* dst = P.out + OWIN_S + ((size_t)bs * 512 + j0) * 512 + 4 * lane;
        f32x4 v[16];
#pragma unroll
        for (int q = 0; q < 16; ++q) { const int j = j0 + (q >> 1); v[q] = (j < 511) ? __builtin_nontemporal_load((const f32x4*)(src + (size_t)(q >> 1) * 512 + (q & 1) * 256)) : (f32x4){0.f, 0.f, 0.f, 0.f}; }
#pragma unroll
        for (int q = 0; q < 16; ++q) { const int j = j0 + (q >> 1); if (j < 511) __builtin_nontemporal_store(v[q], (f32x4*)(dst + (size_t)(q >> 1) * 512 + (q & 1) * 256)); } }
}

template <int MODE>
__device__ __forceinline__ void cmp_finish_unit(const bf16* T, const float* cbias, const bf16* W2T, void* outp, int C, int bg, int rt, int lane) {
    const int fr = lane & 15, fq = lane >> 4, NB = C - 1, i0 = 16 * rt;
    const int ib = i0 + fr, ic = ib < NB ? ib : NB - 1;
    const bf16* ta = T + ((size_t)bg * C + ic) * 512 + 8 * fq; const bf16* tb = ta + 512 + 256;
    bf16x8 hf[8];
#pragma unroll
    for (int ks = 0; ks < 8; ++ks) { float a[8], b[8]; unpack8(*(const v4u*)(ta + 32 * ks), a); unpack8(*(const v4u*)(tb + 32 * ks), b);
        const f32x4 c0 = *(const f32x4*)(cbias + 32 * ks + 8 * fq), c1 = *(const f32x4*)(cbias + 32 * ks + 8 * fq + 4);
        f32x4 h0, h1;
#pragma unroll
        for (int e = 0; e < 4; ++e) { h0[e] = gelu_tanh_f(c0[e] + a[e] + b[e]); h1[e] = gelu_tanh_f(c1[e] + a[e + 4] + b[e + 4]); }
        const v4u w = pack8(h0, h1); hf[ks] = __builtin_bit_cast(bf16x8, w); }
    f32x4 acc[4];
#pragma unroll
    for (int nt = 0; nt < 4; ++nt) { acc[nt] = (f32x4){0.f, 0.f, 0.f, 0.f};
#pragma unroll
        for (int ks = 0; ks < 8; ++ks) { const bf16x8 wf = *(const bf16x8*)(W2T + (size_t)(16 * nt + fr) * 256 + 32 * ks + 8 * fq);
            if (MODE == 1) acc[nt] = __builtin_amdgcn_mfma_f32_16x16x32_bf16(hf[ks], wf, acc[nt], 0, 0, 0);
            else acc[nt] = __builtin_amdgcn_mfma_f32_16x16x32_bf16(wf, hf[ks], acc[nt], 0, 0, 0); } }
#pragma unroll
    for (int nt = 0; nt < 4; ++nt) {
        if (MODE == 0) { f32x4 v = acc[nt]; if (ib >= NB) v = (f32x4){0.f, 0.f, 0.f, 0.f}; v2u w; w.x = pk2(v[0], v[1]); w.y = pk2(v[2], v[3]);
            *(v2u*)((bf16*)outp + ((size_t)bg * 512 + ib) * 64 + 16 * nt + 4 * fq) = w; }
        else if (MODE == 1) { f32x4 v = acc[nt];
#pragma unroll
            for (int e = 0; e < 4; ++e) if (i0 + 4 * fq + e >= NB) v[e] = 0.f;
            v2u w; w.x = pk2(v[0], v[1]); w.y = pk2(v[2], v[3]);
            *(v2u*)((bf16*)outp + (((size_t)bg * 16 + (i0 >> 5)) * 64 + 16 * nt + fr) * 32 + (i0 & 31) + 4 * fq) = w; }
        else { f32x4 v = acc[nt]; if (ib >= NB) v = (f32x4){0.f, 0.f, 0.f, 0.f};
            *(f32x4*)((float*)outp + ((size_t)bg * 128 + ib) * 64 + 16 * nt + 4 * fq) = v; }
    }
}

__device__ __forceinline__ void spatial2_phase(const Ptrs& P, int l, LAS unsigned char* lds, int wave, int lane, int tid, int gw, int NGW) {
    const bf16* Z = WSP(bf16, WS_Z); const bf16* WS = WSP(bf16, WS_WSP); bf16* PO = WSP(bf16, WS_P);
    const float* VS = WSP(float, WS_CTL) + CW_VS + (size_t)l * RT * 2;
    const float* lg = P.ln_g + l * DV; const float* lb = P.ln_b + l * DV;
    LAS float* stats = (LAS float*)lds;
    LAS unsigned* tile = (LAS unsigned*)(lds + 1024);
    const int fr = lane & 15, fq = lane >> 4, nks = (wave >> 1) + 1;
    for (int u = blockIdx.x; u < 128 * 24; u += gridDim.x) {
        const int n = u / 24, cb = u - n * 24, g = cb / 3;
        if (tid < 128) { const float s = VS[2 * (n * 128 + tid)], q = VS[2 * (n * 128 + tid) + 1]; const float mean = s * (1.0f / DV); float var = q * (1.0f / DV) - mean * mean; var = var > 0.f ? var : 0.f;
            stats[2 * tid] = mean; stats[2 * tid + 1] = 1.0f / sqrtf(var + 1e-6f); }
        __syncthreads();
#pragma unroll
        for (int q = 0; q < 2; ++q) { const int ccg = wave + 8 * q, tp = lane, cc = cb * 128 + 8 * ccg;
            const bf16* z0 = Z + (size_t)(n * 128 + 2 * tp) * 6144 + DV + cc;
            float a[8], b[8]; unpack8(*(const v4u*)z0, a); unpack8(*(const v4u*)(z0 + 6144), b);
            const float m0 = stats[4 * tp], r0 = stats[4 * tp + 1], m1 = stats[4 * tp + 2], r1 = stats[4 * tp + 3];
            const f32x4 g0 = *(const f32x4*)(lg + cc), g1 = *(const f32x4*)(lg + cc + 4), b0 = *(const f32x4*)(lb + cc), b1 = *(const f32x4*)(lb + cc + 4);
#pragma unroll
            for (int e = 0; e < 8; ++e) { const float gg = e < 4 ? g0[e] : g1[e - 4], bb = e < 4 ? b0[e] : b1[e - 4];
                tile[(8 * ccg + e) * 68 + tp] = pk2((a[e] - m0) * r0 * gg + bb, (b[e] - m1) * r1 * gg + bb); } }
        __syncthreads();
        f32x4 acc[8];
#pragma unroll
        for (int j = 0; j < 8; ++j) acc[j] = (f32x4){0.f, 0.f, 0.f, 0.f};
        const bf16* wp = WS + ((size_t)(l * 8 + g) * 128 + 16 * wave + fr) * 128 + 8 * fq;
        const LAS char* vp = (const LAS char*)tile + (8 * (fr >> 2) + (fr & 3)) * 272 + 16 * fq;
        for (int ks = 0; ks < nks; ++ks) {
            const bf16x8 wf = *(const bf16x8*)(wp + 32 * ks);
#pragma unroll
            for (int j = 0; j < 8; ++j) { const bf16x8 vf = *(const LAS bf16x8*)(vp + (32 * (j >> 1) + 4 * (j & 1)) * 272 + 64 * ks);
                acc[j] = __builtin_amdgcn_mfma_f32_16x16x32_bf16(vf, wf, acc[j], 0, 0, 0); }
        }
        const int t = 16 * wave + fr, row = n * 128 + t; const float bt = P.b_sp[(l * 8 + g) * 128 + t];
#pragma unroll
        for (int m = 0; m < 4; ++m) { const int c = cb * 128 + 32 * m + 8 * fq; float uu[8]; unpack8(*(const v4u*)(Z + (size_t)row * 6144 + c), uu);
            f32x4 p0, p1;
#pragma unroll
            for (int e = 0; e < 4; ++e) { p0[e] = uu[e] * (acc[2 * m][e] + bt); p1[e] = uu[4 + e] * (acc[2 * m + 1][e] + bt); }
            *(v4u*)(PO + (size_t)row * DV + c) = pack8(p0, p1); }
        __syncthreads();
    }
    for (int bs = gw; bs < MS; bs += NGW) {
        const int row = MP + bs; const bf16* zr = Z + (size_t)row * 6144 + 8 * lane;
        const float mean = VS[2 * row] * (1.0f / DV); float var = VS[2 * row + 1] * (1.0f / DV) - mean * mean; var = var > 0.f ? var : 0.f; const float rstd = 1.0f / sqrtf(var + 1e-6f);
#pragma unroll
        for (int j = 0; j < 6; ++j) { const int c = 512 * j + 8 * lane, g = c / CGW;
            const float w00 = P.w_sp[(size_t)(l * 8 + g) * 128 * 128], b00 = P.b_sp[(l * 8 + g) * 128];
            const f32x4 g0 = *(const f32x4*)(lg + c), g1 = *(const f32x4*)(lg + c + 4), b0 = *(const f32x4*)(lb + c), b1 = *(const f32x4*)(lb + c + 4);
            float vv[8], uu[8]; unpack8(*(const v4u*)(zr + DV + 512 * j), vv); unpack8(*(const v4u*)(zr + 512 * j), uu);
            f32x4 o0, o1, p0, p1;
#pragma unroll
            for (int e = 0; e < 4; ++e) { o0[e] = (vv[e] - mean) * rstd * g0[e] + b0[e]; o1[e] = (vv[4 + e] - mean) * rstd * g1[e] + b1[e];
                p0[e] = uu[e] * (w00 * o0[e] + b00); p1[e] = uu[4 + e] * (w00 * o1[e] + b00); }
            float* gv = P.out + OGV + ((size_t)l * MS + bs) * DV + c; *(f32x4*)gv = o0; *(f32x4*)(gv + 4) = o1;
            *(v4u*)(WSP(bf16, WS_P) + (size_t)row * DV + c) = pack8(p0, p1); }
    }
}

#define NEG_INF (-__builtin_inff())
__device__ __forceinline__ bf16x8 ld_v2x8(const GAS bf16* p) {
    const bf16x4 lo = *(const GAS bf16x4*)p, hi = *(const GAS bf16x4*)(p + 16);
    return __builtin_shufflevector(lo, hi, 0, 1, 2, 3, 4, 5, 6, 7);
}
struct SampleAcc { float acc[4][8]; float m, l; };
__device__ __forceinline__ float sample_compute(const f32x4 k0, const f32x4 k1, const f32x4 v0, const f32x4 v1, bool valid, float dist, const float (&qv)[4][8], float slope2_own, int lane, SampleAcc& A) {
    const int j8 = lane & 7;
    float part[4];
#pragma unroll
    for (int h = 0; h < 4; ++h) { float a = (qv[h][0] * k0[0] + qv[h][1] * k0[1]) + (qv[h][2] * k0[2] + qv[h][3] * k0[3]) + (qv[h][4] * k1[0] + qv[h][5] * k1[1]) + (qv[h][6] * k1[2] + qv[h][7] * k1[3]);
        a += __shfl_xor(a, 1); a += __shfl_xor(a, 2); a += __shfl_xor(a, 4); part[h] = a; }
    const int hown = j8 & 3;
    const float sown = hown == 0 ? part[0] : hown == 1 ? part[1] : hown == 2 ? part[2] : part[3];
    const float s2 = valid ? (sown - slope2_own * dist) : NEG_INF;
    float tm = s2;
#pragma unroll
    for (int off = 8; off < 64; off <<= 1) tm = fmaxf(tm, __shfl_xor(tm, off));
    const float mnew = fmaxf(A.m, tm), msafe = (mnew == NEG_INF) ? 0.f : mnew, alpha = fexp2(A.m - msafe), p = fexp2(s2 - msafe);
    A.m = mnew; A.l = A.l * alpha + p;
    float ph[4], ah[4];
#pragma unroll
    for (int h = 0; h < 4; ++h) { ph[h] = __shfl(p, (lane & ~7) | h); ah[h] = __shfl(alpha, (lane & ~7) | h); }
#pragma unroll
    for (int h = 0; h < 4; ++h)
#pragma unroll
        for (int e = 0; e < 4; ++e) { A.acc[h][e] = A.acc[h][e] * ah[h] + ph[h] * v0[e]; A.acc[h][4 + e] = A.acc[h][4 + e] * ah[h] + ph[h] * v1[e]; }
    return s2;
}
__device__ __forceinline__ float sample_step8(const float* krow, const float* vrow, bool valid, float dist, const float (&qv)[4][8], float slope2_own, int lane, SampleAcc& A) {
    const int j8 = lane & 7;
    const f32x4 k0 = *(const f32x4*)(krow + 8 * j8), k1 = *(const f32x4*)(krow + 8 * j8 + 4), v0 = *(const f32x4*)(vrow + 8 * j8), v1 = *(const f32x4*)(vrow + 8 * j8 + 4);
    return sample_compute(k0, k1, v0, v1, valid, dist, qv, slope2_own, lane, A);
}
__device__ __forceinline__ void sample_batch4(const float* kbase, const float* vbase, int rstride, int r0, int rlimit, int rclamp, float dist0, float ddist,
                                              const float (&qv)[4][8], float slope2_own, int lane, SampleAcc& A, LAS float* sraw) {
    const int j8 = lane & 7;
    f32x4 kk[4][2], vv[4][2];
#pragma unroll
    for (int s = 0; s < 4; ++s) { int r = r0 + 8 * s; r = r < rlimit ? r : rclamp; const float* kr = kbase + (size_t)r * rstride + 8 * j8; const float* vr = vbase + (size_t)r * rstride + 8 * j8;
        kk[s][0] = *(const f32x4*)kr; kk[s][1] = *(const f32x4*)(kr + 4); vv[s][0] = *(const f32x4*)vr; vv[s][1] = *(const f32x4*)(vr + 4); }
#pragma unroll
    for (int s = 0; s < 4; ++s) { const float s2 = sample_compute(kk[s][0], kk[s][1], vv[s][0], vv[s][1], r0 + 8 * s < rlimit, dist0 - ddist * (float)s, qv, slope2_own, lane, A);
        if (sraw) sraw[s * 64 + lane] = s2; }
}
__device__ __forceinline__ void sample_reset(SampleAcc& A) {
    A.m = NEG_INF; A.l = 0.f;
#pragma unroll
    for (int h = 0; h < 4; ++h)
#pragma unroll
        for (int i = 0; i < 8; ++i) A.acc[h][i] = 0.f;
}
__device__ __forceinline__ void sample_finish(SampleAcc& A, const float* gates_bg, int br, LAS float* wl, int lane, bool first) {
    float lt = A.l;
#pragma unroll
    for (int off = 8; off < 64; off <<= 1) lt += __shfl_xor(lt, off);
    float sc[4];
#pragma unroll
    for (int h = 0; h < 4; ++h) { const float lh = __shfl(lt, h); sc[h] = lh > 0.f ? gates_bg[h * 3 + br] / lh : 0.f; }
#pragma unroll
    for (int h = 0; h < 4; ++h)
#pragma unroll
        for (int i = 0; i < 8; ++i) { float a = A.acc[h][i];
#pragma unroll
            for (int off = 8; off < 64; off <<= 1) a += __shfl_xor(a, off);
            A.acc[h][i] = a * sc[h]; }
    if (lane < 8) {
#pragma unroll
        for (int h = 0; h < 4; ++h)
#pragma unroll
            for (int i = 0; i < 8; ++i) { LAS float* p = wl + h * 64 + 8 * lane + i; *p = first ? A.acc[h][i] : (*p + A.acc[h][i]); }
    }
}
__device__ __forceinline__ void attn_sample_unit(const Ptrs& P, int bs, int g, LAS float* wl, int lane_in) {
    int lane = lane_in; asm volatile("" : "+v"(lane));
    const int kq = lane >> 3, j8 = lane & 7, row = MP + bs;
    const bf16* Q = WSP(bf16, WS_Q) + (size_t)row * DM + (4 * g) * 64; const float* GT = WSP(float, WS_GATES) + (size_t)row * 48 + g * 12;
    float qv[4][8];
#pragma unroll
    for (int h = 0; h < 4; ++h) unpack8(*(const v4u*)(Q + h * 64 + 8 * j8), qv[h]);
    const float slope2_own = fexp2(-0.5f * (float)(4 * g + (j8 & 3) + 1)) * LOG2E;
    SampleAcc A;
    LAS float* pimp = wl + 256;
    LAS float* sraw = wl + 512;
    const float* KCS = WSP(float, WS_KCS) + (size_t)(bs * 4 + g) * 128 * 64; const float* VCS = WSP(float, WS_VCS) + (size_t)(bs * 4 + g) * 128 * 64;
    sample_reset(A);
#pragma unroll 1
    for (int bt = 0; bt < 4; ++bt) sample_batch4(KCS, VCS, 64, 32 * bt + kq, 127, 126, (float)(PAST - (16 * (32 * bt + kq) + 31)), 128.f, qv, slope2_own, lane, A, sraw + bt * 256);
    { float lt = A.l;
#pragma unroll
      for (int off = 8; off < 64; off <<= 1) lt += __shfl_xor(lt, off);
      const float il = lt > 0.f ? 1.0f / lt : 0.f, mm = A.m == NEG_INF ? 0.f : A.m;
#pragma unroll 1
      for (int it = 0; it < 16; ++it) { float p = fexp2(sraw[it * 64 + lane] - mm) * il; p += __shfl_xor(p, 1); p += __shfl_xor(p, 2); if (j8 == 0) pimp[8 * it + kq] = p; } }
    sample_finish(A, GT, 0, wl, lane, true);
    unsigned long long selmask;
    { float v = -1.f;
      if (lane < 33) { float sacc = 0.f;
#pragma unroll
          for (int e = -1; e < 4; ++e) { const int n = 4 * lane + e; if (n >= 0 && n < 127) sacc += pimp[n]; }
          v = (lane == 0 || lane >= 31) ? sacc + 1e4f : sacc; }
      int rank = 0;
#pragma unroll 1
      for (int i = 0; i < 33; ++i) { const float vi = __shfl(v, i); rank += (vi > v || (vi == v && i < lane)) ? 1 : 0; }
      selmask = __ballot(lane < 33 && rank < 16); }
    sample_reset(A);
#pragma unroll 1
    for (int j = 0; j < 32; ++j) {
        if (!((selmask >> j) & 1ull)) continue;
        const int page = P.page_table[bs * NPAGES + (j >> 1)];
        const float* kb = P.cache_kv + ((size_t)page * 128 * 4 + 2) * 256 + g * 64;
#pragma unroll 1
        for (int bb = 0; bb < 2; ++bb) { const int r0 = ((64 * j) & 127) + 32 * bb + kq;
            sample_batch4(kb, kb + 256, 1024, r0, 1 << 30, 0, (float)(PAST - (64 * j + 32 * bb + kq)), 8.f, qv, slope2_own, lane, A, nullptr); }
    }
    { const float* kr = P.out + OKV_S + ((size_t)bs * 4 + 2) * 256 + g * 64;
      (void)sample_step8(kr, kr + 256, kq == 0, 0.f, qv, slope2_own, lane, A); }
    sample_finish(A, GT, 1, wl, lane, false);
    sample_reset(A);
    { const float* kb = P.state_win + (size_t)bs * 512 * 512 + g * 64;
#pragma unroll 1
      for (int bt = 0; bt < 16; ++bt) sample_batch4(kb, kb + 256, 512, 32 * bt + kq, 1 << 30, 0, (float)(512 - (32 * bt + kq)), 8.f, qv, slope2_own, lane, A, nullptr); }
    { const float* kr = P.out + OWIN_S + ((size_t)bs * 512 + 511) * 512 + g * 64;
      (void)sample_step8(kr, kr + 256, kq == 0, 0.f, qv, slope2_own, lane, A); }
    sample_finish(A, GT, 2, wl, lane, false);
    { const f32x4 v = *(const LAS f32x4*)(wl + 4 * lane); v2u w; w.x = pk2(v[0], v[1]); w.y = pk2(v[2], v[3]);
      *(v2u*)(WSP(bf16, WS_O) + (size_t)row * DM + 256 * g + 4 * lane) = w; }
}

__device__ __forceinline__ void ldK(bf16x8 (&kf)[2][2], const GAS bf16* Kp, int k0, unsigned koff) {
#pragma unroll
    for (int kt = 0; kt < 2; ++kt)
#pragma unroll
        for (int ks = 0; ks < 2; ++ks) kf[kt][ks] = *(const GAS bf16x8*)((const GAS char*)(Kp + (size_t)k0 * 64 + kt * 256 + ks * 32) + koff);
}
__device__ __forceinline__ void ldV(bf16x8 (&vf)[4], const GAS bf16* Vp, int VP, int k0, unsigned voff) {
#pragma unroll
    for (int dt = 0; dt < 4; ++dt) vf[dt] = *(const GAS bf16x8*)((const GAS char*)(Vp + (size_t)(k0 >> 5) * 2048 + dt * 512) + voff);
}
template <int MODE, int GEN>
__device__ __forceinline__ void att_run(const GAS bf16* Kp, const GAS bf16* Vp, int VP, unsigned koff, unsigned voff, int n, int base, const LAS int* list,
                                        int KA, int KB, int W, unsigned M0, unsigned M1, unsigned M2, unsigned M3, int t, int fr, int fq, int lane,
                                        LAS float* wl, const float (&slope2)[4], f32x4 (&o)[4][4], float (&m)[4], float (&l)[4]) {
    if (n <= 0) return;
    bf16x8 kf[2][2], vf[4];
    int k0 = GEN == 0 ? 0 : (GEN == 1 ? base : list[0]);
    ldK(kf, Kp, k0, koff);
    if (MODE != 1) ldV(vf, Vp, VP, k0, voff);
    float carry = 0.f;
#pragma unroll 1
    for (int i = 0; i < n; ++i) {
        const int inx = (i + 1 < n) ? i + 1 : i;
        const int k0n = GEN == 0 ? 32 * inx : (GEN == 1 ? base - 32 * inx : list[inx]);
        bool extra = true;
        if (GEN == 2) { const int j = k0 >> 6, f = j & 3; const unsigned Mw = f == 0 ? M0 : f == 1 ? M1 : f == 2 ? M2 : M3; extra = (Mw >> (j >> 2)) & 1u; }
        float dist[2][4];
#pragma unroll
        for (int kt = 0; kt < 2; ++kt)
#pragma unroll
            for (int e = 0; e < 4; ++e) { const int nn = k0 + 8 * fq + 4 * kt + e, d = t - (KA * nn + KB); dist[kt][e] = (extra && (unsigned)d <= (unsigned)W) ? (float)d : __builtin_inff(); }
        f32x4 s[2][4];
        {
            unsigned qa = (unsigned)lane * 16u; asm volatile("" : "+v"(qa));
            const LAS char* qb = (const LAS char*)wl + qa;
#pragma unroll
            for (int h = 0; h < 4; ++h) {
                const bf16x8 q0 = *(const LAS bf16x8*)(qb + (h * 2 + 0) * 1024), q1 = *(const LAS bf16x8*)(qb + (h * 2 + 1) * 1024);
#pragma unroll
                for (int kt = 0; kt < 2; ++kt) { f32x4 c;
#pragma unroll
                    for (int e = 0; e < 4; ++e) c[e] = -slope2[h] * dist[kt][e] - m[h];
                    c = __builtin_amdgcn_mfma_f32_16x16x32_bf16(kf[kt][0], q0, c, 0, 0, 0);
                    c = __builtin_amdgcn_mfma_f32_16x16x32_bf16(kf[kt][1], q1, c, 0, 0, 0); s[kt][h] = c; }
            }
        }
        ldK(kf, Kp, k0n, koff);
        if (MODE == 2) {
#pragma unroll
            for (int h = 0; h < 4; ++h)
#pragma unroll
                for (int kt = 0; kt < 2; ++kt)
#pragma unroll
                    for (int e = 0; e < 4; ++e) s[kt][h][e] = fexp2(s[kt][h][e]) * l[h];
            float as0[4], as1[4];
#pragma unroll
            for (int e = 0; e < 4; ++e) { as0[e] = (s[0][0][e] + s[0][1][e]) + (s[0][2][e] + s[0][3][e]); as1[e] = (s[1][0][e] + s[1][1][e]) + (s[1][2][e] + s[1][3][e]); }
            const float r1 = __shfl(as1[3], (lane + 48) & 63);
            const float y0 = fq > 0 ? r1 : carry, y1 = as0[3]; carry = r1;
            wl[2048 + fr * 128 + 8 * i + 2 * fq]     = ((as0[0] + as0[1]) + (as0[2] + as0[3])) + y0;
            wl[2048 + fr * 128 + 8 * i + 2 * fq + 1] = ((as1[0] + as1[1]) + (as1[2] + as1[3])) + y1;
        } else {
            float tmx[4]; bool grow = false;
#pragma unroll
            for (int h = 0; h < 4; ++h) {
                float tm = fmaxf(fmaxf(fmaxf(s[0][h][0], s[0][h][1]), fmaxf(s[0][h][2], s[0][h][3])), fmaxf(fmaxf(s[1][h][0], s[1][h][1]), fmaxf(s[1][h][2], s[1][h][3])));
                tm = fmaxf(tm, __shfl_xor(tm, 16)); tm = fmaxf(tm, __shfl_xor(tm, 32));
                tmx[h] = tm; grow = grow || (tm > 0.f);
            }
            if (__any(grow)) {
#pragma unroll
                for (int h = 0; h < 4; ++h) { const float dl = fmaxf(tmx[h], 0.f), alpha = fexp2(-dl); m[h] += dl; l[h] *= alpha;
#pragma unroll
                    for (int kt = 0; kt < 2; ++kt)
#pragma unroll
                        for (int e = 0; e < 4; ++e) s[kt][h][e] -= dl;
                    if (MODE == 0) {
#pragma unroll
                        for (int dt = 0; dt < 4; ++dt) o[dt][h] = o[dt][h] * alpha; } }
            }
#pragma unroll
            for (int h = 0; h < 4; ++h) { float ps = 0.f;
#pragma unroll
                for (int kt = 0; kt < 2; ++kt)
#pragma unroll
                    for (int e = 0; e < 4; ++e) { const float p = fexp2(s[kt][h][e]); s[kt][h][e] = p; ps += p; }
                l[h] += ps; }
        }
        if (MODE != 1) {
            bf16x8 pf[4];
#pragma unroll
            for (int h = 0; h < 4; ++h) { const v4u w = pack8(s[0][h], s[1][h]); pf[h] = __builtin_bit_cast(bf16x8, w); }
#pragma unroll
            for (int dt = 0; dt < 4; ++dt)
#pragma unroll
                for (int h = 0; h < 4; ++h) o[dt][h] = __builtin_amdgcn_mfma_f32_16x16x32_bf16(vf[dt], pf[h], o[dt][h], 0, 0, 0);
            ldV(vf, Vp, VP, k0n, voff);
        }
        k0 = k0n;
    }
}
__device__ __forceinline__ void attn_prompt_unit2(const Ptrs& P, int bg, int tt, LAS float* wl, int lane_in) {
    int lane = lane_in; asm volatile("" : "+v"(lane));
    const int fr = lane & 15, fq = lane >> 4, b = bg >> 2, g = bg & 3, t0 = 16 * tt, t = t0 + fr, row = b * SEQ + t;
    const float* GT = WSP(float, WS_GATES) + (size_t)row * 48 + g * 12;
    const GAS bf16* KC = (const GAS bf16*)WSP(bf16, WS_KC) + (size_t)bg * 512 * 64; const GAS bf16* VCT = (const GAS bf16*)WSP(bf16, WS_VCT) + (size_t)bg * 64 * 512;
    const GAS bf16* SK = (const GAS bf16*)WSP(bf16, WS_SK) + (size_t)bg * SEQ * 64; const GAS bf16* SVT = (const GAS bf16*)WSP(bf16, WS_SVT) + (size_t)bg * 64 * SEQ;
    const GAS bf16* WK = (const GAS bf16*)WSP(bf16, WS_WK) + (size_t)bg * SEQ * 64; const GAS bf16* WVT = (const GAS bf16*)WSP(bf16, WS_WVT) + (size_t)bg * 64 * SEQ;
    GAS float* OA = (GAS float*)WSP(float, WS_OACC) + (size_t)row * DM + 256 * g + 4 * fq;
    float slope2[4];
    { const GAS bf16* Q = (const GAS bf16*)WSP(bf16, WS_Q) + (size_t)row * DM + (4 * g) * 64 + 8 * fq;
#pragma unroll
      for (int h = 0; h < 4; ++h) { slope2[h] = fexp2(-0.5f * (float)(4 * g + h + 1)) * LOG2E;
#pragma unroll
          for (int ks = 0; ks < 2; ++ks) *(LAS v4u*)((LAS char*)wl + (h * 2 + ks) * 1024 + lane * 16) = *(const GAS v4u*)(Q + h * 64 + 32 * ks); } }
    f32x4 o[4][4]; float m[4], l[4];
    const int BIG = 1 << 30;
    const unsigned koff = (unsigned)((8 * (fr >> 2) + (fr & 3)) * 64 + 8 * fq) * 2u, voffc = (unsigned)(fr * 32 + 8 * fq) * 2u, voffs = voffc;
    const int nst = (tt >> 5) + 1;
#pragma unroll
    for (int h = 0; h < 4; ++h) { m[h] = 0.f; l[h] = 0.f; }
    att_run<1, 0>(KC, VCT, 512, koff, voffc, nst, 0, nullptr, 16, 31, BIG, 0u, 0u, 0u, 0u, t, fr, fq, lane, wl, slope2, o, m, l);
#pragma unroll
    for (int h = 0; h < 4; ++h) { float lt = l[h]; lt += __shfl_xor(lt, 16); lt += __shfl_xor(lt, 32); l[h] = lt > 0.f ? 1.0f / lt : 0.f;
#pragma unroll
        for (int dt = 0; dt < 4; ++dt) o[dt][h] = (f32x4){0.f, 0.f, 0.f, 0.f}; }
    att_run<2, 0>(KC, VCT, 512, koff, voffc, nst, 0, nullptr, 16, 31, BIG, 0u, 0u, 0u, 0u, t, fr, fq, lane, wl, slope2, o, m, l);
#pragma unroll
    for (int h = 0; h < 4; ++h) { const float gc = GT[h * 3 + 0];
#pragma unroll
        for (int dt = 0; dt < 4; ++dt) *(GAS f32x4*)(OA + h * 64 + 16 * dt) = o[dt][h] * gc; }
    const int qblk = t0 >> 6;
    unsigned M0, M1, M2, M3;
    {
        float cv[32];
#pragma unroll
        for (int q = 0; q < 32; ++q) { const int j = 4 * q + fq; const float x = wl[2048 + fr * 128 + j];
            const bool forced = (j == 0) | (j == qblk) | (j == qblk - 1); cv[q] = (j <= qblk) ? (forced ? x + 1e4f : x) : -1.f; }
        unsigned mask = 0u;
#pragma unroll 1
        for (int r = 0; r < 16; ++r) {
            float bv = cv[0]; int bq = 0;
#pragma unroll
            for (int q = 1; q < 32; ++q) if (cv[q] > bv) { bv = cv[q]; bq = q; }
            int bj = 4 * bq + fq;
#pragma unroll
            for (int off = 16; off <= 32; off <<= 1) { const float ov = __shfl_xor(bv, off); const int oj = __shfl_xor(bj, off); if (ov > bv || (ov == bv && oj < bj)) { bv = ov; bj = oj; } }
            const bool mine = (bv >= 0.f) && ((bj & 3) == fq); const int wq = bj >> 2;
#pragma unroll
            for (int q = 0; q < 32; ++q) if (mine && q == wq) cv[q] = -2.f;
            if (mine) mask |= 1u << wq;
        }
        M0 = __shfl(mask, fr); M1 = __shfl(mask, fr + 16); M2 = __shfl(mask, fr + 32); M3 = __shfl(mask, fr + 48);
    }
    int nlist = 0;
    {
        unsigned U0 = M0, U1 = M1, U2 = M2, U3 = M3;
#pragma unroll
        for (int off = 1; off < 16; off <<= 1) { U0 |= __shfl_xor(U0, off); U1 |= __shfl_xor(U1, off); U2 |= __shfl_xor(U2, off); U3 |= __shfl_xor(U3, off); }
        U0 = __builtin_amdgcn_readfirstlane(U0); U1 = __builtin_amdgcn_readfirstlane(U1); U2 = __builtin_amdgcn_readfirstlane(U2); U3 = __builtin_amdgcn_readfirstlane(U3);
        LAS int* lst = (LAS int*)(wl + 2048);
#pragma unroll 1
        for (int j = qblk; j >= 0; --j) { const int f = j & 3; const unsigned Uw = f == 0 ? U0 : f == 1 ? U1 : f == 2 ? U2 : U3;
            if ((Uw >> (j >> 2)) & 1u) { if (lane == 0) { lst[nlist] = 64 * j + 32; lst[nlist + 1] = 64 * j; } nlist += 2; } }
    }
#pragma unroll
    for (int h = 0; h < 4; ++h) { m[h] = 0.f; l[h] = 0.f;
#pragma unroll
        for (int dt = 0; dt < 4; ++dt) o[dt][h] = (f32x4){0.f, 0.f, 0.f, 0.f}; }
    att_run<0, 2>(SK, SVT, SEQ, koff, voffs, nlist, 0, (const LAS int*)(wl + 2048), 1, 0, BIG, M0, M1, M2, M3, t, fr, fq, lane, wl, slope2, o, m, l);
    asm volatile("s_waitcnt vmcnt(0)" ::: "memory");
#pragma unroll
    for (int h = 0; h < 4; ++h) { float lt = l[h]; lt += __shfl_xor(lt, 16); lt += __shfl_xor(lt, 32); const float sc = lt > 0.f ? GT[h * 3 + 1] / lt : 0.f;
#pragma unroll
        for (int dt = 0; dt < 4; ++dt) { GAS f32x4* p = (GAS f32x4*)(OA + h * 64 + 16 * dt); *p = *p + o[dt][h] * sc; } }
#pragma unroll
    for (int h = 0; h < 4; ++h) { m[h] = 0.f; l[h] = 0.f;
#pragma unroll
        for (int dt = 0; dt < 4; ++dt) o[dt][h] = (f32x4){0.f, 0.f, 0.f, 0.f}; }
    { const int kend = (t0 > 512 ? (t0 - 512) : 0) & ~31, ktop = t0 & ~31;
      att_run<0, 1>(WK, WVT, SEQ, koff, voffs, ((ktop - kend) >> 5) + 1, ktop, nullptr, 1, 0, 512, 0u, 0u, 0u, 0u, t, fr, fq, lane, wl, slope2, o, m, l); }
    asm volatile("s_waitcnt vmcnt(0)" ::: "memory");
    GAS bf16* O = (GAS bf16*)WSP(bf16, WS_O) + (size_t)row * DM + 256 * g + 4 * fq;
#pragma unroll
    for (int h = 0; h < 4; ++h) { float lt = l[h]; lt += __shfl_xor(lt, 16); lt += __shfl_xor(lt, 32); const float sc = lt > 0.f ? GT[h * 3 + 2] / lt : 0.f;
#pragma unroll
        for (int dt = 0; dt < 4; ++dt) { const f32x4 v = *(const GAS f32x4*)(OA + h * 64 + 16 * dt) + o[dt][h] * sc;
            v2u w; w.x = pk2(v[0], v[1]); w.y = pk2(v[2], v[3]); *(GAS v2u*)(O + h * 64 + 16 * dt) = w; } }
}

#define ATTN_UNIT attn_prompt_unit2
struct Args { const void* in[31]; float* out; unsigned char* ws; int ph_lo, ph_hi; };
constexpr int N_PHASES = 2 + 1 + 12 + 2 * 1 + 2 * 1 + 12 + 1;

__global__ void __launch_bounds__(NWAVES * 64, 2) yoco_fwd(Args args) {
    extern __shared__ __attribute__((aligned(16))) unsigned char lds_raw[];
    LAS unsigned char* lds = (LAS unsigned char*)lds_raw;
    const int tid0 = threadIdx.x, wave = __builtin_amdgcn_readfirstlane(tid0 >> 6);
    const int G = gridDim.x; const int bx = blockIdx.x; const int vcu = (G % 8 == 0) ? (bx % 8) * (G / 8) + bx / 8 : bx;
    const int gw0 = vcu * NWAVES + wave, NGW = G * NWAVES;

    for (int u = tid0; u < (LDS_BYTES - LDSCTL_OFF) / 4; u += NWAVES * 64) ((LAS unsigned*)(lds + LDSCTL_OFF))[u] = 0u;
    __syncthreads();
    volatile LAS unsigned* MISC = (volatile LAS unsigned*)(lds + MISC_OFF);
    unsigned* barw = (unsigned*)(args.ws + WS_CTL) + CW_BAR;
    XcdBarrier bar; bar.bar = barw; bar.x = 0; bar.st = nullptr;
    const int lo = args.ph_lo, hi = args.ph_hi;
    if (hi - lo > 1) bar = xcd_barrier_post(barw, MISC + 8);
    int pid = 0;
#define IN_PH() (lo <= pid && pid < hi)
#define NIN() NormIn{P.ws, sl > 0 ? sl - 1 : 0, sl, sl > 0 ? 1 : 0}
#define LOADP() int tid = tid0; asm volatile("" : "+v"(tid)); const int lane = tid & 63; int gw = gw0; asm volatile("" : "+s"(gw)); (void)lane; (void)gw; Ptrs P; load_ptrs(P); const f16* X = WSP(f16, WS_X); bf16* H = WSP(bf16, WS_H); const float* MOD = WSP(float, WS_MOD); (void)X; (void)H; (void)MOD
#define END_PH() do { if (lo <= pid && pid + 1 < hi) xcd_barrier(bar); ++pid; } while (0)


    if (IN_PH()) { LOADP(); prologue_phase(P, lds, gw, NGW, wave, lane, tid); }
    END_PH();
    if (IN_PH()) { LOADP();
        run_gemm(lds, WSP(bf16, WS_SC), WSP(bf16, WS_WMOD), 256, NMOD, DM, FMod{WSP(float, WS_MOD), P.ada_b, P.kv_ada_b, P.final_ada_b, WSP(bf16, WS_SHB)});
        run_gemm(lds, WSP(bf16, WS_ACMP), WSP(bf16, WS_WC1), 65536, 512, 1024, FBf16{WSP(bf16, WS_TS), 512});
        run_gemm(lds, WSP(bf16, WS_ACMP) + (size_t)65536 * 1024, WSP(bf16, WS_WC1) + (size_t)512 * 1024, 65536, 512, 1024, FBf16{WSP(bf16, WS_TS) + (size_t)65536 * 512, 512});
    }
    END_PH();

    for (int sl = 0; sl < 12; ++sl) {
        const int l = sl / 3, sub = sl - 3 * l;
        if (sl == 0) {
            if (IN_PH()) { LOADP();
                norm_phase<false>(X, P.norm_g, MOD, 0, DM, H, nullptr, gw, NGW, lane);
                { pg8::Gemm g{WSP(bf16, WS_SHB), WSP(bf16, WS_WGU), 13 * 256, 0, DM}; int cb = (int)blockIdx.x; asm volatile("" : "+s"(cb)); ShiftOrder S{(int)gridDim.x, cb}; Epi8<FB2> E{FB2{WSP(float, WS_B2)}};
                  pg8::gemm_phase<Epi8<FB2>, ShiftOrder, true, true>(lds, g, S, E); }
                for (int u = gw; u < 2 * 512 * 8; u += NGW) { const int kv = u >> 12, r = u & 4095, bg = r >> 3, rt = r & 7;
                    cmp_finish_unit<2>(WSP(bf16, WS_TS) + (size_t)kv * 65536 * 512, WSP(float, WS_CBIAS) + kv * 256, WSP(bf16, WS_WC2) + kv * 64 * 256,
                                       kv == 0 ? (void*)WSP(float, WS_KCS) : (void*)WSP(float, WS_VCS), 128, bg, rt, lane); }
            }
            END_PH();
        }
        if (sub != 1) {
            const int s = sub >> 1;
            if (IN_PH()) { LOADP();
                if (sl == 6) {
                    run_gemm2(lds, WSP(bf16, WS_HKV), WSP(bf16, WS_WKV), NKVP, NKVP, DM, FKv{P.out, WSP(bf16, WS_KCIN), NormIn{P.ws, 5, 12, 1}}, 0, 0);
                    run_gemm2(lds, H, WSP(bf16, WS_WGU) + (size_t)(l * 2 + s) * 5632 * 1024, 5632, 5632, DM, FSwiglu{WSP(bf16, WS_HID), NIN()}, (int)gridDim.x / 2, 0);
                } else
                run_gemm2(lds, H, WSP(bf16, WS_WGU) + (size_t)(l * 2 + s) * 5632 * 1024, 5632, 5632, DM, FSwiglu{WSP(bf16, WS_HID), NIN()}); }
            END_PH();
        } else if (l < 2) {
            if (IN_PH()) { LOADP(); run_gemm2(lds, H, WSP(bf16, WS_WUV) + (size_t)l * 6144 * 1024, 6144, 6144, DM, FGelu{WSP(bf16, WS_Z), NIN(), WSP(float, WS_CTL) + CW_VS + (size_t)l * RT * 2}); }
            END_PH();
            if (IN_PH()) { LOADP(); spatial2_phase(P, l, lds, wave, lane, tid, gw, NGW); }
            END_PH();
        } else {
            if (IN_PH()) { LOADP();
                if (sl == 7) {
                    for (int u = gw; u < 2 * 8 * 32; u += NGW) { const int kv = u >> 8, r = u & 255, bg = r >> 5, rt = r & 31;
                        if (kv == 0) cmp_finish_unit<0>(WSP(bf16, WS_TK), WSP(float, WS_CBIAS), WSP(bf16, WS_WC2), (void*)WSP(bf16, WS_KC), 512, bg, rt, lane);
                        else cmp_finish_unit<1>(WSP(bf16, WS_TV), WSP(float, WS_CBIAS) + 256, WSP(bf16, WS_WC2) + 64 * 256, (void*)WSP(bf16, WS_VCT), 512, bg, rt, lane); }
                }
                run_gemm2(lds, H, WSP(bf16, WS_WQG) + (size_t)(l - 2) * NQG * 1024, NQG, 1072, DM, FQg{WSP(bf16, WS_Q), WSP(float, WS_GATES), NIN()}); }
            END_PH();
            if (IN_PH()) { LOADP(); LAS float* wl = (LAS float*)(lds + (gw & 7) * 16384);
                {
                    int r = 0;
                    for (;;) {
                        const int q = ((int)(xb_xcc_id() & 7u) + r) & 7;
                        unsigned idx = 0u; if (lane == 0) idx = __hip_atomic_fetch_add((unsigned*)(P.ws + WS_CTL) + CW_QUEUE + 64 * (8 * (l - 2) + q), 1u, __ATOMIC_RELAXED, __HIP_MEMORY_SCOPE_AGENT);
                        idx = (unsigned)__builtin_amdgcn_readfirstlane((int)idx);
                        if (idx >= 64u + 512u) { if (++r == 8) break; continue; }
                        if (idx < 64u) { const int id = q * 64 + (int)idx; attn_sample_unit(P, id >> 2, id & 3, wl, lane); }
                        else ATTN_UNIT(P, q, 511 - ((int)idx - 64), wl, lane);
                    }
                }
            }
            END_PH();
        }
        if (IN_PH()) { LOADP();
            const bf16* A2 = sub != 1 ? WSP(bf16, WS_HID) : (l < 2 ? WSP(bf16, WS_P) : WSP(bf16, WS_O));
            const bf16* B2 = sub != 1 ? WSP(bf16, WS_WDN) + (size_t)(l * 2 + (sub >> 1)) * 1024 * DFF : (l < 2 ? WSP(bf16, WS_WOUT) + (size_t)l * 1024 * DV : WSP(bf16, WS_WO) + (size_t)(l - 2) * 1024 * 1024);
            const int K2 = sub != 1 ? DFF : (l < 2 ? DV : DM);
            if (sl == 6) {
                run_gemm(lds, WSP(bf16, WS_KCIN), WSP(bf16, WS_WC1), 4096, 512, 1024, FBf16{WSP(bf16, WS_TK), 512}, 64);
                run_gemm(lds, WSP(bf16, WS_VCIN), WSP(bf16, WS_WC1) + (size_t)512 * 1024, 4096, 512, 1024, FBf16{WSP(bf16, WS_TV), 512}, 32);
            }
            const int sn = sl + 1, ln = sn / 3, subn = sn - 3 * ln;
            const bool more = sl < 11;
            run_gemm2(lds, A2, B2, DM, DM, K2, FResid{P.ws, l * 9216 + (sub * 3 + 2) * DM, sub != 1 ? 0.5f : 1.0f, more ? sn : -1, ln * 9216 + (subn * 3 + 1) * DM, sl == 5 ? 12 : -1, MODKV + DM, more ? sl : -1});
        }
        END_PH();
    }
    if (IN_PH()) { LOADP(); norm_phase<true>(X, P.final_g, MOD, MODFIN, MODFIN + DM, nullptr, P.out, gw, NGW, lane); }
    ++pid;
#undef IN_PH
#undef END_PH
}

extern "C" void kernel_launch(void* const* d_in, const int* in_sizes, int n_in, void* d_out, int out_size, void* d_ws, size_t ws_size, hipStream_t stream) {
    static int grid = 0;
    if (grid == 0) {
        if (n_in != 31 || (size_t)out_size != OUT_TOTAL || ws_size < WS_END) { fprintf(stderr, "kernel_launch: unexpected shapes (n_in %d, out %d, ws %zu need %zu); nothing launched\n", n_in, out_size, ws_size, (size_t)WS_END); grid = -1; return; }
        int dev = 0, cus = 0, per_cu = 0;
        if (hipGetDevice(&dev) != hipSuccess || hipDeviceGetAttribute(&cus, hipDeviceAttributeMultiprocessorCount, dev) != hipSuccess) { grid = -1; return; }
        if (hipFuncSetAttribute((const void*)yoco_fwd, hipFuncAttributeMaxDynamicSharedMemorySize, LDS_BYTES) != hipSuccess) { fprintf(stderr, "kernel_launch: hipFuncSetAttribute failed\n"); grid = -1; return; }
        if (hipOccupancyMaxActiveBlocksPerMultiprocessor(&per_cu, (const void*)yoco_fwd, NWAVES * 64, LDS_BYTES) != hipSuccess || per_cu < 1) { fprintf(stderr, "kernel_launch: occupancy query says %d blocks per CU\n", per_cu); }
        (void)hipGetLastError();
        grid = cus;
    }
    if (grid < 0) return;
    if (hipMemsetAsync((char*)d_ws + WS_CTL, 0, CTL_ZERO_BYTES, stream) != hipSuccess) return;
    Args a{};
    for (int i = 0; i < 31; ++i) a.in[i] = d_in[i];
    a.out = (float*)d_out; a.ws = (unsigned char*)d_ws;
#if ONE_LAUNCH
    a.ph_lo = 0; a.ph_hi = N_PHASES;
    hipLaunchKernelGGL(yoco_fwd, dim3(grid), dim3(NWAVES * 64), LDS_BYTES, stream, a);
#else
    for (int p = 0; p < N_PHASES; ++p) { a.ph_lo = p; a.ph_hi = p + 1; hipLaunchKernelGGL(yoco_fwd, dim3(grid), dim3(NWAVES * 64), LDS_BYTES, stream, a); }
#endif
}
```

```cpp
#include <hip/hip_runtime.h>
#include <cstdio>
#include <cstdint>
#include <cmath>
namespace pg8 {
#define PG8_LAS __attribute__((address_space(3)))
typedef unsigned short bf16_t;
typedef short bf16x8 __attribute__((ext_vector_type(8)));
typedef float f32x4 __attribute__((ext_vector_type(4)));
typedef unsigned u32x4 __attribute__((ext_vector_type(4)));
constexpr int BM = 256, BK = 64, HALF = 128, HTB = HALF * BK * 2  , STAGE_BYTES = 8 * HTB, NXCD = 8, WGM = 8;

__host__ __device__ __forceinline__ int lds_byte(int r, int c) { const int st = (r >> 4) * 2 + (c >> 5), rr = r & 15, cc = c & 31, ob = rr * 64 + cc * 2; return st * 1024 + (ob ^ (((ob >> 9) & 1) << 5)); }
__host__ __device__ __forceinline__ void stage_rc(int b, int& R, int& C) { const int st = b / 1024, sb = b % 1024, swz = sb ^ (((sb >> 9) & 1) << 5); R = (st >> 1) * 16 + swz / 64; C = (st & 1) * 32 + (swz % 64) / 2; }
__host__ __device__ __forceinline__ int perm32(int rho) { const int n = rho >> 4, i = rho & 15; return 8 * (i >> 2) + 4 * n + (i & 3); }

struct Unit { int pm, pn; };
struct Gemm { const bf16_t* A; const bf16_t* Bt; int M, N, K; };

struct StaticOrder {
    int nM, nN, nwg, G, c;
    __host__ __device__ void init(int M, int N, int G_, int c_) { nM = M / BM; nN = N / BM; nwg = nM * nN; G = G_; c = c_; }
    __host__ __device__ bool next(int i, Unit& u) const {
        const long L = (long)i * G + c; if (L >= nwg) return false;
        int wgid = (int)L; { const int q = nwg / NXCD, r = nwg % NXCD, xcd = wgid % NXCD, off = wgid / NXCD; wgid = (xcd < r ? xcd * (q + 1) : r * (q + 1) + (xcd - r) * q) + off; }
        const int nig = WGM * nN, gid = wgid / nig, fm = gid * WGM, gsz = (nM - fm) < WGM ? (nM - fm) : WGM;
        u.pm = fm + ((wgid % nig) % gsz); u.pn = (wgid % nig) / gsz; return true;
    }
    __device__ __forceinline__ void a_ready(const Unit&) const {}
    __device__ __forceinline__ void done(const Unit&) const {}
};

__device__ __forceinline__ unsigned cvt_pk_bf16(float lo, float hi) { unsigned r; asm volatile("v_cvt_pk_bf16_f32 %0, %1, %2" : "=v"(r) : "v"(lo), "v"(hi)); return r; }
typedef float f32x2 __attribute__((ext_vector_type(2)));
template <class Epi, class Sched, bool ALIGN_EPI = false, bool SP2 = false>
__device__ __forceinline__ void gemm_phase(PG8_LAS unsigned char* lds, const Gemm g, const Sched& S, const Epi& E) {
    int tid_raw = threadIdx.x; asm volatile("" : "+v"(tid_raw));
    const int tid = tid_raw, wid = __builtin_amdgcn_readfirstlane(tid >> 6), lane = tid & 63, wr = wid >> 2, wc = wid & 3, fr = lane & 15, fq = lane >> 4;
    const int K = g.K, nt = K / BK;
    unsigned voffA[2], voffB[2];
#pragma unroll
    for (int i = 0; i < 2; ++i) { int R, C; stage_rc(tid * 16 + i * 8192, R, C); const int Rb = Epi::PERM ? ((R & ~31) + perm32(R & 31)) : R;
        voffA[i] = (unsigned)(R * K + C) * 2u; voffB[i] = (unsigned)(Rb * K + C) * 2u; }
    const size_t kstep = (size_t)(BK * 2);
    const size_t hstep = (size_t)HALF * K * 2;
    const size_t tstep = 2 * hstep;
    const unsigned ldsw = (unsigned)wid * 1024u;
    const int aoff = lds_byte(wr * 64 + fr, fq * 8), boff = lds_byte(wc * 32 + fr, fq * 8);
#define PG8_SA(b, h) (((b) * 2 + (h)) * HTB)
#define PG8_SB(b, h) ((4 + (b) * 2 + (h)) * HTB)
#define PG8_STAGE(bufoff, gbase, voff) do { _Pragma("unroll") for (int _i = 0; _i < 2; ++_i) \
        __builtin_amdgcn_global_load_lds((const unsigned*)((const char*)(gbase) + (voff)[_i]), (PG8_LAS unsigned*)(lds + (bufoff) + ldsw + _i * 8192), 16, 0, 0); } while (0)
#define PG8_LDA(dst, b, h) do { _Pragma("unroll") for (int m = 0; m < 4; ++m) _Pragma("unroll") for (int k = 0; k < 2; ++k) dst[m][k] = *(const PG8_LAS bf16x8*)(lds + PG8_SA(b, h) + aoff + m * 2048 + k * 1024); } while (0)
#define PG8_LDB(dst, b, h) do { _Pragma("unroll") for (int n = 0; n < 2; ++n) _Pragma("unroll") for (int k = 0; k < 2; ++k) dst[n][k] = *(const PG8_LAS bf16x8*)(lds + PG8_SB(b, h) + boff + n * 2048 + k * 1024); } while (0)
#define PG8_MMA(ai, bj, At, Bt) do { __builtin_amdgcn_s_setprio(1); _Pragma("unroll") for (int m = 0; m < 4; ++m) _Pragma("unroll") for (int n = 0; n < 2; ++n) _Pragma("unroll") for (int k = 0; k < 2; ++k) \
        acc[ai][bj][m][n] = __builtin_amdgcn_mfma_f32_16x16x32_bf16(Bt[n][k], At[m][k], acc[ai][bj][m][n], 0, 0, 0); __builtin_amdgcn_s_setprio(0); } while (0)
#define PG8_WAIT_V(n) asm volatile("s_waitcnt vmcnt(" #n ")" ::: "memory")
#define PG8_WAIT_L(n) asm volatile("s_waitcnt lgkmcnt(" #n ")" ::: "memory")
#define PG8_BAR __builtin_amdgcn_s_barrier()
#define PG8_SCHED __builtin_amdgcn_sched_barrier(0)
    Unit cur, nxt; int ui = 0;
    if (!S.next(0, cur)) return;
    f32x4 acc[2][2][4][2];
#pragma unroll
    for (int a = 0; a < 2; ++a)
#pragma unroll
        for (int b = 0; b < 2; ++b)
#pragma unroll
            for (int m = 0; m < 4; ++m)
#pragma unroll
                for (int n = 0; n < 2; ++n) acc[a][b][m][n] = (f32x4){0.f, 0.f, 0.f, 0.f};
    bf16x8 At[4][2], B0[2][2], B1[2][2];
    const char* cA = (const char*)g.A + (size_t)cur.pm * tstep; const char* cB = (const char*)g.Bt + (size_t)cur.pn * tstep;
    S.a_ready(cur);
    if constexpr (SP2) {
        PG8_STAGE(PG8_SB(0, 0), cB, voffB); PG8_STAGE(PG8_SB(0, 1), cB + hstep, voffB); PG8_STAGE(PG8_SA(0, 0), cA, voffA); PG8_STAGE(PG8_SA(0, 1), cA + hstep, voffA);
        if (wr == 1) PG8_BAR;
        PG8_WAIT_V(2); PG8_BAR;
        PG8_STAGE(PG8_SB(1, 0), cB + kstep, voffB); PG8_STAGE(PG8_SA(1, 0), cA + kstep, voffA); PG8_STAGE(PG8_SB(1, 1), cB + hstep + kstep, voffB);
        PG8_WAIT_V(6); PG8_BAR;
    } else {
        PG8_STAGE(PG8_SB(0, 0), cB, voffB); PG8_STAGE(PG8_SA(0, 0), cA, voffA); PG8_STAGE(PG8_SB(0, 1), cB + hstep, voffB); PG8_STAGE(PG8_SA(0, 1), cA + hstep, voffA);
        if (wr == 1) PG8_BAR;
        PG8_WAIT_V(4); PG8_BAR;
        PG8_STAGE(PG8_SB(1, 0), cB + kstep, voffB); PG8_STAGE(PG8_SA(1, 0), cA + kstep, voffA); PG8_STAGE(PG8_SB(1, 1), cB + hstep + kstep, voffB);
        PG8_WAIT_V(6); PG8_BAR;
    }
    for (;;) {
        const bool has_next = S.next(ui + 1, nxt);
        const char* nA = has_next ? (const char*)g.A + (size_t)nxt.pm * tstep : cA; const char* nB = has_next ? (const char*)g.Bt + (size_t)nxt.pn * tstep : cB;
        for (int t = 0; t < nt; t += 2) {
            const bool last = (t == nt - 2);
            const char* a1 = cA + (size_t)(t + 1) * kstep;
            const char* a2 = last ? nA : cA + (size_t)(t + 2) * kstep; const char* b2 = last ? nB : cB + (size_t)(t + 2) * kstep;
            const char* a3 = a2 + kstep; const char* b3 = b2 + kstep;
            if (last && has_next) S.a_ready(nxt);
            if constexpr (SP2) {
            PG8_LDB(B0, 0, 0); PG8_LDB(B1, 0, 1); PG8_SCHED; PG8_LDA(At, 0, 0); PG8_STAGE(PG8_SA(1, 1), a1 + hstep, voffA);
            PG8_WAIT_V(8); PG8_WAIT_L(0); PG8_BAR; PG8_MMA(0, 0, At, B0); PG8_MMA(0, 1, At, B1); PG8_BAR; PG8_SCHED;
            PG8_LDA(At, 0, 1); PG8_STAGE(PG8_SB(0, 0), b2, voffB); PG8_STAGE(PG8_SB(0, 1), b2 + hstep, voffB); PG8_STAGE(PG8_SA(0, 0), a2, voffA);
            PG8_WAIT_V(8); PG8_WAIT_L(0); PG8_BAR; PG8_MMA(1, 0, At, B0); PG8_MMA(1, 1, At, B1); PG8_BAR; PG8_SCHED;
            PG8_LDB(B0, 1, 0); PG8_LDB(B1, 1, 1); PG8_SCHED; PG8_LDA(At, 1, 0); PG8_STAGE(PG8_SA(0, 1), a2 + hstep, voffA);
            PG8_WAIT_V(8); PG8_WAIT_L(0); PG8_BAR; PG8_MMA(0, 0, At, B0); PG8_MMA(0, 1, At, B1); PG8_BAR; PG8_SCHED;
            PG8_LDA(At, 1, 1); PG8_STAGE(PG8_SB(1, 0), b3, voffB); PG8_STAGE(PG8_SB(1, 1), b3 + hstep, voffB); PG8_STAGE(PG8_SA(1, 0), a3, voffA);
            PG8_WAIT_V(8); PG8_WAIT_L(0); PG8_BAR; PG8_MMA(1, 0, At, B0); PG8_MMA(1, 1, At, B1); PG8_BAR; PG8_SCHED;
            } else {
            PG8_LDB(B0, 0, 0); PG8_SCHED; PG8_LDA(At, 0, 0); PG8_STAGE(PG8_SA(1, 1), a1 + hstep, voffA);
            PG8_WAIT_L(8); PG8_BAR; PG8_WAIT_L(0); PG8_MMA(0, 0, At, B0); PG8_BAR; PG8_SCHED;
            PG8_LDB(B1, 0, 1); PG8_STAGE(PG8_SB(0, 0), b2, voffB);
            PG8_BAR; PG8_WAIT_L(0); PG8_MMA(0, 1, At, B1); PG8_BAR;
            PG8_LDA(At, 0, 1); PG8_STAGE(PG8_SA(0, 0), a2, voffA);
            PG8_BAR; PG8_WAIT_L(0); PG8_MMA(1, 0, At, B0); PG8_BAR; PG8_SCHED;
            PG8_STAGE(PG8_SB(0, 1), b2 + hstep, voffB);
            PG8_WAIT_V(6); PG8_BAR; PG8_MMA(1, 1, At, B1); PG8_BAR;
            PG8_LDB(B0, 1, 0); PG8_SCHED; PG8_LDA(At, 1, 0); PG8_STAGE(PG8_SA(0, 1), a2 + hstep, voffA);
            PG8_WAIT_L(8); PG8_BAR; PG8_WAIT_L(0); PG8_MMA(0, 0, At, B0); PG8_BAR; PG8_SCHED;
            PG8_LDB(B1, 1, 1); PG8_STAGE(PG8_SB(1, 0), b3, voffB);
            PG8_BAR; PG8_WAIT_L(0); PG8_MMA(0, 1, At, B1); PG8_BAR;
            PG8_LDA(At, 1, 1); PG8_STAGE(PG8_SA(1, 0), a3, voffA);
            PG8_BAR; PG8_WAIT_L(0); PG8_MMA(1, 0, At, B0); PG8_BAR; PG8_SCHED;
            PG8_STAGE(PG8_SB(1, 1), b3 + hstep, voffB);
            PG8_WAIT_V(6); PG8_BAR; PG8_MMA(1, 1, At, B1); PG8_BAR;
            }
        }
        if constexpr (ALIGN_EPI) { if (wr == 0) PG8_BAR; }
        if constexpr (!Epi::AFTER_DRAIN) { E(acc, cur, wr, wc, fr, fq); S.done(cur); }
        if (!has_next) break;
#pragma unroll
        for (int a = 0; a < 2; ++a)
#pragma unroll
            for (int b = 0; b < 2; ++b)
#pragma unroll
                for (int m = 0; m < 4; ++m)
#pragma unroll
                    for (int n = 0; n < 2; ++n) acc[a][b][m][n] = (f32x4){0.f, 0.f, 0.f, 0.f};
        cur = nxt; cA = nA; cB = nB; ++ui;
        if constexpr (ALIGN_EPI) { if (wr == 1) PG8_BAR; }
    }
    PG8_WAIT_V(0);
    if constexpr (!ALIGN_EPI) { if (wr == 0) PG8_BAR; }
    PG8_BAR;
    if constexpr (Epi::AFTER_DRAIN) { E.fused(acc, cur, wr, wc, fr, fq, lds, wid, lane); S.done(cur); }
#undef PG8_SA
#undef PG8_SB
#undef PG8_STAGE
#undef PG8_LDA
#undef PG8_LDB
#undef PG8_MMA
#undef PG8_WAIT_V
#undef PG8_WAIT_L
#undef PG8_BAR
#undef PG8_SCHED
}
}
#define LAS __attribute__((address_space(3)))
#define XB_TMO      128
#define XB_XCNT(j)  (256  + 64 * (j))
#define XB_XSUB(j)  (1280 + 64 * (j))
#define XB_XGEN(j)  (2304 + 64 * (j))
#define XB_TOP      3328
#define XB_TOPGEN   3392
#define XCD_BAR_WORDS 3456
#define XB_SPIN_CAP (1u << 18)

__device__ __forceinline__ unsigned xb_ld(unsigned* p)              { return __hip_atomic_load(p, __ATOMIC_RELAXED, __HIP_MEMORY_SCOPE_AGENT); }
__device__ __forceinline__ unsigned xb_add(unsigned* p, unsigned v) { return __hip_atomic_fetch_add(p, v, __ATOMIC_RELAXED, __HIP_MEMORY_SCOPE_AGENT); }
__device__ __forceinline__ unsigned xb_xcc_id() { return (unsigned)__builtin_amdgcn_s_getreg((3 << 11) | 20) & 0xFu; }
#define XB_SPIN(cond, bar) do { unsigned _sp = 0; while (cond) { __builtin_amdgcn_s_sleep(1); \
    if ((++_sp & 255u) == 0u) { if (xb_ld(&(bar)[XB_TMO])) break; if (_sp > XB_SPIN_CAP) { atomicAdd(&(bar)[XB_TMO], 1u); break; } } } } while (0)

struct XcdBarrier {
    unsigned* bar; unsigned x;
    volatile LAS unsigned* st;
};

__device__ __forceinline__ XcdBarrier xcd_barrier_post(unsigned* bar, volatile LAS unsigned* st) {
    XcdBarrier b; b.bar = bar; b.x = xb_xcc_id(); b.st = st;
    if (threadIdx.x == 0) (void)xb_add(&bar[XB_XCNT(b.x)], 1u);
    return b;
}
__device__ __forceinline__ void xcd_barrier_complete(unsigned* bar, unsigned x, unsigned& nloc, unsigned& nx) {
    const unsigned G = gridDim.x * gridDim.y * gridDim.z;
    unsigned sum, cnt, mine, sp = 0u;
    for (;;) {
        sum = 0u; cnt = 0u; mine = 0u;
#pragma unroll
        for (unsigned j = 0; j < 16; ++j) { const unsigned c = xb_ld(&bar[XB_XCNT(j)]); sum += c; cnt += (c > 0u) ? 1u : 0u; mine = (j == x) ? c : mine; }
        if (sum == G) break;
        __builtin_amdgcn_s_sleep(1);
        if ((++sp & 255u) == 0u) { if (xb_ld(&bar[XB_TMO])) break; if (sp > XB_SPIN_CAP) { atomicAdd(&bar[XB_TMO], 1u); break; } }
    }
    nloc = mine > 0u ? mine : 1u; nx = cnt > 0u ? cnt : 1u;
}

__device__ __forceinline__ void xcd_barrier(const XcdBarrier& b) {
    asm volatile("s_waitcnt vmcnt(0)" ::: "memory");
    __syncthreads();
    if (threadIdx.x == 0) {
        unsigned* bar = b.bar;
        __builtin_amdgcn_s_waitcnt(0);
        unsigned nloc = b.st[0], nx = b.st[1];
        if (nloc == 0u) { xcd_barrier_complete(bar, b.x, nloc, nx); b.st[0] = nloc; b.st[1] = nx; }
        const unsigned old = xb_add(&bar[XB_XSUB(b.x)], 1u);
        const unsigned gen = old / nloc;
        if (old + 1u == (gen + 1u) * nloc) {
            __builtin_amdgcn_fence(__ATOMIC_RELEASE, "agent");
            asm volatile("s_waitcnt vmcnt(0)" ::: "memory");
            const unsigned og = xb_add(&bar[XB_TOP], 1u);
            const unsigned tg = og / nx;
            if (og + 1u == (tg + 1u) * nx) xb_add(&bar[XB_TOPGEN], 1u);
            else XB_SPIN(xb_ld(&bar[XB_TOPGEN]) == tg, bar);
            __builtin_amdgcn_fence(__ATOMIC_ACQUIRE, "agent");
            xb_add(&bar[XB_XGEN(b.x)], 1u);
            asm volatile("s_waitcnt vmcnt(0)" ::: "memory");
        } else {
            XB_SPIN(xb_ld(&bar[XB_XGEN(b.x)]) == gen, bar);
            __builtin_amdgcn_fence(__ATOMIC_ACQUIRE, "agent");
            asm volatile("s_waitcnt vmcnt(0)" ::: "memory");
        }
    }
    __syncthreads();
}

constexpr int DM = 1024, SEQ = 8192, MP = 16384, MS = 128, MR = MP + MS, RT = 16640;
constexpr int DFF = 2816, DV = 3072, NGA = 8, CGW = 384, NQG = 1280, NKVP = 1536;
constexpr int NMOD = 40960;
constexpr int MODKV = 36864, MODFIN = 38912;
constexpr int NPAGES = 16, PAST = 2048;
constexpr float LOG2E = 1.4426950408889634f;
#ifndef ONE_LAUNCH
#define ONE_LAUNCH 1
#endif

constexpr size_t OY_P = 0, OY_S = 16777216, OKV_P = 16908288, OKV_S = 33685504, OWIN_P = 33816576, OWIN_S = 34340864, OGV = 67895296, OUT_TOTAL = 68681728;

constexpr size_t al(size_t x) { return (x + 0xFFFFFull) & ~0xFFFFFull; }
constexpr size_t WS_CTL = 0, CTL_ZERO_BYTES = 2u << 20;
constexpr size_t WS_WMOD = al(CTL_ZERO_BYTES);
constexpr size_t WS_WGU = al(WS_WMOD + (size_t)NMOD * DM * 2);
constexpr size_t WS_WDN = al(WS_WGU + (size_t)8 * 5632 * DM * 2);
constexpr size_t WS_WUV = al(WS_WDN + (size_t)8 * DM * DFF * 2);
constexpr size_t WS_WOUT = al(WS_WUV + (size_t)2 * 6144 * DM * 2);
constexpr size_t WS_WQG = al(WS_WOUT + (size_t)2 * DM * DV * 2);
constexpr size_t WS_WO = al(WS_WQG + (size_t)2 * NQG * DM * 2);
constexpr size_t WS_WKV = al(WS_WO + (size_t)2 * DM * DM * 2);
constexpr size_t WS_WC1 = al(WS_WKV + (size_t)NKVP * DM * 2);
constexpr size_t WS_WC2 = al(WS_WC1 + (size_t)2 * 512 * 1024 * 2);
constexpr size_t WS_WSP = al(WS_WC2 + (size_t)2 * 64 * 256 * 2);
constexpr size_t WS_CBIAS = al(WS_WSP + (size_t)2 * 8 * 128 * 128 * 2);
constexpr size_t WS_X = al(WS_CBIAS + 4096);
constexpr size_t WS_H = al(WS_X + (size_t)RT * DM * 2);
constexpr size_t WS_HID = al(WS_H + (size_t)RT * DM * 2);
constexpr size_t WS_Z = al(WS_HID + (size_t)RT * DFF * 2);
constexpr size_t WS_VT = al(WS_Z + (size_t)RT * 6144 * 2);
constexpr size_t WS_P = al(WS_VT + (size_t)128 * DV * 128 * 2);
constexpr size_t WS_Q = al(WS_P + (size_t)RT * DV * 2);
constexpr size_t WS_GATES = al(WS_Q + (size_t)RT * DM * 2);
constexpr size_t WS_O = al(WS_GATES + (size_t)RT * 48 * 4);
constexpr size_t KVB = (size_t)8 * SEQ * 64 * 2;
constexpr size_t WS_KCIN = al(WS_O + (size_t)RT * DM * 2);
constexpr size_t WS_VCIN = WS_KCIN + KVB, WS_SK = WS_VCIN + KVB, WS_SVT = WS_SK + KVB, WS_WK = WS_SVT + KVB, WS_WVT = WS_WK + KVB;
constexpr size_t WS_MOD = al(WS_WVT + KVB);
constexpr size_t WS_SC = al(WS_MOD + (size_t)256 * NMOD * 4);
constexpr size_t WS_TK = al(WS_SC + (size_t)256 * DM * 2);
constexpr size_t WS_TV = al(WS_TK + (size_t)4096 * 512 * 2);
constexpr size_t WS_KC = al(WS_TV + (size_t)4096 * 512 * 2);
constexpr size_t WS_VCT = al(WS_KC + (size_t)8 * 512 * 64 * 2);
constexpr size_t WS_ACMP = al(WS_VCT + (size_t)8 * 64 * 512 * 2);
constexpr size_t WS_TS = al(WS_ACMP + (size_t)2 * 65536 * 1024 * 2);
constexpr size_t WS_KCS = al(WS_TS + (size_t)2 * 65536 * 512 * 2);
constexpr size_t WS_VCS = al(WS_KCS + (size_t)512 * 128 * 64 * 4);
constexpr size_t WS_OACC = al(WS_VCS + (size_t)512 * 128 * 64 * 4);
constexpr size_t WS_HKV = al(WS_OACC + (size_t)MP * DM * 4);
constexpr size_t WS_SHB = al(WS_HKV + (size_t)RT * DM * 2);
constexpr size_t WS_B2 = al(WS_SHB + (size_t)13 * 256 * 1024 * 2);
constexpr size_t WS_NG = al(WS_B2 + (size_t)13 * 256 * 6144 * 4);
constexpr size_t WS_SSP = al(WS_NG + (size_t)13 * 1024 * 4);
constexpr size_t WS_SSPS = al(WS_SSP + (size_t)11 * MP * 16 * 4);
constexpr size_t WS_END = al(WS_SSPS + (size_t)11 * MS * 32 * 4);

constexpr int CW_BAR = 4096, CW_QUEUE = 8192, CW_SS = 32768, CW_VS = CW_SS + 11 * 16640;
static_assert((size_t)(CW_VS + 2 * 16640 * 2) * 4 <= CTL_ZERO_BYTES, "SS / VS accumulators inside the memset region");

constexpr int RING_BYTES = 131072, LDSCTL_OFF = RING_BYTES, MISC_OFF = LDSCTL_OFF + 320, LDS_BYTES = 147456;
constexpr int NWAVES = 8;

#define GAS __attribute__((address_space(1)))
typedef unsigned short bf16;
typedef unsigned v4u __attribute__((ext_vector_type(4)));
typedef unsigned v2u __attribute__((ext_vector_type(2)));
typedef float f32x4 __attribute__((ext_vector_type(4)));
typedef short bf16x8 __attribute__((ext_vector_type(8)));
typedef short bf16x4 __attribute__((ext_vector_type(4)));
typedef float f32x2 __attribute__((ext_vector_type(2)));
typedef _Float16 f16x4 __attribute__((ext_vector_type(4)));
typedef _Float16 f16x8 __attribute__((ext_vector_type(8)));
typedef _Float16 f16;

__device__ __forceinline__ float bf2f(unsigned b) { return __uint_as_float(b << 16); }
__device__ __forceinline__ float bflo(unsigned w) { return __uint_as_float(w << 16); }
__device__ __forceinline__ float bfhi(unsigned w) { return __uint_as_float(w & 0xffff0000u); }
__device__ __forceinline__ unsigned pk2(float lo, float hi) { return pg8::cvt_pk_bf16(lo, hi); }
__device__ __forceinline__ float frcp(float x) { return __builtin_amdgcn_rcpf(x); }
__device__ __forceinline__ float fexp2(float x) { return __builtin_amdgcn_exp2f(x); }
__device__ __forceinline__ float sigmoid_f(float x) { return frcp(1.f + fexp2(-LOG2E * x)); }
__device__ __forceinline__ float silu_f(float x) { return x * sigmoid_f(x); }
__device__ __forceinline__ float gelu_tanh_f(float x) { const float u = x + 0.044715f * x * x * x; return x * frcp(1.f + fexp2(-2.302208198f * u)); }
__device__ __forceinline__ int row_b(int r) { return r < SEQ ? 0 : (r < MP ? 1 : 2 + ((r - MP) < MS ? (r - MP) : (MS - 1))); }
__device__ __forceinline__ float wave_sum(float v) {
#pragma unroll
    for (int o = 1; o < 64; o <<= 1) v += __shfl_xor(v, o);
    return v;
}
__device__ __forceinline__ v4u pack8(const f32x4 a, const f32x4 b) { v4u w; w.x = pk2(a[0], a[1]); w.y = pk2(a[2], a[3]); w.z = pk2(b[0], b[1]); w.w = pk2(b[2], b[3]); return w; }
__device__ __forceinline__ void unpack8(const v4u w, float (&f)[8]) { f[0] = bflo(w.x); f[1] = bfhi(w.x); f[2] = bflo(w.y); f[3] = bfhi(w.y); f[4] = bflo(w.z); f[5] = bfhi(w.z); f[6] = bflo(w.w); f[7] = bfhi(w.w); }

template <class F> struct Epi8 {
    static constexpr bool PERM = true, AFTER_DRAIN = false; F f;
    __device__ __forceinline__ void operator()(const pg8::f32x4 (&acc)[2][2][4][2], const pg8::Unit& u, int wr, int wc, int fr, int fq) const {
        const int row0 = u.pm * pg8::BM + wr * 64 + fr, col0 = u.pn * pg8::BM + wc * 32 + 8 * fq;
        typename F::Pre pre; f.prep(pre, row0, col0, false);
#pragma unroll
        for (int ai = 0; ai < 2; ++ai)
#pragma unroll
            for (int mh = 0; mh < 2; ++mh) {
                typename F::Ld ld[2][2];
#pragma unroll
                for (int m2 = 0; m2 < 2; ++m2)
#pragma unroll
                    for (int bj = 0; bj < 2; ++bj) f.fetch(ld[m2][bj], row0 + ai * pg8::HALF + (2 * mh + m2) * 16, col0 + bj * pg8::HALF);
#pragma unroll
                for (int m2 = 0; m2 < 2; ++m2) { const int m = 2 * mh + m2, row = row0 + ai * pg8::HALF + m * 16;
                    f32x2 part = (f32x2){0.f, 0.f};
#pragma unroll
                    for (int bj = 0; bj < 2; ++bj) part = part + f(pre, ld[m2][bj], ai * 4 + m, bj, row, col0 + bj * pg8::HALF, acc[ai][bj][m][0], acc[ai][bj][m][1]);
                    f.row_done(row, part, fq); }
            }
    }
};
struct NoLd {};
struct NoPre {};
struct NormPre { float rs[8]; f32x4 b[2][2]; };
struct NormIn { unsigned char* ws; int ssi, inst, on;
    __device__ __forceinline__ void prep(NormPre& p, int row0, int col0, bool skinny) const {
        if (!on) return;
        const float* SS = (const float*)(ws + WS_CTL) + CW_SS + (size_t)ssi * RT; const float* b = (const float*)(ws + WS_B2) + ((size_t)inst * 256 + row_b(row0)) * 6144 + col0;
        if (skinny) { p.rs[0] = SS[row0]; p.b[0][0] = *(const f32x4*)b; p.b[0][1] = *(const f32x4*)(b + 4); p.rs[0] = __builtin_amdgcn_rsqf(p.rs[0] * (1.0f / DM) + 1e-6f); }
        else {
#pragma unroll
            for (int i = 0; i < 8; ++i) p.rs[i] = SS[row0 + (i >> 2) * 128 + (i & 3) * 16];
#pragma unroll
            for (int bj = 0; bj < 2; ++bj) { p.b[bj][0] = *(const f32x4*)(b + 128 * bj); p.b[bj][1] = *(const f32x4*)(b + 128 * bj + 4); }
#pragma unroll
            for (int i = 0; i < 8; ++i) p.rs[i] = __builtin_amdgcn_rsqf(p.rs[i] * (1.0f / DM) + 1e-6f);
        }
    }
    __device__ __forceinline__ void apply(const NormPre& p, int ri, int bj, f32x4& v0, f32x4& v1) const { if (on) { v0 = v0 * p.rs[ri] + p.b[bj][0]; v1 = v1 * p.rs[ri] + p.b[bj][1]; } }
};
struct FSwiglu {
    typedef NormPre Pre; typedef NoLd Ld; __device__ __forceinline__ void fetch(Ld&, int, int) const {} bf16* HID; NormIn ni;
    __device__ __forceinline__ void prep(Pre& p, int row0, int col0, bool sk) const { ni.prep(p, row0, col0, sk); }
    __device__ __forceinline__ f32x2 operator()(const Pre& p, const Ld&, int ri, int bj, int row, int col0, f32x4 g, f32x4 u) const {
        ni.apply(p, ri, bj, g, u);
        v2u w; w.x = pk2(silu_f(g[0]) * u[0], silu_f(g[1]) * u[1]); w.y = pk2(silu_f(g[2]) * u[2], silu_f(g[3]) * u[3]);
        *(v2u*)(HID + (size_t)row * DFF + (col0 >> 1)) = w; return (f32x2){0.f, 0.f};
    }
    __device__ __forceinline__ void row_done(int, f32x2, int) const {}
};
struct ResidPre { f32x4 gate[2][2], hm[2][2]; };
struct FResid {
    typedef ResidPre Pre; struct Ld { f32x4 x0, x1; };
    unsigned char* ws; int gcol; float coef; int n1, sc1, n2, sc2, ssi;
    __device__ __forceinline__ void fetch(Ld& d, int row, int col0) const { const f16x8 h = *(const f16x8*)((const f16*)(ws + WS_X) + (size_t)row * DM + col0); const f16x4 lo = __builtin_shufflevector(h, h, 0, 1, 2, 3), hi = __builtin_shufflevector(h, h, 4, 5, 6, 7);
        d.x0 = __builtin_convertvector(lo, f32x4); d.x1 = __builtin_convertvector(hi, f32x4); }
    __device__ __forceinline__ void prep(Pre& p, int row0, int col0, bool skinny) const {
        const float* mrow = (const float*)(ws + WS_MOD) + (size_t)row_b(row0) * NMOD + col0;
#pragma unroll
        for (int bj = 0; bj < 2; ++bj) { if (skinny && bj) break;
            p.gate[bj][0] = *(const f32x4*)(mrow + gcol + 128 * bj) * coef; p.gate[bj][1] = *(const f32x4*)(mrow + gcol + 128 * bj + 4) * coef;
            if (n1 >= 0) { const float* g1 = (const float*)(ws + WS_NG) + n1 * DM + col0 + 128 * bj;
                p.hm[bj][0] = *(const f32x4*)g1 * (*(const f32x4*)(mrow + sc1 + 128 * bj) + 1.0f); p.hm[bj][1] = *(const f32x4*)(g1 + 4) * (*(const f32x4*)(mrow + sc1 + 128 * bj + 4) + 1.0f); } }
    }
    __device__ __forceinline__ f32x2 operator()(const Pre& p, const Ld& d, int ri, int bj, int row, int col0, f32x4 v0, f32x4 v1) const {
        const f32x4 x0 = d.x0 + p.gate[bj][0] * v0, x1 = d.x1 + p.gate[bj][1] * v1;
        { const f16x4 lo = __builtin_convertvector(x0, f16x4), hi = __builtin_convertvector(x1, f16x4); *(f16x8*)((f16*)(ws + WS_X) + (size_t)row * DM + col0) = __builtin_shufflevector(lo, hi, 0, 1, 2, 3, 4, 5, 6, 7); }
        if (n1 >= 0) *(v4u*)((bf16*)(ws + WS_H) + (size_t)row * DM + col0) = pack8(x0 * p.hm[bj][0], x1 * p.hm[bj][1]);
        if (n2 >= 0) { const float* mrow = (const float*)(ws + WS_MOD) + (size_t)row_b(row) * NMOD + col0; const float* g2 = (const float*)(ws + WS_NG) + n2 * DM + col0;
            const f32x4 a0 = *(const f32x4*)g2, a1 = *(const f32x4*)(g2 + 4), s0 = *(const f32x4*)(mrow + sc2), s1 = *(const f32x4*)(mrow + sc2 + 4);
            *(v4u*)((bf16*)(ws + WS_HKV) + (size_t)row * DM + col0) = pack8(x0 * a0 * (s0 + 1.0f), x1 * a1 * (s1 + 1.0f)); }
        return (f32x2){((x0[0] * x0[0] + x0[1] * x0[1]) + (x0[2] * x0[2] + x0[3] * x0[3])) + ((x1[0] * x1[0] + x1[1] * x1[1]) + (x1[2] * x1[2] + x1[3] * x1[3])), 0.f};
    }
    __device__ __forceinline__ void row_done(int row, f32x2 part2, int fq) const {
        float part = part2[0];
        if (ssi >= 0) { part += __shfl_xor(part, 16); part += __shfl_xor(part, 32); if (fq == 0) atomicAdd((float*)(ws + WS_CTL) + CW_SS + (size_t)ssi * RT + row, part); }
    }
};
struct FGelu {
    typedef NormPre Pre; typedef NoLd Ld; __device__ __forceinline__ void fetch(Ld&, int, int) const {} bf16* Z; NormIn ni; float* VS;
    __device__ __forceinline__ void prep(Pre& p, int row0, int col0, bool sk) const { ni.prep(p, row0, col0, sk); }
    __device__ __forceinline__ f32x2 operator()(const Pre& p, const Ld&, int ri, int bj, int row, int col0, f32x4 v0, f32x4 v1) const {
        ni.apply(p, ri, bj, v0, v1);
        f32x4 a, b;
#pragma unroll
        for (int i = 0; i < 4; ++i) { a[i] = gelu_tanh_f(v0[i]); b[i] = gelu_tanh_f(v1[i]); }
        *(v4u*)(Z + (size_t)row * 6144 + col0) = pack8(a, b);
        if (col0 < DV) return (f32x2){0.f, 0.f};
        const f32x4 s = a + b, q = a * a + b * b; return (f32x2){(s[0] + s[1]) + (s[2] + s[3]), (q[0] + q[1]) + (q[2] + q[3])};
    }
    __device__ __forceinline__ void row_done(int row, f32x2 part, int fq) const {
        float s = part[0], q = part[1];
        s += __shfl_xor(s, 16); s += __shfl_xor(s, 32); q += __shfl_xor(q, 16); q += __shfl_xor(q, 32);
        if (fq == 0 && q != 0.f) { atomicAdd(VS + 2 * (size_t)row, s); atomicAdd(VS + 2 * (size_t)row + 1, q); }
    }
};
struct FQg {
    typedef NormPre Pre; typedef NoLd Ld; __device__ __forceinline__ void fetch(Ld&, int, int) const {} bf16* Q; float* GATES; NormIn ni;
    __device__ __forceinline__ void prep(Pre& p, int row0, int col0, bool sk) const { ni.prep(p, row0, col0, sk); }
    __device__ __forceinline__ f32x2 operator()(const Pre& p, const Ld&, int ri, int bj, int row, int col0, f32x4 v0, f32x4 v1) const {
        ni.apply(p, ri, bj, v0, v1);
        if (col0 < DM) { *(v4u*)(Q + (size_t)row * DM + col0) = pack8(v0 * (0.125f * LOG2E), v1 * (0.125f * LOG2E)); }
        else if (col0 < DM + 48) { f32x4 a, b;
#pragma unroll
            for (int i = 0; i < 4; ++i) { a[i] = sigmoid_f(v0[i]); b[i] = sigmoid_f(v1[i]); }
            float* gp = GATES + (size_t)row * 48 + (col0 - DM); *(f32x4*)gp = a; *(f32x4*)(gp + 4) = b; }
        return (f32x2){0.f, 0.f};
    }
    __device__ __forceinline__ void row_done(int, f32x2, int) const {}
};
struct FKv {
    typedef NormPre Pre; typedef NoLd Ld; __device__ __forceinline__ void fetch(Ld&, int, int) const {} float* out; bf16 *KCIN; NormIn ni;
    __device__ __forceinline__ void prep(Pre& p, int row0, int col0, bool sk) const { ni.prep(p, row0, col0, sk); }
    __device__ __forceinline__ f32x2 operator()(const Pre& p, const Ld&, int ri, int bj, int row, int col0, f32x4 v0, f32x4 v1) const {
        ni.apply(p, ri, bj, v0, v1);
        const int slot = col0 >> 8, g = (col0 >> 6) & 3, d0 = col0 & 63;
        if (row < MP) {
            const int b = row >> 13, t = row & (SEQ - 1);
            if (slot < 4) { float* q = out + OKV_P + (size_t)row * DM + col0; *(f32x4*)q = v0; *(f32x4*)(q + 4) = v1; }
            else if (t >= SEQ - 512) { float* q = out + OWIN_P + ((size_t)(b * 512 + (t - (SEQ - 512))) * 2 + (slot - 4)) * 256 + g * 64 + d0; *(f32x4*)q = v0; *(f32x4*)(q + 4) = v1; }
            const int bg = b * 4 + g;
            if (slot == 3 || slot == 5) {
                bf16* base = KCIN + (size_t)slot * (KVB / 2) + (((size_t)bg * (SEQ / 32) + (t >> 5)) * 64 + d0) * 32 + (t & 31);
#pragma unroll
                for (int i = 0; i < 4; ++i) { base[i * 32] = (bf16)(pk2(v0[i], 0.f) & 0xffffu); base[(i + 4) * 32] = (bf16)(pk2(v1[i], 0.f) & 0xffffu); }
            } else {
                bf16* base = KCIN + (size_t)slot * (KVB / 2) + ((size_t)bg * SEQ + t) * 64 + d0;
                *(v4u*)base = pack8(v0, v1);
            }
        } else {
            const int bs = row - MP;
            if (slot < 4) { float* q = out + OKV_S + (size_t)bs * DM + col0; *(f32x4*)q = v0; *(f32x4*)(q + 4) = v1; }
            else { float* q = out + OWIN_S + ((size_t)bs * 512 + 511) * 512 + (slot - 4) * 256 + g * 64 + d0; *(f32x4*)q = v0; *(f32x4*)(q + 4) = v1; }
        }
        return (f32x2){0.f, 0.f};
    }
    __device__ __forceinline__ void row_done(int, f32x2, int) const {}
};
constexpr int SH_NINST = 13;
struct FMod {
    typedef NoPre Pre; typedef NoLd Ld; __device__ __forceinline__ void fetch(Ld&, int, int) const {} float* MOD; const float *b0, *b1, *b2; bf16* SHB;
    __device__ __forceinline__ void prep(Pre&, int, int, bool) const {}
    __device__ __forceinline__ f32x2 operator()(const Pre&, const Ld&, int, int, int row, int col0, f32x4 v0, f32x4 v1) const {
        const float* bp = col0 < MODKV ? b0 + col0 : (col0 < MODFIN ? b1 + (col0 - MODKV) : b2 + (col0 - MODFIN));
        v0 = v0 + *(const f32x4*)bp; v1 = v1 + *(const f32x4*)(bp + 4);
        float* p = MOD + (size_t)row * NMOD + col0; *(f32x4*)p = v0; *(f32x4*)(p + 4) = v1;
        int inst = -1, k = 0;
        if (col0 < MODKV) { const int l = col0 / 9216, r = col0 - l * 9216, sub = r / 3072, rr = r - sub * 3072; if (rr < DM) { inst = l * 3 + sub; k = rr; } }
        else if (col0 < MODKV + DM) { inst = 12; k = col0 - MODKV; }
        if (inst >= 0) *(v4u*)(SHB + ((size_t)inst * 256 + row) * DM + k) = pack8(v0, v1);
        return (f32x2){0.f, 0.f};
    }
    __device__ __forceinline__ void row_done(int, f32x2, int) const {}
};
struct FBf16 {
    typedef NoPre Pre; typedef NoLd Ld; __device__ __forceinline__ void fetch(Ld&, int, int) const {} bf16* T; int ld;
    __device__ __forceinline__ void prep(Pre&, int, int, bool) const {}
    __device__ __forceinline__ f32x2 operator()(const Pre&, const Ld&, int, int, int row, int col0, f32x4 v0, f32x4 v1) const { *(v4u*)(T + (size_t)row * ld + col0) = pack8(v0, v1); return (f32x2){0.f, 0.f}; }
    __device__ __forceinline__ void row_done(int, f32x2, int) const {}
};
constexpr int TILEB = 256 * 1024 * 2;
constexpr int PN_UV = (int)((WS_WUV - WS_WGU) / TILEB), PN_QG = (int)((WS_WQG - WS_WGU) / TILEB), PN_KV = (int)((WS_WKV - WS_WGU) / TILEB);
static_assert((WS_WUV - WS_WGU) % TILEB == 0 && (WS_WQG - WS_WGU) % TILEB == 0 && (WS_WKV - WS_WGU) % TILEB == 0, "weight copies on 256-row tile boundaries");
struct ShiftOrder {
    int G, c;
    __device__ __forceinline__ bool next(int i, pg8::Unit& u) const {
        const int L = i * G + c; if (L >= 240) return false;
        if (L < 176) { const int f = L / 22, t = L - f * 22; u.pm = (f >> 1) * 3 + 2 * (f & 1); u.pn = f * 22 + t; }
        else if (L < 224) { const int q = L - 176, l = q / 24, t = q - l * 24; u.pm = l * 3 + 1; u.pn = PN_UV + l * 24 + t; }
        else if (L < 234) { const int q = L - 224, j = q / 5, t = q - j * 5; u.pm = (2 + j) * 3 + 1; u.pn = PN_QG + j * 5 + t; }
        else { u.pm = 12; u.pn = PN_KV + (L - 234); }
        return true;
    }
    __device__ __forceinline__ void a_ready(const pg8::Unit&) const {}
    __device__ __forceinline__ void done(const pg8::Unit&) const {}
};
struct FB2 {
    typedef NoPre Pre; typedef NoLd Ld; __device__ __forceinline__ void fetch(Ld&, int, int) const {} float* B2;
    __device__ __forceinline__ void prep(Pre&, int, int, bool) const {}
    __device__ __forceinline__ f32x2 operator()(const Pre&, const Ld&, int, int, int row, int col0, f32x4 v0, f32x4 v1) const {
        const int inst = row >> 8, b = row & 255, pn = col0 >> 8;
        int t;
        if (pn < 176) t = pn % 22; else if (pn < PN_QG) t = (pn - PN_UV) % 24; else if (pn < PN_KV) t = (pn - PN_QG) % 5; else t = pn - PN_KV;
        float* p = B2 + ((size_t)inst * 256 + b) * 6144 + t * 256 + (col0 & 255); *(f32x4*)p = v0; *(f32x4*)(p + 4) = v1; return (f32x2){0.f, 0.f};
    }
    __device__ __forceinline__ void row_done(int, f32x2, int) const {}
};

template <class F> __device__ __forceinline__ void run_gemm(LAS unsigned char* lds, const bf16* A, const bf16* Bt, int M, int N, int K, const F& f, int rot = 0) {
    int cblk = ((int)blockIdx.x + rot) % (int)gridDim.x; asm volatile("" : "+s"(cblk));
    pg8::Gemm g{A, Bt, M, N, K}; pg8::StaticOrder S; S.init(M, N, (int)gridDim.x, cblk);
    Epi8<F> E{f};
    pg8::gemm_phase<Epi8<F>, pg8::StaticOrder, true, true>(lds, g, S, E);
}

template <int RTU, int SB, class F> __device__ __forceinline__ void skinny_gemm(LAS unsigned char* lds, const bf16* A, const bf16* Bt, int ncol32, int K, int rem, const F& f) {
    int tid_raw = threadIdx.x; asm volatile("" : "+v"(tid_raw));
    const int lane = tid_raw & 63, wave = __builtin_amdgcn_readfirstlane(tid_raw >> 6), fr = lane & 15, fq = lane >> 4;
    constexpr int NR = 8 / RTU;
    const int kper = K >> 3, nsteps = kper >> 5, nunits = NR * ncol32;
    int cblk = (int)blockIdx.x; asm volatile("" : "+s"(cblk));
    const int nl = (int)gridDim.x - rem;
    LAS f32x4* red = (LAS f32x4*)lds;
    if (cblk < rem) return;
    for (int u = cblk - rem; u < nunits; u += nl) {
        const int n0 = 32 * (u / NR), r0 = MP + 16 * RTU * (u % NR);
        f32x4 acc[RTU][2];
#pragma unroll
        for (int rt = 0; rt < RTU; ++rt) { acc[rt][0] = (f32x4){0.f, 0.f, 0.f, 0.f}; acc[rt][1] = (f32x4){0.f, 0.f, 0.f, 0.f}; }
        const bf16* bp = Bt + (size_t)(n0 + 8 * (fr >> 2) + (fr & 3)) * K + wave * kper + 8 * fq;
        const bf16* ap = A + (size_t)(r0 + fr) * K + wave * kper + 8 * fq;
        const int row = r0 + 16 * (wave < RTU ? wave : 0) + fr;
        typename F::Pre pre; typename F::Ld ld;
        if (wave < RTU) { f.fetch(ld, row, n0 + 8 * fq); f.prep(pre, row, n0 + 8 * fq, true); }
#pragma unroll 1
        for (int ks0 = 0; ks0 < nsteps; ks0 += SB) {
            bf16x8 bb[SB][2], aa[SB][RTU];
#pragma unroll
            for (int s = 0; s < SB; ++s) { const int ks = (ks0 + s < nsteps) ? ks0 + s : nsteps - 1;
                bb[s][0] = *(const bf16x8*)(bp + 32 * ks); bb[s][1] = *(const bf16x8*)(bp + (size_t)4 * K + 32 * ks);
#pragma unroll
                for (int rt = 0; rt < RTU; ++rt) aa[s][rt] = *(const bf16x8*)(ap + (size_t)(16 * rt) * K + 32 * ks); }
#pragma unroll
            for (int s = 0; s < SB; ++s) if (ks0 + s < nsteps) {
#pragma unroll
                for (int rt = 0; rt < RTU; ++rt) { acc[rt][0] = __builtin_amdgcn_mfma_f32_16x16x32_bf16(bb[s][0], aa[s][rt], acc[rt][0], 0, 0, 0); acc[rt][1] = __builtin_amdgcn_mfma_f32_16x16x32_bf16(bb[s][1], aa[s][rt], acc[rt][1], 0, 0, 0); } }
        }
#pragma unroll
        for (int rt = 0; rt < RTU; ++rt) { red[((wave * RTU + rt) * 2 + 0) * 64 + lane] = acc[rt][0]; red[((wave * RTU + rt) * 2 + 1) * 64 + lane] = acc[rt][1]; }
        __syncthreads();
        if (wave < RTU) {
            f32x4 s0 = (f32x4){0.f, 0.f, 0.f, 0.f}, s1 = (f32x4){0.f, 0.f, 0.f, 0.f};
#pragma unroll
            for (int w2 = 0; w2 < 8; ++w2) { s0 = s0 + red[((w2 * RTU + wave) * 2 + 0) * 64 + lane]; s1 = s1 + red[((w2 * RTU + wave) * 2 + 1) * 64 + lane]; }
            const f32x2 part = f(pre, ld, 0, 0, row, n0 + 8 * fq, s0, s1); f.row_done(row, part, fq);
        }
        __syncthreads();
    }
}
template <class F> __device__ __forceinline__ void run_gemm2(LAS unsigned char* lds, const bf16* A, const bf16* Bt, int N, int Nreal, int K, const F& f, int rot = 0, int rem = -1) {
    run_gemm(lds, A, Bt, MP, N, K, f, rot);
    skinny_gemm<4, 6>(lds, A, Bt, (Nreal + 31) >> 5, K, rem >= 0 ? rem : ((MP / 256) * (N / 256)) % (int)gridDim.x, f);
}
template <class F> __device__ __forceinline__ void run_gemm2r(LAS unsigned char* lds, const bf16* A, const bf16* Bt, int K, const F& f) {
    run_gemm(lds, A, Bt, MP, DM, K, f, 0);
    skinny_gemm<1, 12>(lds, A, Bt, DM / 32, K, 0, f);
}

template <bool FINAL>
__device__ __forceinline__ void norm_phase(const f16* X, const float* gvec, const float* MOD, int shift_col, int scale_col, bf16* H, float* out, int gw, int NGW, int lane) {
    for (int r = gw; r < MR; r += NGW) {
        const f16x4* xr = (const f16x4*)(X + (size_t)r * DM) + lane;
        f32x4 v[4]; float ss = 0.f;
#pragma unroll
        for (int j = 0; j < 4; ++j) { v[j] = __builtin_convertvector(xr[64 * j], f32x4); ss += (v[j][0] * v[j][0] + v[j][1] * v[j][1]) + (v[j][2] * v[j][2] + v[j][3] * v[j][3]); }
        ss = wave_sum(ss);
        const float rstd = 1.0f / sqrtf(ss * (1.0f / DM) + 1e-6f);
        const float* mrow = MOD + (size_t)row_b(r) * NMOD;
#pragma unroll
        for (int j = 0; j < 4; ++j) { const int c = 4 * lane + 256 * j;
            const f32x4 gv = *(const f32x4*)(gvec + c), sh = *(const f32x4*)(mrow + shift_col + c), sc = *(const f32x4*)(mrow + scale_col + c);
            const f32x4 y = (v[j] * rstd) * gv * (sc + 1.0f) + sh;
            if (FINAL) { float* o = (r < MP) ? out + OY_P + (size_t)r * DM + c : out + OY_S + (size_t)(r - MP) * DM + c; *(f32x4*)o = y; }
            else { v2u w; w.x = pk2(y[0], y[1]); w.y = pk2(y[2], y[3]); *(v2u*)(H + (size_t)r * DM + c) = w; }
        }
    }
}

__device__ __forceinline__ void transpose_item(const float* W, int N, int ldw, bf16* WT, int ldt, int mode, int row_off, LAS float* scr, int item, int lane) {
    const int nblk = (N + 31) >> 5, kb = item / nblk, nb = item - kb * nblk, k0 = 64 * kb, n0 = 32 * nb;
    const int nn = n0 + (lane & 31); const bool okn = nn < N;
    float tv[32];
#pragma unroll
    for (int i = 0; i < 32; ++i) { const int kk = 2 * i + (lane >> 5); tv[i] = okn ? __builtin_nontemporal_load(W + (size_t)(k0 + kk) * ldw + nn) : 0.f; }
#pragma unroll
    for (int i = 0; i < 32; ++i) { const int kk = 2 * i + (lane >> 5); scr[kk * 33 + (lane & 31)] = tv[i]; }
    asm volatile("s_waitcnt lgkmcnt(0)" ::: "memory");
    const int c = lane & 7;
#pragma unroll
    for (int j = 0; j < 4; ++j) { const int n = (lane >> 3) + 8 * j; const LAS float* s = scr + (8 * c) * 33 + n;
        v4u o; o.x = pk2(s[0 * 33], s[1 * 33]); o.y = pk2(s[2 * 33], s[3 * 33]); o.z = pk2(s[4 * 33], s[5 * 33]); o.w = pk2(s[6 * 33], s[7 * 33]);
        const int ng = n0 + n;
        const int drow = mode == 0 ? row_off + ng : (8 * (ng >> 2) + (ng & 3) + (mode == 2 ? 4 : 0));
        if (ng < N) *(v4u*)(WT + (size_t)drow * ldt + k0 + 8 * c) = o; }
    asm volatile("s_waitcnt lgkmcnt(0)" ::: "memory");
}
struct TDesc { const float* src; int K, N, ldw; bf16* dst; int ldt, mode, row_off; };
struct Ptrs {
    const float *x_prompt, *x_sample, *cache_kv, *state_win; const int* page_table; const float *c_prompt, *c_sample, *ada_w, *ada_b, *norm_g, *w_gate, *w_up, *w_down,
        *w_uv, *ln_g, *ln_b, *w_sp, *b_sp, *w_out, *w_qg, *w_o, *kv_norm_g, *kv_ada_w, *kv_ada_b, *kv_w, *cmp_w1, *cmp_w2, *cmp_pe, *final_g, *final_ada_w, *final_ada_b;
    float* out; unsigned char* ws;
};
#define WSP(T, off) ((T*)(P.ws + (off)))
typedef const __attribute__((address_space(4))) unsigned long long* kptr_t;
__device__ __forceinline__ void load_ptrs(Ptrs& P) {
    kptr_t k = (kptr_t)__builtin_amdgcn_kernarg_segment_ptr();
    asm volatile("" : "+s"(k));
    P.x_prompt = (const float*)(GAS const float*)k[0]; P.x_sample = (const float*)(GAS const float*)k[1]; P.cache_kv = (const float*)(GAS const float*)k[2]; P.state_win = (const float*)(GAS const float*)k[3];
    P.page_table = (const int*)(GAS const int*)k[4]; P.c_prompt = (const float*)(GAS const float*)k[5]; P.c_sample = (const float*)(GAS const float*)k[6]; P.ada_w = (const float*)(GAS const float*)k[7];
    P.ada_b = (const float*)(GAS const float*)k[8]; P.norm_g = (const float*)(GAS const float*)k[9]; P.w_gate = (const float*)(GAS const float*)k[10]; P.w_up = (const float*)(GAS const float*)k[11];
    P.w_down = (const float*)(GAS const float*)k[12]; P.w_uv = (const float*)(GAS const float*)k[13]; P.ln_g = (const float*)(GAS const float*)k[14]; P.ln_b = (const float*)(GAS const float*)k[15];
    P.w_sp = (const float*)(GAS const float*)k[16]; P.b_sp = (const float*)(GAS const float*)k[17]; P.w_out = (const float*)(GAS const float*)k[18]; P.w_qg = (const float*)(GAS const float*)k[19];
    P.w_o = (const float*)(GAS const float*)k[20]; P.kv_norm_g = (const float*)(GAS const float*)k[21]; P.kv_ada_w = (const float*)(GAS const float*)k[22]; P.kv_ada_b = (const float*)(GAS const float*)k[23];
    P.kv_w = (const float*)(GAS const float*)k[24]; P.cmp_w1 = (const float*)(GAS const float*)k[25]; P.cmp_w2 = (const float*)(GAS const float*)k[26]; P.cmp_pe = (const float*)(GAS const float*)k[27];
    P.final_g = (const float*)(GAS const float*)k[28]; P.final_ada_w = (const float*)(GAS const float*)k[29]; P.final_ada_b = (const float*)(GAS const float*)k[30];
    P.out = (float*)(GAS float*)k[31]; P.ws = (unsigned char*)(GAS unsigned char*)k[32];
}
__device__ __forceinline__ void get_tdesc(const Ptrs& P, int id, TDesc& d) {
    d.mode = 0; d.row_off = 0; d.K = 1024; d.ldt = 1024;
    if (id < 4) { d.src = P.ada_w + (size_t)id * 1024 * 9216; d.N = 9216; d.dst = WSP(bf16, WS_WMOD); d.row_off = id * 9216; }
    else if (id == 4) { d.src = P.kv_ada_w; d.N = 2048; d.dst = WSP(bf16, WS_WMOD); d.row_off = MODKV; }
    else if (id == 5) { d.src = P.final_ada_w; d.N = 2048; d.dst = WSP(bf16, WS_WMOD); d.row_off = MODFIN; }
    else if (id < 14) { const int i = id - 6; d.src = P.w_gate + (size_t)i * 1024 * DFF; d.N = DFF; d.dst = WSP(bf16, WS_WGU) + (size_t)i * 5632 * 1024; d.mode = 1; }
    else if (id < 22) { const int i = id - 14; d.src = P.w_up + (size_t)i * 1024 * DFF; d.N = DFF; d.dst = WSP(bf16, WS_WGU) + (size_t)i * 5632 * 1024; d.mode = 2; }
    else if (id < 30) { const int i = id - 22; d.src = P.w_down + (size_t)i * DFF * 1024; d.K = DFF; d.N = 1024; d.dst = WSP(bf16, WS_WDN) + (size_t)i * 1024 * DFF; d.ldt = DFF; }
    else if (id < 32) { const int i = id - 30; d.src = P.w_uv + (size_t)i * 1024 * 6144; d.N = 6144; d.dst = WSP(bf16, WS_WUV) + (size_t)i * 6144 * 1024; }
    else if (id < 34) { const int i = id - 32; d.src = P.w_out + (size_t)i * DV * 1024; d.K = DV; d.N = 1024; d.dst = WSP(bf16, WS_WOUT) + (size_t)i * 1024 * DV; d.ldt = DV; }
    else if (id < 36) { const int i = id - 34; d.src = P.w_qg + (size_t)i * 1024 * 1072; d.N = 1072; d.dst = WSP(bf16, WS_WQG) + (size_t)i * NQG * 1024; }
    else if (id < 38) { const int i = id - 36; d.src = P.w_o + (size_t)i * 1024 * 1024; d.N = 1024; d.dst = WSP(bf16, WS_WO) + (size_t)i * 1024 * 1024; }
    else if (id == 38) { d.src = P.kv_w; d.N = NKVP; d.dst = WSP(bf16, WS_WKV); }
    else if (id < 43) { const int i = id - 39, kv = i >> 1, r = i & 1; d.src = P.cmp_w1 + (size_t)kv * 2048 * 256 + (size_t)r * 1024 * 256; d.N = 256; d.dst = WSP(bf16, WS_WC1) + (size_t)kv * 512 * 1024; d.row_off = r * 256; }
    else { const int kv = id - 43; d.src = P.cmp_w2 + (size_t)kv * 256 * 64; d.K = 256; d.N = 64; d.dst = WSP(bf16, WS_WC2) + (size_t)kv * 64 * 256; d.ldt = 256; }
    d.ldw = d.N;
}
constexpr int N_TMAT = 45;

__device__ __forceinline__ void prologue_phase(const Ptrs& P, LAS unsigned char* lds, int gw, int NGW, int wave, int lane, int tid) {
    if (blockIdx.x < 8) {
        const int kv = blockIdx.x >> 2, hb = blockIdx.x & 3; const float* pe = P.cmp_pe + kv * 2048; const float* w1 = P.cmp_w1 + (size_t)kv * 2048 * 256 + hb * 64 + lane;
        float acc = 0.f;
#pragma unroll 8
        for (int k = wave * 256; k < wave * 256 + 256; ++k) acc += pe[k] * w1[(size_t)k * 256];
        LAS float* red = (LAS float*)lds;
        red[wave * 64 + lane] = acc;
        __syncthreads();
        if (wave == 0) { float s = 0.f;
#pragma unroll
            for (int w = 0; w < 8; ++w) s += red[w * 64 + lane];
            WSP(float, WS_CBIAS)[kv * 256 + hb * 64 + lane] = s; }
        __syncthreads();
    }
    { LAS float* scr = (LAS float*)(lds + wave * 16384); int off = 0;
      for (int id = 0; id < N_TMAT; ++id) { TDesc d; get_tdesc(P, id, d);
          const int nitems = (d.K >> 6) * ((d.N + 31) >> 5);
          for (int it = (gw + NGW - (off % NGW)) % NGW; it < nitems; it += NGW) transpose_item(d.src, d.N, d.ldw, d.dst, d.ldt, d.mode, d.row_off, scr, it, lane);
          off += nitems; } }
    for (int r = gw; r < RT; r += NGW) { f16x4* xo = (f16x4*)(WSP(f16, WS_X) + (size_t)r * DM) + lane;
        const f32x4* xi = r < MP ? (const f32x4*)(P.x_prompt + (size_t)r * DM) + lane : (const f32x4*)(P.x_sample + (size_t)((r < MR ? r : MR - 1) - MP) * DM) + lane;
#pragma unroll
        for (int j = 0; j < 4; ++j) { f32x4 v = xi[64 * j]; if (r >= MR) v = (f32x4){0.f, 0.f, 0.f, 0.f}; xo[64 * j] = __builtin_convertvector(v, f16x4); } }
    for (int r = gw; r < 256; r += NGW) { const float* ci = r < 2 ? P.c_prompt + (size_t)r * DM : P.c_sample + (size_t)((r < 130 ? r : 129) - 2) * DM;
#pragma unroll
        for (int j = 0; j < 4; ++j) { const int c = 4 * lane + 256 * j; f32x4 v = *(const f32x4*)(ci + c); v2u w; w.x = pk2(silu_f(v[0]), silu_f(v[1])); w.y = pk2(silu_f(v[2]), silu_f(v[3])); if (r >= 130) { w.x = 0u; w.y = 0u; }
            *(v2u*)(WSP(bf16, WS_SC) + (size_t)r * DM + c) = w; } }
    for (int it0 = gw * 8; it0 < MS * PAST; it0 += NGW * 8) { const int bs = it0 >> 11, pos0 = it0 & (PAST - 1); const int page = P.page_table[bs * NPAGES + (pos0 >> 7)];
        const float* src = P.cache_kv + ((size_t)page * 128 + (pos0 & 127)) * 1024 + 8 * lane;
        f32x4 a[8], b[8];
#pragma unroll
        for (int q = 0; q < 8; ++q) { a[q] = __builtin_nontemporal_load((const f32x4*)(src + (size_t)q * 1024)); b[q] = __builtin_nontemporal_load((const f32x4*)(src + (size_t)q * 1024 + 4)); }
        const int slot = lane >> 5, g = (lane >> 3) & 3, d0 = (lane & 7) * 8;
        bf16* dst = WSP(bf16, WS_ACMP) + (size_t)slot * 65536 * 1024 + ((size_t)(bs * 4 + g) * 128 + (pos0 >> 4)) * 1024 + (pos0 & 15) * 64 + d0;
#pragma unroll
        for (int q = 0; q < 8; ++q) *(v4u*)(dst + q * 64) = pack8(a[q], b[q]); }
    for (int i = gw * 64 + lane; i < 13 * DM; i += NGW * 64) WSP(float, WS_NG)[i] = i < 12 * DM ? P.norm_g[i] : P.kv_norm_g[i - 12 * DM];
    for (int i = gw * 64 + lane; i < 2 * 8 * 128 * 128; i += NGW * 64) { const int t = (i >> 7) & 127, s = i & 127; WSP(bf16, WS_WSP)[i] = (bf16)(pk2(s <= t ? P.w_sp[i] : 0.f, 0.f) & 0xffffu); }
    for (int it = gw; it < MS * 64; it += NGW) { const int bs = it >> 6, j0 = (it & 63) * 8;
        const float* src = P.state_win + ((size_t)bs * 512 + j0 + 1) * 512 + 4 * lane; float* dst = P.out + OWIN_S + ((size_t)bs * 512 + j0) * 512 + 4 * lane;
        f32x4 v[16];
#pragma unroll
        for (int q = 0; q < 16; ++q) { const int j = j0 + (q >> 1); v[q] = (j < 511) ? __builtin_nontemporal_load((const f32x4*)(src + (size_t)(q >> 1) * 512 + (q & 1) * 256)) : (f32x4){0.f, 0.f, 0.f, 0.f}; }
#pragma unroll
        for (int q = 0; q < 16; ++q) { const int j = j0 + (q >> 1); if (j < 511) __builtin_nontemporal_store(v[q], (f32x4*)(dst + (size_t)(q >> 1) * 512 + (q & 1) * 256)); } }
}

template <int MODE>
__device__ __forceinline__ void cmp_finish_unit(const bf16* T, const float* cbias, const bf16* W2T, void* outp, int C, int bg, int rt, int lane) {
    const int fr = lane & 15, fq = lane >> 4, NB = C - 1, i0 = 16 * rt;
    const int ib = i0 + fr, ic = ib < NB ? ib : NB - 1;
    const bf16* ta = T + ((size_t)bg * C + ic) * 512 + 8 * fq; const bf16* tb = ta + 512 + 256;
    v4u ra[8], rb[8];
#pragma unroll
    for (int ks = 0; ks < 8; ++ks) { ra[ks] = *(const v4u*)(ta + 32 * ks); rb[ks] = *(const v4u*)(tb + 32 * ks); }
    asm volatile("" ::: "memory");
    bf16x8 hf[8];
#pragma unroll
    for (int ks = 0; ks < 8; ++ks) { float a[8], b[8]; unpack8(ra[ks], a); unpack8(rb[ks], b);
        const f32x4 c0 = *(const f32x4*)(cbias + 32 * ks + 8 * fq), c1 = *(const f32x4*)(cbias + 32 * ks + 8 * fq + 4);
        f32x4 h0, h1;
#pragma unroll
        for (int e = 0; e < 4; ++e) { h0[e] = gelu_tanh_f(c0[e] + a[e] + b[e]); h1[e] = gelu_tanh_f(c1[e] + a[e + 4] + b[e + 4]); }
        const v4u w = pack8(h0, h1); hf[ks] = __builtin_bit_cast(bf16x8, w); }
    f32x4 acc[4];
#pragma unroll
    for (int nt = 0; nt < 4; ++nt) { acc[nt] = (f32x4){0.f, 0.f, 0.f, 0.f};
        bf16x8 wf[8];
#pragma unroll
        for (int ks = 0; ks < 8; ++ks) wf[ks] = *(const bf16x8*)(W2T + (size_t)(16 * nt + fr) * 256 + 32 * ks + 8 * fq);
#pragma unroll
        for (int ks = 0; ks < 8; ++ks) {
            if (MODE == 1) acc[nt] = __builtin_amdgcn_mfma_f32_16x16x32_bf16(hf[ks], wf[ks], acc[nt], 0, 0, 0);
            else acc[nt] = __builtin_amdgcn_mfma_f32_16x16x32_bf16(wf[ks], hf[ks], acc[nt], 0, 0, 0); } }
#pragma unroll
    for (int nt = 0; nt < 4; ++nt) {
        if (MODE == 0) { f32x4 v = acc[nt]; if (ib >= NB) v = (f32x4){0.f, 0.f, 0.f, 0.f}; v2u w; w.x = pk2(v[0], v[1]); w.y = pk2(v[2], v[3]);
            *(v2u*)((bf16*)outp + ((size_t)bg * 512 + ib) * 64 + 16 * nt + 4 * fq) = w; }
        else if (MODE == 1) { f32x4 v = acc[nt];
#pragma unroll
            for (int e = 0; e < 4; ++e) if (i0 + 4 * fq + e >= NB) v[e] = 0.f;
            v2u w; w.x = pk2(v[0], v[1]); w.y = pk2(v[2], v[3]);
            *(v2u*)((bf16*)outp + (((size_t)bg * 16 + (i0 >> 5)) * 64 + 16 * nt + fr) * 32 + (i0 & 31) + 4 * fq) = w; }
        else { f32x4 v = acc[nt]; if (ib >= NB) v = (f32x4){0.f, 0.f, 0.f, 0.f};
            *(f32x4*)((float*)outp + ((size_t)bg * 128 + ib) * 64 + 16 * nt + 4 * fq) = v; }
    }
}

struct SpRegs { f32x4 st; v4u za[2], zb[2]; bf16x8 wf[4]; v4u uv[4]; float bt; };
__device__ __forceinline__ void sp_load(SpRegs& R, const Ptrs& P, int l, int u, int wave, int lane) {
    const bf16* Z = WSP(bf16, WS_Z); const bf16* WS = WSP(bf16, WS_WSP); const float* VS = WSP(float, WS_CTL) + CW_VS + (size_t)l * RT * 2;
    const int fr = lane & 15, fq = lane >> 4, nks = (wave >> 1) + 1, n = u / 24, cb = u - n * 24, g = cb / 3;
    R.st = *(const f32x4*)(VS + 2 * (n * 128 + 2 * lane));
#pragma unroll
    for (int q = 0; q < 2; ++q) { const int cc = cb * 128 + 8 * (wave + 8 * q); const bf16* z0 = Z + (size_t)(n * 128 + 2 * lane) * 6144 + DV + cc; R.za[q] = *(const v4u*)z0; R.zb[q] = *(const v4u*)(z0 + 6144); }
    const bf16* wp = WS + ((size_t)(l * 8 + g) * 128 + 16 * wave + fr) * 128 + 8 * fq;
#pragma unroll
    for (int ks = 0; ks < 4; ++ks) R.wf[ks] = *(const bf16x8*)(wp + 32 * (ks < nks ? ks : 0));
    const int t = 16 * wave + fr, row = n * 128 + t; R.bt = P.b_sp[(l * 8 + g) * 128 + t];
#pragma unroll
    for (int mm = 0; mm < 4; ++mm) R.uv[mm] = *(const v4u*)(Z + (size_t)row * 6144 + cb * 128 + 32 * mm + 8 * fq);
}
__device__ __forceinline__ void sp_compute(const SpRegs& R, const Ptrs& P, int l, int u, LAS unsigned* tile, int wave, int lane) {
    bf16* PO = WSP(bf16, WS_P); const float* lg = P.ln_g + l * DV; const float* lb = P.ln_b + l * DV;
    const int fr = lane & 15, fq = lane >> 4, nks = (wave >> 1) + 1, n = u / 24, cb = u - n * 24;
    const float m0 = R.st[0] * (1.0f / DV), m1 = R.st[2] * (1.0f / DV); float v0 = R.st[1] * (1.0f / DV) - m0 * m0, v1 = R.st[3] * (1.0f / DV) - m1 * m1; v0 = v0 > 0.f ? v0 : 0.f; v1 = v1 > 0.f ? v1 : 0.f;
    const float r0 = 1.0f / sqrtf(v0 + 1e-6f), r1 = 1.0f / sqrtf(v1 + 1e-6f);
#pragma unroll
    for (int q = 0; q < 2; ++q) { const int ccg = wave + 8 * q, cc = cb * 128 + 8 * ccg; float a[8], b[8]; unpack8(R.za[q], a); unpack8(R.zb[q], b);
        const f32x4 g0 = *(const f32x4*)(lg + cc), g1 = *(const f32x4*)(lg + cc + 4), b0 = *(const f32x4*)(lb + cc), b1 = *(const f32x4*)(lb + cc + 4);
#pragma unroll
        for (int e = 0; e < 8; ++e) { const float gg = e < 4 ? g0[e] : g1[e - 4], bb = e < 4 ? b0[e] : b1[e - 4];
            tile[(8 * ccg + e) * 68 + lane] = pk2((a[e] - m0) * r0 * gg + bb, (b[e] - m1) * r1 * gg + bb); } }
    __syncthreads();
    f32x4 acc[8];
#pragma unroll
    for (int j = 0; j < 8; ++j) acc[j] = (f32x4){0.f, 0.f, 0.f, 0.f};
    const LAS char* vp = (const LAS char*)tile + (8 * (fr >> 2) + (fr & 3)) * 272 + 16 * fq;
#pragma unroll
    for (int ks = 0; ks < 4; ++ks) if (ks < nks) {
#pragma unroll
        for (int j = 0; j < 8; ++j) { const bf16x8 vf = *(const LAS bf16x8*)(vp + (32 * (j >> 1) + 4 * (j & 1)) * 272 + 64 * ks);
            acc[j] = __builtin_amdgcn_mfma_f32_16x16x32_bf16(vf, R.wf[ks], acc[j], 0, 0, 0); }
    }
    const int row = n * 128 + 16 * wave + fr;
#pragma unroll
    for (int mm = 0; mm < 4; ++mm) { const int c = cb * 128 + 32 * mm + 8 * fq; float uu[8]; unpack8(R.uv[mm], uu);
        f32x4 p0, p1;
#pragma unroll
        for (int e = 0; e < 4; ++e) { p0[e] = uu[e] * (acc[2 * mm][e] + R.bt); p1[e] = uu[4 + e] * (acc[2 * mm + 1][e] + R.bt); }
        *(v4u*)(PO + (size_t)row * DV + c) = pack8(p0, p1); }
}
__device__ __forceinline__ void spatial2_phase(const Ptrs& P, int l, LAS unsigned char* lds, int wave, int lane, int tid, int gw, int NGW) {
    const bf16* Z = WSP(bf16, WS_Z);
    const float* VS = WSP(float, WS_CTL) + CW_VS + (size_t)l * RT * 2;
    const float* lg = P.ln_g + l * DV; const float* lb = P.ln_b + l * DV;
    { const int NU = 128 * 24, G_ = (int)gridDim.x; int u = (int)blockIdx.x;
      LAS unsigned* t0 = (LAS unsigned*)lds; LAS unsigned* t1 = (LAS unsigned*)(lds + 34816);
      SpRegs A, B;
      if (u < NU) sp_load(A, P, l, u, wave, lane);
      while (u < NU) {
          int un = u + G_; if (un < NU) sp_load(B, P, l, un, wave, lane);
          sp_compute(A, P, l, u, t0, wave, lane);
          u = un; if (u >= NU) break;
          un = u + G_; if (un < NU) sp_load(A, P, l, un, wave, lane);
          sp_compute(B, P, l, u, t1, wave, lane);
          u = un;
      } }
    __syncthreads();
    for (int bs = gw; bs < MS; bs += NGW) {
        const int row = MP + bs; const bf16* zr = Z + (size_t)row * 6144 + 8 * lane;
        const float mean = VS[2 * row] * (1.0f / DV); float var = VS[2 * row + 1] * (1.0f / DV) - mean * mean; var = var > 0.f ? var : 0.f; const float rstd = 1.0f / sqrtf(var + 1e-6f);
#pragma unroll
        for (int j = 0; j < 6; ++j) { const int c = 512 * j + 8 * lane, g = c / CGW;
            const float w00 = P.w_sp[(size_t)(l * 8 + g) * 128 * 128], b00 = P.b_sp[(l * 8 + g) * 128];
            const f32x4 g0 = *(const f32x4*)(lg + c), g1 = *(const f32x4*)(lg + c + 4), b0 = *(const f32x4*)(lb + c), b1 = *(const f32x4*)(lb + c + 4);
            float vv[8], uu[8]; unpack8(*(const v4u*)(zr + DV + 512 * j), vv); unpack8(*(const v4u*)(zr + 512 * j), uu);
            f32x4 o0, o1, p0, p1;
#pragma unroll
            for (int e = 0; e < 4; ++e) { o0[e] = (vv[e] - mean) * rstd * g0[e] + b0[e]; o1[e] = (vv[4 + e] - mean) * rstd * g1[e] + b1[e];
                p0[e] = uu[e] * (w00 * o0[e] + b00); p1[e] = uu[4 + e] * (w00 * o1[e] + b00); }
            float* gv = P.out + OGV + ((size_t)l * MS + bs) * DV + c; *(f32x4*)gv = o0; *(f32x4*)(gv + 4) = o1;
            *(v4u*)(WSP(bf16, WS_P) + (size_t)row * DV + c) = pack8(p0, p1); }
    }
}

#define NEG_INF (-__builtin_inff())
__device__ __forceinline__ bf16x8 ld_v2x8(const GAS bf16* p) {
    const bf16x4 lo = *(const GAS bf16x4*)p, hi = *(const GAS bf16x4*)(p + 16);
    return __builtin_shufflevector(lo, hi, 0, 1, 2, 3, 4, 5, 6, 7);
}
struct SampleAcc { float acc[4][8]; float m, l; };
__device__ __forceinline__ float sample_compute(const f32x4 k0, const f32x4 k1, const f32x4 v0, const f32x4 v1, bool valid, float dist, const float (&qv)[4][8], float slope2_own, int lane, SampleAcc& A) {
    const int j8 = lane & 7;
    float part[4];
#pragma unroll
    for (int h = 0; h < 4; ++h) { float a = (qv[h][0] * k0[0] + qv[h][1] * k0[1]) + (qv[h][2] * k0[2] + qv[h][3] * k0[3]) + (qv[h][4] * k1[0] + qv[h][5] * k1[1]) + (qv[h][6] * k1[2] + qv[h][7] * k1[3]);
        a += __shfl_xor(a, 1); a += __shfl_xor(a, 2); a += __shfl_xor(a, 4); part[h] = a; }
    const int hown = j8 & 3;
    const float sown = hown == 0 ? part[0] : hown == 1 ? part[1] : hown == 2 ? part[2] : part[3];
    const float s2 = valid ? (sown - slope2_own * dist) : NEG_INF;
    float tm = s2;
#pragma unroll
    for (int off = 8; off < 64; off <<= 1) tm = fmaxf(tm, __shfl_xor(tm, off));
    const float mnew = fmaxf(A.m, tm), msafe = (mnew == NEG_INF) ? 0.f : mnew, alpha = fexp2(A.m - msafe), p = fexp2(s2 - msafe);
    A.m = mnew; A.l = A.l * alpha + p;
    float ph[4], ah[4];
#pragma unroll
    for (int h = 0; h < 4; ++h) { ph[h] = __shfl(p, (lane & ~7) | h); ah[h] = __shfl(alpha, (lane & ~7) | h); }
#pragma unroll
    for (int h = 0; h < 4; ++h)
#pragma unroll
        for (int e = 0; e < 4; ++e) { A.acc[h][e] = A.acc[h][e] * ah[h] + ph[h] * v0[e]; A.acc[h][4 + e] = A.acc[h][4 + e] * ah[h] + ph[h] * v1[e]; }
    return s2;
}
__device__ __forceinline__ float sample_step8(const float* krow, const float* vrow, bool valid, float dist, const float (&qv)[4][8], float slope2_own, int lane, SampleAcc& A) {
    const int j8 = lane & 7;
    const f32x4 k0 = *(const f32x4*)(krow + 8 * j8), k1 = *(const f32x4*)(krow + 8 * j8 + 4), v0 = *(const f32x4*)(vrow + 8 * j8), v1 = *(const f32x4*)(vrow + 8 * j8 + 4);
    return sample_compute(k0, k1, v0, v1, valid, dist, qv, slope2_own, lane, A);
}
__device__ __forceinline__ void sample_batch4(const float* kbase, const float* vbase, int rstride, int r0, int rlimit, int rclamp, float dist0, float ddist,
                                              const float (&qv)[4][8], float slope2_own, int lane, SampleAcc& A, LAS float* sraw) {
    const int j8 = lane & 7;
    f32x4 kk[4][2], vv[4][2];
#pragma unroll
    for (int s = 0; s < 4; ++s) { int r = r0 + 8 * s; r = r < rlimit ? r : rclamp; const float* kr = kbase + (size_t)r * rstride + 8 * j8; const float* vr = vbase + (size_t)r * rstride + 8 * j8;
        kk[s][0] = *(const f32x4*)kr; kk[s][1] = *(const f32x4*)(kr + 4); vv[s][0] = *(const f32x4*)vr; vv[s][1] = *(const f32x4*)(vr + 4); }
#pragma unroll
    for (int s = 0; s < 4; ++s) { const float s2 = sample_compute(kk[s][0], kk[s][1], vv[s][0], vv[s][1], r0 + 8 * s < rlimit, dist0 - ddist * (float)s, qv, slope2_own, lane, A);
        if (sraw) sraw[s * 64 + lane] = s2; }
}
__device__ __forceinline__ void sample_reset(SampleAcc& A) {
    A.m = NEG_INF; A.l = 0.f;
#pragma unroll
    for (int h = 0; h < 4; ++h)
#pragma unroll
        for (int i = 0; i < 8; ++i) A.acc[h][i] = 0.f;
}
__device__ __forceinline__ void sample_finish(SampleAcc& A, const float* gates_bg, int br, LAS float* wl, int lane, bool first) {
    float lt = A.l;
#pragma unroll
    for (int off = 8; off < 64; off <<= 1) lt += __shfl_xor(lt, off);
    float sc[4];
#pragma unroll
    for (int h = 0; h < 4; ++h) { const float lh = __shfl(lt, h); sc[h] = lh > 0.f ? gates_bg[h * 3 + br] / lh : 0.f; }
#pragma unroll
    for (int h = 0; h < 4; ++h)
#pragma unroll
        for (int i = 0; i < 8; ++i) { float a = A.acc[h][i];
#pragma unroll
            for (int off = 8; off < 64; off <<= 1) a += __shfl_xor(a, off);
            A.acc[h][i] = a * sc[h]; }
    if (lane < 8) {
#pragma unroll
        for (int h = 0; h < 4; ++h)
#pragma unroll
            for (int i = 0; i < 8; ++i) { LAS float* p = wl + h * 64 + 8 * lane + i; *p = first ? A.acc[h][i] : (*p + A.acc[h][i]); }
    }
}
__device__ __forceinline__ void attn_sample_unit(const Ptrs& P, int bs, int g, LAS float* wl, int lane_in) {
    int lane = lane_in; asm volatile("" : "+v"(lane));
    const int kq = lane >> 3, j8 = lane & 7, row = MP + bs;
    const bf16* Q = WSP(bf16, WS_Q) + (size_t)row * DM + (4 * g) * 64; const float* GT = WSP(float, WS_GATES) + (size_t)row * 48 + g * 12;
    float qv[4][8];
#pragma unroll
    for (int h = 0; h < 4; ++h) unpack8(*(const v4u*)(Q + h * 64 + 8 * j8), qv[h]);
    const float slope2_own = fexp2(-0.5f * (float)(4 * g + (j8 & 3) + 1)) * LOG2E;
    SampleAcc A;
    LAS float* pimp = wl + 256;
    LAS float* sraw = wl + 512;
    const float* KCS = WSP(float, WS_KCS) + (size_t)(bs * 4 + g) * 128 * 64; const float* VCS = WSP(float, WS_VCS) + (size_t)(bs * 4 + g) * 128 * 64;
    sample_reset(A);
#pragma unroll 1
    for (int bt = 0; bt < 4; ++bt) sample_batch4(KCS, VCS, 64, 32 * bt + kq, 127, 126, (float)(PAST - (16 * (32 * bt + kq) + 31)), 128.f, qv, slope2_own, lane, A, sraw + bt * 256);
    { float lt = A.l;
#pragma unroll
      for (int off = 8; off < 64; off <<= 1) lt += __shfl_xor(lt, off);
      const float il = lt > 0.f ? 1.0f / lt : 0.f, mm = A.m == NEG_INF ? 0.f : A.m;
#pragma unroll 1
      for (int it = 0; it < 16; ++it) { float p = fexp2(sraw[it * 64 + lane] - mm) * il; p += __shfl_xor(p, 1); p += __shfl_xor(p, 2); if (j8 == 0) pimp[8 * it + kq] = p; } }
    sample_finish(A, GT, 0, wl, lane, true);
    unsigned long long selmask;
    { float v = -1.f;
      if (lane < 33) { float sacc = 0.f;
#pragma unroll
          for (int e = -1; e < 4; ++e) { const int n = 4 * lane + e; if (n >= 0 && n < 127) sacc += pimp[n]; }
          v = (lane == 0 || lane >= 31) ? sacc + 1e4f : sacc; }
      int rank = 0;
#pragma unroll 1
      for (int i = 0; i < 33; ++i) { const float vi = __shfl(v, i); rank += (vi > v || (vi == v && i < lane)) ? 1 : 0; }
      selmask = __ballot(lane < 33 && rank < 16); }
    sample_reset(A);
#pragma unroll 1
    for (int j = 0; j < 32; ++j) {
        if (!((selmask >> j) & 1ull)) continue;
        const int page = P.page_table[bs * NPAGES + (j >> 1)];
        const float* kb = P.cache_kv + ((size_t)page * 128 * 4 + 2) * 256 + g * 64;
#pragma unroll 1
        for (int bb = 0; bb < 2; ++bb) { const int r0 = ((64 * j) & 127) + 32 * bb + kq;
            sample_batch4(kb, kb + 256, 1024, r0, 1 << 30, 0, (float)(PAST - (64 * j + 32 * bb + kq)), 8.f, qv, slope2_own, lane, A, nullptr); }
    }
    { const float* kr = P.out + OKV_S + ((size_t)bs * 4 + 2) * 256 + g * 64;
      (void)sample_step8(kr, kr + 256, kq == 0, 0.f, qv, slope2_own, lane, A); }
    sample_finish(A, GT, 1, wl, lane, false);
    sample_reset(A);
    { const float* kb = P.state_win + (size_t)bs * 512 * 512 + g * 64;
#pragma unroll 1
      for (int bt = 0; bt < 16; ++bt) sample_batch4(kb, kb + 256, 512, 32 * bt + kq, 1 << 30, 0, (float)(512 - (32 * bt + kq)), 8.f, qv, slope2_own, lane, A, nullptr); }
    { const float* kr = P.out + OWIN_S + ((size_t)bs * 512 + 511) * 512 + g * 64;
      (void)sample_step8(kr, kr + 256, kq == 0, 0.f, qv, slope2_own, lane, A); }
    sample_finish(A, GT, 2, wl, lane, false);
    { const f32x4 v = *(const LAS f32x4*)(wl + 4 * lane); v2u w; w.x = pk2(v[0], v[1]); w.y = pk2(v[2], v[3]);
      *(v2u*)(WSP(bf16, WS_O) + (size_t)row * DM + 256 * g + 4 * lane) = w; }
}

__device__ __forceinline__ void ldK(bf16x8 (&kf)[2][2], const GAS bf16* Kp, int k0, unsigned koff) {
#pragma unroll
    for (int kt = 0; kt < 2; ++kt)
#pragma unroll
        for (int ks = 0; ks < 2; ++ks) kf[kt][ks] = *(const GAS bf16x8*)((const GAS char*)(Kp + (size_t)k0 * 64 + kt * 256 + ks * 32) + koff);
}
__device__ __forceinline__ void ldV(bf16x8 (&vf)[4], const GAS bf16* Vp, int VP, int k0, unsigned voff) {
#pragma unroll
    for (int dt = 0; dt < 4; ++dt) vf[dt] = *(const GAS bf16x8*)((const GAS char*)(Vp + (size_t)(k0 >> 5) * 2048 + dt * 512) + voff);
}
template <int MODE, int GEN>
__device__ __forceinline__ void att_run(const GAS bf16* Kp, const GAS bf16* Vp, int VP, unsigned koff, unsigned voff, int n, int base, const LAS int* list,
                                        int KA, int KB, int W, unsigned M0, unsigned M1, unsigned M2, unsigned M3, int t, int fr, int fq, int lane,
                                        LAS float* wl, const float (&slope2)[4], f32x4 (&o)[4][4], float (&m)[4], float (&l)[4]) {
    if (n <= 0) return;
    bf16x8 kf[2][2], vf[4];
    int k0 = GEN == 0 ? 0 : (GEN == 1 ? base : list[0]);
    ldK(kf, Kp, k0, koff);
    if (MODE != 1) ldV(vf, Vp, VP, k0, voff);
    float carry = 0.f;
#pragma unroll 1
    for (int i = 0; i < n; ++i) {
        const int inx = (i + 1 < n) ? i + 1 : i;
        const int k0n = GEN == 0 ? 32 * inx : (GEN == 1 ? base - 32 * inx : list[inx]);
        f32x4 s[2][4];
        {
            unsigned qa = (unsigned)lane * 16u; asm volatile("" : "+v"(qa));
            const LAS char* qb = (const LAS char*)wl + qa;
#pragma unroll
            for (int h = 0; h < 4; ++h) {
                const bf16x8 q0 = *(const LAS bf16x8*)(qb + (h * 2 + 0) * 1024), q1 = *(const LAS bf16x8*)(qb + (h * 2 + 1) * 1024);
#pragma unroll
                for (int kt = 0; kt < 2; ++kt) { f32x4 a = (f32x4){0.f, 0.f, 0.f, 0.f};
                    a = __builtin_amdgcn_mfma_f32_16x16x32_bf16(kf[kt][0], q0, a, 0, 0, 0);
                    a = __builtin_amdgcn_mfma_f32_16x16x32_bf16(kf[kt][1], q1, a, 0, 0, 0); s[kt][h] = a; }
            }
        }
        ldK(kf, Kp, k0n, koff);
        bool extra = true;
        if (GEN == 2) { const int j = k0 >> 6, f = j & 3; const unsigned Mw = f == 0 ? M0 : f == 1 ? M1 : f == 2 ? M2 : M3; extra = (Mw >> (j >> 2)) & 1u; }
        f32x2 dp[2][2];
#pragma unroll
        for (int kt = 0; kt < 2; ++kt)
#pragma unroll
            for (int e = 0; e < 4; ++e) { const int nn = k0 + 8 * fq + 4 * kt + e, d = t - (KA * nn + KB); const float dv = (extra && (unsigned)d <= (unsigned)W) ? (float)d : __builtin_inff();
                if (e & 1) dp[kt][e >> 1].y = dv; else dp[kt][e >> 1].x = dv; }
        f32x2 sp[2][4][2];
#pragma unroll
        for (int h = 0; h < 4; ++h)
#pragma unroll
            for (int kt = 0; kt < 2; ++kt) { const f32x2 nsl = (f32x2){-slope2[h], -slope2[h]};
                sp[kt][h][0] = (f32x2){s[kt][h][0], s[kt][h][1]} + dp[kt][0] * nsl; sp[kt][h][1] = (f32x2){s[kt][h][2], s[kt][h][3]} + dp[kt][1] * nsl; }
        if (MODE == 2) {
#pragma unroll
            for (int h = 0; h < 4; ++h) { const f32x2 mm = (f32x2){m[h], m[h]}, ll = (f32x2){l[h], l[h]};
#pragma unroll
                for (int kt = 0; kt < 2; ++kt)
#pragma unroll
                    for (int pr = 0; pr < 2; ++pr) { const f32x2 a = sp[kt][h][pr] - mm; f32x2 p; p.x = fexp2(a.x); p.y = fexp2(a.y); sp[kt][h][pr] = p * ll; } }
            f32x2 as0[2], as1[2];
#pragma unroll
            for (int pr = 0; pr < 2; ++pr) { as0[pr] = (sp[0][0][pr] + sp[0][1][pr]) + (sp[0][2][pr] + sp[0][3][pr]); as1[pr] = (sp[1][0][pr] + sp[1][1][pr]) + (sp[1][2][pr] + sp[1][3][pr]); }
            const float r1 = __shfl(as1[1].y, (lane + 48) & 63);
            const float y0 = fq > 0 ? r1 : carry, y1 = as0[1].y; carry = r1;
            wl[2048 + fr * 128 + 8 * i + 2 * fq]     = ((as0[0].x + as0[0].y) + (as0[1].x + as0[1].y)) + y0;
            wl[2048 + fr * 128 + 8 * i + 2 * fq + 1] = ((as1[0].x + as1[0].y) + (as1[1].x + as1[1].y)) + y1;
        } else {
            float mn[4]; bool grow = false;
#pragma unroll
            for (int h = 0; h < 4; ++h) {
                const f32x2 mx = __builtin_elementwise_max(__builtin_elementwise_max(sp[0][h][0], sp[0][h][1]), __builtin_elementwise_max(sp[1][h][0], sp[1][h][1]));
                float tm = fmaxf(mx.x, mx.y);
                tm = fmaxf(tm, __shfl_xor(tm, 16)); tm = fmaxf(tm, __shfl_xor(tm, 32));
                mn[h] = fmaxf(m[h], tm); grow = grow || (mn[h] > m[h]);
            }
            if (__any(grow)) {
#pragma unroll
                for (int h = 0; h < 4; ++h) { const float ms = (mn[h] == NEG_INF) ? 0.f : mn[h], alpha = fexp2(m[h] - ms); l[h] *= alpha; m[h] = mn[h];
                    if (MODE == 0) {
#pragma unroll
                        for (int dt = 0; dt < 4; ++dt) o[dt][h] = o[dt][h] * alpha; } }
            }
#pragma unroll
            for (int h = 0; h < 4; ++h) { const float ms = (m[h] == NEG_INF) ? 0.f : m[h]; const f32x2 mm = (f32x2){ms, ms}; f32x2 ps = (f32x2){0.f, 0.f};
#pragma unroll
                for (int kt = 0; kt < 2; ++kt)
#pragma unroll
                    for (int pr = 0; pr < 2; ++pr) { const f32x2 a = sp[kt][h][pr] - mm; f32x2 p; p.x = fexp2(a.x); p.y = fexp2(a.y); sp[kt][h][pr] = p; ps = ps + p; }
                l[h] += ps.x + ps.y; }
        }
#pragma unroll
        for (int h = 0; h < 4; ++h)
#pragma unroll
            for (int kt = 0; kt < 2; ++kt) s[kt][h] = (f32x4){sp[kt][h][0].x, sp[kt][h][0].y, sp[kt][h][1].x, sp[kt][h][1].y};
        if (MODE != 1) {
            bf16x8 pf[4];
#pragma unroll
            for (int h = 0; h < 4; ++h) { const v4u w = pack8(s[0][h], s[1][h]); pf[h] = __builtin_bit_cast(bf16x8, w); }
#pragma unroll
            for (int dt = 0; dt < 4; ++dt)
#pragma unroll
                for (int h = 0; h < 4; ++h) o[dt][h] = __builtin_amdgcn_mfma_f32_16x16x32_bf16(vf[dt], pf[h], o[dt][h], 0, 0, 0);
            ldV(vf, Vp, VP, k0n, voff);
        }
        k0 = k0n;
    }
}
__device__ __forceinline__ void attn_prompt_unit2(const Ptrs& P, int bg, int tt, LAS float* wl, int lane_in) {
    int lane = lane_in; asm volatile("" : "+v"(lane));
    const int fr = lane & 15, fq = lane >> 4, b = bg >> 2, g = bg & 3, t0 = 16 * tt, t = t0 + fr, row = b * SEQ + t;
    const float* GT = WSP(float, WS_GATES) + (size_t)row * 48 + g * 12;
    const GAS bf16* KC = (const GAS bf16*)WSP(bf16, WS_KC) + (size_t)bg * 512 * 64; const GAS bf16* VCT = (const GAS bf16*)WSP(bf16, WS_VCT) + (size_t)bg * 64 * 512;
    const GAS bf16* SK = (const GAS bf16*)WSP(bf16, WS_SK) + (size_t)bg * SEQ * 64; const GAS bf16* SVT = (const GAS bf16*)WSP(bf16, WS_SVT) + (size_t)bg * 64 * SEQ;
    const GAS bf16* WK = (const GAS bf16*)WSP(bf16, WS_WK) + (size_t)bg * SEQ * 64; const GAS bf16* WVT = (const GAS bf16*)WSP(bf16, WS_WVT) + (size_t)bg * 64 * SEQ;
    GAS float* OA = (GAS float*)WSP(float, WS_OACC) + (size_t)row * DM + 256 * g + 4 * fq;
    float slope2[4];
    { const GAS bf16* Q = (const GAS bf16*)WSP(bf16, WS_Q) + (size_t)row * DM + (4 * g) * 64 + 8 * fq;
#pragma unroll
      for (int h = 0; h < 4; ++h) { slope2[h] = fexp2(-0.5f * (float)(4 * g + h + 1)) * LOG2E;
#pragma unroll
          for (int ks = 0; ks < 2; ++ks) *(LAS v4u*)((LAS char*)wl + (h * 2 + ks) * 1024 + lane * 16) = *(const GAS v4u*)(Q + h * 64 + 32 * ks); } }
    f32x4 o[4][4]; float m[4], l[4];
    const int BIG = 1 << 30;
    const unsigned koff = (unsigned)((8 * (fr >> 2) + (fr & 3)) * 64 + 8 * fq) * 2u, voffc = (unsigned)(fr * 32 + 8 * fq) * 2u, voffs = voffc;
    const int nst = (tt >> 5) + 1;
#pragma unroll
    for (int h = 0; h < 4; ++h) { m[h] = NEG_INF; l[h] = 0.f; }
    att_run<1, 0>(KC, VCT, 512, koff, voffc, nst, 0, nullptr, 16, 31, BIG, 0u, 0u, 0u, 0u, t, fr, fq, lane, wl, slope2, o, m, l);
#pragma unroll
    for (int h = 0; h < 4; ++h) { float lt = l[h]; lt += __shfl_xor(lt, 16); lt += __shfl_xor(lt, 32); l[h] = lt > 0.f ? 1.0f / lt : 0.f; if (m[h] == NEG_INF) m[h] = 0.f;
#pragma unroll
        for (int dt = 0; dt < 4; ++dt) o[dt][h] = (f32x4){0.f, 0.f, 0.f, 0.f}; }
    att_run<2, 0>(KC, VCT, 512, koff, voffc, nst, 0, nullptr, 16, 31, BIG, 0u, 0u, 0u, 0u, t, fr, fq, lane, wl, slope2, o, m, l);
#pragma unroll
    for (int h = 0; h < 4; ++h) { const float gc = GT[h * 3 + 0];
#pragma unroll
        for (int dt = 0; dt < 4; ++dt) *(GAS f32x4*)(OA + h * 64 + 16 * dt) = o[dt][h] * gc; }
    const int qblk = t0 >> 6;
    unsigned M0, M1, M2, M3;
    {
        float cv[32];
#pragma unroll
        for (int q = 0; q < 32; ++q) { const int j = 4 * q + fq; const float x = wl[2048 + fr * 128 + j];
            const bool forced = (j == 0) | (j == qblk) | (j == qblk - 1); cv[q] = (j <= qblk) ? (forced ? x + 1e4f : x) : -1.f; }
        unsigned mask = 0u;
#pragma unroll 1
        for (int r = 0; r < 16; ++r) {
            float bv = cv[0]; int bq = 0;
#pragma unroll
            for (int q = 1; q < 32; ++q) if (cv[q] > bv) { bv = cv[q]; bq = q; }
            int bj = 4 * bq + fq;
#pragma unroll
            for (int off = 16; off <= 32; off <<= 1) { const float ov = __shfl_xor(bv, off); const int oj = __shfl_xor(bj, off); if (ov > bv || (ov == bv && oj < bj)) { bv = ov; bj = oj; } }
            const bool mine = (bv >= 0.f) && ((bj & 3) == fq); const int wq = bj >> 2;
#pragma unroll
            for (int q = 0; q < 32; ++q) if (mine && q == wq) cv[q] = -2.f;
            if (mine) mask |= 1u << wq;
        }
        M0 = __shfl(mask, fr); M1 = __shfl(mask, fr + 16); M2 = __shfl(mask, fr + 32); M3 = __shfl(mask, fr + 48);
    }
    int nlist = 0;
    {
        unsigned U0 = M0, U1 = M1, U2 = M2, U3 = M3;
#pragma unroll
        for (int off = 1; off < 16; off <<= 1) { U0 |= __shfl_xor(U0, off); U1 |= __shfl_xor(U1, off); U2 |= __shfl_xor(U2, off); U3 |= __shfl_xor(U3, off); }
        U0 = __builtin_amdgcn_readfirstlane(U0); U1 = __builtin_amdgcn_readfirstlane(U1); U2 = __builtin_amdgcn_readfirstlane(U2); U3 = __builtin_amdgcn_readfirstlane(U3);
        LAS int* lst = (LAS int*)(wl + 2048);
#pragma unroll 1
        for (int j = qblk; j >= 0; --j) { const int f = j & 3; const unsigned Uw = f == 0 ? U0 : f == 1 ? U1 : f == 2 ? U2 : U3;
            if ((Uw >> (j >> 2)) & 1u) { if (lane == 0) { lst[nlist] = 64 * j + 32; lst[nlist + 1] = 64 * j; } nlist += 2; } }
    }
#pragma unroll
    for (int h = 0; h < 4; ++h) { m[h] = NEG_INF; l[h] = 0.f;
#pragma unroll
        for (int dt = 0; dt < 4; ++dt) o[dt][h] = (f32x4){0.f, 0.f, 0.f, 0.f}; }
    att_run<0, 2>(SK, SVT, SEQ, koff, voffs, nlist, 0, (const LAS int*)(wl + 2048), 1, 0, BIG, M0, M1, M2, M3, t, fr, fq, lane, wl, slope2, o, m, l);
    asm volatile("s_waitcnt vmcnt(0)" ::: "memory");
#pragma unroll
    for (int h = 0; h < 4; ++h) { float lt = l[h]; lt += __shfl_xor(lt, 16); lt += __shfl_xor(lt, 32); const float sc = lt > 0.f ? GT[h * 3 + 1] / lt : 0.f;
#pragma unroll
        for (int dt = 0; dt < 4; ++dt) { GAS f32x4* p = (GAS f32x4*)(OA + h * 64 + 16 * dt); *p = *p + o[dt][h] * sc; } }
#pragma unroll
    for (int h = 0; h < 4; ++h) { m[h] = NEG_INF; l[h] = 0.f;
#pragma unroll
        for (int dt = 0; dt < 4; ++dt) o[dt][h] = (f32x4){0.f, 0.f, 0.f, 0.f}; }
    { const int kend = (t0 > 512 ? (t0 - 512) : 0) & ~31, ktop = t0 & ~31;
      att_run<0, 1>(WK, WVT, SEQ, koff, voffs, ((ktop - kend) >> 5) + 1, ktop, nullptr, 1, 0, 512, 0u, 0u, 0u, 0u, t, fr, fq, lane, wl, slope2, o, m, l); }
    asm volatile("s_waitcnt vmcnt(0)" ::: "memory");
    GAS bf16* O = (GAS bf16*)WSP(bf16, WS_O) + (size_t)row * DM + 256 * g + 4 * fq;
#pragma unroll
    for (int h = 0; h < 4; ++h) { float lt = l[h]; lt += __shfl_xor(lt, 16); lt += __shfl_xor(lt, 32); const float sc = lt > 0.f ? GT[h * 3 + 2] / lt : 0.f;
#pragma unroll
        for (int dt = 0; dt < 4; ++dt) { const f32x4 v = *(const GAS f32x4*)(OA + h * 64 + 16 * dt) + o[dt][h] * sc;
            v2u w; w.x = pk2(v[0], v[1]); w.y = pk2(v[2], v[3]); *(GAS v2u*)(O + h * 64 + 16 * dt) = w; } }
}

#define ATTN_UNIT attn_prompt_unit2
#ifdef PROBE_MODE
#ifndef PROBE_BLK
#define PROBE_BLK 0
#endif
#ifndef PROBE_MULT
#define PROBE_MULT 8
#endif
#define PROBE_SEL(p) ((p) >= PROBE_A && (p) <= PROBE_B)
#endif
struct Args { const void* in[31]; float* out; unsigned char* ws; int ph_lo, ph_hi; };
constexpr int N_PHASES = 2 + 1 + 12 + 2 * 1 + 2 * 1 + 12 + 1;

__global__ void __launch_bounds__(NWAVES * 64, 2) yoco_fwd(Args args) {
    extern __shared__ __attribute__((aligned(16))) unsigned char lds_raw[];
    LAS unsigned char* lds = (LAS unsigned char*)lds_raw;
    const int tid0 = threadIdx.x, wave = __builtin_amdgcn_readfirstlane(tid0 >> 6);
    const int G = gridDim.x; const int bx = blockIdx.x; const int vcu = (G % 8 == 0) ? (bx % 8) * (G / 8) + bx / 8 : bx;
    const int gw0 = vcu * NWAVES + wave, NGW = G * NWAVES;

    for (int u = tid0; u < (LDS_BYTES - LDSCTL_OFF) / 4; u += NWAVES * 64) ((LAS unsigned*)(lds + LDSCTL_OFF))[u] = 0u;
    __syncthreads();
    volatile LAS unsigned* MISC = (volatile LAS unsigned*)(lds + MISC_OFF);
    unsigned* barw = (unsigned*)(args.ws + WS_CTL) + CW_BAR;
    XcdBarrier bar; bar.bar = barw; bar.x = 0; bar.st = nullptr;
    const int lo = args.ph_lo, hi = args.ph_hi;
    if (hi - lo > 1) bar = xcd_barrier_post(barw, MISC + 8);
    int pid = 0;
#define IN_PH() (lo <= pid && pid < hi)
#define NIN() NormIn{P.ws, sl > 0 ? sl - 1 : 0, sl, sl > 0 ? 1 : 0}
#define LOADP() int tid = tid0; asm volatile("" : "+v"(tid)); const int lane = tid & 63; int gw = gw0; asm volatile("" : "+s"(gw)); (void)lane; (void)gw; Ptrs P; load_ptrs(P); const f16* X = WSP(f16, WS_X); bf16* H = WSP(bf16, WS_H); const float* MOD = WSP(float, WS_MOD); (void)X; (void)H; (void)MOD
#ifdef PROBE_MODE
#define PRB_ON() ((int)blockIdx.x == PROBE_BLK && tid0 == 0)
#define PRB_NOW() ((unsigned)__builtin_amdgcn_s_memrealtime())
#define END_PH() do { if (PRB_ON()) { const unsigned tm_ = PRB_NOW(); if ((PROBE_MODE & 1) && PROBE_SEL(pid)) MISC[16] = MISC[16] + (tm_ - MISC[17]); MISC[17] = tm_; } \
    if (lo <= pid && pid + 1 < hi) xcd_barrier(bar); \
    if (PRB_ON()) { const unsigned te_ = PRB_NOW(); if ((PROBE_MODE & 2) && PROBE_SEL(pid)) MISC[16] = MISC[16] + (te_ - MISC[17]); MISC[17] = te_; } ++pid; } while (0)
#else
#define END_PH() do { if (lo <= pid && pid + 1 < hi) xcd_barrier(bar); ++pid; } while (0)
#endif


#ifdef PROBE_MODE
    if (PRB_ON()) { MISC[16] = 0u; MISC[17] = PRB_NOW(); }
#endif
    if (IN_PH()) { LOADP(); prologue_phase(P, lds, gw, NGW, wave, lane, tid); }
    END_PH();
    if (IN_PH()) { LOADP();
        run_gemm(lds, WSP(bf16, WS_SC), WSP(bf16, WS_WMOD), 256, NMOD, DM, FMod{WSP(float, WS_MOD), P.ada_b, P.kv_ada_b, P.final_ada_b, WSP(bf16, WS_SHB)});
        run_gemm(lds, WSP(bf16, WS_ACMP), WSP(bf16, WS_WC1), 65536, 512, 1024, FBf16{WSP(bf16, WS_TS), 512});
        run_gemm(lds, WSP(bf16, WS_ACMP) + (size_t)65536 * 1024, WSP(bf16, WS_WC1) + (size_t)512 * 1024, 65536, 512, 1024, FBf16{WSP(bf16, WS_TS) + (size_t)65536 * 512, 512});
    }
    END_PH();

    for (int sl = 0; sl < 12; ++sl) {
        const int l = sl / 3, sub = sl - 3 * l;
        if (sl == 0) {
            if (IN_PH()) { LOADP();
                norm_phase<false>(X, P.norm_g, MOD, 0, DM, H, nullptr, gw, NGW, lane);
                { pg8::Gemm g{WSP(bf16, WS_SHB), WSP(bf16, WS_WGU), 13 * 256, 0, DM}; int cb = (int)blockIdx.x; asm volatile("" : "+s"(cb)); ShiftOrder S{(int)gridDim.x, cb}; Epi8<FB2> E{FB2{WSP(float, WS_B2)}};
                  pg8::gemm_phase<Epi8<FB2>, ShiftOrder, true, true>(lds, g, S, E); }
                for (int u = gw; u < 2 * 512 * 8; u += NGW) { const int kv = u >> 12, r = u & 4095, bg = r >> 3, rt = r & 7;
                    cmp_finish_unit<2>(WSP(bf16, WS_TS) + (size_t)kv * 65536 * 512, WSP(float, WS_CBIAS) + kv * 256, WSP(bf16, WS_WC2) + kv * 64 * 256,
                                       kv == 0 ? (void*)WSP(float, WS_KCS) : (void*)WSP(float, WS_VCS), 128, bg, rt, lane); }
            }
            END_PH();
        }
        if (sub != 1) {
            const int s = sub >> 1;
            if (IN_PH()) { LOADP();
                if (sl == 6) {
                    run_gemm2(lds, WSP(bf16, WS_HKV), WSP(bf16, WS_WKV), NKVP, NKVP, DM, FKv{P.out, WSP(bf16, WS_KCIN), NormIn{P.ws, 5, 12, 1}}, 0, 0);
                    run_gemm2(lds, H, WSP(bf16, WS_WGU) + (size_t)(l * 2 + s) * 5632 * 1024, 5632, 5632, DM, FSwiglu{WSP(bf16, WS_HID), NIN()}, (int)gridDim.x / 2, 0);
                } else
                run_gemm2(lds, H, WSP(bf16, WS_WGU) + (size_t)(l * 2 + s) * 5632 * 1024, 5632, 5632, DM, FSwiglu{WSP(bf16, WS_HID), NIN()}); }
            END_PH();
        } else if (l < 2) {
            if (IN_PH()) { LOADP(); run_gemm2(lds, H, WSP(bf16, WS_WUV) + (size_t)l * 6144 * 1024, 6144, 6144, DM, FGelu{WSP(bf16, WS_Z), NIN(), WSP(float, WS_CTL) + CW_VS + (size_t)l * RT * 2}); }
            END_PH();
            if (IN_PH()) { LOADP(); spatial2_phase(P, l, lds, wave, lane, tid, gw, NGW); }
            END_PH();
        } else {
            if (IN_PH()) { LOADP();
                if (sl == 7) {
                    for (int u = gw; u < 2 * 8 * 32; u += NGW) { const int kv = u >> 8, r = u & 255, bg = r >> 5, rt = r & 31;
                        if (kv == 0) cmp_finish_unit<0>(WSP(bf16, WS_TK), WSP(float, WS_CBIAS), WSP(bf16, WS_WC2), (void*)WSP(bf16, WS_KC), 512, bg, rt, lane);
                        else cmp_finish_unit<1>(WSP(bf16, WS_TV), WSP(float, WS_CBIAS) + 256, WSP(bf16, WS_WC2) + 64 * 256, (void*)WSP(bf16, WS_VCT), 512, bg, rt, lane); }
                }
                run_gemm2(lds, H, WSP(bf16, WS_WQG) + (size_t)(l - 2) * NQG * 1024, NQG, 1072, DM, FQg{WSP(bf16, WS_Q), WSP(float, WS_GATES), NIN()}); }
            END_PH();
            if (IN_PH()) { LOADP(); LAS float* wl = (LAS float*)(lds + (gw & 7) * 16384);
                {
                    int r = 0;
                    for (;;) {
                        const int q = ((int)(xb_xcc_id() & 7u) + r) & 7;
                        unsigned idx = 0u; if (lane == 0) idx = __hip_atomic_fetch_add((unsigned*)(P.ws + WS_CTL) + CW_QUEUE + 64 * (8 * (l - 2) + q), 1u, __ATOMIC_RELAXED, __HIP_MEMORY_SCOPE_AGENT);
                        idx = (unsigned)__builtin_amdgcn_readfirstlane((int)idx);
                        if (idx >= 64u + 512u) { if (++r == 8) break; continue; }
                        if (idx < 64u) { const int id = q * 64 + (int)idx; attn_sample_unit(P, id >> 2, id & 3, wl, lane); }
                        else ATTN_UNIT(P, q, 511 - ((int)idx - 64), wl, lane);
                    }
                }
            }
            END_PH();
        }
        if (IN_PH()) { LOADP();
            const bf16* A2 = sub != 1 ? WSP(bf16, WS_HID) : (l < 2 ? WSP(bf16, WS_P) : WSP(bf16, WS_O));
            const bf16* B2 = sub != 1 ? WSP(bf16, WS_WDN) + (size_t)(l * 2 + (sub >> 1)) * 1024 * DFF : (l < 2 ? WSP(bf16, WS_WOUT) + (size_t)l * 1024 * DV : WSP(bf16, WS_WO) + (size_t)(l - 2) * 1024 * 1024);
            const int K2 = sub != 1 ? DFF : (l < 2 ? DV : DM);
            if (sl == 6) {
                run_gemm(lds, WSP(bf16, WS_KCIN), WSP(bf16, WS_WC1), 4096, 512, 1024, FBf16{WSP(bf16, WS_TK), 512}, 64);
                run_gemm(lds, WSP(bf16, WS_VCIN), WSP(bf16, WS_WC1) + (size_t)512 * 1024, 4096, 512, 1024, FBf16{WSP(bf16, WS_TV), 512}, 32);
            }
            const int sn = sl + 1, ln = sn / 3, subn = sn - 3 * ln;
            const bool more = sl < 11;
            run_gemm2r(lds, A2, B2, K2, FResid{P.ws, l * 9216 + (sub * 3 + 2) * DM, sub != 1 ? 0.5f : 1.0f, more ? sn : -1, ln * 9216 + (subn * 3 + 1) * DM, sl == 5 ? 12 : -1, MODKV + DM, more ? sl : -1});
        }
        END_PH();
    }
    if (IN_PH()) { LOADP(); norm_phase<true>(X, P.final_g, MOD, MODFIN, MODFIN + DM, nullptr, P.out, gw, NGW, lane); }
#ifdef PROBE_MODE
    if (PRB_ON()) { const unsigned tm_ = PRB_NOW(); if ((PROBE_MODE & 1) && PROBE_SEL(pid)) MISC[16] = MISC[16] + (tm_ - MISC[17]);
        const unsigned want = MISC[16] * (unsigned)PROBE_MULT; const unsigned t0_ = PRB_NOW(); while (PRB_NOW() - t0_ < want) __builtin_amdgcn_s_sleep(32); }
#endif
    ++pid;
#undef IN_PH
#undef END_PH
}

extern "C" void kernel_launch(void* const* d_in, const int* in_sizes, int n_in, void* d_out, int out_size, void* d_ws, size_t ws_size, hipStream_t stream) {
    static int grid = 0;
    if (grid == 0) {
        if (n_in != 31 || (size_t)out_size != OUT_TOTAL || ws_size < WS_END) { fprintf(stderr, "kernel_launch: unexpected shapes (n_in %d, out %d, ws %zu need %zu); nothing launched\n", n_in, out_size, ws_size, (size_t)WS_END); grid = -1; return; }
        int dev = 0, cus = 0, per_cu = 0;
        if (hipGetDevice(&dev) != hipSuccess || hipDeviceGetAttribute(&cus, hipDeviceAttributeMultiprocessorCount, dev) != hipSuccess) { grid = -1; return; }
        if (hipFuncSetAttribute((const void*)yoco_fwd, hipFuncAttributeMaxDynamicSharedMemorySize, LDS_BYTES) != hipSuccess) { fprintf(stderr, "kernel_launch: hipFuncSetAttribute failed\n"); grid = -1; return; }
        if (hipOccupancyMaxActiveBlocksPerMultiprocessor(&per_cu, (const void*)yoco_fwd, NWAVES * 64, LDS_BYTES) != hipSuccess || per_cu < 1) { fprintf(stderr, "kernel_launch: occupancy query says %d blocks per CU\n", per_cu); }
        (void)hipGetLastError();
        grid = cus;
    }
    if (grid < 0) return;
    if (hipMemsetAsync((char*)d_ws + WS_CTL, 0, CTL_ZERO_BYTES, stream) != hipSuccess) return;
    Args a{};
    for (int i = 0; i < 31; ++i) a.in[i] = d_in[i];
    a.out = (float*)d_out; a.ws = (unsigned char*)d_ws;
#if ONE_LAUNCH
    a.ph_lo = 0; a.ph_hi = N_PHASES;
    hipLaunchKernelGGL(yoco_fwd, dim3(grid), dim3(NWAVES * 64), LDS_BYTES, stream, a);
#else
    for (int p = 0; p < N_PHASES; ++p) { a.ph_lo = p; a.ph_hi = p + 1; hipLaunchKernelGGL(yoco_fwd, dim3(grid), dim3(NWAVES * 64), LDS_BYTES, stream, a); }
#endif
}
```

```cpp
#include <hip/hip_runtime.h>
#include <cstdio>
#include <cstdint>
#include <cmath>
namespace pg8 {
#define PG8_LAS __attribute__((address_space(3)))
typedef unsigned short bf16_t;
typedef short bf16x8 __attribute__((ext_vector_type(8)));
typedef float f32x4 __attribute__((ext_vector_type(4)));
typedef unsigned u32x4 __attribute__((ext_vector_type(4)));
constexpr int BM = 256, BK = 64, HALF = 128, HTB = HALF * BK * 2  , STAGE_BYTES = 8 * HTB, NXCD = 8, WGM = 8;

__host__ __device__ __forceinline__ int lds_byte(int r, int c) { const int st = (r >> 4) * 2 + (c >> 5), rr = r & 15, cc = c & 31, ob = rr * 64 + cc * 2; return st * 1024 + (ob ^ (((ob >> 9) & 1) << 5)); }
__host__ __device__ __forceinline__ void stage_rc(int b, int& R, int& C) { const int st = b / 1024, sb = b % 1024, swz = sb ^ (((sb >> 9) & 1) << 5); R = (st >> 1) * 16 + swz / 64; C = (st & 1) * 32 + (swz % 64) / 2; }
__host__ __device__ __forceinline__ int perm32(int rho) { const int n = rho >> 4, i = rho & 15; return 8 * (i >> 2) + 4 * n + (i & 3); }

struct Unit { int pm, pn; };
struct Gemm { const bf16_t* A; const bf16_t* Bt; int M, N, K; };

struct StaticOrder {
    int nM, nN, nwg, G, c;
    __host__ __device__ void init(int M, int N, int G_, int c_) { nM = M / BM; nN = N / BM; nwg = nM * nN; G = G_; c = c_; }
    __host__ __device__ bool next(int i, Unit& u) const {
        const long L = (long)i * G + c; if (L >= nwg) return false;
        int wgid = (int)L; { const int q = nwg / NXCD, r = nwg % NXCD, xcd = wgid % NXCD, off = wgid / NXCD; wgid = (xcd < r ? xcd * (q + 1) : r * (q + 1) + (xcd - r) * q) + off; }
        const int nig = WGM * nN, gid = wgid / nig, fm = gid * WGM, gsz = (nM - fm) < WGM ? (nM - fm) : WGM;
        u.pm = fm + ((wgid % nig) % gsz); u.pn = (wgid % nig) / gsz; return true;
    }
    __device__ __forceinline__ void a_ready(const Unit&) const {}
    __device__ __forceinline__ void done(const Unit&) const {}
};

__device__ __forceinline__ unsigned cvt_pk_bf16(float lo, float hi) { unsigned r; asm volatile("v_cvt_pk_bf16_f32 %0, %1, %2" : "=v"(r) : "v"(lo), "v"(hi)); return r; }
typedef float f32x2 __attribute__((ext_vector_type(2)));
template <class Epi, class Sched, bool ALIGN_EPI = false, bool SP2 = false>
__device__ __forceinline__ void gemm_phase(PG8_LAS unsigned char* lds, const Gemm g, const Sched& S, const Epi& E) {
    int tid_raw = threadIdx.x; asm volatile("" : "+v"(tid_raw));
    const int tid = tid_raw, wid = __builtin_amdgcn_readfirstlane(tid >> 6), lane = tid & 63, wr = wid >> 2, wc = wid & 3, fr = lane & 15, fq = lane >> 4;
    const int K = g.K, nt = K / BK;
    unsigned voffA[2], voffB[2];
#pragma unroll
    for (int i = 0; i < 2; ++i) { int R, C; stage_rc(tid * 16 + i * 8192, R, C); const int Rb = Epi::PERM ? ((R & ~31) + perm32(R & 31)) : R;
        voffA[i] = (unsigned)(R * K + C) * 2u; voffB[i] = (unsigned)(Rb * K + C) * 2u; }
    const size_t kstep = (size_t)(BK * 2);
    const size_t hstep = (size_t)HALF * K * 2;
    const size_t tstep = 2 * hstep;
    const unsigned ldsw = (unsigned)wid * 1024u;
    const int aoff = lds_byte(wr * 64 + fr, fq * 8), boff = lds_byte(wc * 32 + fr, fq * 8);
#define PG8_SA(b, h) (((b) * 2 + (h)) * HTB)
#define PG8_SB(b, h) ((4 + (b) * 2 + (h)) * HTB)
#define PG8_STAGE(bufoff, gbase, voff) do { _Pragma("unroll") for (int _i = 0; _i < 2; ++_i) \
        __builtin_amdgcn_global_load_lds((const unsigned*)((const char*)(gbase) + (voff)[_i]), (PG8_LAS unsigned*)(lds + (bufoff) + ldsw + _i * 8192), 16, 0, 0); } while (0)
#define PG8_LDA(dst, b, h) do { _Pragma("unroll") for (int m = 0; m < 4; ++m) _Pragma("unroll") for (int k = 0; k < 2; ++k) dst[m][k] = *(const PG8_LAS bf16x8*)(lds + PG8_SA(b, h) + aoff + m * 2048 + k * 1024); } while (0)
#define PG8_LDB(dst, b, h) do { _Pragma("unroll") for (int n = 0; n < 2; ++n) _Pragma("unroll") for (int k = 0; k < 2; ++k) dst[n][k] = *(const PG8_LAS bf16x8*)(lds + PG8_SB(b, h) + boff + n * 2048 + k * 1024); } while (0)
#define PG8_MMA(ai, bj, At, Bt) do { __builtin_amdgcn_s_setprio(1); _Pragma("unroll") for (int m = 0; m < 4; ++m) _Pragma("unroll") for (int n = 0; n < 2; ++n) _Pragma("unroll") for (int k = 0; k < 2; ++k) \
        acc[ai][bj][m][n] = __builtin_amdgcn_mfma_f32_16x16x32_bf16(Bt[n][k], At[m][k], acc[ai][bj][m][n], 0, 0, 0); __builtin_amdgcn_s_setprio(0); } while (0)
#define PG8_WAIT_V(n) asm volatile("s_waitcnt vmcnt(" #n ")" ::: "memory")
#define PG8_WAIT_L(n) asm volatile("s_waitcnt lgkmcnt(" #n ")" ::: "memory")
#define PG8_BAR __builtin_amdgcn_s_barrier()
#define PG8_SCHED __builtin_amdgcn_sched_barrier(0)
    Unit cur, nxt; int ui = 0;
    if (!S.next(0, cur)) return;
    f32x4 acc[2][2][4][2];
#pragma unroll
    for (int a = 0; a < 2; ++a)
#pragma unroll
        for (int b = 0; b < 2; ++b)
#pragma unroll
            for (int m = 0; m < 4; ++m)
#pragma unroll
                for (int n = 0; n < 2; ++n) acc[a][b][m][n] = (f32x4){0.f, 0.f, 0.f, 0.f};
    bf16x8 At[4][2], B0[2][2], B1[2][2];
    const char* cA = (const char*)g.A + (size_t)cur.pm * tstep; const char* cB = (const char*)g.Bt + (size_t)cur.pn * tstep;
    S.a_ready(cur);
    if constexpr (SP2) {
        PG8_STAGE(PG8_SB(0, 0), cB, voffB); PG8_STAGE(PG8_SB(0, 1), cB + hstep, voffB); PG8_STAGE(PG8_SA(0, 0), cA, voffA); PG8_STAGE(PG8_SA(0, 1), cA + hstep, voffA);
        if (wr == 1) PG8_BAR;
        PG8_WAIT_V(2); PG8_BAR;
        PG8_STAGE(PG8_SB(1, 0), cB + kstep, voffB); PG8_STAGE(PG8_SA(1, 0), cA + kstep, voffA); PG8_STAGE(PG8_SB(1, 1), cB + hstep + kstep, voffB);
        PG8_WAIT_V(6); PG8_BAR;
    } else {
        PG8_STAGE(PG8_SB(0, 0), cB, voffB); PG8_STAGE(PG8_SA(0, 0), cA, voffA); PG8_STAGE(PG8_SB(0, 1), cB + hstep, voffB); PG8_STAGE(PG8_SA(0, 1), cA + hstep, voffA);
        if (wr == 1) PG8_BAR;
        PG8_WAIT_V(4); PG8_BAR;
        PG8_STAGE(PG8_SB(1, 0), cB + kstep, voffB); PG8_STAGE(PG8_SA(1, 0), cA + kstep, voffA); PG8_STAGE(PG8_SB(1, 1), cB + hstep + kstep, voffB);
        PG8_WAIT_V(6); PG8_BAR;
    }
    for (;;) {
        const bool has_next = S.next(ui + 1, nxt);
        const char* nA = has_next ? (const char*)g.A + (size_t)nxt.pm * tstep : cA; const char* nB = has_next ? (const char*)g.Bt + (size_t)nxt.pn * tstep : cB;
        for (int t = 0; t < nt; t += 2) {
            const bool last = (t == nt - 2);
            const char* a1 = cA + (size_t)(t + 1) * kstep;
            const char* a2 = last ? nA : cA + (size_t)(t + 2) * kstep; const char* b2 = last ? nB : cB + (size_t)(t + 2) * kstep;
            const char* a3 = a2 + kstep; const char* b3 = b2 + kstep;
            if (last && has_next) S.a_ready(nxt);
            if constexpr (SP2) {
            PG8_LDB(B0, 0, 0); PG8_LDB(B1, 0, 1); PG8_SCHED; PG8_LDA(At, 0, 0); PG8_STAGE(PG8_SA(1, 1), a1 + hstep, voffA);
            PG8_WAIT_V(8); PG8_WAIT_L(0); PG8_BAR; PG8_MMA(0, 0, At, B0); PG8_MMA(0, 1, At, B1); PG8_BAR; PG8_SCHED;
            PG8_LDA(At, 0, 1); PG8_STAGE(PG8_SB(0, 0), b2, voffB); PG8_STAGE(PG8_SB(0, 1), b2 + hstep, voffB); PG8_STAGE(PG8_SA(0, 0), a2, voffA);
            PG8_WAIT_V(8); PG8_WAIT_L(0); PG8_BAR; PG8_MMA(1, 0, At, B0); PG8_MMA(1, 1, At, B1); PG8_BAR; PG8_SCHED;
            PG8_LDB(B0, 1, 0); PG8_LDB(B1, 1, 1); PG8_SCHED; PG8_LDA(At, 1, 0); PG8_STAGE(PG8_SA(0, 1), a2 + hstep, voffA);
            PG8_WAIT_V(8); PG8_WAIT_L(0); PG8_BAR; PG8_MMA(0, 0, At, B0); PG8_MMA(0, 1, At, B1); PG8_BAR; PG8_SCHED;
            PG8_LDA(At, 1, 1); PG8_STAGE(PG8_SB(1, 0), b3, voffB); PG8_STAGE(PG8_SB(1, 1), b3 + hstep, voffB); PG8_STAGE(PG8_SA(1, 0), a3, voffA);
            PG8_WAIT_V(8); PG8_WAIT_L(0); PG8_BAR; PG8_MMA(1, 0, At, B0); PG8_MMA(1, 1, At, B1); PG8_BAR; PG8_SCHED;
            } else {
            PG8_LDB(B0, 0, 0); PG8_SCHED; PG8_LDA(At, 0, 0); PG8_STAGE(PG8_SA(1, 1), a1 + hstep, voffA);
            PG8_WAIT_L(8); PG8_BAR; PG8_WAIT_L(0); PG8_MMA(0, 0, At, B0); PG8_BAR; PG8_SCHED;
            PG8_LDB(B1, 0, 1); PG8_STAGE(PG8_SB(0, 0), b2, voffB);
            PG8_BAR; PG8_WAIT_L(0); PG8_MMA(0, 1, At, B1); PG8_BAR;
            PG8_LDA(At, 0, 1); PG8_STAGE(PG8_SA(0, 0), a2, voffA);
            PG8_BAR; PG8_WAIT_L(0); PG8_MMA(1, 0, At, B0); PG8_BAR; PG8_SCHED;
            PG8_STAGE(PG8_SB(0, 1), b2 + hstep, voffB);
            PG8_WAIT_V(6); PG8_BAR; PG8_MMA(1, 1, At, B1); PG8_BAR;
            PG8_LDB(B0, 1, 0); PG8_SCHED; PG8_LDA(At, 1, 0); PG8_STAGE(PG8_SA(0, 1), a2 + hstep, voffA);
            PG8_WAIT_L(8); PG8_BAR; PG8_WAIT_L(0); PG8_MMA(0, 0, At, B0); PG8_BAR; PG8_SCHED;
            PG8_LDB(B1, 1, 1); PG8_STAGE(PG8_SB(1, 0), b3, voffB);
            PG8_BAR; PG8_WAIT_L(0); PG8_MMA(0, 1, At, B1); PG8_BAR;
            PG8_LDA(At, 1, 1); PG8_STAGE(PG8_SA(1, 0), a3, voffA);
            PG8_BAR; PG8_WAIT_L(0); PG8_MMA(1, 0, At, B0); PG8_BAR; PG8_SCHED;
            PG8_STAGE(PG8_SB(1, 1), b3 + hstep, voffB);
            PG8_WAIT_V(6); PG8_BAR; PG8_MMA(1, 1, At, B1); PG8_BAR;
            }
        }
        if constexpr (ALIGN_EPI) { if (wr == 0) PG8_BAR; }
        if constexpr (!Epi::AFTER_DRAIN) { E(acc, cur, wr, wc, fr, fq); S.done(cur); }
        if (!has_next) break;
#pragma unroll
        for (int a = 0; a < 2; ++a)
#pragma unroll
            for (int b = 0; b < 2; ++b)
#pragma unroll
                for (int m = 0; m < 4; ++m)
#pragma unroll
                    for (int n = 0; n < 2; ++n) acc[a][b][m][n] = (f32x4){0.f, 0.f, 0.f, 0.f};
        cur = nxt; cA = nA; cB = nB; ++ui;
        if constexpr (ALIGN_EPI) { if (wr == 1) PG8_BAR; }
    }
    PG8_WAIT_V(0);
    if constexpr (!ALIGN_EPI) { if (wr == 0) PG8_BAR; }
    PG8_BAR;
    if constexpr (Epi::AFTER_DRAIN) { E.fused(acc, cur, wr, wc, fr, fq, lds, wid, lane); S.done(cur); }
#undef PG8_SA
#undef PG8_SB
#undef PG8_STAGE
#undef PG8_LDA
#undef PG8_LDB
#undef PG8_MMA
#undef PG8_WAIT_V
#undef PG8_WAIT_L
#undef PG8_BAR
#undef PG8_SCHED
}
}
#define LAS __attribute__((address_space(3)))
#define XB_TMO      128
#define XB_XCNT(j)  (256  + 64 * (j))
#define XB_XSUB(j)  (1280 + 64 * (j))
#define XB_XGEN(j)  (2304 + 64 * (j))
#define XB_TOP      3328
#define XB_TOPGEN   3392
#define XCD_BAR_WORDS 3456
#define XB_SPIN_CAP (1u << 18)

__device__ __forceinline__ unsigned xb_ld(unsigned* p)              { return __hip_atomic_load(p, __ATOMIC_RELAXED, __HIP_MEMORY_SCOPE_AGENT); }
__device__ __forceinline__ unsigned xb_add(unsigned* p, unsigned v) { return __hip_atomic_fetch_add(p, v, __ATOMIC_RELAXED, __HIP_MEMORY_SCOPE_AGENT); }
__device__ __forceinline__ unsigned xb_xcc_id() { return (unsigned)__builtin_amdgcn_s_getreg((3 << 11) | 20) & 0xFu; }
#define XB_SPIN(cond, bar) do { unsigned _sp = 0; while (cond) { __builtin_amdgcn_s_sleep(1); \
    if ((++_sp & 255u) == 0u) { if (xb_ld(&(bar)[XB_TMO])) break; if (_sp > XB_SPIN_CAP) { atomicAdd(&(bar)[XB_TMO], 1u); break; } } } } while (0)

struct XcdBarrier {
    unsigned* bar; unsigned x;
    volatile LAS unsigned* st;
};

__device__ __forceinline__ XcdBarrier xcd_barrier_post(unsigned* bar, volatile LAS unsigned* st) {
    XcdBarrier b; b.bar = bar; b.x = xb_xcc_id(); b.st = st;
    if (threadIdx.x == 0) (void)xb_add(&bar[XB_XCNT(b.x)], 1u);
    return b;
}
__device__ __forceinline__ void xcd_barrier_complete(unsigned* bar, unsigned x, unsigned& nloc, unsigned& nx) {
    const unsigned G = gridDim.x * gridDim.y * gridDim.z;
    unsigned sum, cnt, mine, sp = 0u;
    for (;;) {
        sum = 0u; cnt = 0u; mine = 0u;
#pragma unroll
        for (unsigned j = 0; j < 16; ++j) { const unsigned c = xb_ld(&bar[XB_XCNT(j)]); sum += c; cnt += (c > 0u) ? 1u : 0u; mine = (j == x) ? c : mine; }
        if (sum == G) break;
        __builtin_amdgcn_s_sleep(1);
        if ((++sp & 255u) == 0u) { if (xb_ld(&bar[XB_TMO])) break; if (sp > XB_SPIN_CAP) { atomicAdd(&bar[XB_TMO], 1u); break; } }
    }
    nloc = mine > 0u ? mine : 1u; nx = cnt > 0u ? cnt : 1u;
}

__device__ __forceinline__ void xcd_barrier(const XcdBarrier& b) {
    asm volatile("s_waitcnt vmcnt(0)" ::: "memory");
    __syncthreads();
    if (threadIdx.x == 0) {
        unsigned* bar = b.bar;
        __builtin_amdgcn_s_waitcnt(0);
        unsigned nloc = b.st[0], nx = b.st[1];
        if (nloc == 0u) { xcd_barrier_complete(bar, b.x, nloc, nx); b.st[0] = nloc; b.st[1] = nx; }
        const unsigned old = xb_add(&bar[XB_XSUB(b.x)], 1u);
        const unsigned gen = old / nloc;
        if (old + 1u == (gen + 1u) * nloc) {
            __builtin_amdgcn_fence(__ATOMIC_RELEASE, "agent");
            asm volatile("s_waitcnt vmcnt(0)" ::: "memory");
            const unsigned og = xb_add(&bar[XB_TOP], 1u);
            const unsigned tg = og / nx;
            if (og + 1u == (tg + 1u) * nx) xb_add(&bar[XB_TOPGEN], 1u);
            else XB_SPIN(xb_ld(&bar[XB_TOPGEN]) == tg, bar);
            __builtin_amdgcn_fence(__ATOMIC_ACQUIRE, "agent");
            xb_add(&bar[XB_XGEN(b.x)], 1u);
            asm volatile("s_waitcnt vmcnt(0)" ::: "memory");
        } else {
            XB_SPIN(xb_ld(&bar[XB_XGEN(b.x)]) == gen, bar);
            __builtin_amdgcn_fence(__ATOMIC_ACQUIRE, "agent");
            asm volatile("s_waitcnt vmcnt(0)" ::: "memory");
        }
    }
    __syncthreads();
}

constexpr int DM = 1024, SEQ = 8192, MP = 16384, MS = 128, MR = MP + MS, RT = 16640;
constexpr int DFF = 2816, DV = 3072, NGA = 8, CGW = 384, NQG = 1280, NKVP = 1536;
constexpr int NMOD = 40960;
constexpr int MODKV = 36864, MODFIN = 38912;
constexpr int NPAGES = 16, PAST = 2048;
constexpr float LOG2E = 1.4426950408889634f;
#ifndef ONE_LAUNCH
#define ONE_LAUNCH 1
#endif

constexpr size_t OY_P = 0, OY_S = 16777216, OKV_P = 16908288, OKV_S = 33685504, OWIN_P = 33816576, OWIN_S = 34340864, OGV = 67895296, OUT_TOTAL = 68681728;

constexpr size_t al(size_t x) { return (x + 0xFFFFFull) & ~0xFFFFFull; }
constexpr size_t WS_CTL = 0, CTL_ZERO_BYTES = 2u << 20;
constexpr size_t WS_WMOD = al(CTL_ZERO_BYTES);
constexpr size_t WS_WGU = al(WS_WMOD + (size_t)NMOD * DM * 2);
constexpr size_t WS_WDN = al(WS_WGU + (size_t)8 * 5632 * DM * 2);
constexpr size_t WS_WUV = al(WS_WDN + (size_t)8 * DM * DFF * 2);
constexpr size_t WS_WOUT = al(WS_WUV + (size_t)2 * 6144 * DM * 2);
constexpr size_t WS_WQG = al(WS_WOUT + (size_t)2 * DM * DV * 2);
constexpr size_t WS_WO = al(WS_WQG + (size_t)2 * NQG * DM * 2);
constexpr size_t WS_WKV = al(WS_WO + (size_t)2 * DM * DM * 2);
constexpr size_t WS_WC1 = al(WS_WKV + (size_t)NKVP * DM * 2);
constexpr size_t WS_WC2 = al(WS_WC1 + (size_t)2 * 512 * 1024 * 2);
constexpr size_t WS_WSP = al(WS_WC2 + (size_t)2 * 64 * 256 * 2);
constexpr size_t WS_CBIAS = al(WS_WSP + (size_t)2 * 8 * 128 * 128 * 2);
constexpr size_t WS_X = al(WS_CBIAS + 4096);
constexpr size_t WS_H = al(WS_X + (size_t)RT * DM * 2);
constexpr size_t WS_HID = al(WS_H + (size_t)RT * DM * 2);
constexpr size_t WS_Z = al(WS_HID + (size_t)RT * DFF * 2);
constexpr size_t WS_VT = al(WS_Z + (size_t)RT * 6144 * 2);
constexpr size_t WS_P = al(WS_VT + (size_t)128 * DV * 128 * 2);
constexpr size_t WS_Q = al(WS_P + (size_t)RT * DV * 2);
constexpr size_t WS_GATES = al(WS_Q + (size_t)RT * DM * 2);
constexpr size_t WS_O = al(WS_GATES + (size_t)RT * 48 * 4);
constexpr size_t KVB = (size_t)8 * SEQ * 64 * 2;
constexpr size_t WS_KCIN = al(WS_O + (size_t)RT * DM * 2);
constexpr size_t WS_VCIN = WS_KCIN + KVB, WS_SK = WS_VCIN + KVB, WS_SVT = WS_SK + KVB, WS_WK = WS_SVT + KVB, WS_WVT = WS_WK + KVB;
constexpr size_t WS_MOD = al(WS_WVT + KVB);
constexpr size_t WS_SC = al(WS_MOD + (size_t)256 * NMOD * 4);
constexpr size_t WS_TK = al(WS_SC + (size_t)256 * DM * 2);
constexpr size_t WS_TV = al(WS_TK + (size_t)4096 * 512 * 2);
constexpr size_t WS_KC = al(WS_TV + (size_t)4096 * 512 * 2);
constexpr size_t WS_VCT = al(WS_KC + (size_t)8 * 512 * 64 * 2);
constexpr size_t WS_ACMP = al(WS_VCT + (size_t)8 * 64 * 512 * 2);
constexpr size_t WS_TS = al(WS_ACMP + (size_t)2 * 65536 * 1024 * 2);
constexpr size_t WS_KCS = al(WS_TS + (size_t)2 * 65536 * 512 * 2);
constexpr size_t WS_VCS = al(WS_KCS + (size_t)512 * 128 * 64 * 4);
constexpr size_t WS_OACC = al(WS_VCS + (size_t)512 * 128 * 64 * 4);
constexpr size_t WS_HKV = al(WS_OACC + (size_t)MP * DM * 4);
constexpr size_t WS_SHB = al(WS_HKV + (size_t)RT * DM * 2);
constexpr size_t WS_B2 = al(WS_SHB + (size_t)13 * 256 * 1024 * 2);
constexpr size_t WS_NG = al(WS_B2 + (size_t)13 * 256 * 6144 * 4);
constexpr size_t WS_SSP = al(WS_NG + (size_t)13 * 1024 * 4);
constexpr size_t WS_SSPS = al(WS_SSP + (size_t)11 * MP * 16 * 4);
constexpr size_t WS_END = al(WS_SSPS + (size_t)11 * MS * 32 * 4);

constexpr int CW_BAR = 4096, CW_QUEUE = 8192, CW_SS = 32768, CW_VS = CW_SS + 11 * 16640;
static_assert((size_t)(CW_VS + 2 * 16640 * 2) * 4 <= CTL_ZERO_BYTES, "SS / VS accumulators inside the memset region");

constexpr int RING_BYTES = 131072, LDSCTL_OFF = RING_BYTES, MISC_OFF = LDSCTL_OFF + 320, LDS_BYTES = 147456;
constexpr int NWAVES = 8;

#define GAS __attribute__((address_space(1)))
typedef unsigned short bf16;
typedef unsigned v4u __attribute__((ext_vector_type(4)));
typedef unsigned v2u __attribute__((ext_vector_type(2)));
typedef float f32x4 __attribute__((ext_vector_type(4)));
typedef short bf16x8 __attribute__((ext_vector_type(8)));
typedef short bf16x4 __attribute__((ext_vector_type(4)));
typedef float f32x2 __attribute__((ext_vector_type(2)));
typedef _Float16 f16x4 __attribute__((ext_vector_type(4)));
typedef _Float16 f16x8 __attribute__((ext_vector_type(8)));
typedef _Float16 f16;

__device__ __forceinline__ float bf2f(unsigned b) { return __uint_as_float(b << 16); }
__device__ __forceinline__ float bflo(unsigned w) { return __uint_as_float(w << 16); }
__device__ __forceinline__ float bfhi(unsigned w) { return __uint_as_float(w & 0xffff0000u); }
__device__ __forceinline__ unsigned pk2(float lo, float hi) { return pg8::cvt_pk_bf16(lo, hi); }
__device__ __forceinline__ float frcp(float x) { return __builtin_amdgcn_rcpf(x); }
__device__ __forceinline__ float fexp2(float x) { return __builtin_amdgcn_exp2f(x); }
__device__ __forceinline__ float sigmoid_f(float x) { return frcp(1.f + fexp2(-LOG2E * x)); }
__device__ __forceinline__ float silu_f(float x) { return x * sigmoid_f(x); }
__device__ __forceinline__ float gelu_tanh_f(float x) { const float u = x + 0.044715f * x * x * x; return x * frcp(1.f + fexp2(-2.302208198f * u)); }
__device__ __forceinline__ int row_b(int r) { return r < SEQ ? 0 : (r < MP ? 1 : 2 + ((r - MP) < MS ? (r - MP) : (MS - 1))); }
__device__ __forceinline__ float wave_sum(float v) {
#pragma unroll
    for (int o = 1; o < 64; o <<= 1) v += __shfl_xor(v, o);
    return v;
}
__device__ __forceinline__ v4u pack8(const f32x4 a, const f32x4 b) { v4u w; w.x = pk2(a[0], a[1]); w.y = pk2(a[2], a[3]); w.z = pk2(b[0], b[1]); w.w = pk2(b[2], b[3]); return w; }
__device__ __forceinline__ void unpack8(const v4u w, float (&f)[8]) { f[0] = bflo(w.x); f[1] = bfhi(w.x); f[2] = bflo(w.y); f[3] = bfhi(w.y); f[4] = bflo(w.z); f[5] = bfhi(w.z); f[6] = bflo(w.w); f[7] = bfhi(w.w); }

template <class F> struct Epi8 {
    static constexpr bool PERM = true, AFTER_DRAIN = false; F f;
    __device__ __forceinline__ void operator()(const pg8::f32x4 (&acc)[2][2][4][2], const pg8::Unit& u, int wr, int wc, int fr, int fq) const {
        const int row0 = u.pm * pg8::BM + wr * 64 + fr, col0 = u.pn * pg8::BM + wc * 32 + 8 * fq;
        typename F::Pre pre; f.prep(pre, row0, col0, false);
#pragma unroll
        for (int ai = 0; ai < 2; ++ai)
#pragma unroll
            for (int mh = 0; mh < 2; ++mh) {
                typename F::Ld ld[2][2];
#pragma unroll
                for (int m2 = 0; m2 < 2; ++m2)
#pragma unroll
                    for (int bj = 0; bj < 2; ++bj) f.fetch(ld[m2][bj], row0 + ai * pg8::HALF + (2 * mh + m2) * 16, col0 + bj * pg8::HALF);
#pragma unroll
                for (int m2 = 0; m2 < 2; ++m2) { const int m = 2 * mh + m2, row = row0 + ai * pg8::HALF + m * 16;
                    f32x2 part = (f32x2){0.f, 0.f};
#pragma unroll
                    for (int bj = 0; bj < 2; ++bj) part = part + f(pre, ld[m2][bj], ai * 4 + m, bj, row, col0 + bj * pg8::HALF, acc[ai][bj][m][0], acc[ai][bj][m][1]);
                    f.row_done(row, part, fq); }
            }
    }
};
struct NoLd {};
struct NoPre {};
struct NormPre { float rs[8]; f32x4 b[2][2]; };
struct NormIn { unsigned char* ws; int ssi, inst, on;
    __device__ __forceinline__ void prep(NormPre& p, int row0, int col0, bool skinny) const {
        if (!on) return;
        const float* SS = (const float*)(ws + WS_CTL) + CW_SS + (size_t)ssi * RT; const float* b = (const float*)(ws + WS_B2) + ((size_t)inst * 256 + row_b(row0)) * 6144 + col0;
        if (skinny) { p.rs[0] = SS[row0]; p.b[0][0] = *(const f32x4*)b; p.b[0][1] = *(const f32x4*)(b + 4); p.rs[0] = __builtin_amdgcn_rsqf(p.rs[0] * (1.0f / DM) + 1e-6f); }
        else {
#pragma unroll
            for (int i = 0; i < 8; ++i) p.rs[i] = SS[row0 + (i >> 2) * 128 + (i & 3) * 16];
#pragma unroll
            for (int bj = 0; bj < 2; ++bj) { p.b[bj][0] = *(const f32x4*)(b + 128 * bj); p.b[bj][1] = *(const f32x4*)(b + 128 * bj + 4); }
#pragma unroll
            for (int i = 0; i < 8; ++i) p.rs[i] = __builtin_amdgcn_rsqf(p.rs[i] * (1.0f / DM) + 1e-6f);
        }
    }
    __device__ __forceinline__ void apply(const NormPre& p, int ri, int bj, f32x4& v0, f32x4& v1) const { if (on) { v0 = v0 * p.rs[ri] + p.b[bj][0]; v1 = v1 * p.rs[ri] + p.b[bj][1]; } }
};
struct FSwiglu {
    typedef NormPre Pre; typedef NoLd Ld; __device__ __forceinline__ void fetch(Ld&, int, int) const {} bf16* HID; NormIn ni;
    __device__ __forceinline__ void prep(Pre& p, int row0, int col0, bool sk) const { ni.prep(p, row0, col0, sk); }
    __device__ __forceinline__ f32x2 operator()(const Pre& p, const Ld&, int ri, int bj, int row, int col0, f32x4 g, f32x4 u) const {
        ni.apply(p, ri, bj, g, u);
        v2u w; w.x = pk2(silu_f(g[0]) * u[0], silu_f(g[1]) * u[1]); w.y = pk2(silu_f(g[2]) * u[2], silu_f(g[3]) * u[3]);
        *(v2u*)(HID + (size_t)row * DFF + (col0 >> 1)) = w; return (f32x2){0.f, 0.f};
    }
    __device__ __forceinline__ void row_done(int, f32x2, int) const {}
};
struct ResidPre { f32x4 gate[2][2], hm[2][2]; };
struct FResid {
    typedef ResidPre Pre; struct Ld { f32x4 x0, x1; };
    unsigned char* ws; int gcol; float coef; int n1, sc1, n2, sc2, ssi;
    __device__ __forceinline__ void fetch(Ld& d, int row, int col0) const { const f16x8 h = *(const f16x8*)((const f16*)(ws + WS_X) + (size_t)row * DM + col0); const f16x4 lo = __builtin_shufflevector(h, h, 0, 1, 2, 3), hi = __builtin_shufflevector(h, h, 4, 5, 6, 7);
        d.x0 = __builtin_convertvector(lo, f32x4); d.x1 = __builtin_convertvector(hi, f32x4); }
    __device__ __forceinline__ void prep(Pre& p, int row0, int col0, bool skinny) const {
        const float* mrow = (const float*)(ws + WS_MOD) + (size_t)row_b(row0) * NMOD + col0;
#pragma unroll
        for (int bj = 0; bj < 2; ++bj) { if (skinny && bj) break;
            p.gate[bj][0] = *(const f32x4*)(mrow + gcol + 128 * bj) * coef; p.gate[bj][1] = *(const f32x4*)(mrow + gcol + 128 * bj + 4) * coef;
            if (n1 >= 0) { const float* g1 = (const float*)(ws + WS_NG) + n1 * DM + col0 + 128 * bj;
                p.hm[bj][0] = *(const f32x4*)g1 * (*(const f32x4*)(mrow + sc1 + 128 * bj) + 1.0f); p.hm[bj][1] = *(const f32x4*)(g1 + 4) * (*(const f32x4*)(mrow + sc1 + 128 * bj + 4) + 1.0f); } }
    }
    __device__ __forceinline__ f32x2 operator()(const Pre& p, const Ld& d, int ri, int bj, int row, int col0, f32x4 v0, f32x4 v1) const {
        const f32x4 x0 = d.x0 + p.gate[bj][0] * v0, x1 = d.x1 + p.gate[bj][1] * v1;
        { const f16x4 lo = __builtin_convertvector(x0, f16x4), hi = __builtin_convertvector(x1, f16x4); *(f16x8*)((f16*)(ws + WS_X) + (size_t)row * DM + col0) = __builtin_shufflevector(lo, hi, 0, 1, 2, 3, 4, 5, 6, 7); }
        if (n1 >= 0) *(v4u*)((bf16*)(ws + WS_H) + (size_t)row * DM + col0) = pack8(x0 * p.hm[bj][0], x1 * p.hm[bj][1]);
        if (n2 >= 0) { const float* mrow = (const float*)(ws + WS_MOD) + (size_t)row_b(row) * NMOD + col0; const float* g2 = (const float*)(ws + WS_NG) + n2 * DM + col0;
            const f32x4 a0 = *(const f32x4*)g2, a1 = *(const f32x4*)(g2 + 4), s0 = *(const f32x4*)(mrow + sc2), s1 = *(const f32x4*)(mrow + sc2 + 4);
            *(v4u*)((bf16*)(ws + WS_HKV) + (size_t)row * DM + col0) = pack8(x0 * a0 * (s0 + 1.0f), x1 * a1 * (s1 + 1.0f)); }
        return (f32x2){((x0[0] * x0[0] + x0[1] * x0[1]) + (x0[2] * x0[2] + x0[3] * x0[3])) + ((x1[0] * x1[0] + x1[1] * x1[1]) + (x1[2] * x1[2] + x1[3] * x1[3])), 0.f};
    }
    __device__ __forceinline__ void row_done(int row, f32x2 part2, int fq) const {
        float part = part2[0];
        if (ssi >= 0) { part += __shfl_xor(part, 16); part += __shfl_xor(part, 32); if (fq == 0) atomicAdd((float*)(ws + WS_CTL) + CW_SS + (size_t)ssi * RT + row, part); }
    }
};
struct FGelu {
    typedef NormPre Pre; typedef NoLd Ld; __device__ __forceinline__ void fetch(Ld&, int, int) const {} bf16* Z; NormIn ni; float* VS;
    __device__ __forceinline__ void prep(Pre& p, int row0, int col0, bool sk) const { ni.prep(p, row0, col0, sk); }
    __device__ __forceinline__ f32x2 operator()(const Pre& p, const Ld&, int ri, int bj, int row, int col0, f32x4 v0, f32x4 v1) const {
        ni.apply(p, ri, bj, v0, v1);
        f32x4 a, b;
#pragma unroll
        for (int i = 0; i < 4; ++i) { a[i] = gelu_tanh_f(v0[i]); b[i] = gelu_tanh_f(v1[i]); }
        *(v4u*)(Z + (size_t)row * 6144 + col0) = pack8(a, b);
        if (col0 < DV) return (f32x2){0.f, 0.f};
        const f32x4 s = a + b, q = a * a + b * b; return (f32x2){(s[0] + s[1]) + (s[2] + s[3]), (q[0] + q[1]) + (q[2] + q[3])};
    }
    __device__ __forceinline__ void row_done(int row, f32x2 part, int fq) const {
        float s = part[0], q = part[1];
        s += __shfl_xor(s, 16); s += __shfl_xor(s, 32); q += __shfl_xor(q, 16); q += __shfl_xor(q, 32);
        if (fq == 0 && q != 0.f) { atomicAdd(VS + 2 * (size_t)row, s); atomicAdd(VS + 2 * (size_t)row + 1, q); }
    }
};
struct FQg {
    typedef NormPre Pre; typedef NoLd Ld; __device__ __forceinline__ void fetch(Ld&, int, int) const {} bf16* Q; float* GATES; NormIn ni;
    __device__ __forceinline__ void prep(Pre& p, int row0, int col0, bool sk) const { ni.prep(p, row0, col0, sk); }
    __device__ __forceinline__ f32x2 operator()(const Pre& p, const Ld&, int ri, int bj, int row, int col0, f32x4 v0, f32x4 v1) const {
        ni.apply(p, ri, bj, v0, v1);
        if (col0 < DM) { *(v4u*)(Q + (size_t)row * DM + col0) = pack8(v0 * (0.125f * LOG2E), v1 * (0.125f * LOG2E)); }
        else if (col0 < DM + 48) { f32x4 a, b;
#pragma unroll
            for (int i = 0; i < 4; ++i) { a[i] = sigmoid_f(v0[i]); b[i] = sigmoid_f(v1[i]); }
            float* gp = GATES + (size_t)row * 48 + (col0 - DM); *(f32x4*)gp = a; *(f32x4*)(gp + 4) = b; }
        return (f32x2){0.f, 0.f};
    }
    __device__ __forceinline__ void row_done(int, f32x2, int) const {}
};
struct FKv {
    typedef NormPre Pre; typedef NoLd Ld; __device__ __forceinline__ void fetch(Ld&, int, int) const {} float* out; bf16 *KCIN; NormIn ni;
    __device__ __forceinline__ void prep(Pre& p, int row0, int col0, bool sk) const { ni.prep(p, row0, col0, sk); }
    __device__ __forceinline__ f32x2 operator()(const Pre& p, const Ld&, int ri, int bj, int row, int col0, f32x4 v0, f32x4 v1) const {
        ni.apply(p, ri, bj, v0, v1);
        const int slot = col0 >> 8, g = (col0 >> 6) & 3, d0 = col0 & 63;
        if (row < MP) {
            const int b = row >> 13, t = row & (SEQ - 1);
            if (slot < 4) { float* q = out + OKV_P + (size_t)row * DM + col0; *(f32x4*)q = v0; *(f32x4*)(q + 4) = v1; }
            else if (t >= SEQ - 512) { float* q = out + OWIN_P + ((size_t)(b * 512 + (t - (SEQ - 512))) * 2 + (slot - 4)) * 256 + g * 64 + d0; *(f32x4*)q = v0; *(f32x4*)(q + 4) = v1; }
            const int bg = b * 4 + g;
            if (slot == 3 || slot == 5) {
                bf16* base = KCIN + (size_t)slot * (KVB / 2) + (((size_t)bg * (SEQ / 32) + (t >> 5)) * 64 + d0) * 32 + (t & 31);
#pragma unroll
                for (int i = 0; i < 4; ++i) { base[i * 32] = (bf16)(pk2(v0[i], 0.f) & 0xffffu); base[(i + 4) * 32] = (bf16)(pk2(v1[i], 0.f) & 0xffffu); }
            } else {
                bf16* base = KCIN + (size_t)slot * (KVB / 2) + ((size_t)bg * SEQ + t) * 64 + d0;
                *(v4u*)base = pack8(v0, v1);
            }
        } else {
            const int bs = row - MP;
            if (slot < 4) { float* q = out + OKV_S + (size_t)bs * DM + col0; *(f32x4*)q = v0; *(f32x4*)(q + 4) = v1; }
            else { float* q = out + OWIN_S + ((size_t)bs * 512 + 511) * 512 + (slot - 4) * 256 + g * 64 + d0; *(f32x4*)q = v0; *(f32x4*)(q + 4) = v1; }
        }
        return (f32x2){0.f, 0.f};
    }
    __device__ __forceinline__ void row_done(int, f32x2, int) const {}
};
constexpr int SH_NINST = 13;
struct FMod {
    typedef NoPre Pre; typedef NoLd Ld; __device__ __forceinline__ void fetch(Ld&, int, int) const {} float* MOD; const float *b0, *b1, *b2; bf16* SHB;
    __device__ __forceinline__ void prep(Pre&, int, int, bool) const {}
    __device__ __forceinline__ f32x2 operator()(const Pre&, const Ld&, int, int, int row, int col0, f32x4 v0, f32x4 v1) const {
        const float* bp = col0 < MODKV ? b0 + col0 : (col0 < MODFIN ? b1 + (col0 - MODKV) : b2 + (col0 - MODFIN));
        v0 = v0 + *(const f32x4*)bp; v1 = v1 + *(const f32x4*)(bp + 4);
        float* p = MOD + (size_t)row * NMOD + col0; *(f32x4*)p = v0; *(f32x4*)(p + 4) = v1;
        int inst = -1, k = 0;
        if (col0 < MODKV) { const int l = col0 / 9216, r = col0 - l * 9216, sub = r / 3072, rr = r - sub * 3072; if (rr < DM) { inst = l * 3 + sub; k = rr; } }
        else if (col0 < MODKV + DM) { inst = 12; k = col0 - MODKV; }
        if (inst >= 0) *(v4u*)(SHB + ((size_t)inst * 256 + row) * DM + k) = pack8(v0, v1);
        return (f32x2){0.f, 0.f};
    }
    __device__ __forceinline__ void row_done(int, f32x2, int) const {}
};
struct FBf16 {
    typedef NoPre Pre; typedef NoLd Ld; __device__ __forceinline__ void fetch(Ld&, int, int) const {} bf16* T; int ld;
    __device__ __forceinline__ void prep(Pre&, int, int, bool) const {}
    __device__ __forceinline__ f32x2 operator()(const Pre&, const Ld&, int, int, int row, int col0, f32x4 v0, f32x4 v1) const { *(v4u*)(T + (size_t)row * ld + col0) = pack8(v0, v1); return (f32x2){0.f, 0.f}; }
    __device__ __forceinline__ void row_done(int, f32x2, int) const {}
};
constexpr int TILEB = 256 * 1024 * 2;
constexpr int PN_UV = (int)((WS_WUV - WS_WGU) / TILEB), PN_QG = (int)((WS_WQG - WS_WGU) / TILEB), PN_KV = (int)((WS_WKV - WS_WGU) / TILEB);
static_assert((WS_WUV - WS_WGU) % TILEB == 0 && (WS_WQG - WS_WGU) % TILEB == 0 && (WS_WKV - WS_WGU) % TILEB == 0, "weight copies on 256-row tile boundaries");
struct ShiftOrder {
    int G, c;
    __device__ __forceinline__ bool next(int i, pg8::Unit& u) const {
        const int L = i * G + c; if (L >= 240) return false;
        if (L < 176) { const int f = L / 22, t = L - f * 22; u.pm = (f >> 1) * 3 + 2 * (f & 1); u.pn = f * 22 + t; }
        else if (L < 224) { const int q = L - 176, l = q / 24, t = q - l * 24; u.pm = l * 3 + 1; u.pn = PN_UV + l * 24 + t; }
        else if (L < 234) { const int q = L - 224, j = q / 5, t = q - j * 5; u.pm = (2 + j) * 3 + 1; u.pn = PN_QG + j * 5 + t; }
        else { u.pm = 12; u.pn = PN_KV + (L - 234); }
        return true;
    }
    __device__ __forceinline__ void a_ready(const pg8::Unit&) const {}
    __device__ __forceinline__ void done(const pg8::Unit&) const {}
};
struct FB2 {
    typedef NoPre Pre; typedef NoLd Ld; __device__ __forceinline__ void fetch(Ld&, int, int) const {} float* B2;
    __device__ __forceinline__ void prep(Pre&, int, int, bool) const {}
    __device__ __forceinline__ f32x2 operator()(const Pre&, const Ld&, int, int, int row, int col0, f32x4 v0, f32x4 v1) const {
        const int inst = row >> 8, b = row & 255, pn = col0 >> 8;
        int t;
        if (pn < 176) t = pn % 22; else if (pn < PN_QG) t = (pn - PN_UV) % 24; else if (pn < PN_KV) t = (pn - PN_QG) % 5; else t = pn - PN_KV;
        float* p = B2 + ((size_t)inst * 256 + b) * 6144 + t * 256 + (col0 & 255); *(f32x4*)p = v0; *(f32x4*)(p + 4) = v1; return (f32x2){0.f, 0.f};
    }
    __device__ __forceinline__ void row_done(int, f32x2, int) const {}
};

template <class F> __device__ __forceinline__ void run_gemm(LAS unsigned char* lds, const bf16* A, const bf16* Bt, int M, int N, int K, const F& f, int rot = 0) {
    int cblk = ((int)blockIdx.x + rot) % (int)gridDim.x; asm volatile("" : "+s"(cblk));
    pg8::Gemm g{A, Bt, M, N, K}; pg8::StaticOrder S; S.init(M, N, (int)gridDim.x, cblk);
    Epi8<F> E{f};
    pg8::gemm_phase<Epi8<F>, pg8::StaticOrder, true, true>(lds, g, S, E);
}

template <int RTU, int SB, class F> __device__ __forceinline__ void skinny_gemm(LAS unsigned char* lds, const bf16* A, const bf16* Bt, int ncol32, int K, int rem, const F& f) {
    int tid_raw = threadIdx.x; asm volatile("" : "+v"(tid_raw));
    const int lane = tid_raw & 63, wave = __builtin_amdgcn_readfirstlane(tid_raw >> 6), fr = lane & 15, fq = lane >> 4;
    constexpr int NR = 8 / RTU;
    const int kper = K >> 3, nsteps = kper >> 5, nunits = NR * ncol32;
    int cblk = (int)blockIdx.x; asm volatile("" : "+s"(cblk));
    const int nl = (int)gridDim.x - rem;
    LAS f32x4* red = (LAS f32x4*)lds;
    if (cblk < rem) return;
    for (int u = cblk - rem; u < nunits; u += nl) {
        const int n0 = 32 * (u / NR), r0 = MP + 16 * RTU * (u % NR);
        f32x4 acc[RTU][2];
#pragma unroll
        for (int rt = 0; rt < RTU; ++rt) { acc[rt][0] = (f32x4){0.f, 0.f, 0.f, 0.f}; acc[rt][1] = (f32x4){0.f, 0.f, 0.f, 0.f}; }
        const bf16* bp = Bt + (size_t)(n0 + 8 * (fr >> 2) + (fr & 3)) * K + wave * kper + 8 * fq;
        const bf16* ap = A + (size_t)(r0 + fr) * K + wave * kper + 8 * fq;
        const int row = r0 + 16 * (wave < RTU ? wave : 0) + fr;
        typename F::Pre pre; typename F::Ld ld;
        if (wave < RTU) { f.fetch(ld, row, n0 + 8 * fq); f.prep(pre, row, n0 + 8 * fq, true); }
#pragma unroll 1
        for (int ks0 = 0; ks0 < nsteps; ks0 += SB) {
            bf16x8 bb[SB][2], aa[SB][RTU];
#pragma unroll
            for (int s = 0; s < SB; ++s) { const int ks = (ks0 + s < nsteps) ? ks0 + s : nsteps - 1;
                bb[s][0] = *(const bf16x8*)(bp + 32 * ks); bb[s][1] = *(const bf16x8*)(bp + (size_t)4 * K + 32 * ks);
#pragma unroll
                for (int rt = 0; rt < RTU; ++rt) aa[s][rt] = *(const bf16x8*)(ap + (size_t)(16 * rt) * K + 32 * ks); }
#pragma unroll
            for (int s = 0; s < SB; ++s) if (ks0 + s < nsteps) {
#pragma unroll
                for (int rt = 0; rt < RTU; ++rt) { acc[rt][0] = __builtin_amdgcn_mfma_f32_16x16x32_bf16(bb[s][0], aa[s][rt], acc[rt][0], 0, 0, 0); acc[rt][1] = __builtin_amdgcn_mfma_f32_16x16x32_bf16(bb[s][1], aa[s][rt], acc[rt][1], 0, 0, 0); } }
        }
#pragma unroll
        for (int rt = 0; rt < RTU; ++rt) { red[((wave * RTU + rt) * 2 + 0) * 64 + lane] = acc[rt][0]; red[((wave * RTU + rt) * 2 + 1) * 64 + lane] = acc[rt][1]; }
        __syncthreads();
        if (wave < RTU) {
            f32x4 s0 = (f32x4){0.f, 0.f, 0.f, 0.f}, s1 = (f32x4){0.f, 0.f, 0.f, 0.f};
#pragma unroll
            for (int w2 = 0; w2 < 8; ++w2) { s0 = s0 + red[((w2 * RTU + wave) * 2 + 0) * 64 + lane]; s1 = s1 + red[((w2 * RTU + wave) * 2 + 1) * 64 + lane]; }
            const f32x2 part = f(pre, ld, 0, 0, row, n0 + 8 * fq, s0, s1); f.row_done(row, part, fq);
        }
        __syncthreads();
    }
}
template <class F> __device__ __forceinline__ void run_gemm2(LAS unsigned char* lds, const bf16* A, const bf16* Bt, int N, int Nreal, int K, const F& f, int rot = 0, int rem = -1) {
    run_gemm(lds, A, Bt, MP, N, K, f, rot);
    skinny_gemm<4, 6>(lds, A, Bt, (Nreal + 31) >> 5, K, rem >= 0 ? rem : ((MP / 256) * (N / 256)) % (int)gridDim.x, f);
}
template <class F> __device__ __forceinline__ void run_gemm2r(LAS unsigned char* lds, const bf16* A, const bf16* Bt, int K, const F& f) {
    run_gemm(lds, A, Bt, MP, DM, K, f, 0);
    skinny_gemm<1, 12>(lds, A, Bt, DM / 32, K, 0, f);
}

template <bool FINAL>
__device__ __forceinline__ void norm_phase(const f16* X, const float* gvec, const float* MOD, int shift_col, int scale_col, bf16* H, float* out, int gw, int NGW, int lane) {
    for (int r = gw; r < MR; r += NGW) {
        const f16x4* xr = (const f16x4*)(X + (size_t)r * DM) + lane;
        f32x4 v[4]; float ss = 0.f;
#pragma unroll
        for (int j = 0; j < 4; ++j) { v[j] = __builtin_convertvector(xr[64 * j], f32x4); ss += (v[j][0] * v[j][0] + v[j][1] * v[j][1]) + (v[j][2] * v[j][2] + v[j][3] * v[j][3]); }
        ss = wave_sum(ss);
        const float rstd = 1.0f / sqrtf(ss * (1.0f / DM) + 1e-6f);
        const float* mrow = MOD + (size_t)row_b(r) * NMOD;
#pragma unroll
        for (int j = 0; j < 4; ++j) { const int c = 4 * lane + 256 * j;
            const f32x4 gv = *(const f32x4*)(gvec + c), sh = *(const f32x4*)(mrow + shift_col + c), sc = *(const f32x4*)(mrow + scale_col + c);
            const f32x4 y = (v[j] * rstd) * gv * (sc + 1.0f) + sh;
            if (FINAL) { float* o = (r < MP) ? out + OY_P + (size_t)r * DM + c : out + OY_S + (size_t)(r - MP) * DM + c; *(f32x4*)o = y; }
            else { v2u w; w.x = pk2(y[0], y[1]); w.y = pk2(y[2], y[3]); *(v2u*)(H + (size_t)r * DM + c) = w; }
        }
    }
}

__device__ __forceinline__ void transpose_item(const float* W, int N, int ldw, bf16* WT, int ldt, int mode, int row_off, LAS float* scr, int item, int lane) {
    const int nblk = (N + 31) >> 5, kb = item / nblk, nb = item - kb * nblk, k0 = 64 * kb, n0 = 32 * nb;
    const int nn = n0 + (lane & 31); const bool okn = nn < N;
    float tv[32];
#pragma unroll
    for (int i = 0; i < 32; ++i) { const int kk = 2 * i + (lane >> 5); tv[i] = okn ? __builtin_nontemporal_load(W + (size_t)(k0 + kk) * ldw + nn) : 0.f; }
#pragma unroll
    for (int i = 0; i < 32; ++i) { const int kk = 2 * i + (lane >> 5); scr[kk * 33 + (lane & 31)] = tv[i]; }
    asm volatile("s_waitcnt lgkmcnt(0)" ::: "memory");
    const int c = lane & 7;
#pragma unroll
    for (int j = 0; j < 4; ++j) { const int n = (lane >> 3) + 8 * j; const LAS float* s = scr + (8 * c) * 33 + n;
        v4u o; o.x = pk2(s[0 * 33], s[1 * 33]); o.y = pk2(s[2 * 33], s[3 * 33]); o.z = pk2(s[4 * 33], s[5 * 33]); o.w = pk2(s[6 * 33], s[7 * 33]);
        const int ng = n0 + n;
        const int drow = mode == 0 ? row_off + ng : (8 * (ng >> 2) + (ng & 3) + (mode == 2 ? 4 : 0));
        if (ng < N) *(v4u*)(WT + (size_t)drow * ldt + k0 + 8 * c) = o; }
    asm volatile("s_waitcnt lgkmcnt(0)" ::: "memory");
}
struct TDesc { const float* src; int K, N, ldw; bf16* dst; int ldt, mode, row_off; };
struct Ptrs {
    const float *x_prompt, *x_sample, *cache_kv, *state_win; const int* page_table; const float *c_prompt, *c_sample, *ada_w, *ada_b, *norm_g, *w_gate, *w_up, *w_down,
        *w_uv, *ln_g, *ln_b, *w_sp, *b_sp, *w_out, *w_qg, *w_o, *kv_norm_g, *kv_ada_w, *kv_ada_b, *kv_w, *cmp_w1, *cmp_w2, *cmp_pe, *final_g, *final_ada_w, *final_ada_b;
    float* out; unsigned char* ws;
};
#define WSP(T, off) ((T*)(P.ws + (off)))
typedef const __attribute__((address_space(4))) unsigned long long* kptr_t;
__device__ __forceinline__ void load_ptrs(Ptrs& P) {
    kptr_t k = (kptr_t)__builtin_amdgcn_kernarg_segment_ptr();
    asm volatile("" : "+s"(k));
    P.x_prompt = (const float*)(GAS const float*)k[0]; P.x_sample = (const float*)(GAS const float*)k[1]; P.cache_kv = (const float*)(GAS const float*)k[2]; P.state_win = (const float*)(GAS const float*)k[3];
    P.page_table = (const int*)(GAS const int*)k[4]; P.c_prompt = (const float*)(GAS const float*)k[5]; P.c_sample = (const float*)(GAS const float*)k[6]; P.ada_w = (const float*)(GAS const float*)k[7];
    P.ada_b = (const float*)(GAS const float*)k[8]; P.norm_g = (const float*)(GAS const float*)k[9]; P.w_gate = (const float*)(GAS const float*)k[10]; P.w_up = (const float*)(GAS const float*)k[11];
    P.w_down = (const float*)(GAS const float*)k[12]; P.w_uv = (const float*)(GAS const float*)k[13]; P.ln_g = (const float*)(GAS const float*)k[14]; P.ln_b = (const float*)(GAS const float*)k[15];
    P.w_sp = (const float*)(GAS const float*)k[16]; P.b_sp = (const float*)(GAS const float*)k[17]; P.w_out = (const float*)(GAS const float*)k[18]; P.w_qg = (const float*)(GAS const float*)k[19];
    P.w_o = (const float*)(GAS const float*)k[20]; P.kv_norm_g = (const float*)(GAS const float*)k[21]; P.kv_ada_w = (const float*)(GAS const float*)k[22]; P.kv_ada_b = (const float*)(GAS const float*)k[23];
    P.kv_w = (const float*)(GAS const float*)k[24]; P.cmp_w1 = (const float*)(GAS const float*)k[25]; P.cmp_w2 = (const float*)(GAS const float*)k[26]; P.cmp_pe = (const float*)(GAS const float*)k[27];
    P.final_g = (const float*)(GAS const float*)k[28]; P.final_ada_w = (const float*)(GAS const float*)k[29]; P.final_ada_b = (const float*)(GAS const float*)k[30];
    P.out = (float*)(GAS float*)k[31]; P.ws = (unsigned char*)(GAS unsigned char*)k[32];
}
__device__ __forceinline__ void get_tdesc(const Ptrs& P, int id, TDesc& d) {
    d.mode = 0; d.row_off = 0; d.K = 1024; d.ldt = 1024;
    if (id < 4) { d.src = P.ada_w + (size_t)id * 1024 * 9216; d.N = 9216; d.dst = WSP(bf16, WS_WMOD); d.row_off = id * 9216; }
    else if (id == 4) { d.src = P.kv_ada_w; d.N = 2048; d.dst = WSP(bf16, WS_WMOD); d.row_off = MODKV; }
    else if (id == 5) { d.src = P.final_ada_w; d.N = 2048; d.dst = WSP(bf16, WS_WMOD); d.row_off = MODFIN; }
    else if (id < 14) { const int i = id - 6; d.src = P.w_gate + (size_t)i * 1024 * DFF; d.N = DFF; d.dst = WSP(bf16, WS_WGU) + (size_t)i * 5632 * 1024; d.mode = 1; }
    else if (id < 22) { const int i = id - 14; d.src = P.w_up + (size_t)i * 1024 * DFF; d.N = DFF; d.dst = WSP(bf16, WS_WGU) + (size_t)i * 5632 * 1024; d.mode = 2; }
    else if (id < 30) { const int i = id - 22; d.src = P.w_down + (size_t)i * DFF * 1024; d.K = DFF; d.N = 1024; d.dst = WSP(bf16, WS_WDN) + (size_t)i * 1024 * DFF; d.ldt = DFF; }
    else if (id < 32) { const int i = id - 30; d.src = P.w_uv + (size_t)i * 1024 * 6144; d.N = 6144; d.dst = WSP(bf16, WS_WUV) + (size_t)i * 6144 * 1024; }
    else if (id < 34) { const int i = id - 32; d.src = P.w_out + (size_t)i * DV * 1024; d.K = DV; d.N = 1024; d.dst = WSP(bf16, WS_WOUT) + (size_t)i * 1024 * DV; d.ldt = DV; }
    else if (id < 36) { const int i = id - 34; d.src = P.w_qg + (size_t)i * 1024 * 1072; d.N = 1072; d.dst = WSP(bf16, WS_WQG) + (size_t)i * NQG * 1024; }
    else if (id < 38) { const int i = id - 36; d.src = P.w_o + (size_t)i * 1024 * 1024; d.N = 1024; d.dst = WSP(bf16, WS_WO) + (size_t)i * 1024 * 1024; }
    else if (id == 38) { d.src = P.kv_w; d.N = NKVP; d.dst = WSP(bf16, WS_WKV); }
    else if (id < 43) { const int i = id - 39, kv = i >> 1, r = i & 1; d.src = P.cmp_w1 + (size_t)kv * 2048 * 256 + (size_t)r * 1024 * 256; d.N = 256; d.dst = WSP(bf16, WS_WC1) + (size_t)kv * 512 * 1024; d.row_off = r * 256; }
    else { const int kv = id - 43; d.src = P.cmp_w2 + (size_t)kv * 256 * 64; d.K = 256; d.N = 64; d.dst = WSP(bf16, WS_WC2) + (size_t)kv * 64 * 256; d.ldt = 256; }
    d.ldw = d.N;
}
constexpr int N_TMAT = 45;

__device__ __forceinline__ void prologue_phase(const Ptrs& P, LAS unsigned char* lds, int gw, int NGW, int wave, int lane, int tid) {
    if (blockIdx.x < 8) {
        const int kv = blockIdx.x >> 2, hb = blockIdx.x & 3; const float* pe = P.cmp_pe + kv * 2048; const float* w1 = P.cmp_w1 + (size_t)kv * 2048 * 256 + hb * 64 + lane;
        float acc = 0.f;
#pragma unroll 8
        for (int k = wave * 256; k < wave * 256 + 256; ++k) acc += pe[k] * w1[(size_t)k * 256];
        LAS float* red = (LAS float*)lds;
        red[wave * 64 + lane] = acc;
        __syncthreads();
        if (wave == 0) { float s = 0.f;
#pragma unroll
            for (int w = 0; w < 8; ++w) s += red[w * 64 + lane];
            WSP(float, WS_CBIAS)[kv * 256 + hb * 64 + lane] = s; }
        __syncthreads();
    }
    { LAS float* scr = (LAS float*)(lds + wave * 16384); int off = 0;
      for (int id = 0; id < N_TMAT; ++id) { TDesc d; get_tdesc(P, id, d);
          const int nitems = (d.K >> 6) * ((d.N + 31) >> 5);
          for (int it = (gw + NGW - (off % NGW)) % NGW; it < nitems; it += NGW) transpose_item(d.src, d.N, d.ldw, d.dst, d.ldt, d.mode, d.row_off, scr, it, lane);
          off += nitems; } }
    for (int r = gw; r < RT; r += NGW) { f16x4* xo = (f16x4*)(WSP(f16, WS_X) + (size_t)r * DM) + lane;
        const f32x4* xi = r < MP ? (const f32x4*)(P.x_prompt + (size_t)r * DM) + lane : (const f32x4*)(P.x_sample + (size_t)((r < MR ? r : MR - 1) - MP) * DM) + lane;
#pragma unroll
        for (int j = 0; j < 4; ++j) { f32x4 v = xi[64 * j]; if (r >= MR) v = (f32x4){0.f, 0.f, 0.f, 0.f}; xo[64 * j] = __builtin_convertvector(v, f16x4); } }
    for (int r = gw; r < 256; r += NGW) { const float* ci = r < 2 ? P.c_prompt + (size_t)r * DM : P.c_sample + (size_t)((r < 130 ? r : 129) - 2) * DM;
#pragma unroll
        for (int j = 0; j < 4; ++j) { const int c = 4 * lane + 256 * j; f32x4 v = *(const f32x4*)(ci + c); v2u w; w.x = pk2(silu_f(v[0]), silu_f(v[1])); w.y = pk2(silu_f(v[2]), silu_f(v[3])); if (r >= 130) { w.x = 0u; w.y = 0u; }
            *(v2u*)(WSP(bf16, WS_SC) + (size_t)r * DM + c) = w; } }
    for (int it0 = gw * 8; it0 < MS * PAST; it0 += NGW * 8) { const int bs = it0 >> 11, pos0 = it0 & (PAST - 1); const int page = P.page_table[bs * NPAGES + (pos0 >> 7)];
        const float* src = P.cache_kv + ((size_t)page * 128 + (pos0 & 127)) * 1024 + 8 * lane;
        f32x4 a[8], b[8];
#pragma unroll
        for (int q = 0; q < 8; ++q) { a[q] = __builtin_nontemporal_load((const f32x4*)(src + (size_t)q * 1024)); b[q] = __builtin_nontemporal_load((const f32x4*)(src + (size_t)q * 1024 + 4)); }
        const int slot = lane >> 5, g = (lane >> 3) & 3, d0 = (lane & 7) * 8;
        bf16* dst = WSP(bf16, WS_ACMP) + (size_t)slot * 65536 * 1024 + ((size_t)(bs * 4 + g) * 128 + (pos0 >> 4)) * 1024 + (pos0 & 15) * 64 + d0;
#pragma unroll
        for (int q = 0; q < 8; ++q) *(v4u*)(dst + q * 64) = pack8(a[q], b[q]); }
    for (int i = gw * 64 + lane; i < 13 * DM; i += NGW * 64) WSP(float, WS_NG)[i] = i < 12 * DM ? P.norm_g[i] : P.kv_norm_g[i - 12 * DM];
    for (int i = gw * 64 + lane; i < 2 * 8 * 128 * 128; i += NGW * 64) { const int t = (i >> 7) & 127, s = i & 127; WSP(bf16, WS_WSP)[i] = (bf16)(pk2(s <= t ? P.w_sp[i] : 0.f, 0.f) & 0xffffu); }
    for (int it = gw; it < MS * 64; it += NGW) { const int bs = it >> 6, j0 = (it & 63) * 8;
        const float* src = P.state_win + ((size_t)bs * 512 + j0 + 1) * 512 + 4 * lane; float* dst = P.out + OWIN_S + ((size_t)bs * 512 + j0) * 512 + 4 * lane;
        f32x4 v[16];
#pragma unroll
        for (int q = 0; q < 16; ++q) { const int j = j0 + (q >> 1); v[q] = (j < 511) ? __builtin_nontemporal_load((const f32x4*)(src + (size_t)(q >> 1) * 512 + (q & 1) * 256)) : (f32x4){0.f, 0.f, 0.f, 0.f}; }
#pragma unroll
        for (int q = 0; q < 16; ++q) { const int j = j0 + (q >> 1); if (j < 511) __builtin_nontemporal_store(v[q], (f32x4*)(dst + (size_t)(q >> 1) * 512 + (q & 1) * 256)); } }
}

template <int MODE>
__device__ __forceinline__ void cmp_finish_unit(const bf16* T, const float* cbias, const bf16* W2T, void* outp, int C, int bg, int rt, int lane) {
    const int fr = lane & 15, fq = lane >> 4, NB = C - 1, i0 = 16 * rt;
    const int ib = i0 + fr, ic = ib < NB ? ib : NB - 1;
    const bf16* ta = T + ((size_t)bg * C + ic) * 512 + 8 * fq; const bf16* tb = ta + 512 + 256;
    v4u ra[8], rb[8];
#pragma unroll
    for (int ks = 0; ks < 8; ++ks) { ra[ks] = *(const v4u*)(ta + 32 * ks); rb[ks] = *(const v4u*)(tb + 32 * ks); }
    asm volatile("" ::: "memory");
    bf16x8 hf[8];
#pragma unroll
    for (int ks = 0; ks < 8; ++ks) { float a[8], b[8]; unpack8(ra[ks], a); unpack8(rb[ks], b);
        const f32x4 c0 = *(const f32x4*)(cbias + 32 * ks + 8 * fq), c1 = *(const f32x4*)(cbias + 32 * ks + 8 * fq + 4);
        f32x4 h0, h1;
#pragma unroll
        for (int e = 0; e < 4; ++e) { h0[e] = gelu_tanh_f(c0[e] + a[e] + b[e]); h1[e] = gelu_tanh_f(c1[e] + a[e + 4] + b[e + 4]); }
        const v4u w = pack8(h0, h1); hf[ks] = __builtin_bit_cast(bf16x8, w); }
    f32x4 acc[4];
#pragma unroll
    for (int nt = 0; nt < 4; ++nt) { acc[nt] = (f32x4){0.f, 0.f, 0.f, 0.f};
        bf16x8 wf[8];
#pragma unroll
        for (int ks = 0; ks < 8; ++ks) wf[ks] = *(const bf16x8*)(W2T + (size_t)(16 * nt + fr) * 256 + 32 * ks + 8 * fq);
#pragma unroll
        for (int ks = 0; ks < 8; ++ks) {
            if (MODE == 1) acc[nt] = __builtin_amdgcn_mfma_f32_16x16x32_bf16(hf[ks], wf[ks], acc[nt], 0, 0, 0);
            else acc[nt] = __builtin_amdgcn_mfma_f32_16x16x32_bf16(wf[ks], hf[ks], acc[nt], 0, 0, 0); } }
#pragma unroll
    for (int nt = 0; nt < 4; ++nt) {
        if (MODE == 0) { f32x4 v = acc[nt]; if (ib >= NB) v = (f32x4){0.f, 0.f, 0.f, 0.f}; v2u w; w.x = pk2(v[0], v[1]); w.y = pk2(v[2], v[3]);
            *(v2u*)((bf16*)outp + ((size_t)bg * 512 + ib) * 64 + 16 * nt + 4 * fq) = w; }
        else if (MODE == 1) { f32x4 v = acc[nt];
#pragma unroll
            for (int e = 0; e < 4; ++e) if (i0 + 4 * fq + e >= NB) v[e] = 0.f;
            v2u w; w.x = pk2(v[0], v[1]); w.y = pk2(v[2], v[3]);
            *(v2u*)((bf16*)outp + (((size_t)bg * 16 + (i0 >> 5)) * 64 + 16 * nt + fr) * 32 + (i0 & 31) + 4 * fq) = w; }
        else { f32x4 v = acc[nt]; if (ib >= NB) v = (f32x4){0.f, 0.f, 0.f, 0.f};
            *(f32x4*)((float*)outp + ((size_t)bg * 128 + ib) * 64 + 16 * nt + 4 * fq) = v; }
    }
}

struct SpRegs { f32x4 st; v4u za[2], zb[2]; bf16x8 wf[4]; v4u uv[4]; float bt; };
__device__ __forceinline__ void sp_load(SpRegs& R, const Ptrs& P, int l, int u, int wave, int lane) {
    const bf16* Z = WSP(bf16, WS_Z); const bf16* WS = WSP(bf16, WS_WSP); const float* VS = WSP(float, WS_CTL) + CW_VS + (size_t)l * RT * 2;
    const int fr = lane & 15, fq = lane >> 4, nks = (wave >> 1) + 1, n = u / 24, cb = u - n * 24, g = cb / 3;
    R.st = *(const f32x4*)(VS + 2 * (n * 128 + 2 * lane));
#pragma unroll
    for (int q = 0; q < 2; ++q) { const int cc = cb * 128 + 8 * (wave + 8 * q); const bf16* z0 = Z + (size_t)(n * 128 + 2 * lane) * 6144 + DV + cc; R.za[q] = *(const v4u*)z0; R.zb[q] = *(const v4u*)(z0 + 6144); }
    const bf16* wp = WS + ((size_t)(l * 8 + g) * 128 + 16 * wave + fr) * 128 + 8 * fq;
#pragma unroll
    for (int ks = 0; ks < 4; ++ks) R.wf[ks] = *(const bf16x8*)(wp + 32 * (ks < nks ? ks : 0));
    const int t = 16 * wave + fr, row = n * 128 + t; R.bt = P.b_sp[(l * 8 + g) * 128 + t];
#pragma unroll
    for (int mm = 0; mm < 4; ++mm) R.uv[mm] = *(const v4u*)(Z + (size_t)row * 6144 + cb * 128 + 32 * mm + 8 * fq);
}
__device__ __forceinline__ void sp_compute(const SpRegs& R, const Ptrs& P, int l, int u, LAS unsigned* tile, int wave, int lane) {
    bf16* PO = WSP(bf16, WS_P); const float* lg = P.ln_g + l * DV; const float* lb = P.ln_b + l * DV;
    const int fr = lane & 15, fq = lane >> 4, nks = (wave >> 1) + 1, n = u / 24, cb = u - n * 24;
    const float m0 = R.st[0] * (1.0f / DV), m1 = R.st[2] * (1.0f / DV); float v0 = R.st[1] * (1.0f / DV) - m0 * m0, v1 = R.st[3] * (1.0f / DV) - m1 * m1; v0 = v0 > 0.f ? v0 : 0.f; v1 = v1 > 0.f ? v1 : 0.f;
    const float r0 = 1.0f / sqrtf(v0 + 1e-6f), r1 = 1.0f / sqrtf(v1 + 1e-6f);
#pragma unroll
    for (int q = 0; q < 2; ++q) { const int ccg = wave + 8 * q, cc = cb * 128 + 8 * ccg; float a[8], b[8]; unpack8(R.za[q], a); unpack8(R.zb[q], b);
        const f32x4 g0 = *(const f32x4*)(lg + cc), g1 = *(const f32x4*)(lg + cc + 4), b0 = *(const f32x4*)(lb + cc), b1 = *(const f32x4*)(lb + cc + 4);
#pragma unroll
        for (int e = 0; e < 8; ++e) { const float gg = e < 4 ? g0[e] : g1[e - 4], bb = e < 4 ? b0[e] : b1[e - 4];
            tile[(8 * ccg + e) * 68 + lane] = pk2((a[e] - m0) * r0 * gg + bb, (b[e] - m1) * r1 * gg + bb); } }
    __syncthreads();
    f32x4 acc[8];
#pragma unroll
    for (int j = 0; j < 8; ++j) acc[j] = (f32x4){0.f, 0.f, 0.f, 0.f};
    const LAS char* vp = (const LAS char*)tile + (8 * (fr >> 2) + (fr & 3)) * 272 + 16 * fq;
#pragma unroll
    for (int ks = 0; ks < 4; ++ks) if (ks < nks) {
#pragma unroll
        for (int j = 0; j < 8; ++j) { const bf16x8 vf = *(const LAS bf16x8*)(vp + (32 * (j >> 1) + 4 * (j & 1)) * 272 + 64 * ks);
            acc[j] = __builtin_amdgcn_mfma_f32_16x16x32_bf16(vf, R.wf[ks], acc[j], 0, 0, 0); }
    }
    const int row = n * 128 + 16 * wave + fr;
#pragma unroll
    for (int mm = 0; mm < 4; ++mm) { const int c = cb * 128 + 32 * mm + 8 * fq; float uu[8]; unpack8(R.uv[mm], uu);
        f32x4 p0, p1;
#pragma unroll
        for (int e = 0; e < 4; ++e) { p0[e] = uu[e] * (acc[2 * mm][e] + R.bt); p1[e] = uu[4 + e] * (acc[2 * mm + 1][e] + R.bt); }
        *(v4u*)(PO + (size_t)row * DV + c) = pack8(p0, p1); }
}
__device__ __forceinline__ void spatial2_phase(const Ptrs& P, int l, LAS unsigned char* lds, int wave, int lane, int tid, int gw, int NGW) {
    const bf16* Z = WSP(bf16, WS_Z);
    const float* VS = WSP(float, WS_CTL) + CW_VS + (size_t)l * RT * 2;
    const float* lg = P.ln_g + l * DV; const float* lb = P.ln_b + l * DV;
    { const int NU = 128 * 24, G_ = (int)gridDim.x; int u = (int)blockIdx.x;
      LAS unsigned* t0 = (LAS unsigned*)lds; LAS unsigned* t1 = (LAS unsigned*)(lds + 34816);
      SpRegs A, B;
      if (u < NU) sp_load(A, P, l, u, wave, lane);
      while (u < NU) {
          int un = u + G_; if (un < NU) sp_load(B, P, l, un, wave, lane);
          sp_compute(A, P, l, u, t0, wave, lane);
          u = un; if (u >= NU) break;
          un = u + G_; if (un < NU) sp_load(A, P, l, un, wave, lane);
          sp_compute(B, P, l, u, t1, wave, lane);
          u = un;
      } }
    __syncthreads();
    for (int bs = gw; bs < MS; bs += NGW) {
        const int row = MP + bs; const bf16* zr = Z + (size_t)row * 6144 + 8 * lane;
        const float mean = VS[2 * row] * (1.0f / DV); float var = VS[2 * row + 1] * (1.0f / DV) - mean * mean; var = var > 0.f ? var : 0.f; const float rstd = 1.0f / sqrtf(var + 1e-6f);
#pragma unroll
        for (int j = 0; j < 6; ++j) { const int c = 512 * j + 8 * lane, g = c / CGW;
            const float w00 = P.w_sp[(size_t)(l * 8 + g) * 128 * 128], b00 = P.b_sp[(l * 8 + g) * 128];
            const f32x4 g0 = *(const f32x4*)(lg + c), g1 = *(const f32x4*)(lg + c + 4), b0 = *(const f32x4*)(lb + c), b1 = *(const f32x4*)(lb + c + 4);
            float vv[8], uu[8]; unpack8(*(const v4u*)(zr + DV + 512 * j), vv); unpack8(*(const v4u*)(zr + 512 * j), uu);
            f32x4 o0, o1, p0, p1;
#pragma unroll
            for (int e = 0; e < 4; ++e) { o0[e] = (vv[e] - mean) * rstd * g0[e] + b0[e]; o1[e] = (vv[4 + e] - mean) * rstd * g1[e] + b1[e];
                p0[e] = uu[e] * (w00 * o0[e] + b00); p1[e] = uu[4 + e] * (w00 * o1[e] + b00); }
            float* gv = P.out + OGV + ((size_t)l * MS + bs) * DV + c; *(f32x4*)gv = o0; *(f32x4*)(gv + 4) = o1;
            *(v4u*)(WSP(bf16, WS_P) + (size_t)row * DV + c) = pack8(p0, p1); }
    }
}

#define NEG_INF (-__builtin_inff())
__device__ __forceinline__ bf16x8 ld_v2x8(const GAS bf16* p) {
    const bf16x4 lo = *(const GAS bf16x4*)p, hi = *(const GAS bf16x4*)(p + 16);
    return __builtin_shufflevector(lo, hi, 0, 1, 2, 3, 4, 5, 6, 7);
}
struct SampleAcc { float acc[4][8]; float m, l; };
__device__ __forceinline__ float sample_compute(const f32x4 k0, const f32x4 k1, const f32x4 v0, const f32x4 v1, bool valid, float dist, const float (&qv)[4][8], float slope2_own, int lane, SampleAcc& A) {
    const int j8 = lane & 7;
    float part[4];
#pragma unroll
    for (int h = 0; h < 4; ++h) { float a = (qv[h][0] * k0[0] + qv[h][1] * k0[1]) + (qv[h][2] * k0[2] + qv[h][3] * k0[3]) + (qv[h][4] * k1[0] + qv[h][5] * k1[1]) + (qv[h][6] * k1[2] + qv[h][7] * k1[3]);
        a += __shfl_xor(a, 1); a += __shfl_xor(a, 2); a += __shfl_xor(a, 4); part[h] = a; }
    const int hown = j8 & 3;
    const float sown = hown == 0 ? part[0] : hown == 1 ? part[1] : hown == 2 ? part[2] : part[3];
    const float s2 = valid ? (sown - slope2_own * dist) : NEG_INF;
    float tm = s2;
#pragma unroll
    for (int off = 8; off < 64; off <<= 1) tm = fmaxf(tm, __shfl_xor(tm, off));
    const float mnew = fmaxf(A.m, tm), msafe = (mnew == NEG_INF) ? 0.f : mnew, alpha = fexp2(A.m - msafe), p = fexp2(s2 - msafe);
    A.m = mnew; A.l = A.l * alpha + p;
    float ph[4], ah[4];
#pragma unroll
    for (int h = 0; h < 4; ++h) { ph[h] = __shfl(p, (lane & ~7) | h); ah[h] = __shfl(alpha, (lane & ~7) | h); }
#pragma unroll
    for (int h = 0; h < 4; ++h)
#pragma unroll
        for (int e = 0; e < 4; ++e) { A.acc[h][e] = A.acc[h][e] * ah[h] + ph[h] * v0[e]; A.acc[h][4 + e] = A.acc[h][4 + e] * ah[h] + ph[h] * v1[e]; }
    return s2;
}
__device__ __forceinline__ float sample_step8(const float* krow, const float* vrow, bool valid, float dist, const float (&qv)[4][8], float slope2_own, int lane, SampleAcc& A) {
    const int j8 = lane & 7;
    const f32x4 k0 = *(const f32x4*)(krow + 8 * j8), k1 = *(const f32x4*)(krow + 8 * j8 + 4), v0 = *(const f32x4*)(vrow + 8 * j8), v1 = *(const f32x4*)(vrow + 8 * j8 + 4);
    return sample_compute(k0, k1, v0, v1, valid, dist, qv, slope2_own, lane, A);
}
__device__ __forceinline__ void sample_batch4(const float* kbase, const float* vbase, int rstride, int r0, int rlimit, int rclamp, float dist0, float ddist,
                                              const float (&qv)[4][8], float slope2_own, int lane, SampleAcc& A, LAS float* sraw) {
    const int j8 = lane & 7;
    f32x4 kk[4][2], vv[4][2];
#pragma unroll
    for (int s = 0; s < 4; ++s) { int r = r0 + 8 * s; r = r < rlimit ? r : rclamp; const float* kr = kbase + (size_t)r * rstride + 8 * j8; const float* vr = vbase + (size_t)r * rstride + 8 * j8;
        kk[s][0] = *(const f32x4*)kr; kk[s][1] = *(const f32x4*)(kr + 4); vv[s][0] = *(const f32x4*)vr; vv[s][1] = *(const f32x4*)(vr + 4); }
#pragma unroll
    for (int s = 0; s < 4; ++s) { const float s2 = sample_compute(kk[s][0], kk[s][1], vv[s][0], vv[s][1], r0 + 8 * s < rlimit, dist0 - ddist * (float)s, qv, slope2_own, lane, A);
        if (sraw) sraw[s * 64 + lane] = s2; }
}
__device__ __forceinline__ void sample_reset(SampleAcc& A) {
    A.m = NEG_INF; A.l = 0.f;
#pragma unroll
    for (int h = 0; h < 4; ++h)
#pragma unroll
        for (int i = 0; i < 8; ++i) A.acc[h][i] = 0.f;
}
__device__ __forceinline__ void sample_finish(SampleAcc& A, const float* gates_bg, int br, LAS float* wl, int lane, bool first) {
    float lt = A.l;
#pragma unroll
    for (int off = 8; off < 64; off <<= 1) lt += __shfl_xor(lt, off);
    float sc[4];
#pragma unroll
    for (int h = 0; h < 4; ++h) { const float lh = __shfl(lt, h); sc[h] = lh > 0.f ? gates_bg[h * 3 + br] / lh : 0.f; }
#pragma unroll
    for (int h = 0; h < 4; ++h)
#pragma unroll
        for (int i = 0; i < 8; ++i) { float a = A.acc[h][i];
#pragma unroll
            for (int off = 8; off < 64; off <<= 1) a += __shfl_xor(a, off);
            A.acc[h][i] = a * sc[h]; }
    if (lane < 8) {
#pragma unroll
        for (int h = 0; h < 4; ++h)
#pragma unroll
            for (int i = 0; i < 8; ++i) { LAS float* p = wl + h * 64 + 8 * lane + i; *p = first ? A.acc[h][i] : (*p + A.acc[h][i]); }
    }
}
__device__ __forceinline__ void attn_sample_unit(const Ptrs& P, int bs, int g, LAS float* wl, int lane_in) {
    int lane = lane_in; asm volatile("" : "+v"(lane));
    const int kq = lane >> 3, j8 = lane & 7, row = MP + bs;
    const bf16* Q = WSP(bf16, WS_Q) + (size_t)row * DM + (4 * g) * 64; const float* GT = WSP(float, WS_GATES) + (size_t)row * 48 + g * 12;
    float qv[4][8];
#pragma unroll
    for (int h = 0; h < 4; ++h) unpack8(*(const v4u*)(Q + h * 64 + 8 * j8), qv[h]);
    const float slope2_own = fexp2(-0.5f * (float)(4 * g + (j8 & 3) + 1)) * LOG2E;
    SampleAcc A;
    LAS float* pimp = wl + 256;
    LAS float* sraw = wl + 512;
    const float* KCS = WSP(float, WS_KCS) + (size_t)(bs * 4 + g) * 128 * 64; const float* VCS = WSP(float, WS_VCS) + (size_t)(bs * 4 + g) * 128 * 64;
    sample_reset(A);
#pragma unroll 1
    for (int bt = 0; bt < 4; ++bt) sample_batch4(KCS, VCS, 64, 32 * bt + kq, 127, 126, (float)(PAST - (16 * (32 * bt + kq) + 31)), 128.f, qv, slope2_own, lane, A, sraw + bt * 256);
    { float lt = A.l;
#pragma unroll
      for (int off = 8; off < 64; off <<= 1) lt += __shfl_xor(lt, off);
      const float il = lt > 0.f ? 1.0f / lt : 0.f, mm = A.m == NEG_INF ? 0.f : A.m;
#pragma unroll 1
      for (int it = 0; it < 16; ++it) { float p = fexp2(sraw[it * 64 + lane] - mm) * il; p += __shfl_xor(p, 1); p += __shfl_xor(p, 2); if (j8 == 0) pimp[8 * it + kq] = p; } }
    sample_finish(A, GT, 0, wl, lane, true);
    unsigned long long selmask;
    { float v = -1.f;
      if (lane < 33) { float sacc = 0.f;
#pragma unroll
          for (int e = -1; e < 4; ++e) { const int n = 4 * lane + e; if (n >= 0 && n < 127) sacc += pimp[n]; }
          v = (lane == 0 || lane >= 31) ? sacc + 1e4f : sacc; }
      int rank = 0;
#pragma unroll 1
      for (int i = 0; i < 33; ++i) { const float vi = __shfl(v, i); rank += (vi > v || (vi == v && i < lane)) ? 1 : 0; }
      selmask = __ballot(lane < 33 && rank < 16); }
    sample_reset(A);
#pragma unroll 1
    for (int j = 0; j < 32; ++j) {
        if (!((selmask >> j) & 1ull)) continue;
        const int page = P.page_table[bs * NPAGES + (j >> 1)];
        const float* kb = P.cache_kv + ((size_t)page * 128 * 4 + 2) * 256 + g * 64;
#pragma unroll 1
        for (int bb = 0; bb < 2; ++bb) { const int r0 = ((64 * j) & 127) + 32 * bb + kq;
            sample_batch4(kb, kb + 256, 1024, r0, 1 << 30, 0, (float)(PAST - (64 * j + 32 * bb + kq)), 8.f, qv, slope2_own, lane, A, nullptr); }
    }
    { const float* kr = P.out + OKV_S + ((size_t)bs * 4 + 2) * 256 + g * 64;
      (void)sample_step8(kr, kr + 256, kq == 0, 0.f, qv, slope2_own, lane, A); }
    sample_finish(A, GT, 1, wl, lane, false);
    sample_reset(A);
    { const float* kb = P.state_win + (size_t)bs * 512 * 512 + g * 64;
#pragma unroll 1
      for (int bt = 0; bt < 16; ++bt) sample_batch4(kb, kb + 256, 512, 32 * bt + kq, 1 << 30, 0, (float)(512 - (32 * bt + kq)), 8.f, qv, slope2_own, lane, A, nullptr); }
    { const float* kr = P.out + OWIN_S + ((size_t)bs * 512 + 511) * 512 + g * 64;
      (void)sample_step8(kr, kr + 256, kq == 0, 0.f, qv, slope2_own, lane, A); }
    sample_finish(A, GT, 2, wl, lane, false);
    { const f32x4 v = *(const LAS f32x4*)(wl + 4 * lane); v2u w; w.x = pk2(v[0], v[1]); w.y = pk2(v[2], v[3]);
      *(v2u*)(WSP(bf16, WS_O) + (size_t)row * DM + 256 * g + 4 * lane) = w; }
}

__device__ __forceinline__ void ldK(bf16x8 (&kf)[2][2], const GAS bf16* Kp, int k0, unsigned koff) {
#pragma unroll
    for (int kt = 0; kt < 2; ++kt)
#pragma unroll
        for (int ks = 0; ks < 2; ++ks) kf[kt][ks] = *(const GAS bf16x8*)((const GAS char*)(Kp + (size_t)k0 * 64 + kt * 256 + ks * 32) + koff);
}
__device__ __forceinline__ void ldV(bf16x8 (&vf)[4], const GAS bf16* Vp, int VP, int k0, unsigned voff) {
#pragma unroll
    for (int dt = 0; dt < 4; ++dt) vf[dt] = *(const GAS bf16x8*)((const GAS char*)(Vp + (size_t)(k0 >> 5) * 2048 + dt * 512) + voff);
}
template <int MODE, int GEN>
__device__ __forceinline__ void att_run(const GAS bf16* Kp, const GAS bf16* Vp, int VP, unsigned koff, unsigned voff, int n, int base, const LAS int* list,
                                        int KA, int KB, int W, unsigned M0, unsigned M1, unsigned M2, unsigned M3, int t, int fr, int fq, int lane,
                                        LAS float* wl, const float (&slope2)[4], f32x4 (&o)[4][4], float (&m)[4], float (&l)[4]) {
    if (n <= 0) return;
    bf16x8 kf[2][2], vf[4];
    int k0 = GEN == 0 ? 0 : (GEN == 1 ? base : list[0]);
    ldK(kf, Kp, k0, koff);
    if (MODE != 1) ldV(vf, Vp, VP, k0, voff);
    float carry = 0.f;
#pragma unroll 1
    for (int i = 0; i < n; ++i) {
        const int inx = (i + 1 < n) ? i + 1 : i;
        const int k0n = GEN == 0 ? 32 * inx : (GEN == 1 ? base - 32 * inx : list[inx]);
        f32x4 s[2][4];
        {
            unsigned qa = (unsigned)lane * 16u; asm volatile("" : "+v"(qa));
            const LAS char* qb = (const LAS char*)wl + qa;
#pragma unroll
            for (int h = 0; h < 4; ++h) {
                const bf16x8 q0 = *(const LAS bf16x8*)(qb + (h * 2 + 0) * 1024), q1 = *(const LAS bf16x8*)(qb + (h * 2 + 1) * 1024);
#pragma unroll
                for (int kt = 0; kt < 2; ++kt) { f32x4 a = (f32x4){0.f, 0.f, 0.f, 0.f};
                    a = __builtin_amdgcn_mfma_f32_16x16x32_bf16(kf[kt][0], q0, a, 0, 0, 0);
                    a = __builtin_amdgcn_mfma_f32_16x16x32_bf16(kf[kt][1], q1, a, 0, 0, 0); s[kt][h] = a; }
            }
        }
        ldK(kf, Kp, k0n, koff);
        bool extra = true;
        if (GEN == 2) { const int j = k0 >> 6, f = j & 3; const unsigned Mw = f == 0 ? M0 : f == 1 ? M1 : f == 2 ? M2 : M3; extra = (Mw >> (j >> 2)) & 1u; }
        f32x2 dp[2][2];
#pragma unroll
        for (int kt = 0; kt < 2; ++kt)
#pragma unroll
            for (int e = 0; e < 4; ++e) { const int nn = k0 + 8 * fq + 4 * kt + e, d = t - (KA * nn + KB); const float dv = (extra && (unsigned)d <= (unsigned)W) ? (float)d : __builtin_inff();
                if (e & 1) dp[kt][e >> 1].y = dv; else dp[kt][e >> 1].x = dv; }
        f32x2 sp[2][4][2];
#pragma unroll
        for (int h = 0; h < 4; ++h)
#pragma unroll
            for (int kt = 0; kt < 2; ++kt) { const f32x2 nsl = (f32x2){-slope2[h], -slope2[h]};
                sp[kt][h][0] = (f32x2){s[kt][h][0], s[kt][h][1]} + dp[kt][0] * nsl; sp[kt][h][1] = (f32x2){s[kt][h][2], s[kt][h][3]} + dp[kt][1] * nsl; }
        if (MODE == 2) {
#pragma unroll
            for (int h = 0; h < 4; ++h) { const f32x2 mm = (f32x2){m[h], m[h]}, ll = (f32x2){l[h], l[h]};
#pragma unroll
                for (int kt = 0; kt < 2; ++kt)
#pragma unroll
                    for (int pr = 0; pr < 2; ++pr) { const f32x2 a = sp[kt][h][pr] - mm; f32x2 p; p.x = fexp2(a.x); p.y = fexp2(a.y); sp[kt][h][pr] = p * ll; } }
            f32x2 as0[2], as1[2];
#pragma unroll
            for (int pr = 0; pr < 2; ++pr) { as0[pr] = (sp[0][0][pr] + sp[0][1][pr]) + (sp[0][2][pr] + sp[0][3][pr]); as1[pr] = (sp[1][0][pr] + sp[1][1][pr]) + (sp[1][2][pr] + sp[1][3][pr]); }
            const float r1 = __shfl(as1[1].y, (lane + 48) & 63);
            const float y0 = fq > 0 ? r1 : carry, y1 = as0[1].y; carry = r1;
            wl[2048 + fr * 128 + 8 * i + 2 * fq]     = ((as0[0].x + as0[0].y) + (as0[1].x + as0[1].y)) + y0;
            wl[2048 + fr * 128 + 8 * i + 2 * fq + 1] = ((as1[0].x + as1[0].y) + (as1[1].x + as1[1].y)) + y1;
        } else {
            float tl[4]; bool grow = false;
#pragma unroll
            for (int h = 0; h < 4; ++h) {
                const f32x2 mx = __builtin_elementwise_max(__builtin_elementwise_max(sp[0][h][0], sp[0][h][1]), __builtin_elementwise_max(sp[1][h][0], sp[1][h][1]));
                tl[h] = fmaxf(mx.x, mx.y); grow = grow || (tl[h] > m[h] + 8.0f);
            }
            if (__any(grow)) {
#pragma unroll
                for (int h = 0; h < 4; ++h) { float tm = tl[h]; tm = fmaxf(tm, __shfl_xor(tm, 16)); tm = fmaxf(tm, __shfl_xor(tm, 32));
                    const float mn = fmaxf(m[h], tm), ms = (mn == NEG_INF) ? 0.f : mn, alpha = fexp2(m[h] - ms); l[h] *= alpha; m[h] = mn;
                    if (MODE == 0) {
#pragma unroll
                        for (int dt = 0; dt < 4; ++dt) o[dt][h] = o[dt][h] * alpha; } }
            }
#pragma unroll
            for (int h = 0; h < 4; ++h) { const float ms = (m[h] == NEG_INF) ? 0.f : m[h]; const f32x2 mm = (f32x2){ms, ms}; f32x2 ps = (f32x2){0.f, 0.f};
#pragma unroll
                for (int kt = 0; kt < 2; ++kt)
#pragma unroll
                    for (int pr = 0; pr < 2; ++pr) { const f32x2 a = sp[kt][h][pr] - mm; f32x2 p; p.x = fexp2(a.x); p.y = fexp2(a.y); sp[kt][h][pr] = p; ps = ps + p; }
                l[h] += ps.x + ps.y; }
        }
#pragma unroll
        for (int h = 0; h < 4; ++h)
#pragma unroll
            for (int kt = 0; kt < 2; ++kt) s[kt][h] = (f32x4){sp[kt][h][0].x, sp[kt][h][0].y, sp[kt][h][1].x, sp[kt][h][1].y};
        if (MODE != 1) {
            bf16x8 pf[4];
#pragma unroll
            for (int h = 0; h < 4; ++h) { const v4u w = pack8(s[0][h], s[1][h]); pf[h] = __builtin_bit_cast(bf16x8, w); }
#pragma unroll
            for (int dt = 0; dt < 4; ++dt)
#pragma unroll
                for (int h = 0; h < 4; ++h) o[dt][h] = __builtin_amdgcn_mfma_f32_16x16x32_bf16(vf[dt], pf[h], o[dt][h], 0, 0, 0);
            ldV(vf, Vp, VP, k0n, voff);
        }
        k0 = k0n;
    }
}
#if defined(PROBE_MODE) && PROBE_MODE == 4
#define SEC_ON(s) (PROBE_A == (s) && (int)blockIdx.x == PROBE_BLK && threadIdx.x == 0)
#define SEC_T0(s) do { if (SEC_ON(s)) { volatile LAS unsigned* pm_ = (volatile LAS unsigned*)(unsigned)MISC_OFF; pm_[17] = (unsigned)__builtin_amdgcn_s_memrealtime(); } } while (0)
#define SEC_T1(s) do { if (SEC_ON(s)) { volatile LAS unsigned* pm_ = (volatile LAS unsigned*)(unsigned)MISC_OFF; pm_[16] = pm_[16] + ((unsigned)__builtin_amdgcn_s_memrealtime() - pm_[17]); } } while (0)
#define SEC_CNT(s, n) do { if (SEC_ON(s)) { volatile LAS unsigned* pm_ = (volatile LAS unsigned*)(unsigned)MISC_OFF; pm_[16] = pm_[16] + (unsigned)(n); } } while (0)
#else
#define SEC_T0(s) do { } while (0)
#define SEC_T1(s) do { } while (0)
#define SEC_CNT(s, n) do { } while (0)
#endif
__device__ __forceinline__ void attn_prompt_unit2(const Ptrs& P, int bg, int tt, LAS float* wl, int lane_in) {
    int lane = lane_in; asm volatile("" : "+v"(lane));
    const int fr = lane & 15, fq = lane >> 4, b = bg >> 2, g = bg & 3, t0 = 16 * tt, t = t0 + fr, row = b * SEQ + t;
    const float* GT = WSP(float, WS_GATES) + (size_t)row * 48 + g * 12;
    const GAS bf16* KC = (const GAS bf16*)WSP(bf16, WS_KC) + (size_t)bg * 512 * 64; const GAS bf16* VCT = (const GAS bf16*)WSP(bf16, WS_VCT) + (size_t)bg * 64 * 512;
    const GAS bf16* SK = (const GAS bf16*)WSP(bf16, WS_SK) + (size_t)bg * SEQ * 64; const GAS bf16* SVT = (const GAS bf16*)WSP(bf16, WS_SVT) + (size_t)bg * 64 * SEQ;
    const GAS bf16* WK = (const GAS bf16*)WSP(bf16, WS_WK) + (size_t)bg * SEQ * 64; const GAS bf16* WVT = (const GAS bf16*)WSP(bf16, WS_WVT) + (size_t)bg * 64 * SEQ;
    GAS float* OA = (GAS float*)WSP(float, WS_OACC) + (size_t)row * DM + 256 * g + 4 * fq;
    float slope2[4];
    { const GAS bf16* Q = (const GAS bf16*)WSP(bf16, WS_Q) + (size_t)row * DM + (4 * g) * 64 + 8 * fq;
#pragma unroll
      for (int h = 0; h < 4; ++h) { slope2[h] = fexp2(-0.5f * (float)(4 * g + h + 1)) * LOG2E;
#pragma unroll
          for (int ks = 0; ks < 2; ++ks) *(LAS v4u*)((LAS char*)wl + (h * 2 + ks) * 1024 + lane * 16) = *(const GAS v4u*)(Q + h * 64 + 32 * ks); } }
    f32x4 o[4][4]; float m[4], l[4];
    const int BIG = 1 << 30;
    const unsigned koff = (unsigned)((8 * (fr >> 2) + (fr & 3)) * 64 + 8 * fq) * 2u, voffc = (unsigned)(fr * 32 + 8 * fq) * 2u, voffs = voffc;
    const int nst = (tt >> 5) + 1;
    SEC_T0(1);
#pragma unroll
    for (int h = 0; h < 4; ++h) { m[h] = NEG_INF; l[h] = 0.f; }
    att_run<1, 0>(KC, VCT, 512, koff, voffc, nst, 0, nullptr, 16, 31, BIG, 0u, 0u, 0u, 0u, t, fr, fq, lane, wl, slope2, o, m, l);
#pragma unroll
    for (int h = 0; h < 4; ++h) { float lt = l[h]; lt += __shfl_xor(lt, 16); lt += __shfl_xor(lt, 32); l[h] = lt > 0.f ? 1.0f / lt : 0.f; if (m[h] == NEG_INF) m[h] = 0.f;
#pragma unroll
        for (int dt = 0; dt < 4; ++dt) o[dt][h] = (f32x4){0.f, 0.f, 0.f, 0.f}; }
    att_run<2, 0>(KC, VCT, 512, koff, voffc, nst, 0, nullptr, 16, 31, BIG, 0u, 0u, 0u, 0u, t, fr, fq, lane, wl, slope2, o, m, l);
#pragma unroll
    for (int h = 0; h < 4; ++h) { const float gc = GT[h * 3 + 0];
#pragma unroll
        for (int dt = 0; dt < 4; ++dt) *(GAS f32x4*)(OA + h * 64 + 16 * dt) = o[dt][h] * gc; }
    SEC_T1(1);
    SEC_T0(2);
    const int qblk = t0 >> 6;
    unsigned M0, M1, M2, M3;
    {
        float cv[32];
#pragma unroll
        for (int q = 0; q < 32; ++q) { const int j = 4 * q + fq; const float x = wl[2048 + fr * 128 + j];
            const bool forced = (j == 0) | (j == qblk) | (j == qblk - 1); cv[q] = (j <= qblk) ? (forced ? x + 1e4f : x) : -1.f; }
        unsigned mask = 0u;
#pragma unroll 1
        for (int r = 0; r < 16; ++r) {
            float bv = cv[0]; int bq = 0;
#pragma unroll
            for (int q = 1; q < 32; ++q) if (cv[q] > bv) { bv = cv[q]; bq = q; }
            int bj = 4 * bq + fq;
#pragma unroll
            for (int off = 16; off <= 32; off <<= 1) { const float ov = __shfl_xor(bv, off); const int oj = __shfl_xor(bj, off); if (ov > bv || (ov == bv && oj < bj)) { bv = ov; bj = oj; } }
            const bool mine = (bv >= 0.f) && ((bj & 3) == fq); const int wq = bj >> 2;
#pragma unroll
            for (int q = 0; q < 32; ++q) if (mine && q == wq) cv[q] = -2.f;
            if (mine) mask |= 1u << wq;
        }
        M0 = __shfl(mask, fr); M1 = __shfl(mask, fr + 16); M2 = __shfl(mask, fr + 32); M3 = __shfl(mask, fr + 48);
    }
    int nlist = 0;
    {
        unsigned U0 = M0, U1 = M1, U2 = M2, U3 = M3;
#pragma unroll
        for (int off = 1; off < 16; off <<= 1) { U0 |= __shfl_xor(U0, off); U1 |= __shfl_xor(U1, off); U2 |= __shfl_xor(U2, off); U3 |= __shfl_xor(U3, off); }
        U0 = __builtin_amdgcn_readfirstlane(U0); U1 = __builtin_amdgcn_readfirstlane(U1); U2 = __builtin_amdgcn_readfirstlane(U2); U3 = __builtin_amdgcn_readfirstlane(U3);
        LAS int* lst = (LAS int*)(wl + 2048);
#pragma unroll 1
        for (int j = qblk; j >= 0; --j) { const int f = j & 3; const unsigned Uw = f == 0 ? U0 : f == 1 ? U1 : f == 2 ? U2 : U3;
            if ((Uw >> (j >> 2)) & 1u) { if (lane == 0) { lst[nlist] = 64 * j + 32; lst[nlist + 1] = 64 * j; } nlist += 2; } }
    }
    SEC_T1(2); SEC_CNT(5, nlist); SEC_T0(3);
#pragma unroll
    for (int h = 0; h < 4; ++h) { m[h] = NEG_INF; l[h] = 0.f;
#pragma unroll
        for (int dt = 0; dt < 4; ++dt) o[dt][h] = (f32x4){0.f, 0.f, 0.f, 0.f}; }
    att_run<0, 2>(SK, SVT, SEQ, koff, voffs, nlist, 0, (const LAS int*)(wl + 2048), 1, 0, BIG, M0, M1, M2, M3, t, fr, fq, lane, wl, slope2, o, m, l);
    asm volatile("s_waitcnt vmcnt(0)" ::: "memory");
#pragma unroll
    for (int h = 0; h < 4; ++h) { float lt = l[h]; lt += __shfl_xor(lt, 16); lt += __shfl_xor(lt, 32); const float sc = lt > 0.f ? GT[h * 3 + 1] / lt : 0.f;
#pragma unroll
        for (int dt = 0; dt < 4; ++dt) { GAS f32x4* p = (GAS f32x4*)(OA + h * 64 + 16 * dt); *p = *p + o[dt][h] * sc; } }
    SEC_T1(3); SEC_T0(4);
#pragma unroll
    for (int h = 0; h < 4; ++h) { m[h] = NEG_INF; l[h] = 0.f;
#pragma unroll
        for (int dt = 0; dt < 4; ++dt) o[dt][h] = (f32x4){0.f, 0.f, 0.f, 0.f}; }
    { const int kend = (t0 > 512 ? (t0 - 512) : 0) & ~31, ktop = t0 & ~31;
      att_run<0, 1>(WK, WVT, SEQ, koff, voffs, ((ktop - kend) >> 5) + 1, ktop, nullptr, 1, 0, 512, 0u, 0u, 0u, 0u, t, fr, fq, lane, wl, slope2, o, m, l); }
    asm volatile("s_waitcnt vmcnt(0)" ::: "memory");
    GAS bf16* O = (GAS bf16*)WSP(bf16, WS_O) + (size_t)row * DM + 256 * g + 4 * fq;
#pragma unroll
    for (int h = 0; h < 4; ++h) { float lt = l[h]; lt += __shfl_xor(lt, 16); lt += __shfl_xor(lt, 32); const float sc = lt > 0.f ? GT[h * 3 + 2] / lt : 0.f;
#pragma unroll
        for (int dt = 0; dt < 4; ++dt) { const f32x4 v = *(const GAS f32x4*)(OA + h * 64 + 16 * dt) + o[dt][h] * sc;
            v2u w; w.x = pk2(v[0], v[1]); w.y = pk2(v[2], v[3]); *(GAS v2u*)(O + h * 64 + 16 * dt) = w; } }
    SEC_T1(4);
}

#define ATTN_UNIT attn_prompt_unit2
#ifdef PROBE_MODE
#ifndef PROBE_BLK
#define PROBE_BLK 0
#endif
#ifndef PROBE_MULT
#define PROBE_MULT 8
#endif
#define PROBE_SEL(p) ((p) >= PROBE_A && (p) <= PROBE_B)
#endif
struct Args { const void* in[31]; float* out; unsigned char* ws; int ph_lo, ph_hi; };
constexpr int N_PHASES = 2 + 1 + 12 + 2 * 1 + 2 * 1 + 12 + 1;

__global__ void __launch_bounds__(NWAVES * 64, 2) yoco_fwd(Args args) {
    extern __shared__ __attribute__((aligned(16))) unsigned char lds_raw[];
    LAS unsigned char* lds = (LAS unsigned char*)lds_raw;
    const int tid0 = threadIdx.x, wave = __builtin_amdgcn_readfirstlane(tid0 >> 6);
    const int G = gridDim.x; const int bx = blockIdx.x; const int vcu = (G % 8 == 0) ? (bx % 8) * (G / 8) + bx / 8 : bx;
    const int gw0 = vcu * NWAVES + wave, NGW = G * NWAVES;

    for (int u = tid0; u < (LDS_BYTES - LDSCTL_OFF) / 4; u += NWAVES * 64) ((LAS unsigned*)(lds + LDSCTL_OFF))[u] = 0u;
    __syncthreads();
    volatile LAS unsigned* MISC = (volatile LAS unsigned*)(lds + MISC_OFF);
    unsigned* barw = (unsigned*)(args.ws + WS_CTL) + CW_BAR;
    XcdBarrier bar; bar.bar = barw; bar.x = 0; bar.st = nullptr;
    const int lo = args.ph_lo, hi = args.ph_hi;
    if (hi - lo > 1) bar = xcd_barrier_post(barw, MISC + 8);
    int pid = 0;
#define IN_PH() (lo <= pid && pid < hi)
#define NIN() NormIn{P.ws, sl > 0 ? sl - 1 : 0, sl, sl > 0 ? 1 : 0}
#define LOADP() int tid = tid0; asm volatile("" : "+v"(tid)); const int lane = tid & 63; int gw = gw0; asm volatile("" : "+s"(gw)); (void)lane; (void)gw; Ptrs P; load_ptrs(P); const f16* X = WSP(f16, WS_X); bf16* H = WSP(bf16, WS_H); const float* MOD = WSP(float, WS_MOD); (void)X; (void)H; (void)MOD
#ifdef PROBE_MODE
#define PRB_ON() ((int)blockIdx.x == PROBE_BLK && tid0 == 0)
#define PRB_NOW() ((unsigned)__builtin_amdgcn_s_memrealtime())
#define END_PH() do { if (PRB_ON()) { const unsigned tm_ = PRB_NOW(); if ((PROBE_MODE & 1) && PROBE_SEL(pid)) MISC[16] = MISC[16] + (tm_ - MISC[17]); MISC[17] = tm_; } \
    if (lo <= pid && pid + 1 < hi) xcd_barrier(bar); \
    if (PRB_ON()) { const unsigned te_ = PRB_NOW(); if ((PROBE_MODE & 2) && PROBE_SEL(pid)) MISC[16] = MISC[16] + (te_ - MISC[17]); MISC[17] = te_; } ++pid; } while (0)
#else
#define END_PH() do { if (lo <= pid && pid + 1 < hi) xcd_barrier(bar); ++pid; } while (0)
#endif


#ifdef PROBE_MODE
    if (PRB_ON()) { MISC[16] = 0u; MISC[17] = PRB_NOW(); }
#endif
    if (IN_PH()) { LOADP(); prologue_phase(P, lds, gw, NGW, wave, lane, tid); }
    END_PH();
    if (IN_PH()) { LOADP();
        run_gemm(lds, WSP(bf16, WS_SC), WSP(bf16, WS_WMOD), 256, NMOD, DM, FMod{WSP(float, WS_MOD), P.ada_b, P.kv_ada_b, P.final_ada_b, WSP(bf16, WS_SHB)});
        run_gemm(lds, WSP(bf16, WS_ACMP), WSP(bf16, WS_WC1), 65536, 512, 1024, FBf16{WSP(bf16, WS_TS), 512});
        run_gemm(lds, WSP(bf16, WS_ACMP) + (size_t)65536 * 1024, WSP(bf16, WS_WC1) + (size_t)512 * 1024, 65536, 512, 1024, FBf16{WSP(bf16, WS_TS) + (size_t)65536 * 512, 512});
    }
    END_PH();

    for (int sl = 0; sl < 12; ++sl) {
        const int l = sl / 3, sub = sl - 3 * l;
        if (sl == 0) {
            if (IN_PH()) { LOADP();
                norm_phase<false>(X, P.norm_g, MOD, 0, DM, H, nullptr, gw, NGW, lane);
                { pg8::Gemm g{WSP(bf16, WS_SHB), WSP(bf16, WS_WGU), 13 * 256, 0, DM}; int cb = (int)blockIdx.x; asm volatile("" : "+s"(cb)); ShiftOrder S{(int)gridDim.x, cb}; Epi8<FB2> E{FB2{WSP(float, WS_B2)}};
                  pg8::gemm_phase<Epi8<FB2>, ShiftOrder, true, true>(lds, g, S, E); }
                for (int u = gw; u < 2 * 512 * 8; u += NGW) { const int kv = u >> 12, r = u & 4095, bg = r >> 3, rt = r & 7;
                    cmp_finish_unit<2>(WSP(bf16, WS_TS) + (size_t)kv * 65536 * 512, WSP(float, WS_CBIAS) + kv * 256, WSP(bf16, WS_WC2) + kv * 64 * 256,
                                       kv == 0 ? (void*)WSP(float, WS_KCS) : (void*)WSP(float, WS_VCS), 128, bg, rt, lane); }
            }
            END_PH();
        }
        if (sub != 1) {
            const int s = sub >> 1;
            if (IN_PH()) { LOADP();
                if (sl == 6) {
                    run_gemm2(lds, WSP(bf16, WS_HKV), WSP(bf16, WS_WKV), NKVP, NKVP, DM, FKv{P.out, WSP(bf16, WS_KCIN), NormIn{P.ws, 5, 12, 1}}, 0, 0);
                    run_gemm2(lds, H, WSP(bf16, WS_WGU) + (size_t)(l * 2 + s) * 5632 * 1024, 5632, 5632, DM, FSwiglu{WSP(bf16, WS_HID), NIN()}, (int)gridDim.x / 2, 0);
                } else
                run_gemm2(lds, H, WSP(bf16, WS_WGU) + (size_t)(l * 2 + s) * 5632 * 1024, 5632, 5632, DM, FSwiglu{WSP(bf16, WS_HID), NIN()}); }
            END_PH();
        } else if (l < 2) {
            if (IN_PH()) { LOADP(); run_gemm2(lds, H, WSP(bf16, WS_WUV) + (size_t)l * 6144 * 1024, 6144, 6144, DM, FGelu{WSP(bf16, WS_Z), NIN(), WSP(float, WS_CTL) + CW_VS + (size_t)l * RT * 2}); }
            END_PH();
            if (IN_PH()) { LOADP(); spatial2_phase(P, l, lds, wave, lane, tid, gw, NGW); }
            END_PH();
        } else {
            if (IN_PH()) { LOADP();
                if (sl == 7) {
                    for (int u = gw; u < 2 * 8 * 32; u += NGW) { const int kv = u >> 8, r = u & 255, bg = r >> 5, rt = r & 31;
                        if (kv == 0) cmp_finish_unit<0>(WSP(bf16, WS_TK), WSP(float, WS_CBIAS), WSP(bf16, WS_WC2), (void*)WSP(bf16, WS_KC), 512, bg, rt, lane);
                        else cmp_finish_unit<1>(WSP(bf16, WS_TV), WSP(float, WS_CBIAS) + 256, WSP(bf16, WS_WC2) + 64 * 256, (void*)WSP(bf16, WS_VCT), 512, bg, rt, lane); }
                }
                run_gemm2(lds, H, WSP(bf16, WS_WQG) + (size_t)(l - 2) * NQG * 1024, NQG, 1072, DM, FQg{WSP(bf16, WS_Q), WSP(float, WS_GATES), NIN()}); }
            END_PH();
            if (IN_PH()) { LOADP(); LAS float* wl = (LAS float*)(lds + (gw & 7) * 16384);
                {
                    int r = 0;
                    for (;;) {
                        const int q = ((int)(xb_xcc_id() & 7u) + r) & 7;
                        unsigned idx = 0u; if (lane == 0) idx = __hip_atomic_fetch_add((unsigned*)(P.ws + WS_CTL) + CW_QUEUE + 64 * (8 * (l - 2) + q), 1u, __ATOMIC_RELAXED, __HIP_MEMORY_SCOPE_AGENT);
                        idx = (unsigned)__builtin_amdgcn_readfirstlane((int)idx);
                        if (idx >= 64u + 512u) { if (++r == 8) break; continue; }
                        if (idx < 64u) { const int id = q * 64 + (int)idx; attn_sample_unit(P, id >> 2, id & 3, wl, lane); }
                        else ATTN_UNIT(P, q, 511 - ((int)idx - 64), wl, lane);
                    }
                }
            }
            END_PH();
        }
        if (IN_PH()) { LOADP();
            const bf16* A2 = sub != 1 ? WSP(bf16, WS_HID) : (l < 2 ? WSP(bf16, WS_P) : WSP(bf16, WS_O));
            const bf16* B2 = sub != 1 ? WSP(bf16, WS_WDN) + (size_t)(l * 2 + (sub >> 1)) * 1024 * DFF : (l < 2 ? WSP(bf16, WS_WOUT) + (size_t)l * 1024 * DV : WSP(bf16, WS_WO) + (size_t)(l - 2) * 1024 * 1024);
            const int K2 = sub != 1 ? DFF : (l < 2 ? DV : DM);
            if (sl == 6) {
                run_gemm(lds, WSP(bf16, WS_KCIN), WSP(bf16, WS_WC1), 4096, 512, 1024, FBf16{WSP(bf16, WS_TK), 512}, 64);
                run_gemm(lds, WSP(bf16, WS_VCIN), WSP(bf16, WS_WC1) + (size_t)512 * 1024, 4096, 512, 1024, FBf16{WSP(bf16, WS_TV), 512}, 32);
            }
            const int sn = sl + 1, ln = sn / 3, subn = sn - 3 * ln;
            const bool more = sl < 11;
            run_gemm2r(lds, A2, B2, K2, FResid{P.ws, l * 9216 + (sub * 3 + 2) * DM, sub != 1 ? 0.5f : 1.0f, more ? sn : -1, ln * 9216 + (subn * 3 + 1) * DM, sl == 5 ? 12 : -1, MODKV + DM, more ? sl : -1});
        }
        END_PH();
    }
    if (IN_PH()) { LOADP(); norm_phase<true>(X, P.final_g, MOD, MODFIN, MODFIN + DM, nullptr, P.out, gw, NGW, lane); }
#ifdef PROBE_MODE
    if (PRB_ON()) { const unsigned tm_ = PRB_NOW(); if ((PROBE_MODE & 1) && PROBE_SEL(pid)) MISC[16] = MISC[16] + (tm_ - MISC[17]);
        const unsigned want = MISC[16] * (unsigned)PROBE_MULT; const unsigned t0_ = PRB_NOW(); while (PRB_NOW() - t0_ < want) __builtin_amdgcn_s_sleep(32); }
#endif
    ++pid;
#undef IN_PH
#undef END_PH
}

extern "C" void kernel_launch(void* const* d_in, const int* in_sizes, int n_in, void* d_out, int out_size, void* d_ws, size_t ws_size, hipStream_t stream) {
    static int grid = 0;
    if (grid == 0) {
        if (n_in != 31 || (size_t)out_size != OUT_TOTAL || ws_size < WS_END) { fprintf(stderr, "kernel_launch: unexpected shapes (n_in %d, out %d, ws %zu need %zu); nothing launched\n", n_in, out_size, ws_size, (size_t)WS_END); grid = -1; return; }
        int dev = 0, cus = 0, per_cu = 0;
        if (hipGetDevice(&dev) != hipSuccess || hipDeviceGetAttribute(&cus, hipDeviceAttributeMultiprocessorCount, dev) != hipSuccess) { grid = -1; return; }
        if (hipFuncSetAttribute((const void*)yoco_fwd, hipFuncAttributeMaxDynamicSharedMemorySize, LDS_BYTES) != hipSuccess) { fprintf(stderr, "kernel_launch: hipFuncSetAttribute failed\n"); grid = -1; return; }
        if (hipOccupancyMaxActiveBlocksPerMultiprocessor(&per_cu, (const void*)yoco_fwd, NWAVES * 64, LDS_BYTES) != hipSuccess || per_cu < 1) { fprintf(stderr, "kernel_launch: occupancy query says %d blocks per CU\n", per_cu); }
        (void)hipGetLastError();
        grid = cus;
    }
    if (grid < 0) return;
    if (hipMemsetAsync((char*)d_ws + WS_CTL, 0, CTL_ZERO_BYTES, stream) != hipSuccess) return;
    Args a{};
    for (int i = 0; i < 31; ++i) a.in[i] = d_in[i];
    a.out = (float*)d_out; a.ws = (unsigned char*)d_ws;
#if ONE_LAUNCH
    a.ph_lo = 0; a.ph_hi = N_PHASES;
    hipLaunchKernelGGL(yoco_fwd, dim3(grid), dim3(NWAVES * 64), LDS_BYTES, stream, a);
#else
    for (int p = 0; p < N_PHASES; ++p) { a.ph_lo = p; a.ph_hi = p + 1; hipLaunchKernelGGL(yoco_fwd, dim3(grid), dim3(NWAVES * 64), LDS_BYTES, stream, a); }
#endif
}
```

```cpp
#include <hip/hip_runtime.h>
#include <cstdio>
#include <cstdint>
#include <cmath>
namespace pg8 {
#define PG8_LAS __attribute__((address_space(3)))
typedef unsigned short bf16_t;
typedef short bf16x8 __attribute__((ext_vector_type(8)));
typedef float f32x4 __attribute__((ext_vector_type(4)));
typedef unsigned u32x4 __attribute__((ext_vector_type(4)));
constexpr int BM = 256, BK = 64, HALF = 128, HTB = HALF * BK * 2  , STAGE_BYTES = 8 * HTB, NXCD = 8, WGM = 8;

__host__ __device__ __forceinline__ int lds_byte(int r, int c) { const int st = (r >> 4) * 2 + (c >> 5), rr = r & 15, cc = c & 31, ob = rr * 64 + cc * 2; return st * 1024 + (ob ^ (((ob >> 9) & 1) << 5)); }
__host__ __device__ __forceinline__ void stage_rc(int b, int& R, int& C) { const int st = b / 1024, sb = b % 1024, swz = sb ^ (((sb >> 9) & 1) << 5); R = (st >> 1) * 16 + swz / 64; C = (st & 1) * 32 + (swz % 64) / 2; }
__host__ __device__ __forceinline__ int perm32(int rho) { const int n = rho >> 4, i = rho & 15; return 8 * (i >> 2) + 4 * n + (i & 3); }

struct Unit { int pm, pn; };
struct Gemm { const bf16_t* A; const bf16_t* Bt; int M, N, K; };

struct StaticOrder {
    int nM, nN, nwg, G, c;
    __host__ __device__ void init(int M, int N, int G_, int c_) { nM = M / BM; nN = N / BM; nwg = nM * nN; G = G_; c = c_; }
    __host__ __device__ bool next(int i, Unit& u) const {
        const long L = (long)i * G + c; if (L >= nwg) return false;
        int wgid = (int)L; { const int q = nwg / NXCD, r = nwg % NXCD, xcd = wgid % NXCD, off = wgid / NXCD; wgid = (xcd < r ? xcd * (q + 1) : r * (q + 1) + (xcd - r) * q) + off; }
        const int nig = WGM * nN, gid = wgid / nig, fm = gid * WGM, gsz = (nM - fm) < WGM ? (nM - fm) : WGM;
        u.pm = fm + ((wgid % nig) % gsz); u.pn = (wgid % nig) / gsz; return true;
    }
    __device__ __forceinline__ void a_ready(const Unit&) const {}
    __device__ __forceinline__ void done(const Unit&) const {}
};

__device__ __forceinline__ unsigned cvt_pk_bf16(float lo, float hi) { unsigned r; asm volatile("v_cvt_pk_bf16_f32 %0, %1, %2" : "=v"(r) : "v"(lo), "v"(hi)); return r; }
typedef float f32x2 __attribute__((ext_vector_type(2)));
template <class Epi, class Sched, bool ALIGN_EPI = false, bool SP2 = false>
__device__ __forceinline__ void gemm_phase(PG8_LAS unsigned char* lds, const Gemm g, const Sched& S, const Epi& E) {
    int tid_raw = threadIdx.x; asm volatile("" : "+v"(tid_raw));
    const int tid = tid_raw, wid = __builtin_amdgcn_readfirstlane(tid >> 6), lane = tid & 63, wr = wid >> 2, wc = wid & 3, fr = lane & 15, fq = lane >> 4;
    const int K = g.K, nt = K / BK;
    unsigned voffA[2], voffB[2];
#pragma unroll
    for (int i = 0; i < 2; ++i) { int R, C; stage_rc(tid * 16 + i * 8192, R, C); const int Rb = Epi::PERM ? ((R & ~31) + perm32(R & 31)) : R;
        voffA[i] = (unsigned)(R * K + C) * 2u; voffB[i] = (unsigned)(Rb * K + C) * 2u; }
    const size_t kstep = (size_t)(BK * 2);
    const size_t hstep = (size_t)HALF * K * 2;
    const size_t tstep = 2 * hstep;
    const unsigned ldsw = (unsigned)wid * 1024u;
    const int aoff = lds_byte(wr * 64 + fr, fq * 8), boff = lds_byte(wc * 32 + fr, fq * 8);
#define PG8_SA(b, h) (((b) * 2 + (h)) * HTB)
#define PG8_SB(b, h) ((4 + (b) * 2 + (h)) * HTB)
#define PG8_STAGE(bufoff, gbase, voff) do { _Pragma("unroll") for (int _i = 0; _i < 2; ++_i) \
        __builtin_amdgcn_global_load_lds((const unsigned*)((const char*)(gbase) + (voff)[_i]), (PG8_LAS unsigned*)(lds + (bufoff) + ldsw + _i * 8192), 16, 0, 0); } while (0)
#define PG8_LDA(dst, b, h) do { _Pragma("unroll") for (int m = 0; m < 4; ++m) _Pragma("unroll") for (int k = 0; k < 2; ++k) dst[m][k] = *(const PG8_LAS bf16x8*)(lds + PG8_SA(b, h) + aoff + m * 2048 + k * 1024); } while (0)
#define PG8_LDB(dst, b, h) do { _Pragma("unroll") for (int n = 0; n < 2; ++n) _Pragma("unroll") for (int k = 0; k < 2; ++k) dst[n][k] = *(const PG8_LAS bf16x8*)(lds + PG8_SB(b, h) + boff + n * 2048 + k * 1024); } while (0)
#define PG8_MMA(ai, bj, At, Bt) do { __builtin_amdgcn_s_setprio(1); _Pragma("unroll") for (int m = 0; m < 4; ++m) _Pragma("unroll") for (int n = 0; n < 2; ++n) _Pragma("unroll") for (int k = 0; k < 2; ++k) \
        acc[ai][bj][m][n] = __builtin_amdgcn_mfma_f32_16x16x32_bf16(Bt[n][k], At[m][k], acc[ai][bj][m][n], 0, 0, 0); __builtin_amdgcn_s_setprio(0); } while (0)
#define PG8_WAIT_V(n) asm volatile("s_waitcnt vmcnt(" #n ")" ::: "memory")
#define PG8_WAIT_L(n) asm volatile("s_waitcnt lgkmcnt(" #n ")" ::: "memory")
#define PG8_BAR __builtin_amdgcn_s_barrier()
#define PG8_SCHED __builtin_amdgcn_sched_barrier(0)
    Unit cur, nxt; int ui = 0;
    if (!S.next(0, cur)) return;
    f32x4 acc[2][2][4][2];
#pragma unroll
    for (int a = 0; a < 2; ++a)
#pragma unroll
        for (int b = 0; b < 2; ++b)
#pragma unroll
            for (int m = 0; m < 4; ++m)
#pragma unroll
                for (int n = 0; n < 2; ++n) acc[a][b][m][n] = (f32x4){0.f, 0.f, 0.f, 0.f};
    bf16x8 At[4][2], B0[2][2], B1[2][2];
    const char* cA = (const char*)g.A + (size_t)cur.pm * tstep; const char* cB = (const char*)g.Bt + (size_t)cur.pn * tstep;
    S.a_ready(cur);
    if constexpr (SP2) {
        PG8_STAGE(PG8_SB(0, 0), cB, voffB); PG8_STAGE(PG8_SB(0, 1), cB + hstep, voffB); PG8_STAGE(PG8_SA(0, 0), cA, voffA); PG8_STAGE(PG8_SA(0, 1), cA + hstep, voffA);
        if (wr == 1) PG8_BAR;
        PG8_WAIT_V(2); PG8_BAR;
        PG8_STAGE(PG8_SB(1, 0), cB + kstep, voffB); PG8_STAGE(PG8_SA(1, 0), cA + kstep, voffA); PG8_STAGE(PG8_SB(1, 1), cB + hstep + kstep, voffB);
        PG8_WAIT_V(6); PG8_BAR;
    } else {
        PG8_STAGE(PG8_SB(0, 0), cB, voffB); PG8_STAGE(PG8_SA(0, 0), cA, voffA); PG8_STAGE(PG8_SB(0, 1), cB + hstep, voffB); PG8_STAGE(PG8_SA(0, 1), cA + hstep, voffA);
        if (wr == 1) PG8_BAR;
        PG8_WAIT_V(4); PG8_BAR;
        PG8_STAGE(PG8_SB(1, 0), cB + kstep, voffB); PG8_STAGE(PG8_SA(1, 0), cA + kstep, voffA); PG8_STAGE(PG8_SB(1, 1), cB + hstep + kstep, voffB);
        PG8_WAIT_V(6); PG8_BAR;
    }
    for (;;) {
        const bool has_next = S.next(ui + 1, nxt);
        const char* nA = has_next ? (const char*)g.A + (size_t)nxt.pm * tstep : cA; const char* nB = has_next ? (const char*)g.Bt + (size_t)nxt.pn * tstep : cB;
        for (int t = 0; t < nt; t += 2) {
            const bool last = (t == nt - 2);
            const char* a1 = cA + (size_t)(t + 1) * kstep;
            const char* a2 = last ? nA : cA + (size_t)(t + 2) * kstep; const char* b2 = last ? nB : cB + (size_t)(t + 2) * kstep;
            const char* a3 = a2 + kstep; const char* b3 = b2 + kstep;
            if (last && has_next) S.a_ready(nxt);
            if constexpr (SP2) {
            PG8_LDB(B0, 0, 0); PG8_LDB(B1, 0, 1); PG8_SCHED; PG8_LDA(At, 0, 0); PG8_STAGE(PG8_SA(1, 1), a1 + hstep, voffA);
            PG8_WAIT_V(8); PG8_WAIT_L(0); PG8_BAR; PG8_MMA(0, 0, At, B0); PG8_MMA(0, 1, At, B1); PG8_BAR; PG8_SCHED;
            PG8_LDA(At, 0, 1); PG8_STAGE(PG8_SB(0, 0), b2, voffB); PG8_STAGE(PG8_SB(0, 1), b2 + hstep, voffB); PG8_STAGE(PG8_SA(0, 0), a2, voffA);
            PG8_WAIT_V(8); PG8_WAIT_L(0); PG8_BAR; PG8_MMA(1, 0, At, B0); PG8_MMA(1, 1, At, B1); PG8_BAR; PG8_SCHED;
            PG8_LDB(B0, 1, 0); PG8_LDB(B1, 1, 1); PG8_SCHED; PG8_LDA(At, 1, 0); PG8_STAGE(PG8_SA(0, 1), a2 + hstep, voffA);
            PG8_WAIT_V(8); PG8_WAIT_L(0); PG8_BAR; PG8_MMA(0, 0, At, B0); PG8_MMA(0, 1, At, B1); PG8_BAR; PG8_SCHED;
            PG8_LDA(At, 1, 1); PG8_STAGE(PG8_SB(1, 0), b3, voffB); PG8_STAGE(PG8_SB(1, 1), b3 + hstep, voffB); PG8_STAGE(PG8_SA(1, 0), a3, voffA);
            PG8_WAIT_V(8); PG8_WAIT_L(0); PG8_BAR; PG8_MMA(1, 0, At, B0); PG8_MMA(1, 1, At, B1); PG8_BAR; PG8_SCHED;
            } else {
            PG8_LDB(B0, 0, 0); PG8_SCHED; PG8_LDA(At, 0, 0); PG8_STAGE(PG8_SA(1, 1), a1 + hstep, voffA);
            PG8_WAIT_L(8); PG8_BAR; PG8_WAIT_L(0); PG8_MMA(0, 0, At, B0); PG8_BAR; PG8_SCHED;
            PG8_LDB(B1, 0, 1); PG8_STAGE(PG8_SB(0, 0), b2, voffB);
            PG8_BAR; PG8_WAIT_L(0); PG8_MMA(0, 1, At, B1); PG8_BAR;
            PG8_LDA(At, 0, 1); PG8_STAGE(PG8_SA(0, 0), a2, voffA);
            PG8_BAR; PG8_WAIT_L(0); PG8_MMA(1, 0, At, B0); PG8_BAR; PG8_SCHED;
            PG8_STAGE(PG8_SB(0, 1), b2 + hstep, voffB);
            PG8_WAIT_V(6); PG8_BAR; PG8_MMA(1, 1, At, B1); PG8_BAR;
            PG8_LDB(B0, 1, 0); PG8_SCHED; PG8_LDA(At, 1, 0); PG8_STAGE(PG8_SA(0, 1), a2 + hstep, voffA);
            PG8_WAIT_L(8); PG8_BAR; PG8_WAIT_L(0); PG8_MMA(0, 0, At, B0); PG8_BAR; PG8_SCHED;
            PG8_LDB(B1, 1, 1); PG8_STAGE(PG8_SB(1, 0), b3, voffB);
            PG8_BAR; PG8_WAIT_L(0); PG8_MMA(0, 1, At, B1); PG8_BAR;
            PG8_LDA(At, 1, 1); PG8_STAGE(PG8_SA(1, 0), a3, voffA);
            PG8_BAR; PG8_WAIT_L(0); PG8_MMA(1, 0, At, B0); PG8_BAR; PG8_SCHED;
            PG8_STAGE(PG8_SB(1, 1), b3 + hstep, voffB);
            PG8_WAIT_V(6); PG8_BAR; PG8_MMA(1, 1, At, B1); PG8_BAR;
            }
        }
        if constexpr (ALIGN_EPI) { if (wr == 0) PG8_BAR; }
        if constexpr (!Epi::AFTER_DRAIN) { E(acc, cur, wr, wc, fr, fq); S.done(cur); }
        if (!has_next) break;
#pragma unroll
        for (int a = 0; a < 2; ++a)
#pragma unroll
            for (int b = 0; b < 2; ++b)
#pragma unroll
                for (int m = 0; m < 4; ++m)
#pragma unroll
                    for (int n = 0; n < 2; ++n) acc[a][b][m][n] = (f32x4){0.f, 0.f, 0.f, 0.f};
        cur = nxt; cA = nA; cB = nB; ++ui;
        if constexpr (ALIGN_EPI) { if (wr == 1) PG8_BAR; }
    }
    PG8_WAIT_V(0);
    if constexpr (!ALIGN_EPI) { if (wr == 0) PG8_BAR; }
    PG8_BAR;
    if constexpr (Epi::AFTER_DRAIN) { E.fused(acc, cur, wr, wc, fr, fq, lds, wid, lane); S.done(cur); }
#undef PG8_SA
#undef PG8_SB
#undef PG8_STAGE
#undef PG8_LDA
#undef PG8_LDB
#undef PG8_MMA
#undef PG8_WAIT_V
#undef PG8_WAIT_L
#undef PG8_BAR
#undef PG8_SCHED
}
}
#define LAS __attribute__((address_space(3)))
#define XB_TMO      128
#define XB_XCNT(j)  (256  + 64 * (j))
#define XB_XSUB(j)  (1280 + 64 * (j))
#define XB_XGEN(j)  (2304 + 64 * (j))
#define XB_TOP      3328
#define XB_TOPGEN   3392
#define XCD_BAR_WORDS 3456
#define XB_SPIN_CAP (1u << 18)

__device__ __forceinline__ unsigned xb_ld(unsigned* p)              { return __hip_atomic_load(p, __ATOMIC_RELAXED, __HIP_MEMORY_SCOPE_AGENT); }
__device__ __forceinline__ unsigned xb_add(unsigned* p, unsigned v) { return __hip_atomic_fetch_add(p, v, __ATOMIC_RELAXED, __HIP_MEMORY_SCOPE_AGENT); }
__device__ __forceinline__ unsigned xb_xcc_id() { return (unsigned)__builtin_amdgcn_s_getreg((3 << 11) | 20) & 0xFu; }
#define XB_SPIN(cond, bar) do { unsigned _sp = 0; while (cond) { __builtin_amdgcn_s_sleep(1); \
    if ((++_sp & 255u) == 0u) { if (xb_ld(&(bar)[XB_TMO])) break; if (_sp > XB_SPIN_CAP) { atomicAdd(&(bar)[XB_TMO], 1u); break; } } } } while (0)

struct XcdBarrier {
    unsigned* bar; unsigned x;
    volatile LAS unsigned* st;
};

__device__ __forceinline__ XcdBarrier xcd_barrier_post(unsigned* bar, volatile LAS unsigned* st) {
    XcdBarrier b; b.bar = bar; b.x = xb_xcc_id(); b.st = st;
    if (threadIdx.x == 0) (void)xb_add(&bar[XB_XCNT(b.x)], 1u);
    return b;
}
__device__ __forceinline__ void xcd_barrier_complete(unsigned* bar, unsigned x, unsigned& nloc, unsigned& nx) {
    const unsigned G = gridDim.x * gridDim.y * gridDim.z;
    unsigned sum, cnt, mine, sp = 0u;
    for (;;) {
        sum = 0u; cnt = 0u; mine = 0u;
#pragma unroll
        for (unsigned j = 0; j < 16; ++j) { const unsigned c = xb_ld(&bar[XB_XCNT(j)]); sum += c; cnt += (c > 0u) ? 1u : 0u; mine = (j == x) ? c : mine; }
        if (sum == G) break;
        __builtin_amdgcn_s_sleep(1);
        if ((++sp & 255u) == 0u) { if (xb_ld(&bar[XB_TMO])) break; if (sp > XB_SPIN_CAP) { atomicAdd(&bar[XB_TMO], 1u); break; } }
    }
    nloc = mine > 0u ? mine : 1u; nx = cnt > 0u ? cnt : 1u;
}

__device__ __forceinline__ void xcd_barrier(const XcdBarrier& b) {
    asm volatile("s_waitcnt vmcnt(0)" ::: "memory");
    __syncthreads();
    if (threadIdx.x == 0) {
        unsigned* bar = b.bar;
        __builtin_amdgcn_s_waitcnt(0);
        unsigned nloc = b.st[0], nx = b.st[1];
        if (nloc == 0u) { xcd_barrier_complete(bar, b.x, nloc, nx); b.st[0] = nloc; b.st[1] = nx; }
        const unsigned old = xb_add(&bar[XB_XSUB(b.x)], 1u);
        const unsigned gen = old / nloc;
        if (old + 1u == (gen + 1u) * nloc) {
            __builtin_amdgcn_fence(__ATOMIC_RELEASE, "agent");
            asm volatile("s_waitcnt vmcnt(0)" ::: "memory");
            const unsigned og = xb_add(&bar[XB_TOP], 1u);
            const unsigned tg = og / nx;
            if (og + 1u == (tg + 1u) * nx) xb_add(&bar[XB_TOPGEN], 1u);
            else XB_SPIN(xb_ld(&bar[XB_TOPGEN]) == tg, bar);
            __builtin_amdgcn_fence(__ATOMIC_ACQUIRE, "agent");
            xb_add(&bar[XB_XGEN(b.x)], 1u);
            asm volatile("s_waitcnt vmcnt(0)" ::: "memory");
        } else {
            XB_SPIN(xb_ld(&bar[XB_XGEN(b.x)]) == gen, bar);
            __builtin_amdgcn_fence(__ATOMIC_ACQUIRE, "agent");
            asm volatile("s_waitcnt vmcnt(0)" ::: "memory");
        }
    }
    __syncthreads();
}

constexpr int DM = 1024, SEQ = 8192, MP = 16384, MS = 128, MR = MP + MS, RT = 16640;
constexpr int DFF = 2816, DV = 3072, NGA = 8, CGW = 384, NQG = 1280, NKVP = 1536;
constexpr int NMOD = 40960;
constexpr int MODKV = 36864, MODFIN = 38912;
constexpr int NPAGES = 16, PAST = 2048;
constexpr float LOG2E = 1.4426950408889634f;
#ifndef ONE_LAUNCH
#define ONE_LAUNCH 1
#endif

constexpr size_t OY_P = 0, OY_S = 16777216, OKV_P = 16908288, OKV_S = 33685504, OWIN_P = 33816576, OWIN_S = 34340864, OGV = 67895296, OUT_TOTAL = 68681728;

constexpr size_t al(size_t x) { return (x + 0xFFFFFull) & ~0xFFFFFull; }
constexpr size_t WS_CTL = 0, CTL_ZERO_BYTES = 2u << 20;
constexpr size_t WS_WMOD = al(CTL_ZERO_BYTES);
constexpr size_t WS_WGU = al(WS_WMOD + (size_t)NMOD * DM * 2);
constexpr size_t WS_WDN = al(WS_WGU + (size_t)8 * 5632 * DM * 2);
constexpr size_t WS_WUV = al(WS_WDN + (size_t)8 * DM * DFF * 2);
constexpr size_t WS_WOUT = al(WS_WUV + (size_t)2 * 6144 * DM * 2);
constexpr size_t WS_WQG = al(WS_WOUT + (size_t)2 * DM * DV * 2);
constexpr size_t WS_WO = al(WS_WQG + (size_t)2 * NQG * DM * 2);
constexpr size_t WS_WKV = al(WS_WO + (size_t)2 * DM * DM * 2);
constexpr size_t WS_WC1 = al(WS_WKV + (size_t)NKVP * DM * 2);
constexpr size_t WS_WC2 = al(WS_WC1 + (size_t)2 * 512 * 1024 * 2);
constexpr size_t WS_WSP = al(WS_WC2 + (size_t)2 * 64 * 256 * 2);
constexpr size_t WS_CBIAS = al(WS_WSP + (size_t)2 * 8 * 128 * 128 * 2);
constexpr size_t WS_X = al(WS_CBIAS + 4096);
constexpr size_t WS_H = al(WS_X + (size_t)RT * DM * 2);
constexpr size_t WS_HID = al(WS_H + (size_t)RT * DM * 2);
constexpr size_t WS_Z = al(WS_HID + (size_t)RT * DFF * 2);
constexpr size_t WS_VT = al(WS_Z + (size_t)RT * 6144 * 2);
constexpr size_t WS_P = al(WS_VT + (size_t)128 * DV * 128 * 2);
constexpr size_t WS_Q = al(WS_P + (size_t)RT * DV * 2);
constexpr size_t WS_GATES = al(WS_Q + (size_t)RT * DM * 2);
constexpr size_t WS_O = al(WS_GATES + (size_t)RT * 48 * 4);
constexpr size_t KVB = (size_t)8 * SEQ * 64 * 2;
constexpr size_t WS_KCIN = al(WS_O + (size_t)RT * DM * 2);
constexpr size_t WS_VCIN = WS_KCIN + KVB, WS_SK = WS_VCIN + KVB, WS_SVT = WS_SK + KVB, WS_WK = WS_SVT + KVB, WS_WVT = WS_WK + KVB;
constexpr size_t WS_MOD = al(WS_WVT + KVB);
constexpr size_t WS_SC = al(WS_MOD + (size_t)256 * NMOD * 4);
constexpr size_t WS_TK = al(WS_SC + (size_t)256 * DM * 2);
constexpr size_t WS_TV = al(WS_TK + (size_t)4096 * 512 * 2);
constexpr size_t WS_KC = al(WS_TV + (size_t)4096 * 512 * 2);
constexpr size_t WS_VCT = al(WS_KC + (size_t)8 * 512 * 64 * 2);
constexpr size_t WS_ACMP = al(WS_VCT + (size_t)8 * 64 * 512 * 2);
constexpr size_t WS_TS = al(WS_ACMP + (size_t)2 * 65536 * 1024 * 2);
constexpr size_t WS_KCS = al(WS_TS + (size_t)2 * 65536 * 512 * 2);
constexpr size_t WS_VCS = al(WS_KCS + (size_t)512 * 128 * 64 * 4);
constexpr size_t WS_OACC = al(WS_VCS + (size_t)512 * 128 * 64 * 4);
constexpr size_t WS_HKV = al(WS_OACC + (size_t)MP * DM * 4);
constexpr size_t WS_SHB = al(WS_HKV + (size_t)RT * DM * 2);
constexpr size_t WS_B2 = al(WS_SHB + (size_t)13 * 256 * 1024 * 2);
constexpr size_t WS_NG = al(WS_B2 + (size_t)13 * 256 * 6144 * 4);
constexpr size_t WS_SSP = al(WS_NG + (size_t)13 * 1024 * 4);
constexpr size_t WS_SSPS = al(WS_SSP + (size_t)11 * MP * 16 * 4);
constexpr size_t WS_END = al(WS_SSPS + (size_t)11 * MS * 32 * 4);

constexpr int CW_BAR = 4096, CW_QUEUE = 8192, CW_SS = 32768, CW_VS = CW_SS + 11 * 16640;
static_assert((size_t)(CW_VS + 2 * 16640 * 2) * 4 <= CTL_ZERO_BYTES, "SS / VS accumulators inside the memset region");

constexpr int RING_BYTES = 131072, LDSCTL_OFF = RING_BYTES, MISC_OFF = LDSCTL_OFF + 320, LDS_BYTES = 147456;
constexpr int NWAVES = 8;

#define GAS __attribute__((address_space(1)))
typedef unsigned short bf16;
typedef unsigned v4u __attribute__((ext_vector_type(4)));
typedef unsigned v2u __attribute__((ext_vector_type(2)));
typedef float f32x4 __attribute__((ext_vector_type(4)));
typedef short bf16x8 __attribute__((ext_vector_type(8)));
typedef short bf16x4 __attribute__((ext_vector_type(4)));
typedef float f32x2 __attribute__((ext_vector_type(2)));
typedef _Float16 f16x4 __attribute__((ext_vector_type(4)));
typedef _Float16 f16x8 __attribute__((ext_vector_type(8)));
typedef _Float16 f16;

__device__ __forceinline__ float bf2f(unsigned b) { return __uint_as_float(b << 16); }
__device__ __forceinline__ float bflo(unsigned w) { return __uint_as_float(w << 16); }
__device__ __forceinline__ float bfhi(unsigned w) { return __uint_as_float(w & 0xffff0000u); }
__device__ __forceinline__ unsigned pk2(float lo, float hi) { return pg8::cvt_pk_bf16(lo, hi); }
__device__ __forceinline__ float frcp(float x) { return __builtin_amdgcn_rcpf(x); }
__device__ __forceinline__ float fexp2(float x) { return __builtin_amdgcn_exp2f(x); }
__device__ __forceinline__ float sigmoid_f(float x) { return frcp(1.f + fexp2(-LOG2E * x)); }
__device__ __forceinline__ float silu_f(float x) { return x * sigmoid_f(x); }
__device__ __forceinline__ float gelu_tanh_f(float x) { const float u = x + 0.044715f * x * x * x; return x * frcp(1.f + fexp2(-2.302208198f * u)); }
__device__ __forceinline__ int row_b(int r) { return r < SEQ ? 0 : (r < MP ? 1 : 2 + ((r - MP) < MS ? (r - MP) : (MS - 1))); }
template <int CTRL> __device__ __forceinline__ float dppf(float x) { return __builtin_bit_cast(float, __builtin_amdgcn_mov_dpp(__builtin_bit_cast(int, x), CTRL, 0xF, 0xF, true)); }
template <int CTRL> __device__ __forceinline__ unsigned dppu(unsigned x) { return (unsigned)__builtin_amdgcn_mov_dpp((int)x, CTRL, 0xF, 0xF, true); }
#define DPP_X1 0xB1
#define DPP_X2 0x4E
#define DPP_HM 0x141
#define DPP_RM 0x140
#define DPP_X8 0x128
__device__ __forceinline__ void xpair16(float x, float& a, float& b) { auto r = __builtin_amdgcn_permlane16_swap(__float_as_uint(x), __float_as_uint(x), false, false); a = __uint_as_float(r[0]); b = __uint_as_float(r[1]); }
__device__ __forceinline__ void xpair32(float x, float& a, float& b) { auto r = __builtin_amdgcn_permlane32_swap(__float_as_uint(x), __float_as_uint(x), false, false); a = __uint_as_float(r[0]); b = __uint_as_float(r[1]); }
__device__ __forceinline__ void xpair16i(int x, int& a, int& b) { auto r = __builtin_amdgcn_permlane16_swap((unsigned)x, (unsigned)x, false, false); a = (int)r[0]; b = (int)r[1]; }
__device__ __forceinline__ void xpair32i(int x, int& a, int& b) { auto r = __builtin_amdgcn_permlane32_swap((unsigned)x, (unsigned)x, false, false); a = (int)r[0]; b = (int)r[1]; }
__device__ __forceinline__ float xsum_16_32(float x) { float a, b; xpair16(x, a, b); x = a + b; xpair32(x, a, b); return a + b; }
__device__ __forceinline__ float xmax_16_32(float x) { float a, b; xpair16(x, a, b); x = fmaxf(a, b); xpair32(x, a, b); return fmaxf(a, b); }
__device__ __forceinline__ float wave_sum(float v) { v += dppf<DPP_X1>(v); v += dppf<DPP_X2>(v); v += dppf<DPP_HM>(v); v += dppf<DPP_RM>(v); return xsum_16_32(v); }
__device__ __forceinline__ v4u pack8(const f32x4 a, const f32x4 b) { v4u w; w.x = pk2(a[0], a[1]); w.y = pk2(a[2], a[3]); w.z = pk2(b[0], b[1]); w.w = pk2(b[2], b[3]); return w; }
__device__ __forceinline__ void unpack8(const v4u w, float (&f)[8]) { f[0] = bflo(w.x); f[1] = bfhi(w.x); f[2] = bflo(w.y); f[3] = bfhi(w.y); f[4] = bflo(w.z); f[5] = bfhi(w.z); f[6] = bflo(w.w); f[7] = bfhi(w.w); }

template <class F> struct Epi8 {
    static constexpr bool PERM = true, AFTER_DRAIN = false; F f;
    __device__ __forceinline__ void operator()(const pg8::f32x4 (&acc)[2][2][4][2], const pg8::Unit& u, int wr, int wc, int fr, int fq) const {
        const int row0 = u.pm * pg8::BM + wr * 64 + fr, col0 = u.pn * pg8::BM + wc * 32 + 8 * fq;
        typename F::Pre pre; f.prep(pre, row0, col0, false);
#pragma unroll
        for (int ai = 0; ai < 2; ++ai)
#pragma unroll
            for (int mh = 0; mh < 2; ++mh) {
                typename F::Ld ld[2][2];
#pragma unroll
                for (int m2 = 0; m2 < 2; ++m2)
#pragma unroll
                    for (int bj = 0; bj < 2; ++bj) f.fetch(ld[m2][bj], row0 + ai * pg8::HALF + (2 * mh + m2) * 16, col0 + bj * pg8::HALF);
#pragma unroll
                for (int m2 = 0; m2 < 2; ++m2) { const int m = 2 * mh + m2, row = row0 + ai * pg8::HALF + m * 16;
                    f32x2 part = (f32x2){0.f, 0.f};
#pragma unroll
                    for (int bj = 0; bj < 2; ++bj) part = part + f(pre, ld[m2][bj], ai * 4 + m, bj, row, col0 + bj * pg8::HALF, acc[ai][bj][m][0], acc[ai][bj][m][1]);
                    f.row_done(row, part, fq); }
            }
    }
};
struct NoLd {};
struct NoPre {};
struct NormPre { float rs[8]; f32x4 b[2][2]; };
struct NormIn { unsigned char* ws; int ssi, inst, on;
    __device__ __forceinline__ void prep(NormPre& p, int row0, int col0, bool skinny) const {
        if (!on) return;
        const float* SS = (const float*)(ws + WS_CTL) + CW_SS + (size_t)ssi * RT; const float* b = (const float*)(ws + WS_B2) + ((size_t)inst * 256 + row_b(row0)) * 6144 + col0;
        if (skinny) { p.rs[0] = SS[row0]; p.b[0][0] = *(const f32x4*)b; p.b[0][1] = *(const f32x4*)(b + 4); p.rs[0] = __builtin_amdgcn_rsqf(p.rs[0] * (1.0f / DM) + 1e-6f); }
        else {
#pragma unroll
            for (int i = 0; i < 8; ++i) p.rs[i] = SS[row0 + (i >> 2) * 128 + (i & 3) * 16];
#pragma unroll
            for (int bj = 0; bj < 2; ++bj) { p.b[bj][0] = *(const f32x4*)(b + 128 * bj); p.b[bj][1] = *(const f32x4*)(b + 128 * bj + 4); }
#pragma unroll
            for (int i = 0; i < 8; ++i) p.rs[i] = __builtin_amdgcn_rsqf(p.rs[i] * (1.0f / DM) + 1e-6f);
        }
    }
    __device__ __forceinline__ void apply(const NormPre& p, int ri, int bj, f32x4& v0, f32x4& v1) const { if (on) { v0 = v0 * p.rs[ri] + p.b[bj][0]; v1 = v1 * p.rs[ri] + p.b[bj][1]; } }
};
struct FSwiglu {
    typedef NormPre Pre; typedef NoLd Ld; __device__ __forceinline__ void fetch(Ld&, int, int) const {} bf16* HID; NormIn ni;
    __device__ __forceinline__ void prep(Pre& p, int row0, int col0, bool sk) const { ni.prep(p, row0, col0, sk); }
    __device__ __forceinline__ f32x2 operator()(const Pre& p, const Ld&, int ri, int bj, int row, int col0, f32x4 g, f32x4 u) const {
        ni.apply(p, ri, bj, g, u);
        v2u w; w.x = pk2(silu_f(g[0]) * u[0], silu_f(g[1]) * u[1]); w.y = pk2(silu_f(g[2]) * u[2], silu_f(g[3]) * u[3]);
        *(v2u*)(HID + (size_t)row * DFF + (col0 >> 1)) = w; return (f32x2){0.f, 0.f};
    }
    __device__ __forceinline__ void row_done(int, f32x2, int) const {}
};
struct ResidPre { f32x4 gate[2][2], hm[2][2]; };
struct FResid {
    typedef ResidPre Pre; struct Ld { f32x4 x0, x1; };
    unsigned char* ws; int gcol; float coef; int n1, sc1, n2, sc2, ssi;
    __device__ __forceinline__ void fetch(Ld& d, int row, int col0) const { const f16x8 h = *(const f16x8*)((const f16*)(ws + WS_X) + (size_t)row * DM + col0); const f16x4 lo = __builtin_shufflevector(h, h, 0, 1, 2, 3), hi = __builtin_shufflevector(h, h, 4, 5, 6, 7);
        d.x0 = __builtin_convertvector(lo, f32x4); d.x1 = __builtin_convertvector(hi, f32x4); }
    __device__ __forceinline__ void prep(Pre& p, int row0, int col0, bool skinny) const {
        const float* mrow = (const float*)(ws + WS_MOD) + (size_t)row_b(row0) * NMOD + col0;
#pragma unroll
        for (int bj = 0; bj < 2; ++bj) { if (skinny && bj) break;
            p.gate[bj][0] = *(const f32x4*)(mrow + gcol + 128 * bj) * coef; p.gate[bj][1] = *(const f32x4*)(mrow + gcol + 128 * bj + 4) * coef;
            if (n1 >= 0) { const float* g1 = (const float*)(ws + WS_NG) + n1 * DM + col0 + 128 * bj;
                p.hm[bj][0] = *(const f32x4*)g1 * (*(const f32x4*)(mrow + sc1 + 128 * bj) + 1.0f); p.hm[bj][1] = *(const f32x4*)(g1 + 4) * (*(const f32x4*)(mrow + sc1 + 128 * bj + 4) + 1.0f); } }
    }
    __device__ __forceinline__ f32x2 operator()(const Pre& p, const Ld& d, int ri, int bj, int row, int col0, f32x4 v0, f32x4 v1) const {
        const f32x4 x0 = d.x0 + p.gate[bj][0] * v0, x1 = d.x1 + p.gate[bj][1] * v1;
        { const f16x4 lo = __builtin_convertvector(x0, f16x4), hi = __builtin_convertvector(x1, f16x4); *(f16x8*)((f16*)(ws + WS_X) + (size_t)row * DM + col0) = __builtin_shufflevector(lo, hi, 0, 1, 2, 3, 4, 5, 6, 7); }
        if (n1 >= 0) *(v4u*)((bf16*)(ws + WS_H) + (size_t)row * DM + col0) = pack8(x0 * p.hm[bj][0], x1 * p.hm[bj][1]);
        if (n2 >= 0) { const float* mrow = (const float*)(ws + WS_MOD) + (size_t)row_b(row) * NMOD + col0; const float* g2 = (const float*)(ws + WS_NG) + n2 * DM + col0;
            const f32x4 a0 = *(const f32x4*)g2, a1 = *(const f32x4*)(g2 + 4), s0 = *(const f32x4*)(mrow + sc2), s1 = *(const f32x4*)(mrow + sc2 + 4);
            *(v4u*)((bf16*)(ws + WS_HKV) + (size_t)row * DM + col0) = pack8(x0 * a0 * (s0 + 1.0f), x1 * a1 * (s1 + 1.0f)); }
        return (f32x2){((x0[0] * x0[0] + x0[1] * x0[1]) + (x0[2] * x0[2] + x0[3] * x0[3])) + ((x1[0] * x1[0] + x1[1] * x1[1]) + (x1[2] * x1[2] + x1[3] * x1[3])), 0.f};
    }
    __device__ __forceinline__ void row_done(int row, f32x2 part2, int fq) const {
        float part = part2[0];
        if (ssi >= 0) { part = xsum_16_32(part); if (fq == 0) atomicAdd((float*)(ws + WS_CTL) + CW_SS + (size_t)ssi * RT + row, part); }
    }
};
struct FGelu {
    typedef NormPre Pre; typedef NoLd Ld; __device__ __forceinline__ void fetch(Ld&, int, int) const {} bf16* Z; NormIn ni; float* VS;
    __device__ __forceinline__ void prep(Pre& p, int row0, int col0, bool sk) const { ni.prep(p, row0, col0, sk); }
    __device__ __forceinline__ f32x2 operator()(const Pre& p, const Ld&, int ri, int bj, int row, int col0, f32x4 v0, f32x4 v1) const {
        ni.apply(p, ri, bj, v0, v1);
        f32x4 a, b;
#pragma unroll
        for (int i = 0; i < 4; ++i) { a[i] = gelu_tanh_f(v0[i]); b[i] = gelu_tanh_f(v1[i]); }
        *(v4u*)(Z + (size_t)row * 6144 + col0) = pack8(a, b);
        if (col0 < DV) return (f32x2){0.f, 0.f};
        const f32x4 s = a + b, q = a * a + b * b; return (f32x2){(s[0] + s[1]) + (s[2] + s[3]), (q[0] + q[1]) + (q[2] + q[3])};
    }
    __device__ __forceinline__ void row_done(int row, f32x2 part, int fq) const {
        float s = part[0], q = part[1];
        s = xsum_16_32(s); q = xsum_16_32(q);
        if (fq == 0 && q != 0.f) { atomicAdd(VS + 2 * (size_t)row, s); atomicAdd(VS + 2 * (size_t)row + 1, q); }
    }
};
struct FQg {
    typedef NormPre Pre; typedef NoLd Ld; __device__ __forceinline__ void fetch(Ld&, int, int) const {} bf16* Q; float* GATES; NormIn ni;
    __device__ __forceinline__ void prep(Pre& p, int row0, int col0, bool sk) const { ni.prep(p, row0, col0, sk); }
    __device__ __forceinline__ f32x2 operator()(const Pre& p, const Ld&, int ri, int bj, int row, int col0, f32x4 v0, f32x4 v1) const {
        ni.apply(p, ri, bj, v0, v1);
        if (col0 < DM) { *(v4u*)(Q + (size_t)row * DM + col0) = pack8(v0 * (0.125f * LOG2E), v1 * (0.125f * LOG2E)); }
        else if (col0 < DM + 48) { f32x4 a, b;
#pragma unroll
            for (int i = 0; i < 4; ++i) { a[i] = sigmoid_f(v0[i]); b[i] = sigmoid_f(v1[i]); }
            float* gp = GATES + (size_t)row * 48 + (col0 - DM); *(f32x4*)gp = a; *(f32x4*)(gp + 4) = b; }
        return (f32x2){0.f, 0.f};
    }
    __device__ __forceinline__ void row_done(int, f32x2, int) const {}
};
struct FKv {
    typedef NormPre Pre; typedef NoLd Ld; __device__ __forceinline__ void fetch(Ld&, int, int) const {} float* out; bf16 *KCIN; NormIn ni;
    __device__ __forceinline__ void prep(Pre& p, int row0, int col0, bool sk) const { ni.prep(p, row0, col0, sk); }
    __device__ __forceinline__ f32x2 operator()(const Pre& p, const Ld&, int ri, int bj, int row, int col0, f32x4 v0, f32x4 v1) const {
        ni.apply(p, ri, bj, v0, v1);
        const int slot = col0 >> 8, g = (col0 >> 6) & 3, d0 = col0 & 63;
        if (row < MP) {
            const int b = row >> 13, t = row & (SEQ - 1);
            if (slot < 4) { float* q = out + OKV_P + (size_t)row * DM + col0; *(f32x4*)q = v0; *(f32x4*)(q + 4) = v1; }
            else if (t >= SEQ - 512) { float* q = out + OWIN_P + ((size_t)(b * 512 + (t - (SEQ - 512))) * 2 + (slot - 4)) * 256 + g * 64 + d0; *(f32x4*)q = v0; *(f32x4*)(q + 4) = v1; }
            const int bg = b * 4 + g;
            if (slot == 3 || slot == 5) {
                bf16* base = KCIN + (size_t)slot * (KVB / 2) + (((size_t)bg * (SEQ / 32) + (t >> 5)) * 64 + d0) * 32 + (t & 31);
#pragma unroll
                for (int i = 0; i < 4; ++i) { base[i * 32] = (bf16)(pk2(v0[i], 0.f) & 0xffffu); base[(i + 4) * 32] = (bf16)(pk2(v1[i], 0.f) & 0xffffu); }
            } else {
                bf16* base = KCIN + (size_t)slot * (KVB / 2) + ((size_t)bg * SEQ + t) * 64 + d0;
                *(v4u*)base = pack8(v0, v1);
            }
        } else {
            const int bs = row - MP;
            if (slot < 4) { float* q = out + OKV_S + (size_t)bs * DM + col0; *(f32x4*)q = v0; *(f32x4*)(q + 4) = v1; }
            else { float* q = out + OWIN_S + ((size_t)bs * 512 + 511) * 512 + (slot - 4) * 256 + g * 64 + d0; *(f32x4*)q = v0; *(f32x4*)(q + 4) = v1; }
        }
        return (f32x2){0.f, 0.f};
    }
    __device__ __forceinline__ void row_done(int, f32x2, int) const {}
};
constexpr int SH_NINST = 13;
struct FMod {
    typedef NoPre Pre; typedef NoLd Ld; __device__ __forceinline__ void fetch(Ld&, int, int) const {} float* MOD; const float *b0, *b1, *b2; bf16* SHB;
    __device__ __forceinline__ void prep(Pre&, int, int, bool) const {}
    __device__ __forceinline__ f32x2 operator()(const Pre&, const Ld&, int, int, int row, int col0, f32x4 v0, f32x4 v1) const {
        const float* bp = col0 < MODKV ? b0 + col0 : (col0 < MODFIN ? b1 + (col0 - MODKV) : b2 + (col0 - MODFIN));
        v0 = v0 + *(const f32x4*)bp; v1 = v1 + *(const f32x4*)(bp + 4);
        float* p = MOD + (size_t)row * NMOD + col0; *(f32x4*)p = v0; *(f32x4*)(p + 4) = v1;
        int inst = -1, k = 0;
        if (col0 < MODKV) { const int l = col0 / 9216, r = col0 - l * 9216, sub = r / 3072, rr = r - sub * 3072; if (rr < DM) { inst = l * 3 + sub; k = rr; } }
        else if (col0 < MODKV + DM) { inst = 12; k = col0 - MODKV; }
        if (inst >= 0) *(v4u*)(SHB + ((size_t)inst * 256 + row) * DM + k) = pack8(v0, v1);
        return (f32x2){0.f, 0.f};
    }
    __device__ __forceinline__ void row_done(int, f32x2, int) const {}
};
struct FBf16 {
    typedef NoPre Pre; typedef NoLd Ld; __device__ __forceinline__ void fetch(Ld&, int, int) const {} bf16* T; int ld;
    __device__ __forceinline__ void prep(Pre&, int, int, bool) const {}
    __device__ __forceinline__ f32x2 operator()(const Pre&, const Ld&, int, int, int row, int col0, f32x4 v0, f32x4 v1) const { *(v4u*)(T + (size_t)row * ld + col0) = pack8(v0, v1); return (f32x2){0.f, 0.f}; }
    __device__ __forceinline__ void row_done(int, f32x2, int) const {}
};
constexpr int TILEB = 256 * 1024 * 2;
constexpr int PN_UV = (int)((WS_WUV - WS_WGU) / TILEB), PN_QG = (int)((WS_WQG - WS_WGU) / TILEB), PN_KV = (int)((WS_WKV - WS_WGU) / TILEB);
static_assert((WS_WUV - WS_WGU) % TILEB == 0 && (WS_WQG - WS_WGU) % TILEB == 0 && (WS_WKV - WS_WGU) % TILEB == 0, "weight copies on 256-row tile boundaries");
struct ShiftOrder {
    int G, c;
    __device__ __forceinline__ bool next(int i, pg8::Unit& u) const {
        const int L = i * G + c; if (L >= 240) return false;
        if (L < 176) { const int f = L / 22, t = L - f * 22; u.pm = (f >> 1) * 3 + 2 * (f & 1); u.pn = f * 22 + t; }
        else if (L < 224) { const int q = L - 176, l = q / 24, t = q - l * 24; u.pm = l * 3 + 1; u.pn = PN_UV + l * 24 + t; }
        else if (L < 234) { const int q = L - 224, j = q / 5, t = q - j * 5; u.pm = (2 + j) * 3 + 1; u.pn = PN_QG + j * 5 + t; }
        else { u.pm = 12; u.pn = PN_KV + (L - 234); }
        return true;
    }
    __device__ __forceinline__ void a_ready(const pg8::Unit&) const {}
    __device__ __forceinline__ void done(const pg8::Unit&) const {}
};
struct FB2 {
    typedef NoPre Pre; typedef NoLd Ld; __device__ __forceinline__ void fetch(Ld&, int, int) const {} float* B2;
    __device__ __forceinline__ void prep(Pre&, int, int, bool) const {}
    __device__ __forceinline__ f32x2 operator()(const Pre&, const Ld&, int, int, int row, int col0, f32x4 v0, f32x4 v1) const {
        const int inst = row >> 8, b = row & 255, pn = col0 >> 8;
        int t;
        if (pn < 176) t = pn % 22; else if (pn < PN_QG) t = (pn - PN_UV) % 24; else if (pn < PN_KV) t = (pn - PN_QG) % 5; else t = pn - PN_KV;
        float* p = B2 + ((size_t)inst * 256 + b) * 6144 + t * 256 + (col0 & 255); *(f32x4*)p = v0; *(f32x4*)(p + 4) = v1; return (f32x2){0.f, 0.f};
    }
    __device__ __forceinline__ void row_done(int, f32x2, int) const {}
};

template <class F> __device__ __forceinline__ void run_gemm(LAS unsigned char* lds, const bf16* A, const bf16* Bt, int M, int N, int K, const F& f, int rot = 0) {
    int cblk = ((int)blockIdx.x + rot) % (int)gridDim.x; asm volatile("" : "+s"(cblk));
    pg8::Gemm g{A, Bt, M, N, K}; pg8::StaticOrder S; S.init(M, N, (int)gridDim.x, cblk);
    Epi8<F> E{f};
    pg8::gemm_phase<Epi8<F>, pg8::StaticOrder, true, true>(lds, g, S, E);
}

template <int RTU, int SB, class F> __device__ __forceinline__ void skinny_gemm(LAS unsigned char* lds, const bf16* A, const bf16* Bt, int ncol32, int K, int rem, const F& f) {
    int tid_raw = threadIdx.x; asm volatile("" : "+v"(tid_raw));
    const int lane = tid_raw & 63, wave = __builtin_amdgcn_readfirstlane(tid_raw >> 6), fr = lane & 15, fq = lane >> 4;
    constexpr int NR = 8 / RTU;
    const int kper = K >> 3, nsteps = kper >> 5, nunits = NR * ncol32;
    int cblk = (int)blockIdx.x; asm volatile("" : "+s"(cblk));
    const int nl = (int)gridDim.x - rem;
    LAS f32x4* red = (LAS f32x4*)lds;
    if (cblk < rem) return;
    for (int u = cblk - rem; u < nunits; u += nl) {
        const int n0 = 32 * (u / NR), r0 = MP + 16 * RTU * (u % NR);
        f32x4 acc[RTU][2];
#pragma unroll
        for (int rt = 0; rt < RTU; ++rt) { acc[rt][0] = (f32x4){0.f, 0.f, 0.f, 0.f}; acc[rt][1] = (f32x4){0.f, 0.f, 0.f, 0.f}; }
        const bf16* bp = Bt + (size_t)(n0 + 8 * (fr >> 2) + (fr & 3)) * K + wave * kper + 8 * fq;
        const bf16* ap = A + (size_t)(r0 + fr) * K + wave * kper + 8 * fq;
        const int row = r0 + 16 * (wave < RTU ? wave : 0) + fr;
        typename F::Pre pre; typename F::Ld ld;
        if (wave < RTU) { f.fetch(ld, row, n0 + 8 * fq); f.prep(pre, row, n0 + 8 * fq, true); }
#pragma unroll 1
        for (int ks0 = 0; ks0 < nsteps; ks0 += SB) {
            bf16x8 bb[SB][2], aa[SB][RTU];
#pragma unroll
            for (int s = 0; s < SB; ++s) { const int ks = (ks0 + s < nsteps) ? ks0 + s : nsteps - 1;
                bb[s][0] = *(const bf16x8*)(bp + 32 * ks); bb[s][1] = *(const bf16x8*)(bp + (size_t)4 * K + 32 * ks);
#pragma unroll
                for (int rt = 0; rt < RTU; ++rt) aa[s][rt] = *(const bf16x8*)(ap + (size_t)(16 * rt) * K + 32 * ks); }
#pragma unroll
            for (int s = 0; s < SB; ++s) if (ks0 + s < nsteps) {
#pragma unroll
                for (int rt = 0; rt < RTU; ++rt) { acc[rt][0] = __builtin_amdgcn_mfma_f32_16x16x32_bf16(bb[s][0], aa[s][rt], acc[rt][0], 0, 0, 0); acc[rt][1] = __builtin_amdgcn_mfma_f32_16x16x32_bf16(bb[s][1], aa[s][rt], acc[rt][1], 0, 0, 0); } }
        }
#pragma unroll
        for (int rt = 0; rt < RTU; ++rt) { red[((wave * RTU + rt) * 2 + 0) * 64 + lane] = acc[rt][0]; red[((wave * RTU + rt) * 2 + 1) * 64 + lane] = acc[rt][1]; }
        __syncthreads();
        if (wave < RTU) {
            f32x4 s0 = (f32x4){0.f, 0.f, 0.f, 0.f}, s1 = (f32x4){0.f, 0.f, 0.f, 0.f};
#pragma unroll
            for (int w2 = 0; w2 < 8; ++w2) { s0 = s0 + red[((w2 * RTU + wave) * 2 + 0) * 64 + lane]; s1 = s1 + red[((w2 * RTU + wave) * 2 + 1) * 64 + lane]; }
            const f32x2 part = f(pre, ld, 0, 0, row, n0 + 8 * fq, s0, s1); f.row_done(row, part, fq);
        }
        __syncthreads();
    }
}
template <class F> __device__ __forceinline__ void run_gemm2(LAS unsigned char* lds, const bf16* A, const bf16* Bt, int N, int Nreal, int K, const F& f, int rot = 0, int rem = -1) {
    run_gemm(lds, A, Bt, MP, N, K, f, rot);
    skinny_gemm<4, 6>(lds, A, Bt, (Nreal + 31) >> 5, K, rem >= 0 ? rem : ((MP / 256) * (N / 256)) % (int)gridDim.x, f);
}
template <class F> __device__ __forceinline__ void run_gemm2r(LAS unsigned char* lds, const bf16* A, const bf16* Bt, int K, const F& f) {
    run_gemm(lds, A, Bt, MP, DM, K, f, 0);
    skinny_gemm<1, 12>(lds, A, Bt, DM / 32, K, 0, f);
}

template <bool FINAL>
__device__ __forceinline__ void norm_phase(const f16* X, const float* gvec, const float* MOD, int shift_col, int scale_col, bf16* H, float* out, int gw, int NGW, int lane) {
    for (int r = gw; r < MR; r += NGW) {
        const f16x4* xr = (const f16x4*)(X + (size_t)r * DM) + lane;
        f32x4 v[4]; float ss = 0.f;
#pragma unroll
        for (int j = 0; j < 4; ++j) { v[j] = __builtin_convertvector(xr[64 * j], f32x4); ss += (v[j][0] * v[j][0] + v[j][1] * v[j][1]) + (v[j][2] * v[j][2] + v[j][3] * v[j][3]); }
        ss = wave_sum(ss);
        const float rstd = 1.0f / sqrtf(ss * (1.0f / DM) + 1e-6f);
        const float* mrow = MOD + (size_t)row_b(r) * NMOD;
#pragma unroll
        for (int j = 0; j < 4; ++j) { const int c = 4 * lane + 256 * j;
            const f32x4 gv = *(const f32x4*)(gvec + c), sh = *(const f32x4*)(mrow + shift_col + c), sc = *(const f32x4*)(mrow + scale_col + c);
            const f32x4 y = (v[j] * rstd) * gv * (sc + 1.0f) + sh;
            if (FINAL) { float* o = (r < MP) ? out + OY_P + (size_t)r * DM + c : out + OY_S + (size_t)(r - MP) * DM + c; *(f32x4*)o = y; }
            else { v2u w; w.x = pk2(y[0], y[1]); w.y = pk2(y[2], y[3]); *(v2u*)(H + (size_t)r * DM + c) = w; }
        }
    }
}

__device__ __forceinline__ void transpose_item(const float* W, int N, int ldw, bf16* WT, int ldt, int mode, int row_off, LAS float* scr, int item, int lane) {
    const int nblk = (N + 31) >> 5, kb = item / nblk, nb = item - kb * nblk, k0 = 64 * kb, n0 = 32 * nb;
    const int nn = n0 + (lane & 31); const bool okn = nn < N;
    float tv[32];
#pragma unroll
    for (int i = 0; i < 32; ++i) { const int kk = 2 * i + (lane >> 5); tv[i] = okn ? __builtin_nontemporal_load(W + (size_t)(k0 + kk) * ldw + nn) : 0.f; }
#pragma unroll
    for (int i = 0; i < 32; ++i) { const int kk = 2 * i + (lane >> 5); scr[kk * 33 + (lane & 31)] = tv[i]; }
    asm volatile("s_waitcnt lgkmcnt(0)" ::: "memory");
    const int c = lane & 7;
#pragma unroll
    for (int j = 0; j < 4; ++j) { const int n = (lane >> 3) + 8 * j; const LAS float* s = scr + (8 * c) * 33 + n;
        v4u o; o.x = pk2(s[0 * 33], s[1 * 33]); o.y = pk2(s[2 * 33], s[3 * 33]); o.z = pk2(s[4 * 33], s[5 * 33]); o.w = pk2(s[6 * 33], s[7 * 33]);
        const int ng = n0 + n;
        const int drow = mode == 0 ? row_off + ng : (8 * (ng >> 2) + (ng & 3) + (mode == 2 ? 4 : 0));
        if (ng < N) *(v4u*)(WT + (size_t)drow * ldt + k0 + 8 * c) = o; }
    asm volatile("s_waitcnt lgkmcnt(0)" ::: "memory");
}
struct TDesc { const float* src; int K, N, ldw; bf16* dst; int ldt, mode, row_off; };
struct Ptrs {
    const float *x_prompt, *x_sample, *cache_kv, *state_win; const int* page_table; const float *c_prompt, *c_sample, *ada_w, *ada_b, *norm_g, *w_gate, *w_up, *w_down,
        *w_uv, *ln_g, *ln_b, *w_sp, *b_sp, *w_out, *w_qg, *w_o, *kv_norm_g, *kv_ada_w, *kv_ada_b, *kv_w, *cmp_w1, *cmp_w2, *cmp_pe, *final_g, *final_ada_w, *final_ada_b;
    float* out; unsigned char* ws;
};
#define WSP(T, off) ((T*)(P.ws + (off)))
typedef const __attribute__((address_space(4))) unsigned long long* kptr_t;
__device__ __forceinline__ void load_ptrs(Ptrs& P) {
    kptr_t k = (kptr_t)__builtin_amdgcn_kernarg_segment_ptr();
    asm volatile("" : "+s"(k));
    P.x_prompt = (const float*)(GAS const float*)k[0]; P.x_sample = (const float*)(GAS const float*)k[1]; P.cache_kv = (const float*)(GAS const float*)k[2]; P.state_win = (const float*)(GAS const float*)k[3];
    P.page_table = (const int*)(GAS const int*)k[4]; P.c_prompt = (const float*)(GAS const float*)k[5]; P.c_sample = (const float*)(GAS const float*)k[6]; P.ada_w = (const float*)(GAS const float*)k[7];
    P.ada_b = (const float*)(GAS const float*)k[8]; P.norm_g = (const float*)(GAS const float*)k[9]; P.w_gate = (const float*)(GAS const float*)k[10]; P.w_up = (const float*)(GAS const float*)k[11];
    P.w_down = (const float*)(GAS const float*)k[12]; P.w_uv = (const float*)(GAS const float*)k[13]; P.ln_g = (const float*)(GAS const float*)k[14]; P.ln_b = (const float*)(GAS const float*)k[15];
    P.w_sp = (const float*)(GAS const float*)k[16]; P.b_sp = (const float*)(GAS const float*)k[17]; P.w_out = (const float*)(GAS const float*)k[18]; P.w_qg = (const float*)(GAS const float*)k[19];
    P.w_o = (const float*)(GAS const float*)k[20]; P.kv_norm_g = (const float*)(GAS const float*)k[21]; P.kv_ada_w = (const float*)(GAS const float*)k[22]; P.kv_ada_b = (const float*)(GAS const float*)k[23];
    P.kv_w = (const float*)(GAS const float*)k[24]; P.cmp_w1 = (const float*)(GAS const float*)k[25]; P.cmp_w2 = (const float*)(GAS const float*)k[26]; P.cmp_pe = (const float*)(GAS const float*)k[27];
    P.final_g = (const float*)(GAS const float*)k[28]; P.final_ada_w = (const float*)(GAS const float*)k[29]; P.final_ada_b = (const float*)(GAS const float*)k[30];
    P.out = (float*)(GAS float*)k[31]; P.ws = (unsigned char*)(GAS unsigned char*)k[32];
}
__device__ __forceinline__ void get_tdesc(const Ptrs& P, int id, TDesc& d) {
    d.mode = 0; d.row_off = 0; d.K = 1024; d.ldt = 1024;
    if (id < 4) { d.src = P.ada_w + (size_t)id * 1024 * 9216; d.N = 9216; d.dst = WSP(bf16, WS_WMOD); d.row_off = id * 9216; }
    else if (id == 4) { d.src = P.kv_ada_w; d.N = 2048; d.dst = WSP(bf16, WS_WMOD); d.row_off = MODKV; }
    else if (id == 5) { d.src = P.final_ada_w; d.N = 2048; d.dst = WSP(bf16, WS_WMOD); d.row_off = MODFIN; }
    else if (id < 14) { const int i = id - 6; d.src = P.w_gate + (size_t)i * 1024 * DFF; d.N = DFF; d.dst = WSP(bf16, WS_WGU) + (size_t)i * 5632 * 1024; d.mode = 1; }
    else if (id < 22) { const int i = id - 14; d.src = P.w_up + (size_t)i * 1024 * DFF; d.N = DFF; d.dst = WSP(bf16, WS_WGU) + (size_t)i * 5632 * 1024; d.mode = 2; }
    else if (id < 30) { const int i = id - 22; d.src = P.w_down + (size_t)i * DFF * 1024; d.K = DFF; d.N = 1024; d.dst = WSP(bf16, WS_WDN) + (size_t)i * 1024 * DFF; d.ldt = DFF; }
    else if (id < 32) { const int i = id - 30; d.src = P.w_uv + (size_t)i * 1024 * 6144; d.N = 6144; d.dst = WSP(bf16, WS_WUV) + (size_t)i * 6144 * 1024; }
    else if (id < 34) { const int i = id - 32; d.src = P.w_out + (size_t)i * DV * 1024; d.K = DV; d.N = 1024; d.dst = WSP(bf16, WS_WOUT) + (size_t)i * 1024 * DV; d.ldt = DV; }
    else if (id < 36) { const int i = id - 34; d.src = P.w_qg + (size_t)i * 1024 * 1072; d.N = 1072; d.dst = WSP(bf16, WS_WQG) + (size_t)i * NQG * 1024; }
    else if (id < 38) { const int i = id - 36; d.src = P.w_o + (size_t)i * 1024 * 1024; d.N = 1024; d.dst = WSP(bf16, WS_WO) + (size_t)i * 1024 * 1024; }
    else if (id == 38) { d.src = P.kv_w; d.N = NKVP; d.dst = WSP(bf16, WS_WKV); }
    else if (id < 43) { const int i = id - 39, kv = i >> 1, r = i & 1; d.src = P.cmp_w1 + (size_t)kv * 2048 * 256 + (size_t)r * 1024 * 256; d.N = 256; d.dst = WSP(bf16, WS_WC1) + (size_t)kv * 512 * 1024; d.row_off = r * 256; }
    else { const int kv = id - 43; d.src = P.cmp_w2 + (size_t)kv * 256 * 64; d.K = 256; d.N = 64; d.dst = WSP(bf16, WS_WC2) + (size_t)kv * 64 * 256; d.ldt = 256; }
    d.ldw = d.N;
}
constexpr int N_TMAT = 45;

__device__ __forceinline__ void prologue_phase(const Ptrs& P, LAS unsigned char* lds, int gw, int NGW, int wave, int lane, int tid) {
    if (blockIdx.x < 8) {
        const int kv = blockIdx.x >> 2, hb = blockIdx.x & 3; const float* pe = P.cmp_pe + kv * 2048; const float* w1 = P.cmp_w1 + (size_t)kv * 2048 * 256 + hb * 64 + lane;
        float acc = 0.f;
#pragma unroll 8
        for (int k = wave * 256; k < wave * 256 + 256; ++k) acc += pe[k] * w1[(size_t)k * 256];
        LAS float* red = (LAS float*)lds;
        red[wave * 64 + lane] = acc;
        __syncthreads();
        if (wave == 0) { float s = 0.f;
#pragma unroll
            for (int w = 0; w < 8; ++w) s += red[w * 64 + lane];
            WSP(float, WS_CBIAS)[kv * 256 + hb * 64 + lane] = s; }
        __syncthreads();
    }
    { LAS float* scr = (LAS float*)(lds + wave * 16384); int off = 0;
      for (int id = 0; id < N_TMAT; ++id) { TDesc d; get_tdesc(P, id, d);
          const int nitems = (d.K >> 6) * ((d.N + 31) >> 5);
          for (int it = (gw + NGW - (off % NGW)) % NGW; it < nitems; it += NGW) transpose_item(d.src, d.N, d.ldw, d.dst, d.ldt, d.mode, d.row_off, scr, it, lane);
          off += nitems; } }
    for (int r = gw; r < RT; r += NGW) { f16x4* xo = (f16x4*)(WSP(f16, WS_X) + (size_t)r * DM) + lane;
        const f32x4* xi = r < MP ? (const f32x4*)(P.x_prompt + (size_t)r * DM) + lane : (const f32x4*)(P.x_sample + (size_t)((r < MR ? r : MR - 1) - MP) * DM) + lane;
#pragma unroll
        for (int j = 0; j < 4; ++j) { f32x4 v = xi[64 * j]; if (r >= MR) v = (f32x4){0.f, 0.f, 0.f, 0.f}; xo[64 * j] = __builtin_convertvector(v, f16x4); } }
    for (int r = gw; r < 256; r += NGW) { const float* ci = r < 2 ? P.c_prompt + (size_t)r * DM : P.c_sample + (size_t)((r < 130 ? r : 129) - 2) * DM;
#pragma unroll
        for (int j = 0; j < 4; ++j) { const int c = 4 * lane + 256 * j; f32x4 v = *(const f32x4*)(ci + c); v2u w; w.x = pk2(silu_f(v[0]), silu_f(v[1])); w.y = pk2(silu_f(v[2]), silu_f(v[3])); if (r >= 130) { w.x = 0u; w.y = 0u; }
            *(v2u*)(WSP(bf16, WS_SC) + (size_t)r * DM + c) = w; } }
    for (int it0 = gw * 8; it0 < MS * PAST; it0 += NGW * 8) { const int bs = it0 >> 11, pos0 = it0 & (PAST - 1); const int page = P.page_table[bs * NPAGES + (pos0 >> 7)];
        const float* src = P.cache_kv + ((size_t)page * 128 + (pos0 & 127)) * 1024 + 8 * lane;
        f32x4 a[8], b[8];
#pragma unroll
        for (int q = 0; q < 8; ++q) { a[q] = __builtin_nontemporal_load((const f32x4*)(src + (size_t)q * 1024)); b[q] = __builtin_nontemporal_load((const f32x4*)(src + (size_t)q * 1024 + 4)); }
        const int slot = lane >> 5, g = (lane >> 3) & 3, d0 = (lane & 7) * 8;
        bf16* dst = WSP(bf16, WS_ACMP) + (size_t)slot * 65536 * 1024 + ((size_t)(bs * 4 + g) * 128 + (pos0 >> 4)) * 1024 + (pos0 & 15) * 64 + d0;
#pragma unroll
        for (int q = 0; q < 8; ++q) *(v4u*)(dst + q * 64) = pack8(a[q], b[q]); }
    for (int i = gw * 64 + lane; i < 13 * DM; i += NGW * 64) WSP(float, WS_NG)[i] = i < 12 * DM ? P.norm_g[i] : P.kv_norm_g[i - 12 * DM];
    for (int i = gw * 64 + lane; i < 2 * 8 * 128 * 128; i += NGW * 64) { const int t = (i >> 7) & 127, s = i & 127; WSP(bf16, WS_WSP)[i] = (bf16)(pk2(s <= t ? P.w_sp[i] : 0.f, 0.f) & 0xffffu); }
    for (int it = gw; it < MS * 64; it += NGW) { const int bs = it >> 6, j0 = (it & 63) * 8;
        const float* src = P.state_win + ((size_t)bs * 512 + j0 + 1) * 512 + 4 * lane; float* dst = P.out + OWIN_S + ((size_t)bs * 512 + j0) * 512 + 4 * lane;
        f32x4 v[16];
#pragma unroll
        for (int q = 0; q < 16; ++q) { const int j = j0 + (q >> 1); v[q] = (j < 511) ? __builtin_nontemporal_load((const f32x4*)(src + (size_t)(q >> 1) * 512 + (q & 1) * 256)) : (f32x4){0.f, 0.f, 0.f, 0.f}; }
#pragma unroll
        for (int q = 0; q < 16; ++q) { const int j = j0 + (q >> 1); if (j < 511) __builtin_nontemporal_store(v[q], (f32x4*)(dst + (size_t)(q >> 1) * 512 + (q & 1) * 256)); } }
}

template <int MODE>
__device__ __forceinline__ void cmp_finish_unit(const bf16* T, const float* cbias, const bf16* W2T, void* outp, int C, int bg, int rt, int lane) {
    const int fr = lane & 15, fq = lane >> 4, NB = C - 1, i0 = 16 * rt;
    const int ib = i0 + fr, ic = ib < NB ? ib : NB - 1;
    const bf16* ta = T + ((size_t)bg * C + ic) * 512 + 8 * fq; const bf16* tb = ta + 512 + 256;
    v4u ra[8], rb[8];
#pragma unroll
    for (int ks = 0; ks < 8; ++ks) { ra[ks] = *(const v4u*)(ta + 32 * ks); rb[ks] = *(const v4u*)(tb + 32 * ks); }
    asm volatile("" ::: "memory");
    bf16x8 hf[8];
#pragma unroll
    for (int ks = 0; ks < 8; ++ks) { float a[8], b[8]; unpack8(ra[ks], a); unpack8(rb[ks], b);
        const f32x4 c0 = *(const f32x4*)(cbias + 32 * ks + 8 * fq), c1 = *(const f32x4*)(cbias + 32 * ks + 8 * fq + 4);
        f32x4 h0, h1;
#pragma unroll
        for (int e = 0; e < 4; ++e) { h0[e] = gelu_tanh_f(c0[e] + a[e] + b[e]); h1[e] = gelu_tanh_f(c1[e] + a[e + 4] + b[e + 4]); }
        const v4u w = pack8(h0, h1); hf[ks] = __builtin_bit_cast(bf16x8, w); }
    f32x4 acc[4];
#pragma unroll
    for (int nt = 0; nt < 4; ++nt) { acc[nt] = (f32x4){0.f, 0.f, 0.f, 0.f};
        bf16x8 wf[8];
#pragma unroll
        for (int ks = 0; ks < 8; ++ks) wf[ks] = *(const bf16x8*)(W2T + (size_t)(16 * nt + fr) * 256 + 32 * ks + 8 * fq);
#pragma unroll
        for (int ks = 0; ks < 8; ++ks) {
            if (MODE == 1) acc[nt] = __builtin_amdgcn_mfma_f32_16x16x32_bf16(hf[ks], wf[ks], acc[nt], 0, 0, 0);
            else acc[nt] = __builtin_amdgcn_mfma_f32_16x16x32_bf16(wf[ks], hf[ks], acc[nt], 0, 0, 0); } }
#pragma unroll
    for (int nt = 0; nt < 4; ++nt) {
        if (MODE == 0) { f32x4 v = acc[nt]; if (ib >= NB) v = (f32x4){0.f, 0.f, 0.f, 0.f}; v2u w; w.x = pk2(v[0], v[1]); w.y = pk2(v[2], v[3]);
            *(v2u*)((bf16*)outp + ((size_t)bg * 512 + ib) * 64 + 16 * nt + 4 * fq) = w; }
        else if (MODE == 1) { f32x4 v = acc[nt];
#pragma unroll
            for (int e = 0; e < 4; ++e) if (i0 + 4 * fq + e >= NB) v[e] = 0.f;
            v2u w; w.x = pk2(v[0], v[1]); w.y = pk2(v[2], v[3]);
            *(v2u*)((bf16*)outp + (((size_t)bg * 16 + (i0 >> 5)) * 64 + 16 * nt + fr) * 32 + (i0 & 31) + 4 * fq) = w; }
        else { f32x4 v = acc[nt]; if (ib >= NB) v = (f32x4){0.f, 0.f, 0.f, 0.f};
            *(f32x4*)((float*)outp + ((size_t)bg * 128 + ib) * 64 + 16 * nt + 4 * fq) = v; }
    }
}

struct SpRegs { f32x4 st; v4u za[2], zb[2]; bf16x8 wf[4]; v4u uv[4]; float bt; };
__device__ __forceinline__ void sp_load(SpRegs& R, const Ptrs& P, int l, int u, int wave, int lane) {
    const bf16* Z = WSP(bf16, WS_Z); const bf16* WS = WSP(bf16, WS_WSP); const float* VS = WSP(float, WS_CTL) + CW_VS + (size_t)l * RT * 2;
    const int fr = lane & 15, fq = lane >> 4, nks = (wave >> 1) + 1, n = u / 24, cb = u - n * 24, g = cb / 3;
    R.st = *(const f32x4*)(VS + 2 * (n * 128 + 2 * lane));
#pragma unroll
    for (int q = 0; q < 2; ++q) { const int cc = cb * 128 + 8 * (wave + 8 * q); const bf16* z0 = Z + (size_t)(n * 128 + 2 * lane) * 6144 + DV + cc; R.za[q] = *(const v4u*)z0; R.zb[q] = *(const v4u*)(z0 + 6144); }
    const bf16* wp = WS + ((size_t)(l * 8 + g) * 128 + 16 * wave + fr) * 128 + 8 * fq;
#pragma unroll
    for (int ks = 0; ks < 4; ++ks) R.wf[ks] = *(const bf16x8*)(wp + 32 * (ks < nks ? ks : 0));
    const int t = 16 * wave + fr, row = n * 128 + t; R.bt = P.b_sp[(l * 8 + g) * 128 + t];
#pragma unroll
    for (int mm = 0; mm < 4; ++mm) R.uv[mm] = *(const v4u*)(Z + (size_t)row * 6144 + cb * 128 + 32 * mm + 8 * fq);
}
__device__ __forceinline__ void sp_compute(const SpRegs& R, const Ptrs& P, int l, int u, LAS unsigned* tile, int wave, int lane) {
    bf16* PO = WSP(bf16, WS_P); const float* lg = P.ln_g + l * DV; const float* lb = P.ln_b + l * DV;
    const int fr = lane & 15, fq = lane >> 4, nks = (wave >> 1) + 1, n = u / 24, cb = u - n * 24;
    const float m0 = R.st[0] * (1.0f / DV), m1 = R.st[2] * (1.0f / DV); float v0 = R.st[1] * (1.0f / DV) - m0 * m0, v1 = R.st[3] * (1.0f / DV) - m1 * m1; v0 = v0 > 0.f ? v0 : 0.f; v1 = v1 > 0.f ? v1 : 0.f;
    const float r0 = 1.0f / sqrtf(v0 + 1e-6f), r1 = 1.0f / sqrtf(v1 + 1e-6f);
#pragma unroll
    for (int q = 0; q < 2; ++q) { const int ccg = wave + 8 * q, cc = cb * 128 + 8 * ccg; float a[8], b[8]; unpack8(R.za[q], a); unpack8(R.zb[q], b);
        const f32x4 g0 = *(const f32x4*)(lg + cc), g1 = *(const f32x4*)(lg + cc + 4), b0 = *(const f32x4*)(lb + cc), b1 = *(const f32x4*)(lb + cc + 4);
#pragma unroll
        for (int e = 0; e < 8; ++e) { const float gg = e < 4 ? g0[e] : g1[e - 4], bb = e < 4 ? b0[e] : b1[e - 4];
            tile[(8 * ccg + e) * 68 + lane] = pk2((a[e] - m0) * r0 * gg + bb, (b[e] - m1) * r1 * gg + bb); } }
    __syncthreads();
    f32x4 acc[8];
#pragma unroll
    for (int j = 0; j < 8; ++j) acc[j] = (f32x4){0.f, 0.f, 0.f, 0.f};
    const LAS char* vp = (const LAS char*)tile + (8 * (fr >> 2) + (fr & 3)) * 272 + 16 * fq;
#pragma unroll
    for (int ks = 0; ks < 4; ++ks) if (ks < nks) {
#pragma unroll
        for (int j = 0; j < 8; ++j) { const bf16x8 vf = *(const LAS bf16x8*)(vp + (32 * (j >> 1) + 4 * (j & 1)) * 272 + 64 * ks);
            acc[j] = __builtin_amdgcn_mfma_f32_16x16x32_bf16(vf, R.wf[ks], acc[j], 0, 0, 0); }
    }
    const int row = n * 128 + 16 * wave + fr;
#pragma unroll
    for (int mm = 0; mm < 4; ++mm) { const int c = cb * 128 + 32 * mm + 8 * fq; float uu[8]; unpack8(R.uv[mm], uu);
        f32x4 p0, p1;
#pragma unroll
        for (int e = 0; e < 4; ++e) { p0[e] = uu[e] * (acc[2 * mm][e] + R.bt); p1[e] = uu[4 + e] * (acc[2 * mm + 1][e] + R.bt); }
        *(v4u*)(PO + (size_t)row * DV + c) = pack8(p0, p1); }
}
__device__ __forceinline__ void spatial2_phase(const Ptrs& P, int l, LAS unsigned char* lds, int wave, int lane, int tid, int gw, int NGW) {
    const bf16* Z = WSP(bf16, WS_Z);
    const float* VS = WSP(float, WS_CTL) + CW_VS + (size_t)l * RT * 2;
    const float* lg = P.ln_g + l * DV; const float* lb = P.ln_b + l * DV;
    { const int NU = 128 * 24, G_ = (int)gridDim.x; int u = (int)blockIdx.x;
      LAS unsigned* t0 = (LAS unsigned*)lds; LAS unsigned* t1 = (LAS unsigned*)(lds + 34816);
      SpRegs A, B;
      if (u < NU) sp_load(A, P, l, u, wave, lane);
      while (u < NU) {
          int un = u + G_; if (un < NU) sp_load(B, P, l, un, wave, lane);
          sp_compute(A, P, l, u, t0, wave, lane);
          u = un; if (u >= NU) break;
          un = u + G_; if (un < NU) sp_load(A, P, l, un, wave, lane);
          sp_compute(B, P, l, u, t1, wave, lane);
          u = un;
      } }
    __syncthreads();
    for (int bs = gw; bs < MS; bs += NGW) {
        const int row = MP + bs; const bf16* zr = Z + (size_t)row * 6144 + 8 * lane;
        const float mean = VS[2 * row] * (1.0f / DV); float var = VS[2 * row + 1] * (1.0f / DV) - mean * mean; var = var > 0.f ? var : 0.f; const float rstd = 1.0f / sqrtf(var + 1e-6f);
#pragma unroll
        for (int j = 0; j < 6; ++j) { const int c = 512 * j + 8 * lane, g = c / CGW;
            const float w00 = P.w_sp[(size_t)(l * 8 + g) * 128 * 128], b00 = P.b_sp[(l * 8 + g) * 128];
            const f32x4 g0 = *(const f32x4*)(lg + c), g1 = *(const f32x4*)(lg + c + 4), b0 = *(const f32x4*)(lb + c), b1 = *(const f32x4*)(lb + c + 4);
            float vv[8], uu[8]; unpack8(*(const v4u*)(zr + DV + 512 * j), vv); unpack8(*(const v4u*)(zr + 512 * j), uu);
            f32x4 o0, o1, p0, p1;
#pragma unroll
            for (int e = 0; e < 4; ++e) { o0[e] = (vv[e] - mean) * rstd * g0[e] + b0[e]; o1[e] = (vv[4 + e] - mean) * rstd * g1[e] + b1[e];
                p0[e] = uu[e] * (w00 * o0[e] + b00); p1[e] = uu[4 + e] * (w00 * o1[e] + b00); }
            float* gv = P.out + OGV + ((size_t)l * MS + bs) * DV + c; *(f32x4*)gv = o0; *(f32x4*)(gv + 4) = o1;
            *(v4u*)(WSP(bf16, WS_P) + (size_t)row * DV + c) = pack8(p0, p1); }
    }
}

#define NEG_INF (-__builtin_inff())
__device__ __forceinline__ bf16x8 ld_v2x8(const GAS bf16* p) {
    const bf16x4 lo = *(const GAS bf16x4*)p, hi = *(const GAS bf16x4*)(p + 16);
    return __builtin_shufflevector(lo, hi, 0, 1, 2, 3, 4, 5, 6, 7);
}
struct SampleAcc { float acc[4][8]; float m, l; };
__device__ __forceinline__ float sample_compute(const f32x4 k0, const f32x4 k1, const f32x4 v0, const f32x4 v1, bool valid, float dist, const float (&qv)[4][8], float slope2_own, int lane, SampleAcc& A) {
    const int j8 = lane & 7;
    float part[4];
#pragma unroll
    for (int h = 0; h < 4; ++h) { float a = (qv[h][0] * k0[0] + qv[h][1] * k0[1]) + (qv[h][2] * k0[2] + qv[h][3] * k0[3]) + (qv[h][4] * k1[0] + qv[h][5] * k1[1]) + (qv[h][6] * k1[2] + qv[h][7] * k1[3]);
        a += dppf<DPP_X1>(a); a += dppf<DPP_X2>(a); a += dppf<DPP_HM>(a); part[h] = a; }
    const int hown = j8 & 3;
    const float sown = hown == 0 ? part[0] : hown == 1 ? part[1] : hown == 2 ? part[2] : part[3];
    const float s2 = valid ? (sown - slope2_own * dist) : NEG_INF;
    float tm = fmaxf(s2, dppf<DPP_X8>(s2)); tm = xmax_16_32(tm);
    const float mnew = fmaxf(A.m, tm), msafe = (mnew == NEG_INF) ? 0.f : mnew, alpha = fexp2(A.m - msafe), p = fexp2(s2 - msafe);
    A.m = mnew; A.l = A.l * alpha + p;
    const float ph[4] = {dppf<0x00>(p), dppf<0x55>(p), dppf<0xAA>(p), dppf<0xFF>(p)}, ah[4] = {dppf<0x00>(alpha), dppf<0x55>(alpha), dppf<0xAA>(alpha), dppf<0xFF>(alpha)};
#pragma unroll
    for (int h = 0; h < 4; ++h)
#pragma unroll
        for (int e = 0; e < 4; ++e) { A.acc[h][e] = A.acc[h][e] * ah[h] + ph[h] * v0[e]; A.acc[h][4 + e] = A.acc[h][4 + e] * ah[h] + ph[h] * v1[e]; }
    return s2;
}
__device__ __forceinline__ float sample_step8(const float* krow, const float* vrow, bool valid, float dist, const float (&qv)[4][8], float slope2_own, int lane, SampleAcc& A) {
    const int j8 = lane & 7;
    const f32x4 k0 = *(const f32x4*)(krow + 8 * j8), k1 = *(const f32x4*)(krow + 8 * j8 + 4), v0 = *(const f32x4*)(vrow + 8 * j8), v1 = *(const f32x4*)(vrow + 8 * j8 + 4);
    return sample_compute(k0, k1, v0, v1, valid, dist, qv, slope2_own, lane, A);
}
__device__ __forceinline__ void sample_batch4(const float* kbase, const float* vbase, int rstride, int r0, int rlimit, int rclamp, float dist0, float ddist,
                                              const float (&qv)[4][8], float slope2_own, int lane, SampleAcc& A, LAS float* sraw) {
    const int j8 = lane & 7;
    f32x4 kk[4][2], vv[4][2];
#pragma unroll
    for (int s = 0; s < 4; ++s) { int r = r0 + 8 * s; r = r < rlimit ? r : rclamp; const float* kr = kbase + (size_t)r * rstride + 8 * j8; const float* vr = vbase + (size_t)r * rstride + 8 * j8;
        kk[s][0] = *(const f32x4*)kr; kk[s][1] = *(const f32x4*)(kr + 4); vv[s][0] = *(const f32x4*)vr; vv[s][1] = *(const f32x4*)(vr + 4); }
#pragma unroll
    for (int s = 0; s < 4; ++s) { const float s2 = sample_compute(kk[s][0], kk[s][1], vv[s][0], vv[s][1], r0 + 8 * s < rlimit, dist0 - ddist * (float)s, qv, slope2_own, lane, A);
        if (sraw) sraw[s * 64 + lane] = s2; }
}
__device__ __forceinline__ void sample_reset(SampleAcc& A) {
    A.m = NEG_INF; A.l = 0.f;
#pragma unroll
    for (int h = 0; h < 4; ++h)
#pragma unroll
        for (int i = 0; i < 8; ++i) A.acc[h][i] = 0.f;
}
__device__ __forceinline__ void sample_finish(SampleAcc& A, const float* gates_bg, int br, LAS float* wl, int lane, bool first) {
    float lt = A.l; lt += dppf<DPP_X8>(lt); lt = xsum_16_32(lt);
    float sc[4];
#pragma unroll
    for (int h = 0; h < 4; ++h) { const float lh = __shfl(lt, h); sc[h] = lh > 0.f ? gates_bg[h * 3 + br] / lh : 0.f; }
#pragma unroll
    for (int h = 0; h < 4; ++h)
#pragma unroll
        for (int i = 0; i < 8; ++i) { float a = A.acc[h][i]; a += dppf<DPP_X8>(a); a = xsum_16_32(a); A.acc[h][i] = a * sc[h]; }
    if (lane < 8) {
#pragma unroll
        for (int h = 0; h < 4; ++h)
#pragma unroll
            for (int i = 0; i < 8; ++i) { LAS float* p = wl + h * 64 + 8 * lane + i; *p = first ? A.acc[h][i] : (*p + A.acc[h][i]); }
    }
}
__device__ __forceinline__ void attn_sample_unit(const Ptrs& P, int bs, int g, LAS float* wl, int lane_in) {
    int lane = lane_in; asm volatile("" : "+v"(lane));
    const int kq = lane >> 3, j8 = lane & 7, row = MP + bs;
    const bf16* Q = WSP(bf16, WS_Q) + (size_t)row * DM + (4 * g) * 64; const float* GT = WSP(float, WS_GATES) + (size_t)row * 48 + g * 12;
    float qv[4][8];
#pragma unroll
    for (int h = 0; h < 4; ++h) unpack8(*(const v4u*)(Q + h * 64 + 8 * j8), qv[h]);
    const float slope2_own = fexp2(-0.5f * (float)(4 * g + (j8 & 3) + 1)) * LOG2E;
    SampleAcc A;
    LAS float* pimp = wl + 256;
    LAS float* sraw = wl + 512;
    const float* KCS = WSP(float, WS_KCS) + (size_t)(bs * 4 + g) * 128 * 64; const float* VCS = WSP(float, WS_VCS) + (size_t)(bs * 4 + g) * 128 * 64;
    sample_reset(A);
#pragma unroll 1
    for (int bt = 0; bt < 4; ++bt) sample_batch4(KCS, VCS, 64, 32 * bt + kq, 127, 126, (float)(PAST - (16 * (32 * bt + kq) + 31)), 128.f, qv, slope2_own, lane, A, sraw + bt * 256);
    { float lt = A.l; lt += dppf<DPP_X8>(lt); lt = xsum_16_32(lt);
      const float il = lt > 0.f ? 1.0f / lt : 0.f, mm = A.m == NEG_INF ? 0.f : A.m;
#pragma unroll 1
      for (int it = 0; it < 16; ++it) { float p = fexp2(sraw[it * 64 + lane] - mm) * il; p += dppf<DPP_X1>(p); p += dppf<DPP_X2>(p); if (j8 == 0) pimp[8 * it + kq] = p; } }
    sample_finish(A, GT, 0, wl, lane, true);
    unsigned long long selmask;
    { float v = -1.f;
      if (lane < 33) { float sacc = 0.f;
#pragma unroll
          for (int e = -1; e < 4; ++e) { const int n = 4 * lane + e; if (n >= 0 && n < 127) sacc += pimp[n]; }
          v = (lane == 0 || lane >= 31) ? sacc + 1e4f : sacc; }
      int rank = 0;
#pragma unroll 1
      for (int i = 0; i < 33; ++i) { const float vi = __builtin_bit_cast(float, __builtin_amdgcn_readlane(__builtin_bit_cast(int, v), i)); rank += (vi > v || (vi == v && i < lane)) ? 1 : 0; }
      selmask = __ballot(lane < 33 && rank < 16); }
    sample_reset(A);
#pragma unroll 1
    for (int j = 0; j < 32; ++j) {
        if (!((selmask >> j) & 1ull)) continue;
        const int page = P.page_table[bs * NPAGES + (j >> 1)];
        const float* kb = P.cache_kv + ((size_t)page * 128 * 4 + 2) * 256 + g * 64;
#pragma unroll 1
        for (int bb = 0; bb < 2; ++bb) { const int r0 = ((64 * j) & 127) + 32 * bb + kq;
            sample_batch4(kb, kb + 256, 1024, r0, 1 << 30, 0, (float)(PAST - (64 * j + 32 * bb + kq)), 8.f, qv, slope2_own, lane, A, nullptr); }
    }
    { const float* kr = P.out + OKV_S + ((size_t)bs * 4 + 2) * 256 + g * 64;
      (void)sample_step8(kr, kr + 256, kq == 0, 0.f, qv, slope2_own, lane, A); }
    sample_finish(A, GT, 1, wl, lane, false);
    sample_reset(A);
    { const float* kb = P.state_win + (size_t)bs * 512 * 512 + g * 64;
#pragma unroll 1
      for (int bt = 0; bt < 16; ++bt) sample_batch4(kb, kb + 256, 512, 32 * bt + kq, 1 << 30, 0, (float)(512 - (32 * bt + kq)), 8.f, qv, slope2_own, lane, A, nullptr); }
    { const float* kr = P.out + OWIN_S + ((size_t)bs * 512 + 511) * 512 + g * 64;
      (void)sample_step8(kr, kr + 256, kq == 0, 0.f, qv, slope2_own, lane, A); }
    sample_finish(A, GT, 2, wl, lane, false);
    { const f32x4 v = *(const LAS f32x4*)(wl + 4 * lane); v2u w; w.x = pk2(v[0], v[1]); w.y = pk2(v[2], v[3]);
      *(v2u*)(WSP(bf16, WS_O) + (size_t)row * DM + 256 * g + 4 * lane) = w; }
}

__device__ __forceinline__ void ldK(bf16x8 (&kf)[2][2], const GAS bf16* Kp, int k0, unsigned koff) {
#pragma unroll
    for (int kt = 0; kt < 2; ++kt)
#pragma unroll
        for (int ks = 0; ks < 2; ++ks) kf[kt][ks] = *(const GAS bf16x8*)((const GAS char*)(Kp + (size_t)k0 * 64 + kt * 256 + ks * 32) + koff);
}
__device__ __forceinline__ void ldV(bf16x8 (&vf)[4], const GAS bf16* Vp, int VP, int k0, unsigned voff) {
#pragma unroll
    for (int dt = 0; dt < 4; ++dt) vf[dt] = *(const GAS bf16x8*)((const GAS char*)(Vp + (size_t)(k0 >> 5) * 2048 + dt * 512) + voff);
}
template <int MODE, int GEN>
__device__ __forceinline__ void att_run(const GAS bf16* Kp, const GAS bf16* Vp, int VP, unsigned koff, unsigned voff, int n, int base, const LAS int* list,
                                        int KA, int KB, int W, unsigned M0, unsigned M1, unsigned M2, unsigned M3, int t, int fr, int fq, int lane,
                                        LAS float* wl, const float (&slope2)[4], f32x4 (&o)[4][4], float (&m)[4], float (&l)[4]) {
    if (n <= 0) return;
    bf16x8 kf[2][2], vf[4];
    int k0 = GEN == 0 ? 0 : (GEN == 1 ? base : list[0]);
    ldK(kf, Kp, k0, koff);
    if (MODE != 1) ldV(vf, Vp, VP, k0, voff);
    float carry = 0.f;
#pragma unroll 1
    for (int i = 0; i < n; ++i) {
        const int inx = (i + 1 < n) ? i + 1 : i;
        const int k0n = GEN == 0 ? 32 * inx : (GEN == 1 ? base - 32 * inx : list[inx]);
        f32x4 s[2][4];
        {
            unsigned qa = (unsigned)lane * 16u; asm volatile("" : "+v"(qa));
            const LAS char* qb = (const LAS char*)wl + qa;
#pragma unroll
            for (int h = 0; h < 4; ++h) {
                const bf16x8 q0 = *(const LAS bf16x8*)(qb + (h * 2 + 0) * 1024), q1 = *(const LAS bf16x8*)(qb + (h * 2 + 1) * 1024);
#pragma unroll
                for (int kt = 0; kt < 2; ++kt) { f32x4 a = (f32x4){0.f, 0.f, 0.f, 0.f};
                    a = __builtin_amdgcn_mfma_f32_16x16x32_bf16(kf[kt][0], q0, a, 0, 0, 0);
                    a = __builtin_amdgcn_mfma_f32_16x16x32_bf16(kf[kt][1], q1, a, 0, 0, 0); s[kt][h] = a; }
            }
        }
        ldK(kf, Kp, k0n, koff);
        bool extra = true;
        if (GEN == 2) { const int j = k0 >> 6, f = j & 3; const unsigned Mw = f == 0 ? M0 : f == 1 ? M1 : f == 2 ? M2 : M3; extra = (Mw >> (j >> 2)) & 1u; }
        f32x2 dp[2][2];
#pragma unroll
        for (int kt = 0; kt < 2; ++kt)
#pragma unroll
            for (int e = 0; e < 4; ++e) { const int nn = k0 + 8 * fq + 4 * kt + e, d = t - (KA * nn + KB); const float dv = (extra && (unsigned)d <= (unsigned)W) ? (float)d : __builtin_inff();
                if (e & 1) dp[kt][e >> 1].y = dv; else dp[kt][e >> 1].x = dv; }
        f32x2 sp[2][4][2];
#pragma unroll
        for (int h = 0; h < 4; ++h)
#pragma unroll
            for (int kt = 0; kt < 2; ++kt) { const f32x2 nsl = (f32x2){-slope2[h], -slope2[h]};
                sp[kt][h][0] = (f32x2){s[kt][h][0], s[kt][h][1]} + dp[kt][0] * nsl; sp[kt][h][1] = (f32x2){s[kt][h][2], s[kt][h][3]} + dp[kt][1] * nsl; }
        if (MODE == 2) {
#pragma unroll
            for (int h = 0; h < 4; ++h) { const f32x2 mm = (f32x2){m[h], m[h]}, ll = (f32x2){l[h], l[h]};
#pragma unroll
                for (int kt = 0; kt < 2; ++kt)
#pragma unroll
                    for (int pr = 0; pr < 2; ++pr) { const f32x2 a = sp[kt][h][pr] - mm; f32x2 p; p.x = fexp2(a.x); p.y = fexp2(a.y); sp[kt][h][pr] = p * ll; } }
            f32x2 as0[2], as1[2];
#pragma unroll
            for (int pr = 0; pr < 2; ++pr) { as0[pr] = (sp[0][0][pr] + sp[0][1][pr]) + (sp[0][2][pr] + sp[0][3][pr]); as1[pr] = (sp[1][0][pr] + sp[1][1][pr]) + (sp[1][2][pr] + sp[1][3][pr]); }
            const float r1 = __shfl(as1[1].y, (lane + 48) & 63);
            const float y0 = fq > 0 ? r1 : carry, y1 = as0[1].y; carry = r1;
            wl[2048 + fr * 128 + 8 * i + 2 * fq]     = ((as0[0].x + as0[0].y) + (as0[1].x + as0[1].y)) + y0;
            wl[2048 + fr * 128 + 8 * i + 2 * fq + 1] = ((as1[0].x + as1[0].y) + (as1[1].x + as1[1].y)) + y1;
        } else {
            float tl[4]; bool grow = false;
#pragma unroll
            for (int h = 0; h < 4; ++h) {
                const f32x2 mx = __builtin_elementwise_max(__builtin_elementwise_max(sp[0][h][0], sp[0][h][1]), __builtin_elementwise_max(sp[1][h][0], sp[1][h][1]));
                tl[h] = fmaxf(mx.x, mx.y); grow = grow || (tl[h] > m[h] + 8.0f);
            }
            if (__any(grow)) {
#pragma unroll
                for (int h = 0; h < 4; ++h) { const float tm = xmax_16_32(tl[h]);
                    const float mn = fmaxf(m[h], tm), ms = (mn == NEG_INF) ? 0.f : mn, alpha = fexp2(m[h] - ms); l[h] *= alpha; m[h] = mn;
                    if (MODE == 0) {
#pragma unroll
                        for (int dt = 0; dt < 4; ++dt) o[dt][h] = o[dt][h] * alpha; } }
            }
#pragma unroll
            for (int h = 0; h < 4; ++h) { const float ms = (m[h] == NEG_INF) ? 0.f : m[h]; const f32x2 mm = (f32x2){ms, ms}; f32x2 ps = (f32x2){0.f, 0.f};
#pragma unroll
                for (int kt = 0; kt < 2; ++kt)
#pragma unroll
                    for (int pr = 0; pr < 2; ++pr) { const f32x2 a = sp[kt][h][pr] - mm; f32x2 p; p.x = fexp2(a.x); p.y = fexp2(a.y); sp[kt][h][pr] = p; ps = ps + p; }
                l[h] += ps.x + ps.y; }
        }
#pragma unroll
        for (int h = 0; h < 4; ++h)
#pragma unroll
            for (int kt = 0; kt < 2; ++kt) s[kt][h] = (f32x4){sp[kt][h][0].x, sp[kt][h][0].y, sp[kt][h][1].x, sp[kt][h][1].y};
        if (MODE != 1) {
            bf16x8 pf[4];
#pragma unroll
            for (int h = 0; h < 4; ++h) { const v4u w = pack8(s[0][h], s[1][h]); pf[h] = __builtin_bit_cast(bf16x8, w); }
#pragma unroll
            for (int dt = 0; dt < 4; ++dt)
#pragma unroll
                for (int h = 0; h < 4; ++h) o[dt][h] = __builtin_amdgcn_mfma_f32_16x16x32_bf16(vf[dt], pf[h], o[dt][h], 0, 0, 0);
            ldV(vf, Vp, VP, k0n, voff);
        }
        k0 = k0n;
    }
}
#if defined(PROBE_MODE) && PROBE_MODE == 4
#define SEC_ON(s) (PROBE_A == (s) && (int)blockIdx.x == PROBE_BLK && threadIdx.x == 0)
#define SEC_T0(s) do { if (SEC_ON(s)) { volatile LAS unsigned* pm_ = (volatile LAS unsigned*)(unsigned)MISC_OFF; pm_[17] = (unsigned)__builtin_amdgcn_s_memrealtime(); } } while (0)
#define SEC_T1(s) do { if (SEC_ON(s)) { volatile LAS unsigned* pm_ = (volatile LAS unsigned*)(unsigned)MISC_OFF; pm_[16] = pm_[16] + ((unsigned)__builtin_amdgcn_s_memrealtime() - pm_[17]); } } while (0)
#define SEC_CNT(s, n) do { if (SEC_ON(s)) { volatile LAS unsigned* pm_ = (volatile LAS unsigned*)(unsigned)MISC_OFF; pm_[16] = pm_[16] + (unsigned)(n); } } while (0)
#else
#define SEC_T0(s) do { } while (0)
#define SEC_T1(s) do { } while (0)
#define SEC_CNT(s, n) do { } while (0)
#endif
__device__ __forceinline__ void attn_prompt_unit2(const Ptrs& P, int bg, int tt, LAS float* wl, int lane_in) {
    int lane = lane_in; asm volatile("" : "+v"(lane));
    const int fr = lane & 15, fq = lane >> 4, b = bg >> 2, g = bg & 3, t0 = 16 * tt, t = t0 + fr, row = b * SEQ + t;
    const float* GT = WSP(float, WS_GATES) + (size_t)row * 48 + g * 12;
    const GAS bf16* KC = (const GAS bf16*)WSP(bf16, WS_KC) + (size_t)bg * 512 * 64; const GAS bf16* VCT = (const GAS bf16*)WSP(bf16, WS_VCT) + (size_t)bg * 64 * 512;
    const GAS bf16* SK = (const GAS bf16*)WSP(bf16, WS_SK) + (size_t)bg * SEQ * 64; const GAS bf16* SVT = (const GAS bf16*)WSP(bf16, WS_SVT) + (size_t)bg * 64 * SEQ;
    const GAS bf16* WK = (const GAS bf16*)WSP(bf16, WS_WK) + (size_t)bg * SEQ * 64; const GAS bf16* WVT = (const GAS bf16*)WSP(bf16, WS_WVT) + (size_t)bg * 64 * SEQ;
    GAS float* OA = (GAS float*)WSP(float, WS_OACC) + (size_t)row * DM + 256 * g + 4 * fq;
    float slope2[4];
    { const GAS bf16* Q = (const GAS bf16*)WSP(bf16, WS_Q) + (size_t)row * DM + (4 * g) * 64 + 8 * fq;
#pragma unroll
      for (int h = 0; h < 4; ++h) { slope2[h] = fexp2(-0.5f * (float)(4 * g + h + 1)) * LOG2E;
#pragma unroll
          for (int ks = 0; ks < 2; ++ks) *(LAS v4u*)((LAS char*)wl + (h * 2 + ks) * 1024 + lane * 16) = *(const GAS v4u*)(Q + h * 64 + 32 * ks); } }
    f32x4 o[4][4]; float m[4], l[4];
    const int BIG = 1 << 30;
    const unsigned koff = (unsigned)((8 * (fr >> 2) + (fr & 3)) * 64 + 8 * fq) * 2u, voffc = (unsigned)(fr * 32 + 8 * fq) * 2u, voffs = voffc;
    const int nst = (tt >> 5) + 1;
    SEC_T0(1);
#pragma unroll
    for (int h = 0; h < 4; ++h) { m[h] = NEG_INF; l[h] = 0.f; }
    att_run<1, 0>(KC, VCT, 512, koff, voffc, nst, 0, nullptr, 16, 31, BIG, 0u, 0u, 0u, 0u, t, fr, fq, lane, wl, slope2, o, m, l);
#pragma unroll
    for (int h = 0; h < 4; ++h) { const float lt = xsum_16_32(l[h]); l[h] = lt > 0.f ? 1.0f / lt : 0.f; if (m[h] == NEG_INF) m[h] = 0.f;
#pragma unroll
        for (int dt = 0; dt < 4; ++dt) o[dt][h] = (f32x4){0.f, 0.f, 0.f, 0.f}; }
    att_run<2, 0>(KC, VCT, 512, koff, voffc, nst, 0, nullptr, 16, 31, BIG, 0u, 0u, 0u, 0u, t, fr, fq, lane, wl, slope2, o, m, l);
#pragma unroll
    for (int h = 0; h < 4; ++h) { const float gc = GT[h * 3 + 0];
#pragma unroll
        for (int dt = 0; dt < 4; ++dt) *(GAS f32x4*)(OA + h * 64 + 16 * dt) = o[dt][h] * gc; }
    SEC_T1(1);
    SEC_T0(2);
    const int qblk = t0 >> 6;
    unsigned M0, M1, M2, M3;
    {
        float cv[32];
#pragma unroll
        for (int q = 0; q < 32; ++q) { const int j = 4 * q + fq; const float x = wl[2048 + fr * 128 + j];
            const bool forced = (j == 0) | (j == qblk) | (j == qblk - 1); cv[q] = (j <= qblk) ? (forced ? x + 1e4f : x) : -1.f; }
        unsigned mask = 0u;
#pragma unroll 1
        for (int r = 0; r < 16; ++r) {
            float bv = cv[0]; int bq = 0;
#pragma unroll
            for (int q = 1; q < 32; ++q) if (cv[q] > bv) { bv = cv[q]; bq = q; }
            int bj = 4 * bq + fq;
            { float va, vb; int ia, ib; xpair16(bv, va, vb); xpair16i(bj, ia, ib); const bool tb = vb > va || (vb == va && ib < ia); bv = tb ? vb : va; bj = tb ? ib : ia; }
            { float va, vb; int ia, ib; xpair32(bv, va, vb); xpair32i(bj, ia, ib); const bool tb = vb > va || (vb == va && ib < ia); bv = tb ? vb : va; bj = tb ? ib : ia; }
            const bool mine = (bv >= 0.f) && ((bj & 3) == fq); const int wq = bj >> 2;
#pragma unroll
            for (int q = 0; q < 32; ++q) if (mine && q == wq) cv[q] = -2.f;
            if (mine) mask |= 1u << wq;
        }
        M0 = __shfl(mask, fr); M1 = __shfl(mask, fr + 16); M2 = __shfl(mask, fr + 32); M3 = __shfl(mask, fr + 48);
    }
    int nlist = 0;
    {
        unsigned U0 = M0, U1 = M1, U2 = M2, U3 = M3;
        U0 |= dppu<DPP_X1>(U0); U1 |= dppu<DPP_X1>(U1); U2 |= dppu<DPP_X1>(U2); U3 |= dppu<DPP_X1>(U3);
        U0 |= dppu<DPP_X2>(U0); U1 |= dppu<DPP_X2>(U1); U2 |= dppu<DPP_X2>(U2); U3 |= dppu<DPP_X2>(U3);
        U0 |= dppu<DPP_HM>(U0); U1 |= dppu<DPP_HM>(U1); U2 |= dppu<DPP_HM>(U2); U3 |= dppu<DPP_HM>(U3);
        U0 |= dppu<DPP_RM>(U0); U1 |= dppu<DPP_RM>(U1); U2 |= dppu<DPP_RM>(U2); U3 |= dppu<DPP_RM>(U3);
        U0 = __builtin_amdgcn_readfirstlane(U0); U1 = __builtin_amdgcn_readfirstlane(U1); U2 = __builtin_amdgcn_readfirstlane(U2); U3 = __builtin_amdgcn_readfirstlane(U3);
        LAS int* lst = (LAS int*)(wl + 2048);
#pragma unroll 1
        for (int j = qblk; j >= 0; --j) { const int f = j & 3; const unsigned Uw = f == 0 ? U0 : f == 1 ? U1 : f == 2 ? U2 : U3;
            if ((Uw >> (j >> 2)) & 1u) { if (lane == 0) { lst[nlist] = 64 * j + 32; lst[nlist + 1] = 64 * j; } nlist += 2; } }
    }
    SEC_T1(2); SEC_CNT(5, nlist); SEC_T0(3);
#pragma unroll
    for (int h = 0; h < 4; ++h) { m[h] = NEG_INF; l[h] = 0.f;
#pragma unroll
        for (int dt = 0; dt < 4; ++dt) o[dt][h] = (f32x4){0.f, 0.f, 0.f, 0.f}; }
    att_run<0, 2>(SK, SVT, SEQ, koff, voffs, nlist, 0, (const LAS int*)(wl + 2048), 1, 0, BIG, M0, M1, M2, M3, t, fr, fq, lane, wl, slope2, o, m, l);
    asm volatile("s_waitcnt vmcnt(0)" ::: "memory");
#pragma unroll
    for (int h = 0; h < 4; ++h) { const float lt = xsum_16_32(l[h]); const float sc = lt > 0.f ? GT[h * 3 + 1] / lt : 0.f;
#pragma unroll
        for (int dt = 0; dt < 4; ++dt) { GAS f32x4* p = (GAS f32x4*)(OA + h * 64 + 16 * dt); *p = *p + o[dt][h] * sc; } }
    SEC_T1(3); SEC_T0(4);
#pragma unroll
    for (int h = 0; h < 4; ++h) { m[h] = NEG_INF; l[h] = 0.f;
#pragma unroll
        for (int dt = 0; dt < 4; ++dt) o[dt][h] = (f32x4){0.f, 0.f, 0.f, 0.f}; }
    { const int kend = (t0 > 512 ? (t0 - 512) : 0) & ~31, ktop = t0 & ~31;
      att_run<0, 1>(WK, WVT, SEQ, koff, voffs, ((ktop - kend) >> 5) + 1, ktop, nullptr, 1, 0, 512, 0u, 0u, 0u, 0u, t, fr, fq, lane, wl, slope2, o, m, l); }
    asm volatile("s_waitcnt vmcnt(0)" ::: "memory");
    GAS bf16* O = (GAS bf16*)WSP(bf16, WS_O) + (size_t)row * DM + 256 * g + 4 * fq;
#pragma unroll
    for (int h = 0; h < 4; ++h) { const float lt = xsum_16_32(l[h]); const float sc = lt > 0.f ? GT[h * 3 + 2] / lt : 0.f;
#pragma unroll
        for (int dt = 0; dt < 4; ++dt) { const f32x4 v = *(const GAS f32x4*)(OA + h * 64 + 16 * dt) + o[dt][h] * sc;
            v2u w; w.x = pk2(v[0], v[1]); w.y = pk2(v[2], v[3]); *(GAS v2u*)(O + h * 64 + 16 * dt) = w; } }
    SEC_T1(4);
}

#define ATTN_UNIT attn_prompt_unit2
#ifdef PROBE_MODE
#ifndef PROBE_BLK
#define PROBE_BLK 0
#endif
#ifndef PROBE_MULT
#define PROBE_MULT 8
#endif
#define PROBE_SEL(p) ((p) >= PROBE_A && (p) <= PROBE_B)
#endif
struct Args { const void* in[31]; float* out; unsigned char* ws; int ph_lo, ph_hi; };
constexpr int N_PHASES = 2 + 1 + 12 + 2 * 1 + 2 * 1 + 12 + 1;

__global__ void __launch_bounds__(NWAVES * 64, 2) yoco_fwd(Args args) {
    extern __shared__ __attribute__((aligned(16))) unsigned char lds_raw[];
    LAS unsigned char* lds = (LAS unsigned char*)lds_raw;
    const int tid0 = threadIdx.x, wave = __builtin_amdgcn_readfirstlane(tid0 >> 6);
    const int G = gridDim.x; const int bx = blockIdx.x; const int vcu = (G % 8 == 0) ? (bx % 8) * (G / 8) + bx / 8 : bx;
    const int gw0 = vcu * NWAVES + wave, NGW = G * NWAVES;

    for (int u = tid0; u < (LDS_BYTES - LDSCTL_OFF) / 4; u += NWAVES * 64) ((LAS unsigned*)(lds + LDSCTL_OFF))[u] = 0u;
    __syncthreads();
    volatile LAS unsigned* MISC = (volatile LAS unsigned*)(lds + MISC_OFF);
    unsigned* barw = (unsigned*)(args.ws + WS_CTL) + CW_BAR;
    XcdBarrier bar; bar.bar = barw; bar.x = 0; bar.st = nullptr;
    const int lo = args.ph_lo, hi = args.ph_hi;
    if (hi - lo > 1) bar = xcd_barrier_post(barw, MISC + 8);
    int pid = 0;
#define IN_PH() (lo <= pid && pid < hi)
#define NIN() NormIn{P.ws, sl > 0 ? sl - 1 : 0, sl, sl > 0 ? 1 : 0}
#define LOADP() int tid = tid0; asm volatile("" : "+v"(tid)); const int lane = tid & 63; int gw = gw0; asm volatile("" : "+s"(gw)); (void)lane; (void)gw; Ptrs P; load_ptrs(P); const f16* X = WSP(f16, WS_X); bf16* H = WSP(bf16, WS_H); const float* MOD = WSP(float, WS_MOD); (void)X; (void)H; (void)MOD
#ifdef PROBE_MODE
#define PRB_ON() ((int)blockIdx.x == PROBE_BLK && tid0 == 0)
#define PRB_NOW() ((unsigned)__builtin_amdgcn_s_memrealtime())
#define END_PH() do { if (PRB_ON()) { const unsigned tm_ = PRB_NOW(); if ((PROBE_MODE & 1) && PROBE_SEL(pid)) MISC[16] = MISC[16] + (tm_ - MISC[17]); MISC[17] = tm_; } \
    if (lo <= pid && pid + 1 < hi) xcd_barrier(bar); \
    if (PRB_ON()) { const unsigned te_ = PRB_NOW(); if ((PROBE_MODE & 2) && PROBE_SEL(pid)) MISC[16] = MISC[16] + (te_ - MISC[17]); MISC[17] = te_; } ++pid; } while (0)
#else
#define END_PH() do { if (lo <= pid && pid + 1 < hi) xcd_barrier(bar); ++pid; } while (0)
#endif


#ifdef PROBE_MODE
    if (PRB_ON()) { MISC[16] = 0u; MISC[17] = PRB_NOW(); }
#endif
    if (IN_PH()) { LOADP(); prologue_phase(P, lds, gw, NGW, wave, lane, tid); }
    END_PH();
    if (IN_PH()) { LOADP();
        run_gemm(lds, WSP(bf16, WS_SC), WSP(bf16, WS_WMOD), 256, NMOD, DM, FMod{WSP(float, WS_MOD), P.ada_b, P.kv_ada_b, P.final_ada_b, WSP(bf16, WS_SHB)});
        run_gemm(lds, WSP(bf16, WS_ACMP), WSP(bf16, WS_WC1), 65536, 512, 1024, FBf16{WSP(bf16, WS_TS), 512});
        run_gemm(lds, WSP(bf16, WS_ACMP) + (size_t)65536 * 1024, WSP(bf16, WS_WC1) + (size_t)512 * 1024, 65536, 512, 1024, FBf16{WSP(bf16, WS_TS) + (size_t)65536 * 512, 512});
    }
    END_PH();

    for (int sl = 0; sl < 12; ++sl) {
        const int l = sl / 3, sub = sl - 3 * l;
        if (sl == 0) {
            if (IN_PH()) { LOADP();
                norm_phase<false>(X, P.norm_g, MOD, 0, DM, H, nullptr, gw, NGW, lane);
                { pg8::Gemm g{WSP(bf16, WS_SHB), WSP(bf16, WS_WGU), 13 * 256, 0, DM}; int cb = (int)blockIdx.x; asm volatile("" : "+s"(cb)); ShiftOrder S{(int)gridDim.x, cb}; Epi8<FB2> E{FB2{WSP(float, WS_B2)}};
                  pg8::gemm_phase<Epi8<FB2>, ShiftOrder, true, true>(lds, g, S, E); }
                for (int u = gw; u < 2 * 512 * 8; u += NGW) { const int kv = u >> 12, r = u & 4095, bg = r >> 3, rt = r & 7;
                    cmp_finish_unit<2>(WSP(bf16, WS_TS) + (size_t)kv * 65536 * 512, WSP(float, WS_CBIAS) + kv * 256, WSP(bf16, WS_WC2) + kv * 64 * 256,
                                       kv == 0 ? (void*)WSP(float, WS_KCS) : (void*)WSP(float, WS_VCS), 128, bg, rt, lane); }
            }
            END_PH();
        }
        if (sub != 1) {
            const int s = sub >> 1;
            if (IN_PH()) { LOADP();
                if (sl == 6) {
                    run_gemm2(lds, WSP(bf16, WS_HKV), WSP(bf16, WS_WKV), NKVP, NKVP, DM, FKv{P.out, WSP(bf16, WS_KCIN), NormIn{P.ws, 5, 12, 1}}, 0, 0);
                    run_gemm2(lds, H, WSP(bf16, WS_WGU) + (size_t)(l * 2 + s) * 5632 * 1024, 5632, 5632, DM, FSwiglu{WSP(bf16, WS_HID), NIN()}, (int)gridDim.x / 2, 0);
                } else
                run_gemm2(lds, H, WSP(bf16, WS_WGU) + (size_t)(l * 2 + s) * 5632 * 1024, 5632, 5632, DM, FSwiglu{WSP(bf16, WS_HID), NIN()}); }
            END_PH();
        } else if (l < 2) {
            if (IN_PH()) { LOADP(); run_gemm2(lds, H, WSP(bf16, WS_WUV) + (size_t)l * 6144 * 1024, 6144, 6144, DM, FGelu{WSP(bf16, WS_Z), NIN(), WSP(float, WS_CTL) + CW_VS + (size_t)l * RT * 2}); }
            END_PH();
            if (IN_PH()) { LOADP(); spatial2_phase(P, l, lds, wave, lane, tid, gw, NGW); }
            END_PH();
        } else {
            if (IN_PH()) { LOADP();
                if (sl == 7) {
                    for (int u = gw; u < 2 * 8 * 32; u += NGW) { const int kv = u >> 8, r = u & 255, bg = r >> 5, rt = r & 31;
                        if (kv == 0) cmp_finish_unit<0>(WSP(bf16, WS_TK), WSP(float, WS_CBIAS), WSP(bf16, WS_WC2), (void*)WSP(bf16, WS_KC), 512, bg, rt, lane);
                        else cmp_finish_unit<1>(WSP(bf16, WS_TV), WSP(float, WS_CBIAS) + 256, WSP(bf16, WS_WC2) + 64 * 256, (void*)WSP(bf16, WS_VCT), 512, bg, rt, lane); }
                }
                run_gemm2(lds, H, WSP(bf16, WS_WQG) + (size_t)(l - 2) * NQG * 1024, NQG, 1072, DM, FQg{WSP(bf16, WS_Q), WSP(float, WS_GATES), NIN()}); }
            END_PH();
            if (IN_PH()) { LOADP(); LAS float* wl = (LAS float*)(lds + (gw & 7) * 16384);
                {
                    int r = 0;
                    for (;;) {
                        const int q = ((int)(xb_xcc_id() & 7u) + r) & 7;
                        unsigned idx = 0u; if (lane == 0) idx = __hip_atomic_fetch_add((unsigned*)(P.ws + WS_CTL) + CW_QUEUE + 64 * (8 * (l - 2) + q), 1u, __ATOMIC_RELAXED, __HIP_MEMORY_SCOPE_AGENT);
                        idx = (unsigned)__builtin_amdgcn_readfirstlane((int)idx);
                        if (idx >= 64u + 512u) { if (++r == 8) break; continue; }
                        if (idx < 64u) { const int id = q * 64 + (int)idx; attn_sample_unit(P, id >> 2, id & 3, wl, lane); }
                        else ATTN_UNIT(P, q, 511 - ((int)idx - 64), wl, lane);
                    }
                }
            }
            END_PH();
        }
        if (IN_PH()) { LOADP();
            const bf16* A2 = sub != 1 ? WSP(bf16, WS_HID) : (l < 2 ? WSP(bf16, WS_P) : WSP(bf16, WS_O));
            const bf16* B2 = sub != 1 ? WSP(bf16, WS_WDN) + (size_t)(l * 2 + (sub >> 1)) * 1024 * DFF : (l < 2 ? WSP(bf16, WS_WOUT) + (size_t)l * 1024 * DV : WSP(bf16, WS_WO) + (size_t)(l - 2) * 1024 * 1024);
            const int K2 = sub != 1 ? DFF : (l < 2 ? DV : DM);
            if (sl == 6) {
                run_gemm(lds, WSP(bf16, WS_KCIN), WSP(bf16, WS_WC1), 4096, 512, 1024, FBf16{WSP(bf16, WS_TK), 512}, 64);
                run_gemm(lds, WSP(bf16, WS_VCIN), WSP(bf16, WS_WC1) + (size_t)512 * 1024, 4096, 512, 1024, FBf16{WSP(bf16, WS_TV), 512}, 32);
            }
            const int sn = sl + 1, ln = sn / 3, subn = sn - 3 * ln;
            const bool more = sl < 11;
            run_gemm2r(lds, A2, B2, K2, FResid{P.ws, l * 9216 + (sub * 3 + 2) * DM, sub != 1 ? 0.5f : 1.0f, more ? sn : -1, ln * 9216 + (subn * 3 + 1) * DM, sl == 5 ? 12 : -1, MODKV + DM, more ? sl : -1});
        }
        END_PH();
    }
    if (IN_PH()) { LOADP(); norm_phase<true>(X, P.final_g, MOD, MODFIN, MODFIN + DM, nullptr, P.out, gw, NGW, lane); }
#ifdef PROBE_MODE
    if (PRB_ON()) { const unsigned tm_ = PRB_NOW(); if ((PROBE_MODE & 1) && PROBE_SEL(pid)) MISC[16] = MISC[16] + (tm_ - MISC[17]);
        const unsigned want = MISC[16] * (unsigned)PROBE_MULT; const unsigned t0_ = PRB_NOW(); while (PRB_NOW() - t0_ < want) __builtin_amdgcn_s_sleep(32); }
#endif
    ++pid;
#undef IN_PH
#undef END_PH
}

extern "C" void kernel_launch(void* const* d_in, const int* in_sizes, int n_in, void* d_out, int out_size, void* d_ws, size_t ws_size, hipStream_t stream) {
    static int grid = 0;
    if (grid == 0) {
        if (n_in != 31 || (size_t)out_size != OUT_TOTAL || ws_size < WS_END) { fprintf(stderr, "kernel_launch: unexpected shapes (n_in %d, out %d, ws %zu need %zu); nothing launched\n", n_in, out_size, ws_size, (size_t)WS_END); grid = -1; return; }
        int dev = 0, cus = 0, per_cu = 0;
        if (hipGetDevice(&dev) != hipSuccess || hipDeviceGetAttribute(&cus, hipDeviceAttributeMultiprocessorCount, dev) != hipSuccess) { grid = -1; return; }
        if (hipFuncSetAttribute((const void*)yoco_fwd, hipFuncAttributeMaxDynamicSharedMemorySize, LDS_BYTES) != hipSuccess) { fprintf(stderr, "kernel_launch: hipFuncSetAttribute failed\n"); grid = -1; return; }
        if (hipOccupancyMaxActiveBlocksPerMultiprocessor(&per_cu, (const void*)yoco_fwd, NWAVES * 64, LDS_BYTES) != hipSuccess || per_cu < 1) { fprintf(stderr, "kernel_launch: occupancy query says %d blocks per CU\n", per_cu); }
        (void)hipGetLastError();
        grid = cus;
    }
    if (grid < 0) return;
    if (hipMemsetAsync((char*)d_ws + WS_CTL, 0, CTL_ZERO_BYTES, stream) != hipSuccess) return;
    Args a{};
    for (int i = 0; i < 31; ++i) a.in[i] = d_in[i];
    a.out = (float*)d_out; a.ws = (unsigned char*)d_ws;
#if ONE_LAUNCH
    a.ph_lo = 0; a.ph_hi = N_PHASES;
    hipLaunchKernelGGL(yoco_fwd, dim3(grid), dim3(NWAVES * 64), LDS_BYTES, stream, a);
#else
    for (int p = 0; p < N_PHASES; ++p) { a.ph_lo = p; a.ph_hi = p + 1; hipLaunchKernelGGL(yoco_fwd, dim3(grid), dim3(NWAVES * 64), LDS_BYTES, stream, a); }
#endif
}
```

```cpp
#include <hip/hip_runtime.h>
#include <cstdio>
#include <cstdint>
#include <cmath>
namespace pg8 {
#define PG8_LAS __attribute__((address_space(3)))
typedef unsigned short bf16_t;
typedef short bf16x8 __attribute__((ext_vector_type(8)));
typedef float f32x4 __attribute__((ext_vector_type(4)));
typedef unsigned u32x4 __attribute__((ext_vector_type(4)));
constexpr int BM = 256, BK = 64, HALF = 128, HTB = HALF * BK * 2  , STAGE_BYTES = 8 * HTB, NXCD = 8, WGM = 8;

__host__ __device__ __forceinline__ int lds_byte(int r, int c) { const int st = (r >> 4) * 2 + (c >> 5), rr = r & 15, cc = c & 31, ob = rr * 64 + cc * 2; return st * 1024 + (ob ^ (((ob >> 9) & 1) << 5)); }
__host__ __device__ __forceinline__ void stage_rc(int b, int& R, int& C) { const int st = b / 1024, sb = b % 1024, swz = sb ^ (((sb >> 9) & 1) << 5); R = (st >> 1) * 16 + swz / 64; C = (st & 1) * 32 + (swz % 64) / 2; }
__host__ __device__ __forceinline__ int perm32(int rho) { const int n = rho >> 4, i = rho & 15; return 8 * (i >> 2) + 4 * n + (i & 3); }

struct Unit { int pm, pn; };
struct Gemm { const bf16_t* A; const bf16_t* Bt; int M, N, K; };

struct StaticOrder {
    int nM, nN, nwg, G, c;
    __host__ __device__ void init(int M, int N, int G_, int c_) { nM = M / BM; nN = N / BM; nwg = nM * nN; G = G_; c = c_; }
    __host__ __device__ bool next(int i, Unit& u) const {
        const long L = (long)i * G + c; if (L >= nwg) return false;
        int wgid = (int)L; { const int q = nwg / NXCD, r = nwg % NXCD, xcd = wgid % NXCD, off = wgid / NXCD; wgid = (xcd < r ? xcd * (q + 1) : r * (q + 1) + (xcd - r) * q) + off; }
        const int nig = WGM * nN, gid = wgid / nig, fm = gid * WGM, gsz = (nM - fm) < WGM ? (nM - fm) : WGM;
        u.pm = fm + ((wgid % nig) % gsz); u.pn = (wgid % nig) / gsz; return true;
    }
    __device__ __forceinline__ void a_ready(const Unit&) const {}
    __device__ __forceinline__ void done(const Unit&) const {}
};

__device__ __forceinline__ unsigned cvt_pk_bf16(float lo, float hi) { unsigned r; asm volatile("v_cvt_pk_bf16_f32 %0, %1, %2" : "=v"(r) : "v"(lo), "v"(hi)); return r; }
typedef float f32x2 __attribute__((ext_vector_type(2)));
template <class Epi, class Sched, bool ALIGN_EPI = false, bool SP2 = false>
__device__ __forceinline__ void gemm_phase(PG8_LAS unsigned char* lds, const Gemm g, const Sched& S, const Epi& E) {
    int tid_raw = threadIdx.x; asm volatile("" : "+v"(tid_raw));
    const int tid = tid_raw, wid = __builtin_amdgcn_readfirstlane(tid >> 6), lane = tid & 63, wr = wid >> 2, wc = wid & 3, fr = lane & 15, fq = lane >> 4;
    const int K = g.K, nt = K / BK;
    unsigned voffA[2], voffB[2];
#pragma unroll
    for (int i = 0; i < 2; ++i) { int R, C; stage_rc(tid * 16 + i * 8192, R, C); const int Rb = Epi::PERM ? ((R & ~31) + perm32(R & 31)) : R;
        voffA[i] = (unsigned)(R * K + C) * 2u; voffB[i] = (unsigned)(Rb * K + C) * 2u; }
    const size_t kstep = (size_t)(BK * 2);
    const size_t hstep = (size_t)HALF * K * 2;
    const size_t tstep = 2 * hstep;
    const unsigned ldsw = (unsigned)wid * 1024u;
    const int aoff = lds_byte(wr * 64 + fr, fq * 8), boff = lds_byte(wc * 32 + fr, fq * 8);
#define PG8_SA(b, h) (((b) * 2 + (h)) * HTB)
#define PG8_SB(b, h) ((4 + (b) * 2 + (h)) * HTB)
#define PG8_STAGE(bufoff, gbase, voff) do { _Pragma("unroll") for (int _i = 0; _i < 2; ++_i) \
        __builtin_amdgcn_global_load_lds((const unsigned*)((const char*)(gbase) + (voff)[_i]), (PG8_LAS unsigned*)(lds + (bufoff) + ldsw + _i * 8192), 16, 0, 0); } while (0)
#define PG8_LDA(dst, b, h) do { _Pragma("unroll") for (int m = 0; m < 4; ++m) _Pragma("unroll") for (int k = 0; k < 2; ++k) dst[m][k] = *(const PG8_LAS bf16x8*)(lds + PG8_SA(b, h) + aoff + m * 2048 + k * 1024); } while (0)
#define PG8_LDB(dst, b, h) do { _Pragma("unroll") for (int n = 0; n < 2; ++n) _Pragma("unroll") for (int k = 0; k < 2; ++k) dst[n][k] = *(const PG8_LAS bf16x8*)(lds + PG8_SB(b, h) + boff + n * 2048 + k * 1024); } while (0)
#define PG8_MMA(ai, bj, At, Bt) do { __builtin_amdgcn_s_setprio(1); _Pragma("unroll") for (int m = 0; m < 4; ++m) _Pragma("unroll") for (int n = 0; n < 2; ++n) _Pragma("unroll") for (int k = 0; k < 2; ++k) \
        acc[ai][bj][m][n] = __builtin_amdgcn_mfma_f32_16x16x32_bf16(Bt[n][k], At[m][k], acc[ai][bj][m][n], 0, 0, 0); __builtin_amdgcn_s_setprio(0); } while (0)
#define PG8_WAIT_V(n) asm volatile("s_waitcnt vmcnt(" #n ")" ::: "memory")
#define PG8_WAIT_L(n) asm volatile("s_waitcnt lgkmcnt(" #n ")" ::: "memory")
#define PG8_BAR __builtin_amdgcn_s_barrier()
#define PG8_SCHED __builtin_amdgcn_sched_barrier(0)
    Unit cur, nxt; int ui = 0;
    if (!S.next(0, cur)) return;
    f32x4 acc[2][2][4][2];
#pragma unroll
    for (int a = 0; a < 2; ++a)
#pragma unroll
        for (int b = 0; b < 2; ++b)
#pragma unroll
            for (int m = 0; m < 4; ++m)
#pragma unroll
                for (int n = 0; n < 2; ++n) acc[a][b][m][n] = (f32x4){0.f, 0.f, 0.f, 0.f};
    bf16x8 At[4][2], B0[2][2], B1[2][2];
    const char* cA = (const char*)g.A + (size_t)cur.pm * tstep; const char* cB = (const char*)g.Bt + (size_t)cur.pn * tstep;
    S.a_ready(cur);
    if constexpr (SP2) {
        PG8_STAGE(PG8_SB(0, 0), cB, voffB); PG8_STAGE(PG8_SB(0, 1), cB + hstep, voffB); PG8_STAGE(PG8_SA(0, 0), cA, voffA); PG8_STAGE(PG8_SA(0, 1), cA + hstep, voffA);
        if (wr == 1) PG8_BAR;
        PG8_WAIT_V(2); PG8_BAR;
        PG8_STAGE(PG8_SB(1, 0), cB + kstep, voffB); PG8_STAGE(PG8_SA(1, 0), cA + kstep, voffA); PG8_STAGE(PG8_SB(1, 1), cB + hstep + kstep, voffB);
        PG8_WAIT_V(6); PG8_BAR;
    } else {
        PG8_STAGE(PG8_SB(0, 0), cB, voffB); PG8_STAGE(PG8_SA(0, 0), cA, voffA); PG8_STAGE(PG8_SB(0, 1), cB + hstep, voffB); PG8_STAGE(PG8_SA(0, 1), cA + hstep, voffA);
        if (wr == 1) PG8_BAR;
        PG8_WAIT_V(4); PG8_BAR;
        PG8_STAGE(PG8_SB(1, 0), cB + kstep, voffB); PG8_STAGE(PG8_SA(1, 0), cA + kstep, voffA); PG8_STAGE(PG8_SB(1, 1), cB + hstep + kstep, voffB);
        PG8_WAIT_V(6); PG8_BAR;
    }
    for (;;) {
        const bool has_next = S.next(ui + 1, nxt);
        const char* nA = has_next ? (const char*)g.A + (size_t)nxt.pm * tstep : cA; const char* nB = has_next ? (const char*)g.Bt + (size_t)nxt.pn * tstep : cB;
        for (int t = 0; t < nt; t += 2) {
            const bool last = (t == nt - 2);
            const char* a1 = cA + (size_t)(t + 1) * kstep;
            const char* a2 = last ? nA : cA + (size_t)(t + 2) * kstep; const char* b2 = last ? nB : cB + (size_t)(t + 2) * kstep;
            const char* a3 = a2 + kstep; const char* b3 = b2 + kstep;
            if (last && has_next) S.a_ready(nxt);
            if constexpr (SP2) {
            PG8_LDB(B0, 0, 0); PG8_LDB(B1, 0, 1); PG8_SCHED; PG8_LDA(At, 0, 0); PG8_STAGE(PG8_SA(1, 1), a1 + hstep, voffA);
            PG8_WAIT_V(8); PG8_WAIT_L(0); PG8_BAR; PG8_MMA(0, 0, At, B0); PG8_MMA(0, 1, At, B1); PG8_BAR; PG8_SCHED;
            PG8_LDA(At, 0, 1); PG8_STAGE(PG8_SB(0, 0), b2, voffB); PG8_STAGE(PG8_SB(0, 1), b2 + hstep, voffB); PG8_STAGE(PG8_SA(0, 0), a2, voffA);
            PG8_WAIT_V(8); PG8_WAIT_L(0); PG8_BAR; PG8_MMA(1, 0, At, B0); PG8_MMA(1, 1, At, B1); PG8_BAR; PG8_SCHED;
            PG8_LDB(B0, 1, 0); PG8_LDB(B1, 1, 1); PG8_SCHED; PG8_LDA(At, 1, 0); PG8_STAGE(PG8_SA(0, 1), a2 + hstep, voffA);
            PG8_WAIT_V(8); PG8_WAIT_L(0); PG8_BAR; PG8_MMA(0, 0, At, B0); PG8_MMA(0, 1, At, B1); PG8_BAR; PG8_SCHED;
            PG8_LDA(At, 1, 1); PG8_STAGE(PG8_SB(1, 0), b3, voffB); PG8_STAGE(PG8_SB(1, 1), b3 + hstep, voffB); PG8_STAGE(PG8_SA(1, 0), a3, voffA);
            PG8_WAIT_V(8); PG8_WAIT_L(0); PG8_BAR; PG8_MMA(1, 0, At, B0); PG8_MMA(1, 1, At, B1); PG8_BAR; PG8_SCHED;
            } else {
            PG8_LDB(B0, 0, 0); PG8_SCHED; PG8_LDA(At, 0, 0); PG8_STAGE(PG8_SA(1, 1), a1 + hstep, voffA);
            PG8_WAIT_L(8); PG8_BAR; PG8_WAIT_L(0); PG8_MMA(0, 0, At, B0); PG8_BAR; PG8_SCHED;
            PG8_LDB(B1, 0, 1); PG8_STAGE(PG8_SB(0, 0), b2, voffB);
            PG8_BAR; PG8_WAIT_L(0); PG8_MMA(0, 1, At, B1); PG8_BAR;
            PG8_LDA(At, 0, 1); PG8_STAGE(PG8_SA(0, 0), a2, voffA);
            PG8_BAR; PG8_WAIT_L(0); PG8_MMA(1, 0, At, B0); PG8_BAR; PG8_SCHED;
            PG8_STAGE(PG8_SB(0, 1), b2 + hstep, voffB);
            PG8_WAIT_V(6); PG8_BAR; PG8_MMA(1, 1, At, B1); PG8_BAR;
            PG8_LDB(B0, 1, 0); PG8_SCHED; PG8_LDA(At, 1, 0); PG8_STAGE(PG8_SA(0, 1), a2 + hstep, voffA);
            PG8_WAIT_L(8); PG8_BAR; PG8_WAIT_L(0); PG8_MMA(0, 0, At, B0); PG8_BAR; PG8_SCHED;
            PG8_LDB(B1, 1, 1); PG8_STAGE(PG8_SB(1, 0), b3, voffB);
            PG8_BAR; PG8_WAIT_L(0); PG8_MMA(0, 1, At, B1); PG8_BAR;
            PG8_LDA(At, 1, 1); PG8_STAGE(PG8_SA(1, 0), a3, voffA);
            PG8_BAR; PG8_WAIT_L(0); PG8_MMA(1, 0, At, B0); PG8_BAR; PG8_SCHED;
            PG8_STAGE(PG8_SB(1, 1), b3 + hstep, voffB);
            PG8_WAIT_V(6); PG8_BAR; PG8_MMA(1, 1, At, B1); PG8_BAR;
            }
        }
        if constexpr (ALIGN_EPI) { if (wr == 0) PG8_BAR; }
        if constexpr (!Epi::AFTER_DRAIN) { E(acc, cur, wr, wc, fr, fq); S.done(cur); }
        if (!has_next) break;
#pragma unroll
        for (int a = 0; a < 2; ++a)
#pragma unroll
            for (int b = 0; b < 2; ++b)
#pragma unroll
                for (int m = 0; m < 4; ++m)
#pragma unroll
                    for (int n = 0; n < 2; ++n) acc[a][b][m][n] = (f32x4){0.f, 0.f, 0.f, 0.f};
        cur = nxt; cA = nA; cB = nB; ++ui;
        if constexpr (ALIGN_EPI) { if (wr == 1) PG8_BAR; }
    }
    PG8_WAIT_V(0);
    if constexpr (!ALIGN_EPI) { if (wr == 0) PG8_BAR; }
    PG8_BAR;
    if constexpr (Epi::AFTER_DRAIN) { E.fused(acc, cur, wr, wc, fr, fq, lds, wid, lane); S.done(cur); }
#undef PG8_SA
#undef PG8_SB
#undef PG8_STAGE
#undef PG8_LDA
#undef PG8_LDB
#undef PG8_MMA
#undef PG8_WAIT_V
#undef PG8_WAIT_L
#undef PG8_BAR
#undef PG8_SCHED
}
}
#define LAS __attribute__((address_space(3)))
#define XB_TMO      128
#define XB_XCNT(j)  (256  + 64 * (j))
#define XB_XSUB(j)  (1280 + 64 * (j))
#define XB_XGEN(j)  (2304 + 64 * (j))
#define XB_TOP      3328
#define XB_TOPGEN   3392
#define XCD_BAR_WORDS 3456
#define XB_SPIN_CAP (1u << 18)

__device__ __forceinline__ unsigned xb_ld(unsigned* p)              { return __hip_atomic_load(p, __ATOMIC_RELAXED, __HIP_MEMORY_SCOPE_AGENT); }
__device__ __forceinline__ unsigned xb_add(unsigned* p, unsigned v) { return __hip_atomic_fetch_add(p, v, __ATOMIC_RELAXED, __HIP_MEMORY_SCOPE_AGENT); }
__device__ __forceinline__ unsigned xb_xcc_id() { return (unsigned)__builtin_amdgcn_s_getreg((3 << 11) | 20) & 0xFu; }
#define XB_SPIN(cond, bar) do { unsigned _sp = 0; while (cond) { __builtin_amdgcn_s_sleep(1); \
    if ((++_sp & 255u) == 0u) { if (xb_ld(&(bar)[XB_TMO])) break; if (_sp > XB_SPIN_CAP) { atomicAdd(&(bar)[XB_TMO], 1u); break; } } } } while (0)

struct XcdBarrier {
    unsigned* bar; unsigned x;
    volatile LAS unsigned* st;
};

__device__ __forceinline__ XcdBarrier xcd_barrier_post(unsigned* bar, volatile LAS unsigned* st) {
    XcdBarrier b; b.bar = bar; b.x = xb_xcc_id(); b.st = st;
    if (threadIdx.x == 0) (void)xb_add(&bar[XB_XCNT(b.x)], 1u);
    return b;
}
__device__ __forceinline__ void xcd_barrier_complete(unsigned* bar, unsigned x, unsigned& nloc, unsigned& nx) {
    const unsigned G = gridDim.x * gridDim.y * gridDim.z;
    unsigned sum, cnt, mine, sp = 0u;
    for (;;) {
        sum = 0u; cnt = 0u; mine = 0u;
#pragma unroll
        for (unsigned j = 0; j < 16; ++j) { const unsigned c = xb_ld(&bar[XB_XCNT(j)]); sum += c; cnt += (c > 0u) ? 1u : 0u; mine = (j == x) ? c : mine; }
        if (sum == G) break;
        __builtin_amdgcn_s_sleep(1);
        if ((++sp & 255u) == 0u) { if (xb_ld(&bar[XB_TMO])) break; if (sp > XB_SPIN_CAP) { atomicAdd(&bar[XB_TMO], 1u); break; } }
    }
    nloc = mine > 0u ? mine : 1u; nx = cnt > 0u ? cnt : 1u;
}

__device__ __forceinline__ void xcd_barrier(const XcdBarrier& b) {
    asm volatile("s_waitcnt vmcnt(0)" ::: "memory");
    __syncthreads();
    if (threadIdx.x == 0) {
        unsigned* bar = b.bar;
        __builtin_amdgcn_s_waitcnt(0);
        unsigned nloc = b.st[0], nx = b.st[1];
        if (nloc == 0u) { xcd_barrier_complete(bar, b.x, nloc, nx); b.st[0] = nloc; b.st[1] = nx; }
        const unsigned old = xb_add(&bar[XB_XSUB(b.x)], 1u);
        const unsigned gen = old / nloc;
        if (old + 1u == (gen + 1u) * nloc) {
            __builtin_amdgcn_fence(__ATOMIC_RELEASE, "agent");
            asm volatile("s_waitcnt vmcnt(0)" ::: "memory");
            const unsigned og = xb_add(&bar[XB_TOP], 1u);
            const unsigned tg = og / nx;
            if (og + 1u == (tg + 1u) * nx) xb_add(&bar[XB_TOPGEN], 1u);
            else XB_SPIN(xb_ld(&bar[XB_TOPGEN]) == tg, bar);
            __builtin_amdgcn_fence(__ATOMIC_ACQUIRE, "agent");
            xb_add(&bar[XB_XGEN(b.x)], 1u);
            asm volatile("s_waitcnt vmcnt(0)" ::: "memory");
        } else {
            XB_SPIN(xb_ld(&bar[XB_XGEN(b.x)]) == gen, bar);
            __builtin_amdgcn_fence(__ATOMIC_ACQUIRE, "agent");
            asm volatile("s_waitcnt vmcnt(0)" ::: "memory");
        }
    }
    __syncthreads();
}

constexpr int DM = 1024, SEQ = 8192, MP = 16384, MS = 128, MR = MP + MS, RT = 16640;
constexpr int DFF = 2816, DV = 3072, NGA = 8, CGW = 384, NQG = 1280, NKVP = 1536;
constexpr int NMOD = 40960;
constexpr int MODKV = 36864, MODFIN = 38912;
constexpr int NPAGES = 16, PAST = 2048;
constexpr float LOG2E = 1.4426950408889634f;
#ifndef ONE_LAUNCH
#define ONE_LAUNCH 1
#endif

constexpr size_t OY_P = 0, OY_S = 16777216, OKV_P = 16908288, OKV_S = 33685504, OWIN_P = 33816576, OWIN_S = 34340864, OGV = 67895296, OUT_TOTAL = 68681728;

constexpr size_t al(size_t x) { return (x + 0xFFFFFull) & ~0xFFFFFull; }
constexpr size_t WS_CTL = 0, CTL_ZERO_BYTES = 2u << 20;
constexpr size_t WS_WMOD = al(CTL_ZERO_BYTES);
constexpr size_t WS_WGU = al(WS_WMOD + (size_t)NMOD * DM * 2);
constexpr size_t WS_WDN = al(WS_WGU + (size_t)8 * 5632 * DM * 2);
constexpr size_t WS_WUV = al(WS_WDN + (size_t)8 * DM * DFF * 2);
constexpr size_t WS_WOUT = al(WS_WUV + (size_t)2 * 6144 * DM * 2);
constexpr size_t WS_WQG = al(WS_WOUT + (size_t)2 * DM * DV * 2);
constexpr size_t WS_WO = al(WS_WQG + (size_t)2 * NQG * DM * 2);
constexpr size_t WS_WKV = al(WS_WO + (size_t)2 * DM * DM * 2);
constexpr size_t WS_WC1 = al(WS_WKV + (size_t)NKVP * DM * 2);
constexpr size_t WS_WC2 = al(WS_WC1 + (size_t)2 * 512 * 1024 * 2);
constexpr size_t WS_WSP = al(WS_WC2 + (size_t)2 * 64 * 256 * 2);
constexpr size_t WS_CBIAS = al(WS_WSP + (size_t)2 * 8 * 128 * 128 * 2);
constexpr size_t WS_X = al(WS_CBIAS + 4096);
constexpr size_t WS_H = al(WS_X + (size_t)RT * DM * 2);
constexpr size_t WS_HID = al(WS_H + (size_t)RT * DM * 2);
constexpr size_t WS_Z = al(WS_HID + (size_t)RT * DFF * 2);
constexpr size_t WS_VT = al(WS_Z + (size_t)RT * 6144 * 2);
constexpr size_t WS_P = al(WS_VT + (size_t)128 * DV * 128 * 2);
constexpr size_t WS_Q = al(WS_P + (size_t)RT * DV * 2);
constexpr size_t WS_GATES = al(WS_Q + (size_t)RT * DM * 2);
constexpr size_t WS_O = al(WS_GATES + (size_t)RT * 48 * 4);
constexpr size_t KVB = (size_t)8 * SEQ * 64 * 2;
constexpr size_t WS_KCIN = al(WS_O + (size_t)RT * DM * 2);
constexpr size_t WS_VCIN = WS_KCIN + KVB, WS_SK = WS_VCIN + KVB, WS_SVT = WS_SK + KVB, WS_WK = WS_SVT + KVB, WS_WVT = WS_WK + KVB;
constexpr size_t WS_MOD = al(WS_WVT + KVB);
constexpr size_t WS_SC = al(WS_MOD + (size_t)256 * NMOD * 4);
constexpr size_t WS_TK = al(WS_SC + (size_t)256 * DM * 2);
constexpr size_t WS_TV = al(WS_TK + (size_t)4096 * 512 * 2);
constexpr size_t WS_KC = al(WS_TV + (size_t)4096 * 512 * 2);
constexpr size_t WS_VCT = al(WS_KC + (size_t)8 * 512 * 64 * 2);
constexpr size_t WS_ACMP = al(WS_VCT + (size_t)8 * 64 * 512 * 2);
constexpr size_t WS_TS = al(WS_ACMP + (size_t)2 * 65536 * 1024 * 2);
constexpr size_t WS_KCS = al(WS_TS + (size_t)2 * 65536 * 512 * 2);
constexpr size_t WS_VCS = al(WS_KCS + (size_t)512 * 128 * 64 * 4);
constexpr size_t WS_OACC = al(WS_VCS + (size_t)512 * 128 * 64 * 4);
constexpr size_t WS_HKV = al(WS_OACC + (size_t)MP * DM * 4);
constexpr size_t WS_SHB = al(WS_HKV + (size_t)RT * DM * 2);
constexpr size_t WS_B2 = al(WS_SHB + (size_t)13 * 256 * 1024 * 2);
constexpr size_t WS_NG = al(WS_B2 + (size_t)13 * 256 * 6144 * 4);
constexpr size_t WS_SSP = al(WS_NG + (size_t)13 * 1024 * 4);
constexpr size_t WS_SSPS = al(WS_SSP + (size_t)11 * MP * 16 * 4);
constexpr size_t WS_END = al(WS_SSPS + (size_t)11 * MS * 32 * 4);

constexpr int CW_BAR = 4096, CW_QUEUE = 8192, CW_SS = 32768, CW_VS = CW_SS + 11 * 16640;
static_assert((size_t)(CW_VS + 2 * 16640 * 2) * 4 <= CTL_ZERO_BYTES, "SS / VS accumulators inside the memset region");

constexpr int RING_BYTES = 131072, LDSCTL_OFF = RING_BYTES, MISC_OFF = LDSCTL_OFF + 320, LDS_BYTES = 147456;
constexpr int NWAVES = 8;

#define GAS __attribute__((address_space(1)))
typedef unsigned short bf16;
typedef unsigned v4u __attribute__((ext_vector_type(4)));
typedef unsigned v2u __attribute__((ext_vector_type(2)));
typedef float f32x4 __attribute__((ext_vector_type(4)));
typedef short bf16x8 __attribute__((ext_vector_type(8)));
typedef short bf16x4 __attribute__((ext_vector_type(4)));
typedef float f32x2 __attribute__((ext_vector_type(2)));
typedef _Float16 f16x4 __attribute__((ext_vector_type(4)));
typedef _Float16 f16x8 __attribute__((ext_vector_type(8)));
typedef _Float16 f16;

__device__ __forceinline__ float bf2f(unsigned b) { return __uint_as_float(b << 16); }
__device__ __forceinline__ float bflo(unsigned w) { return __uint_as_float(w << 16); }
__device__ __forceinline__ float bfhi(unsigned w) { return __uint_as_float(w & 0xffff0000u); }
__device__ __forceinline__ unsigned pk2(float lo, float hi) { return pg8::cvt_pk_bf16(lo, hi); }
__device__ __forceinline__ float frcp(float x) { return __builtin_amdgcn_rcpf(x); }
__device__ __forceinline__ float fexp2(float x) { return __builtin_amdgcn_exp2f(x); }
__device__ __forceinline__ float sigmoid_f(float x) { return frcp(1.f + fexp2(-LOG2E * x)); }
__device__ __forceinline__ float silu_f(float x) { return x * sigmoid_f(x); }
__device__ __forceinline__ float gelu_tanh_f(float x) { const float u = x + 0.044715f * x * x * x; return x * frcp(1.f + fexp2(-2.302208198f * u)); }
__device__ __forceinline__ int row_b(int r) { return r < SEQ ? 0 : (r < MP ? 1 : 2 + ((r - MP) < MS ? (r - MP) : (MS - 1))); }
template <int CTRL> __device__ __forceinline__ float dppf(float x) { return __builtin_bit_cast(float, __builtin_amdgcn_mov_dpp(__builtin_bit_cast(int, x), CTRL, 0xF, 0xF, true)); }
template <int CTRL> __device__ __forceinline__ unsigned dppu(unsigned x) { return (unsigned)__builtin_amdgcn_mov_dpp((int)x, CTRL, 0xF, 0xF, true); }
#define DPP_X1 0xB1
#define DPP_X2 0x4E
#define DPP_HM 0x141
#define DPP_RM 0x140
#define DPP_X8 0x128
__device__ __forceinline__ void xpair16(float x, float& a, float& b) { auto r = __builtin_amdgcn_permlane16_swap(__float_as_uint(x), __float_as_uint(x), false, false); a = __uint_as_float(r[0]); b = __uint_as_float(r[1]); }
__device__ __forceinline__ void xpair32(float x, float& a, float& b) { auto r = __builtin_amdgcn_permlane32_swap(__float_as_uint(x), __float_as_uint(x), false, false); a = __uint_as_float(r[0]); b = __uint_as_float(r[1]); }
__device__ __forceinline__ void xpair16i(int x, int& a, int& b) { auto r = __builtin_amdgcn_permlane16_swap((unsigned)x, (unsigned)x, false, false); a = (int)r[0]; b = (int)r[1]; }
__device__ __forceinline__ void xpair32i(int x, int& a, int& b) { auto r = __builtin_amdgcn_permlane32_swap((unsigned)x, (unsigned)x, false, false); a = (int)r[0]; b = (int)r[1]; }
__device__ __forceinline__ float xsum_16_32(float x) { float a, b; xpair16(x, a, b); x = a + b; xpair32(x, a, b); return a + b; }
__device__ __forceinline__ float xmax_16_32(float x) { float a, b; xpair16(x, a, b); x = fmaxf(a, b); xpair32(x, a, b); return fmaxf(a, b); }
__device__ __forceinline__ float wave_sum(float v) { v += dppf<DPP_X1>(v); v += dppf<DPP_X2>(v); v += dppf<DPP_HM>(v); v += dppf<DPP_RM>(v); return xsum_16_32(v); }
__device__ __forceinline__ v4u pack8(const f32x4 a, const f32x4 b) { v4u w; w.x = pk2(a[0], a[1]); w.y = pk2(a[2], a[3]); w.z = pk2(b[0], b[1]); w.w = pk2(b[2], b[3]); return w; }
__device__ __forceinline__ void unpack8(const v4u w, float (&f)[8]) { f[0] = bflo(w.x); f[1] = bfhi(w.x); f[2] = bflo(w.y); f[3] = bfhi(w.y); f[4] = bflo(w.z); f[5] = bfhi(w.z); f[6] = bflo(w.w); f[7] = bfhi(w.w); }

template <class F> struct Epi8 {
    static constexpr bool PERM = true, AFTER_DRAIN = false; F f;
    __device__ __forceinline__ void operator()(const pg8::f32x4 (&acc)[2][2][4][2], const pg8::Unit& u, int wr, int wc, int fr, int fq) const {
        const int row0 = u.pm * pg8::BM + wr * 64 + fr, col0 = u.pn * pg8::BM + wc * 32 + 8 * fq;
        typename F::Pre pre; f.prep(pre, row0, col0, false);
#pragma unroll
        for (int ai = 0; ai < 2; ++ai)
#pragma unroll
            for (int mh = 0; mh < 2; ++mh) {
                typename F::Ld ld[2][2];
#pragma unroll
                for (int m2 = 0; m2 < 2; ++m2)
#pragma unroll
                    for (int bj = 0; bj < 2; ++bj) f.fetch(ld[m2][bj], row0 + ai * pg8::HALF + (2 * mh + m2) * 16, col0 + bj * pg8::HALF);
#pragma unroll
                for (int m2 = 0; m2 < 2; ++m2) { const int m = 2 * mh + m2, row = row0 + ai * pg8::HALF + m * 16;
                    f32x2 part = (f32x2){0.f, 0.f};
#pragma unroll
                    for (int bj = 0; bj < 2; ++bj) part = part + f(pre, ld[m2][bj], ai * 4 + m, bj, row, col0 + bj * pg8::HALF, acc[ai][bj][m][0], acc[ai][bj][m][1]);
                    f.row_done(row, part, fq); }
            }
    }
};
struct NoLd {};
struct NoPre {};
struct NormPre { float rs[8]; f32x4 b[2][2]; };
struct NormIn { unsigned char* ws; int ssi, inst, on;
    __device__ __forceinline__ void prep(NormPre& p, int row0, int col0, bool skinny) const {
        if (!on) return;
        const float* SS = (const float*)(ws + WS_CTL) + CW_SS + (size_t)ssi * RT; const float* b = (const float*)(ws + WS_B2) + ((size_t)inst * 256 + row_b(row0)) * 6144 + col0;
        if (skinny) { p.rs[0] = SS[row0]; p.b[0][0] = *(const f32x4*)b; p.b[0][1] = *(const f32x4*)(b + 4); p.rs[0] = __builtin_amdgcn_rsqf(p.rs[0] * (1.0f / DM) + 1e-6f); }
        else {
#pragma unroll
            for (int i = 0; i < 8; ++i) p.rs[i] = SS[row0 + (i >> 2) * 128 + (i & 3) * 16];
#pragma unroll
            for (int bj = 0; bj < 2; ++bj) { p.b[bj][0] = *(const f32x4*)(b + 128 * bj); p.b[bj][1] = *(const f32x4*)(b + 128 * bj + 4); }
#pragma unroll
            for (int i = 0; i < 8; ++i) p.rs[i] = __builtin_amdgcn_rsqf(p.rs[i] * (1.0f / DM) + 1e-6f);
        }
    }
    __device__ __forceinline__ void apply(const NormPre& p, int ri, int bj, f32x4& v0, f32x4& v1) const { if (on) { v0 = v0 * p.rs[ri] + p.b[bj][0]; v1 = v1 * p.rs[ri] + p.b[bj][1]; } }
};
struct FSwiglu {
    typedef NormPre Pre; typedef NoLd Ld; __device__ __forceinline__ void fetch(Ld&, int, int) const {} bf16* HID; NormIn ni;
    __device__ __forceinline__ void prep(Pre& p, int row0, int col0, bool sk) const { ni.prep(p, row0, col0, sk); }
    __device__ __forceinline__ f32x2 operator()(const Pre& p, const Ld&, int ri, int bj, int row, int col0, f32x4 g, f32x4 u) const {
        ni.apply(p, ri, bj, g, u);
        v2u w; w.x = pk2(silu_f(g[0]) * u[0], silu_f(g[1]) * u[1]); w.y = pk2(silu_f(g[2]) * u[2], silu_f(g[3]) * u[3]);
        *(v2u*)(HID + (size_t)row * DFF + (col0 >> 1)) = w; return (f32x2){0.f, 0.f};
    }
    __device__ __forceinline__ void row_done(int, f32x2, int) const {}
};
struct ResidPre { f32x4 gate[2][2], hm[2][2]; };
struct FResid {
    typedef ResidPre Pre; struct Ld { f32x4 x0, x1; };
    unsigned char* ws; int gcol; float coef; int n1, sc1, n2, sc2, ssi;
    __device__ __forceinline__ void fetch(Ld& d, int row, int col0) const { const f16x8 h = *(const f16x8*)((const f16*)(ws + WS_X) + (size_t)row * DM + col0); const f16x4 lo = __builtin_shufflevector(h, h, 0, 1, 2, 3), hi = __builtin_shufflevector(h, h, 4, 5, 6, 7);
        d.x0 = __builtin_convertvector(lo, f32x4); d.x1 = __builtin_convertvector(hi, f32x4); }
    __device__ __forceinline__ void prep(Pre& p, int row0, int col0, bool skinny) const {
        const float* mrow = (const float*)(ws + WS_MOD) + (size_t)row_b(row0) * NMOD + col0;
#pragma unroll
        for (int bj = 0; bj < 2; ++bj) { if (skinny && bj) break;
            p.gate[bj][0] = *(const f32x4*)(mrow + gcol + 128 * bj) * coef; p.gate[bj][1] = *(const f32x4*)(mrow + gcol + 128 * bj + 4) * coef;
            if (n1 >= 0) { const float* g1 = (const float*)(ws + WS_NG) + n1 * DM + col0 + 128 * bj;
                p.hm[bj][0] = *(const f32x4*)g1 * (*(const f32x4*)(mrow + sc1 + 128 * bj) + 1.0f); p.hm[bj][1] = *(const f32x4*)(g1 + 4) * (*(const f32x4*)(mrow + sc1 + 128 * bj + 4) + 1.0f); } }
    }
    __device__ __forceinline__ f32x2 operator()(const Pre& p, const Ld& d, int ri, int bj, int row, int col0, f32x4 v0, f32x4 v1) const {
        const f32x4 x0 = d.x0 + p.gate[bj][0] * v0, x1 = d.x1 + p.gate[bj][1] * v1;
        { const f16x4 lo = __builtin_convertvector(x0, f16x4), hi = __builtin_convertvector(x1, f16x4); *(f16x8*)((f16*)(ws + WS_X) + (size_t)row * DM + col0) = __builtin_shufflevector(lo, hi, 0, 1, 2, 3, 4, 5, 6, 7); }
        if (n1 >= 0) *(v4u*)((bf16*)(ws + WS_H) + (size_t)row * DM + col0) = pack8(x0 * p.hm[bj][0], x1 * p.hm[bj][1]);
        if (n2 >= 0) { const float* mrow = (const float*)(ws + WS_MOD) + (size_t)row_b(row) * NMOD + col0; const float* g2 = (const float*)(ws + WS_NG) + n2 * DM + col0;
            const f32x4 a0 = *(const f32x4*)g2, a1 = *(const f32x4*)(g2 + 4), s0 = *(const f32x4*)(mrow + sc2), s1 = *(const f32x4*)(mrow + sc2 + 4);
            *(v4u*)((bf16*)(ws + WS_HKV) + (size_t)row * DM + col0) = pack8(x0 * a0 * (s0 + 1.0f), x1 * a1 * (s1 + 1.0f)); }
        return (f32x2){((x0[0] * x0[0] + x0[1] * x0[1]) + (x0[2] * x0[2] + x0[3] * x0[3])) + ((x1[0] * x1[0] + x1[1] * x1[1]) + (x1[2] * x1[2] + x1[3] * x1[3])), 0.f};
    }
    __device__ __forceinline__ void row_done(int row, f32x2 part2, int fq) const {
        float part = part2[0];
        if (ssi >= 0) { part = xsum_16_32(part); if (fq == 0) atomicAdd((float*)(ws + WS_CTL) + CW_SS + (size_t)ssi * RT + row, part); }
    }
};
struct FGelu {
    typedef NormPre Pre; typedef NoLd Ld; __device__ __forceinline__ void fetch(Ld&, int, int) const {} bf16* Z; NormIn ni; float* VS;
    __device__ __forceinline__ void prep(Pre& p, int row0, int col0, bool sk) const { ni.prep(p, row0, col0, sk); }
    __device__ __forceinline__ f32x2 operator()(const Pre& p, const Ld&, int ri, int bj, int row, int col0, f32x4 v0, f32x4 v1) const {
        ni.apply(p, ri, bj, v0, v1);
        f32x4 a, b;
#pragma unroll
        for (int i = 0; i < 4; ++i) { a[i] = gelu_tanh_f(v0[i]); b[i] = gelu_tanh_f(v1[i]); }
        *(v4u*)(Z + (size_t)row * 6144 + col0) = pack8(a, b);
        if (col0 < DV) return (f32x2){0.f, 0.f};
        const f32x4 s = a + b, q = a * a + b * b; return (f32x2){(s[0] + s[1]) + (s[2] + s[3]), (q[0] + q[1]) + (q[2] + q[3])};
    }
    __device__ __forceinline__ void row_done(int row, f32x2 part, int fq) const {
        float s = part[0], q = part[1];
        s = xsum_16_32(s); q = xsum_16_32(q);
        if (fq == 0 && q != 0.f) { atomicAdd(VS + 2 * (size_t)row, s); atomicAdd(VS + 2 * (size_t)row + 1, q); }
    }
};
struct FQg {
    typedef NormPre Pre; typedef NoLd Ld; __device__ __forceinline__ void fetch(Ld&, int, int) const {} bf16* Q; float* GATES; NormIn ni;
    __device__ __forceinline__ void prep(Pre& p, int row0, int col0, bool sk) const { ni.prep(p, row0, col0, sk); }
    __device__ __forceinline__ f32x2 operator()(const Pre& p, const Ld&, int ri, int bj, int row, int col0, f32x4 v0, f32x4 v1) const {
        ni.apply(p, ri, bj, v0, v1);
        if (col0 < DM) { *(v4u*)(Q + (size_t)row * DM + col0) = pack8(v0 * (0.125f * LOG2E), v1 * (0.125f * LOG2E)); }
        else if (col0 < DM + 48) { f32x4 a, b;
#pragma unroll
            for (int i = 0; i < 4; ++i) { a[i] = sigmoid_f(v0[i]); b[i] = sigmoid_f(v1[i]); }
            float* gp = GATES + (size_t)row * 48 + (col0 - DM); *(f32x4*)gp = a; *(f32x4*)(gp + 4) = b; }
        return (f32x2){0.f, 0.f};
    }
    __device__ __forceinline__ void row_done(int, f32x2, int) const {}
};
struct FKv {
    typedef NormPre Pre; typedef NoLd Ld; __device__ __forceinline__ void fetch(Ld&, int, int) const {} float* out; bf16 *KCIN; NormIn ni;
    __device__ __forceinline__ void prep(Pre& p, int row0, int col0, bool sk) const { ni.prep(p, row0, col0, sk); }
    __device__ __forceinline__ f32x2 operator()(const Pre& p, const Ld&, int ri, int bj, int row, int col0, f32x4 v0, f32x4 v1) const {
        ni.apply(p, ri, bj, v0, v1);
        const int slot = col0 >> 8, g = (col0 >> 6) & 3, d0 = col0 & 63;
        if (row < MP) {
            const int b = row >> 13, t = row & (SEQ - 1);
            if (slot < 4) { float* q = out + OKV_P + (size_t)row * DM + col0; *(f32x4*)q = v0; *(f32x4*)(q + 4) = v1; }
            else if (t >= SEQ - 512) { float* q = out + OWIN_P + ((size_t)(b * 512 + (t - (SEQ - 512))) * 2 + (slot - 4)) * 256 + g * 64 + d0; *(f32x4*)q = v0; *(f32x4*)(q + 4) = v1; }
            const int bg = b * 4 + g;
            if (slot == 3 || slot == 5) {
                bf16* base = KCIN + (size_t)slot * (KVB / 2) + (((size_t)bg * (SEQ / 32) + (t >> 5)) * 64 + d0) * 32 + (t & 31);
#pragma unroll
                for (int i = 0; i < 4; ++i) { base[i * 32] = (bf16)(pk2(v0[i], 0.f) & 0xffffu); base[(i + 4) * 32] = (bf16)(pk2(v1[i], 0.f) & 0xffffu); }
            } else {
                bf16* base = KCIN + (size_t)slot * (KVB / 2) + ((size_t)bg * SEQ + t) * 64 + d0;
                *(v4u*)base = pack8(v0, v1);
            }
        } else {
            const int bs = row - MP;
            if (slot < 4) { float* q = out + OKV_S + (size_t)bs * DM + col0; *(f32x4*)q = v0; *(f32x4*)(q + 4) = v1; }
            else { float* q = out + OWIN_S + ((size_t)bs * 512 + 511) * 512 + (slot - 4) * 256 + g * 64 + d0; *(f32x4*)q = v0; *(f32x4*)(q + 4) = v1; }
        }
        return (f32x2){0.f, 0.f};
    }
    __device__ __forceinline__ void row_done(int, f32x2, int) const {}
};
constexpr int SH_NINST = 13;
struct FMod {
    typedef NoPre Pre; typedef NoLd Ld; __device__ __forceinline__ void fetch(Ld&, int, int) const {} float* MOD; const float *b0, *b1, *b2; bf16* SHB;
    __device__ __forceinline__ void prep(Pre&, int, int, bool) const {}
    __device__ __forceinline__ f32x2 operator()(const Pre&, const Ld&, int, int, int row, int col0, f32x4 v0, f32x4 v1) const {
        const float* bp = col0 < MODKV ? b0 + col0 : (col0 < MODFIN ? b1 + (col0 - MODKV) : b2 + (col0 - MODFIN));
        v0 = v0 + *(const f32x4*)bp; v1 = v1 + *(const f32x4*)(bp + 4);
        float* p = MOD + (size_t)row * NMOD + col0; *(f32x4*)p = v0; *(f32x4*)(p + 4) = v1;
        int inst = -1, k = 0;
        if (col0 < MODKV) { const int l = col0 / 9216, r = col0 - l * 9216, sub = r / 3072, rr = r - sub * 3072; if (rr < DM) { inst = l * 3 + sub; k = rr; } }
        else if (col0 < MODKV + DM) { inst = 12; k = col0 - MODKV; }
        if (inst >= 0) *(v4u*)(SHB + ((size_t)inst * 256 + row) * DM + k) = pack8(v0, v1);
        return (f32x2){0.f, 0.f};
    }
    __device__ __forceinline__ void row_done(int, f32x2, int) const {}
};
struct FBf16 {
    typedef NoPre Pre; typedef NoLd Ld; __device__ __forceinline__ void fetch(Ld&, int, int) const {} bf16* T; int ld;
    __device__ __forceinline__ void prep(Pre&, int, int, bool) const {}
    __device__ __forceinline__ f32x2 operator()(const Pre&, const Ld&, int, int, int row, int col0, f32x4 v0, f32x4 v1) const { *(v4u*)(T + (size_t)row * ld + col0) = pack8(v0, v1); return (f32x2){0.f, 0.f}; }
    __device__ __forceinline__ void row_done(int, f32x2, int) const {}
};
constexpr int TILEB = 256 * 1024 * 2;
constexpr int PN_UV = (int)((WS_WUV - WS_WGU) / TILEB), PN_QG = (int)((WS_WQG - WS_WGU) / TILEB), PN_KV = (int)((WS_WKV - WS_WGU) / TILEB);
static_assert((WS_WUV - WS_WGU) % TILEB == 0 && (WS_WQG - WS_WGU) % TILEB == 0 && (WS_WKV - WS_WGU) % TILEB == 0, "weight copies on 256-row tile boundaries");
struct ShiftOrder {
    int G, c;
    __device__ __forceinline__ bool next(int i, pg8::Unit& u) const {
        const int L = i * G + c; if (L >= 240) return false;
        if (L < 176) { const int f = L / 22, t = L - f * 22; u.pm = (f >> 1) * 3 + 2 * (f & 1); u.pn = f * 22 + t; }
        else if (L < 224) { const int q = L - 176, l = q / 24, t = q - l * 24; u.pm = l * 3 + 1; u.pn = PN_UV + l * 24 + t; }
        else if (L < 234) { const int q = L - 224, j = q / 5, t = q - j * 5; u.pm = (2 + j) * 3 + 1; u.pn = PN_QG + j * 5 + t; }
        else { u.pm = 12; u.pn = PN_KV + (L - 234); }
        return true;
    }
    __device__ __forceinline__ void a_ready(const pg8::Unit&) const {}
    __device__ __forceinline__ void done(const pg8::Unit&) const {}
};
struct FB2 {
    typedef NoPre Pre; typedef NoLd Ld; __device__ __forceinline__ void fetch(Ld&, int, int) const {} float* B2;
    __device__ __forceinline__ void prep(Pre&, int, int, bool) const {}
    __device__ __forceinline__ f32x2 operator()(const Pre&, const Ld&, int, int, int row, int col0, f32x4 v0, f32x4 v1) const {
        const int inst = row >> 8, b = row & 255, pn = col0 >> 8;
        int t;
        if (pn < 176) t = pn % 22; else if (pn < PN_QG) t = (pn - PN_UV) % 24; else if (pn < PN_KV) t = (pn - PN_QG) % 5; else t = pn - PN_KV;
        float* p = B2 + ((size_t)inst * 256 + b) * 6144 + t * 256 + (col0 & 255); *(f32x4*)p = v0; *(f32x4*)(p + 4) = v1; return (f32x2){0.f, 0.f};
    }
    __device__ __forceinline__ void row_done(int, f32x2, int) const {}
};

template <class F> __device__ __forceinline__ void run_gemm(LAS unsigned char* lds, const bf16* A, const bf16* Bt, int M, int N, int K, const F& f, int rot = 0) {
    int cblk = ((int)blockIdx.x + rot) % (int)gridDim.x; asm volatile("" : "+s"(cblk));
    pg8::Gemm g{A, Bt, M, N, K}; pg8::StaticOrder S; S.init(M, N, (int)gridDim.x, cblk);
    Epi8<F> E{f};
    pg8::gemm_phase<Epi8<F>, pg8::StaticOrder, true, true>(lds, g, S, E);
}

template <int RTU, int SB, class F> __device__ __forceinline__ void skinny_gemm(LAS unsigned char* lds, const bf16* A, const bf16* Bt, int ncol32, int K, int rem, const F& f) {
    int tid_raw = threadIdx.x; asm volatile("" : "+v"(tid_raw));
    const int lane = tid_raw & 63, wave = __builtin_amdgcn_readfirstlane(tid_raw >> 6), fr = lane & 15, fq = lane >> 4;
    constexpr int NR = 8 / RTU;
    const int kper = K >> 3, nsteps = kper >> 5, nunits = NR * ncol32;
    int cblk = (int)blockIdx.x; asm volatile("" : "+s"(cblk));
    const int nl = (int)gridDim.x - rem;
    LAS f32x4* red = (LAS f32x4*)lds;
    if (cblk < rem) return;
    for (int u = cblk - rem; u < nunits; u += nl) {
        const int n0 = 32 * (u / NR), r0 = MP + 16 * RTU * (u % NR);
        f32x4 acc[RTU][2];
#pragma unroll
        for (int rt = 0; rt < RTU; ++rt) { acc[rt][0] = (f32x4){0.f, 0.f, 0.f, 0.f}; acc[rt][1] = (f32x4){0.f, 0.f, 0.f, 0.f}; }
        const bf16* bp = Bt + (size_t)(n0 + 8 * (fr >> 2) + (fr & 3)) * K + wave * kper + 8 * fq;
        const bf16* ap = A + (size_t)(r0 + fr) * K + wave * kper + 8 * fq;
        const int row = r0 + 16 * (wave < RTU ? wave : 0) + fr;
        typename F::Pre pre; typename F::Ld ld;
        if (wave < RTU) { f.fetch(ld, row, n0 + 8 * fq); f.prep(pre, row, n0 + 8 * fq, true); }
#pragma unroll 1
        for (int ks0 = 0; ks0 < nsteps; ks0 += SB) {
            bf16x8 bb[SB][2], aa[SB][RTU];
#pragma unroll
            for (int s = 0; s < SB; ++s) { const int ks = (ks0 + s < nsteps) ? ks0 + s : nsteps - 1;
                bb[s][0] = *(const bf16x8*)(bp + 32 * ks); bb[s][1] = *(const bf16x8*)(bp + (size_t)4 * K + 32 * ks);
#pragma unroll
                for (int rt = 0; rt < RTU; ++rt) aa[s][rt] = *(const bf16x8*)(ap + (size_t)(16 * rt) * K + 32 * ks); }
#pragma unroll
            for (int s = 0; s < SB; ++s) if (ks0 + s < nsteps) {
#pragma unroll
                for (int rt = 0; rt < RTU; ++rt) { acc[rt][0] = __builtin_amdgcn_mfma_f32_16x16x32_bf16(bb[s][0], aa[s][rt], acc[rt][0], 0, 0, 0); acc[rt][1] = __builtin_amdgcn_mfma_f32_16x16x32_bf16(bb[s][1], aa[s][rt], acc[rt][1], 0, 0, 0); } }
        }
#pragma unroll
        for (int rt = 0; rt < RTU; ++rt) { red[((wave * RTU + rt) * 2 + 0) * 64 + lane] = acc[rt][0]; red[((wave * RTU + rt) * 2 + 1) * 64 + lane] = acc[rt][1]; }
        __syncthreads();
        if (wave < RTU) {
            f32x4 s0 = (f32x4){0.f, 0.f, 0.f, 0.f}, s1 = (f32x4){0.f, 0.f, 0.f, 0.f};
#pragma unroll
            for (int w2 = 0; w2 < 8; ++w2) { s0 = s0 + red[((w2 * RTU + wave) * 2 + 0) * 64 + lane]; s1 = s1 + red[((w2 * RTU + wave) * 2 + 1) * 64 + lane]; }
            const f32x2 part = f(pre, ld, 0, 0, row, n0 + 8 * fq, s0, s1); f.row_done(row, part, fq);
        }
        __syncthreads();
    }
}
template <class F> __device__ __forceinline__ void run_gemm2(LAS unsigned char* lds, const bf16* A, const bf16* Bt, int N, int Nreal, int K, const F& f, int rot = 0, int rem = -1) {
    run_gemm(lds, A, Bt, MP, N, K, f, rot);
    skinny_gemm<4, 6>(lds, A, Bt, (Nreal + 31) >> 5, K, rem >= 0 ? rem : ((MP / 256) * (N / 256)) % (int)gridDim.x, f);
}
template <class F> __device__ __forceinline__ void run_gemm2r(LAS unsigned char* lds, const bf16* A, const bf16* Bt, int K, const F& f) {
    run_gemm(lds, A, Bt, MP, DM, K, f, 0);
    skinny_gemm<1, 12>(lds, A, Bt, DM / 32, K, 0, f);
}

template <bool FINAL>
__device__ __forceinline__ void norm_phase(const f16* X, const float* gvec, const float* MOD, int shift_col, int scale_col, bf16* H, float* out, int gw, int NGW, int lane) {
    for (int r = gw; r < MR; r += NGW) {
        const f16x4* xr = (const f16x4*)(X + (size_t)r * DM) + lane;
        f32x4 v[4]; float ss = 0.f;
#pragma unroll
        for (int j = 0; j < 4; ++j) { v[j] = __builtin_convertvector(xr[64 * j], f32x4); ss += (v[j][0] * v[j][0] + v[j][1] * v[j][1]) + (v[j][2] * v[j][2] + v[j][3] * v[j][3]); }
        ss = wave_sum(ss);
        const float rstd = 1.0f / sqrtf(ss * (1.0f / DM) + 1e-6f);
        const float* mrow = MOD + (size_t)row_b(r) * NMOD;
#pragma unroll
        for (int j = 0; j < 4; ++j) { const int c = 4 * lane + 256 * j;
            const f32x4 gv = *(const f32x4*)(gvec + c), sh = *(const f32x4*)(mrow + shift_col + c), sc = *(const f32x4*)(mrow + scale_col + c);
            const f32x4 y = (v[j] * rstd) * gv * (sc + 1.0f) + sh;
            if (FINAL) { float* o = (r < MP) ? out + OY_P + (size_t)r * DM + c : out + OY_S + (size_t)(r - MP) * DM + c; *(f32x4*)o = y; }
            else { v2u w; w.x = pk2(y[0], y[1]); w.y = pk2(y[2], y[3]); *(v2u*)(H + (size_t)r * DM + c) = w; }
        }
    }
}

__device__ __forceinline__ void transpose_item(const float* W, int N, int ldw, bf16* WT, int ldt, int mode, int row_off, LAS float* scr, int item, int lane) {
    const int nblk = (N + 31) >> 5, kb = item / nblk, nb = item - kb * nblk, k0 = 64 * kb, n0 = 32 * nb;
    const int nn = n0 + (lane & 31); const bool okn = nn < N;
    float tv[32];
#pragma unroll
    for (int i = 0; i < 32; ++i) { const int kk = 2 * i + (lane >> 5); tv[i] = okn ? __builtin_nontemporal_load(W + (size_t)(k0 + kk) * ldw + nn) : 0.f; }
#pragma unroll
    for (int i = 0; i < 32; ++i) { const int kk = 2 * i + (lane >> 5); scr[kk * 33 + (lane & 31)] = tv[i]; }
    asm volatile("s_waitcnt lgkmcnt(0)" ::: "memory");
    const int c = lane & 7;
#pragma unroll
    for (int j = 0; j < 4; ++j) { const int n = (lane >> 3) + 8 * j; const LAS float* s = scr + (8 * c) * 33 + n;
        v4u o; o.x = pk2(s[0 * 33], s[1 * 33]); o.y = pk2(s[2 * 33], s[3 * 33]); o.z = pk2(s[4 * 33], s[5 * 33]); o.w = pk2(s[6 * 33], s[7 * 33]);
        const int ng = n0 + n;
        const int drow = mode == 0 ? row_off + ng : (8 * (ng >> 2) + (ng & 3) + (mode == 2 ? 4 : 0));
        if (ng < N) *(v4u*)(WT + (size_t)drow * ldt + k0 + 8 * c) = o; }
    asm volatile("s_waitcnt lgkmcnt(0)" ::: "memory");
}
struct TDesc { const float* src; int K, N, ldw; bf16* dst; int ldt, mode, row_off; };
struct Ptrs {
    const float *x_prompt, *x_sample, *cache_kv, *state_win; const int* page_table; const float *c_prompt, *c_sample, *ada_w, *ada_b, *norm_g, *w_gate, *w_up, *w_down,
        *w_uv, *ln_g, *ln_b, *w_sp, *b_sp, *w_out, *w_qg, *w_o, *kv_norm_g, *kv_ada_w, *kv_ada_b, *kv_w, *cmp_w1, *cmp_w2, *cmp_pe, *final_g, *final_ada_w, *final_ada_b;
    float* out; unsigned char* ws;
};
#define WSP(T, off) ((T*)(P.ws + (off)))
typedef const __attribute__((address_space(4))) unsigned long long* kptr_t;
__device__ __forceinline__ void load_ptrs(Ptrs& P) {
    kptr_t k = (kptr_t)__builtin_amdgcn_kernarg_segment_ptr();
    asm volatile("" : "+s"(k));
    P.x_prompt = (const float*)(GAS const float*)k[0]; P.x_sample = (const float*)(GAS const float*)k[1]; P.cache_kv = (const float*)(GAS const float*)k[2]; P.state_win = (const float*)(GAS const float*)k[3];
    P.page_table = (const int*)(GAS const int*)k[4]; P.c_prompt = (const float*)(GAS const float*)k[5]; P.c_sample = (const float*)(GAS const float*)k[6]; P.ada_w = (const float*)(GAS const float*)k[7];
    P.ada_b = (const float*)(GAS const float*)k[8]; P.norm_g = (const float*)(GAS const float*)k[9]; P.w_gate = (const float*)(GAS const float*)k[10]; P.w_up = (const float*)(GAS const float*)k[11];
    P.w_down = (const float*)(GAS const float*)k[12]; P.w_uv = (const float*)(GAS const float*)k[13]; P.ln_g = (const float*)(GAS const float*)k[14]; P.ln_b = (const float*)(GAS const float*)k[15];
    P.w_sp = (const float*)(GAS const float*)k[16]; P.b_sp = (const float*)(GAS const float*)k[17]; P.w_out = (const float*)(GAS const float*)k[18]; P.w_qg = (const float*)(GAS const float*)k[19];
    P.w_o = (const float*)(GAS const float*)k[20]; P.kv_norm_g = (const float*)(GAS const float*)k[21]; P.kv_ada_w = (const float*)(GAS const float*)k[22]; P.kv_ada_b = (const float*)(GAS const float*)k[23];
    P.kv_w = (const float*)(GAS const float*)k[24]; P.cmp_w1 = (const float*)(GAS const float*)k[25]; P.cmp_w2 = (const float*)(GAS const float*)k[26]; P.cmp_pe = (const float*)(GAS const float*)k[27];
    P.final_g = (const float*)(GAS const float*)k[28]; P.final_ada_w = (const float*)(GAS const float*)k[29]; P.final_ada_b = (const float*)(GAS const float*)k[30];
    P.out = (float*)(GAS float*)k[31]; P.ws = (unsigned char*)(GAS unsigned char*)k[32];
}
__device__ __forceinline__ void get_tdesc(const Ptrs& P, int id, TDesc& d) {
    d.mode = 0; d.row_off = 0; d.K = 1024; d.ldt = 1024;
    if (id < 4) { d.src = P.ada_w + (size_t)id * 1024 * 9216; d.N = 9216; d.dst = WSP(bf16, WS_WMOD); d.row_off = id * 9216; }
    else if (id == 4) { d.src = P.kv_ada_w; d.N = 2048; d.dst = WSP(bf16, WS_WMOD); d.row_off = MODKV; }
    else if (id == 5) { d.src = P.final_ada_w; d.N = 2048; d.dst = WSP(bf16, WS_WMOD); d.row_off = MODFIN; }
    else if (id < 14) { const int i = id - 6; d.src = P.w_gate + (size_t)i * 1024 * DFF; d.N = DFF; d.dst = WSP(bf16, WS_WGU) + (size_t)i * 5632 * 1024; d.mode = 1; }
    else if (id < 22) { const int i = id - 14; d.src = P.w_up + (size_t)i * 1024 * DFF; d.N = DFF; d.dst = WSP(bf16, WS_WGU) + (size_t)i * 5632 * 1024; d.mode = 2; }
    else if (id < 30) { const int i = id - 22; d.src = P.w_down + (size_t)i * DFF * 1024; d.K = DFF; d.N = 1024; d.dst = WSP(bf16, WS_WDN) + (size_t)i * 1024 * DFF; d.ldt = DFF; }
    else if (id < 32) { const int i = id - 30; d.src = P.w_uv + (size_t)i * 1024 * 6144; d.N = 6144; d.dst = WSP(bf16, WS_WUV) + (size_t)i * 6144 * 1024; }
    else if (id < 34) { const int i = id - 32; d.src = P.w_out + (size_t)i * DV * 1024; d.K = DV; d.N = 1024; d.dst = WSP(bf16, WS_WOUT) + (size_t)i * 1024 * DV; d.ldt = DV; }
    else if (id < 36) { const int i = id - 34; d.src = P.w_qg + (size_t)i * 1024 * 1072; d.N = 1072; d.dst = WSP(bf16, WS_WQG) + (size_t)i * NQG * 1024; }
    else if (id < 38) { const int i = id - 36; d.src = P.w_o + (size_t)i * 1024 * 1024; d.N = 1024; d.dst = WSP(bf16, WS_WO) + (size_t)i * 1024 * 1024; }
    else if (id == 38) { d.src = P.kv_w; d.N = NKVP; d.dst = WSP(bf16, WS_WKV); }
    else if (id < 43) { const int i = id - 39, kv = i >> 1, r = i & 1; d.src = P.cmp_w1 + (size_t)kv * 2048 * 256 + (size_t)r * 1024 * 256; d.N = 256; d.dst = WSP(bf16, WS_WC1) + (size_t)kv * 512 * 1024; d.row_off = r * 256; }
    else { const int kv = id - 43; d.src = P.cmp_w2 + (size_t)kv * 256 * 64; d.K = 256; d.N = 64; d.dst = WSP(bf16, WS_WC2) + (size_t)kv * 64 * 256; d.ldt = 256; }
    d.ldw = d.N;
}
constexpr int N_TMAT = 45;

__device__ __forceinline__ void prologue_phase(const Ptrs& P, LAS unsigned char* lds, int gw, int NGW, int wave, int lane, int tid) {
    if (blockIdx.x < 8) {
        const int kv = blockIdx.x >> 2, hb = blockIdx.x & 3; const float* pe = P.cmp_pe + kv * 2048; const float* w1 = P.cmp_w1 + (size_t)kv * 2048 * 256 + hb * 64 + lane;
        float acc = 0.f;
#pragma unroll 8
        for (int k = wave * 256; k < wave * 256 + 256; ++k) acc += pe[k] * w1[(size_t)k * 256];
        LAS float* red = (LAS float*)lds;
        red[wave * 64 + lane] = acc;
        __syncthreads();
        if (wave == 0) { float s = 0.f;
#pragma unroll
            for (int w = 0; w < 8; ++w) s += red[w * 64 + lane];
            WSP(float, WS_CBIAS)[kv * 256 + hb * 64 + lane] = s; }
        __syncthreads();
    }
    { LAS float* scr = (LAS float*)(lds + wave * 16384); int off = 0;
      for (int id = 0; id < N_TMAT; ++id) { TDesc d; get_tdesc(P, id, d);
          const int nitems = (d.K >> 6) * ((d.N + 31) >> 5);
          for (int it = (gw + NGW - (off % NGW)) % NGW; it < nitems; it += NGW) transpose_item(d.src, d.N, d.ldw, d.dst, d.ldt, d.mode, d.row_off, scr, it, lane);
          off += nitems; } }
    for (int r = gw; r < RT; r += NGW) { f16x4* xo = (f16x4*)(WSP(f16, WS_X) + (size_t)r * DM) + lane;
        const f32x4* xi = r < MP ? (const f32x4*)(P.x_prompt + (size_t)r * DM) + lane : (const f32x4*)(P.x_sample + (size_t)((r < MR ? r : MR - 1) - MP) * DM) + lane;
#pragma unroll
        for (int j = 0; j < 4; ++j) { f32x4 v = xi[64 * j]; if (r >= MR) v = (f32x4){0.f, 0.f, 0.f, 0.f}; xo[64 * j] = __builtin_convertvector(v, f16x4); } }
    for (int r = gw; r < 256; r += NGW) { const float* ci = r < 2 ? P.c_prompt + (size_t)r * DM : P.c_sample + (size_t)((r < 130 ? r : 129) - 2) * DM;
#pragma unroll
        for (int j = 0; j < 4; ++j) { const int c = 4 * lane + 256 * j; f32x4 v = *(const f32x4*)(ci + c); v2u w; w.x = pk2(silu_f(v[0]), silu_f(v[1])); w.y = pk2(silu_f(v[2]), silu_f(v[3])); if (r >= 130) { w.x = 0u; w.y = 0u; }
            *(v2u*)(WSP(bf16, WS_SC) + (size_t)r * DM + c) = w; } }
    for (int it0 = gw * 8; it0 < MS * PAST; it0 += NGW * 8) { const int bs = it0 >> 11, pos0 = it0 & (PAST - 1); const int page = P.page_table[bs * NPAGES + (pos0 >> 7)];
        const float* src = P.cache_kv + ((size_t)page * 128 + (pos0 & 127)) * 1024 + 8 * lane;
        f32x4 a[8], b[8];
#pragma unroll
        for (int q = 0; q < 8; ++q) { a[q] = __builtin_nontemporal_load((const f32x4*)(src + (size_t)q * 1024)); b[q] = __builtin_nontemporal_load((const f32x4*)(src + (size_t)q * 1024 + 4)); }
        const int slot = lane >> 5, g = (lane >> 3) & 3, d0 = (lane & 7) * 8;
        bf16* dst = WSP(bf16, WS_ACMP) + (size_t)slot * 65536 * 1024 + ((size_t)(bs * 4 + g) * 128 + (pos0 >> 4)) * 1024 + (pos0 & 15) * 64 + d0;
#pragma unroll
        for (int q = 0; q < 8; ++q) *(v4u*)(dst + q * 64) = pack8(a[q], b[q]); }
    for (int i = gw * 64 + lane; i < 13 * DM; i += NGW * 64) WSP(float, WS_NG)[i] = i < 12 * DM ? P.norm_g[i] : P.kv_norm_g[i - 12 * DM];
    for (int i = gw * 64 + lane; i < 2 * 8 * 128 * 128; i += NGW * 64) { const int t = (i >> 7) & 127, s = i & 127; WSP(bf16, WS_WSP)[i] = (bf16)(pk2(s <= t ? P.w_sp[i] : 0.f, 0.f) & 0xffffu); }
    for (int it = gw; it < MS * 64; it += NGW) { const int bs = it >> 6, j0 = (it & 63) * 8;
        const float* src = P.state_win + ((size_t)bs * 512 + j0 + 1) * 512 + 4 * lane; float* dst = P.out + OWIN_S + ((size_t)bs * 512 + j0) * 512 + 4 * lane;
        f32x4 v[16];
#pragma unroll
        for (int q = 0; q < 16; ++q) { const int j = j0 + (q >> 1); v[q] = (j < 511) ? __builtin_nontemporal_load((const f32x4*)(src + (size_t)(q >> 1) * 512 + (q & 1) * 256)) : (f32x4){0.f, 0.f, 0.f, 0.f}; }
#pragma unroll
        for (int q = 0; q < 16; ++q) { const int j = j0 + (q >> 1); if (j < 511) __builtin_nontemporal_store(v[q], (f32x4*)(dst + (size_t)(q >> 1) * 512 + (q & 1) * 256)); } }
}

__device__ __forceinline__ void load_cbias_lds(const float* cb, LAS unsigned char* lds, int tid) {
    __syncthreads();
    if (tid < 128) *(LAS f32x4*)(lds + tid * 16) = *(const f32x4*)(cb + tid * 4);
    __syncthreads();
}
template <int MODE>
__device__ __forceinline__ void cmp_finish_unit(const bf16* T, const LAS float* cbias, const bf16* W2T, void* outp, int C, int bg, int rt, int lane) {
    const int fr = lane & 15, fq = lane >> 4, NB = C - 1, i0 = 16 * rt;
    const int ib = i0 + fr, ic = ib < NB ? ib : NB - 1;
    const bf16* ta = T + ((size_t)bg * C + ic) * 512 + 8 * fq; const bf16* tb = ta + 512 + 256;
    v4u ra[8], rb[8];
#pragma unroll
    for (int ks = 0; ks < 8; ++ks) { ra[ks] = *(const v4u*)(ta + 32 * ks); rb[ks] = *(const v4u*)(tb + 32 * ks); }
    asm volatile("" ::: "memory");
    bf16x8 hf[8];
#pragma unroll
    for (int ks = 0; ks < 8; ++ks) { float a[8], b[8]; unpack8(ra[ks], a); unpack8(rb[ks], b);
        const f32x4 c0 = *(const LAS f32x4*)(cbias + 32 * ks + 8 * fq), c1 = *(const LAS f32x4*)(cbias + 32 * ks + 8 * fq + 4);
        f32x4 h0, h1;
#pragma unroll
        for (int e = 0; e < 4; ++e) { h0[e] = gelu_tanh_f(c0[e] + a[e] + b[e]); h1[e] = gelu_tanh_f(c1[e] + a[e + 4] + b[e + 4]); }
        const v4u w = pack8(h0, h1); hf[ks] = __builtin_bit_cast(bf16x8, w); }
    f32x4 acc[4];
#pragma unroll
    for (int np = 0; np < 2; ++np) {
        bf16x8 wf[2][8];
#pragma unroll
        for (int n2 = 0; n2 < 2; ++n2)
#pragma unroll
            for (int ks = 0; ks < 8; ++ks) wf[n2][ks] = *(const bf16x8*)(W2T + (size_t)(16 * (2 * np + n2) + fr) * 256 + 32 * ks + 8 * fq);
        asm volatile("" ::: "memory");
#pragma unroll
        for (int n2 = 0; n2 < 2; ++n2) { const int nt = 2 * np + n2; acc[nt] = (f32x4){0.f, 0.f, 0.f, 0.f};
#pragma unroll
            for (int ks = 0; ks < 8; ++ks) {
                if (MODE == 1) acc[nt] = __builtin_amdgcn_mfma_f32_16x16x32_bf16(hf[ks], wf[n2][ks], acc[nt], 0, 0, 0);
                else acc[nt] = __builtin_amdgcn_mfma_f32_16x16x32_bf16(wf[n2][ks], hf[ks], acc[nt], 0, 0, 0); } }
    }
#pragma unroll
    for (int nt = 0; nt < 4; ++nt) {
        if (MODE == 0) { f32x4 v = acc[nt]; if (ib >= NB) v = (f32x4){0.f, 0.f, 0.f, 0.f}; v2u w; w.x = pk2(v[0], v[1]); w.y = pk2(v[2], v[3]);
            *(v2u*)((bf16*)outp + ((size_t)bg * 512 + ib) * 64 + 16 * nt + 4 * fq) = w; }
        else if (MODE == 1) { f32x4 v = acc[nt];
#pragma unroll
            for (int e = 0; e < 4; ++e) if (i0 + 4 * fq + e >= NB) v[e] = 0.f;
            v2u w; w.x = pk2(v[0], v[1]); w.y = pk2(v[2], v[3]);
            *(v2u*)((bf16*)outp + (((size_t)bg * 16 + (i0 >> 5)) * 64 + 16 * nt + fr) * 32 + (i0 & 31) + 4 * fq) = w; }
        else { f32x4 v = acc[nt]; if (ib >= NB) v = (f32x4){0.f, 0.f, 0.f, 0.f};
            *(f32x4*)((float*)outp + ((size_t)bg * 128 + ib) * 64 + 16 * nt + 4 * fq) = v; }
    }
}

struct SpRegs { f32x4 st; v4u za[2], zb[2]; bf16x8 wf[4]; v4u uv[4]; float bt; };
__device__ __forceinline__ void sp_load(SpRegs& R, const Ptrs& P, int l, int u, int wave, int lane) {
    const bf16* Z = WSP(bf16, WS_Z); const bf16* WS = WSP(bf16, WS_WSP); const float* VS = WSP(float, WS_CTL) + CW_VS + (size_t)l * RT * 2;
    const int fr = lane & 15, fq = lane >> 4, nks = (wave >> 1) + 1, n = u / 24, cb = u - n * 24, g = cb / 3;
    R.st = *(const f32x4*)(VS + 2 * (n * 128 + 2 * lane));
#pragma unroll
    for (int q = 0; q < 2; ++q) { const int cc = cb * 128 + 8 * (wave + 8 * q); const bf16* z0 = Z + (size_t)(n * 128 + 2 * lane) * 6144 + DV + cc; R.za[q] = *(const v4u*)z0; R.zb[q] = *(const v4u*)(z0 + 6144); }
    const bf16* wp = WS + ((size_t)(l * 8 + g) * 128 + 16 * wave + fr) * 128 + 8 * fq;
#pragma unroll
    for (int ks = 0; ks < 4; ++ks) R.wf[ks] = *(const bf16x8*)(wp + 32 * (ks < nks ? ks : 0));
    const int t = 16 * wave + fr, row = n * 128 + t; R.bt = P.b_sp[(l * 8 + g) * 128 + t];
#pragma unroll
    for (int mm = 0; mm < 4; ++mm) R.uv[mm] = *(const v4u*)(Z + (size_t)row * 6144 + cb * 128 + 32 * mm + 8 * fq);
}
__device__ __forceinline__ void sp_compute(const SpRegs& R, const Ptrs& P, int l, int u, LAS unsigned* tile, int wave, int lane) {
    bf16* PO = WSP(bf16, WS_P); const float* lg = P.ln_g + l * DV; const float* lb = P.ln_b + l * DV;
    const int fr = lane & 15, fq = lane >> 4, nks = (wave >> 1) + 1, n = u / 24, cb = u - n * 24;
    const float m0 = R.st[0] * (1.0f / DV), m1 = R.st[2] * (1.0f / DV); float v0 = R.st[1] * (1.0f / DV) - m0 * m0, v1 = R.st[3] * (1.0f / DV) - m1 * m1; v0 = v0 > 0.f ? v0 : 0.f; v1 = v1 > 0.f ? v1 : 0.f;
    const float r0 = 1.0f / sqrtf(v0 + 1e-6f), r1 = 1.0f / sqrtf(v1 + 1e-6f);
#pragma unroll
    for (int q = 0; q < 2; ++q) { const int ccg = wave + 8 * q, cc = cb * 128 + 8 * ccg; float a[8], b[8]; unpack8(R.za[q], a); unpack8(R.zb[q], b);
        const f32x4 g0 = *(const f32x4*)(lg + cc), g1 = *(const f32x4*)(lg + cc + 4), b0 = *(const f32x4*)(lb + cc), b1 = *(const f32x4*)(lb + cc + 4);
#pragma unroll
        for (int e = 0; e < 8; ++e) { const float gg = e < 4 ? g0[e] : g1[e - 4], bb = e < 4 ? b0[e] : b1[e - 4];
            tile[(8 * ccg + e) * 68 + lane] = pk2((a[e] - m0) * r0 * gg + bb, (b[e] - m1) * r1 * gg + bb); } }
    __syncthreads();
    f32x4 acc[8];
#pragma unroll
    for (int j = 0; j < 8; ++j) acc[j] = (f32x4){0.f, 0.f, 0.f, 0.f};
    const LAS char* vp = (const LAS char*)tile + (8 * (fr >> 2) + (fr & 3)) * 272 + 16 * fq;
#pragma unroll
    for (int ks = 0; ks < 4; ++ks) if (ks < nks) {
#pragma unroll
        for (int j = 0; j < 8; ++j) { const bf16x8 vf = *(const LAS bf16x8*)(vp + (32 * (j >> 1) + 4 * (j & 1)) * 272 + 64 * ks);
            acc[j] = __builtin_amdgcn_mfma_f32_16x16x32_bf16(vf, R.wf[ks], acc[j], 0, 0, 0); }
    }
    const int row = n * 128 + 16 * wave + fr;
#pragma unroll
    for (int mm = 0; mm < 4; ++mm) { const int c = cb * 128 + 32 * mm + 8 * fq; float uu[8]; unpack8(R.uv[mm], uu);
        f32x4 p0, p1;
#pragma unroll
        for (int e = 0; e < 4; ++e) { p0[e] = uu[e] * (acc[2 * mm][e] + R.bt); p1[e] = uu[4 + e] * (acc[2 * mm + 1][e] + R.bt); }
        *(v4u*)(PO + (size_t)row * DV + c) = pack8(p0, p1); }
}
__device__ __forceinline__ void spatial2_phase(const Ptrs& P, int l, LAS unsigned char* lds, int wave, int lane, int tid, int gw, int NGW) {
    const bf16* Z = WSP(bf16, WS_Z);
    const float* VS = WSP(float, WS_CTL) + CW_VS + (size_t)l * RT * 2;
    const float* lg = P.ln_g + l * DV; const float* lb = P.ln_b + l * DV;
    { const int NU = 128 * 24, G_ = (int)gridDim.x; int u = (int)blockIdx.x;
      LAS unsigned* t0 = (LAS unsigned*)lds; LAS unsigned* t1 = (LAS unsigned*)(lds + 34816);
      SpRegs A, B;
      if (u < NU) sp_load(A, P, l, u, wave, lane);
      while (u < NU) {
          int un = u + G_; if (un < NU) sp_load(B, P, l, un, wave, lane);
          sp_compute(A, P, l, u, t0, wave, lane);
          u = un; if (u >= NU) break;
          un = u + G_; if (un < NU) sp_load(A, P, l, un, wave, lane);
          sp_compute(B, P, l, u, t1, wave, lane);
          u = un;
      } }
    __syncthreads();
    for (int bs = gw; bs < MS; bs += NGW) {
        const int row = MP + bs; const bf16* zr = Z + (size_t)row * 6144 + 8 * lane;
        const float mean = VS[2 * row] * (1.0f / DV); float var = VS[2 * row + 1] * (1.0f / DV) - mean * mean; var = var > 0.f ? var : 0.f; const float rstd = 1.0f / sqrtf(var + 1e-6f);
#pragma unroll
        for (int j = 0; j < 6; ++j) { const int c = 512 * j + 8 * lane, g = c / CGW;
            const float w00 = P.w_sp[(size_t)(l * 8 + g) * 128 * 128], b00 = P.b_sp[(l * 8 + g) * 128];
            const f32x4 g0 = *(const f32x4*)(lg + c), g1 = *(const f32x4*)(lg + c + 4), b0 = *(const f32x4*)(lb + c), b1 = *(const f32x4*)(lb + c + 4);
            float vv[8], uu[8]; unpack8(*(const v4u*)(zr + DV + 512 * j), vv); unpack8(*(const v4u*)(zr + 512 * j), uu);
            f32x4 o0, o1, p0, p1;
#pragma unroll
            for (int e = 0; e < 4; ++e) { o0[e] = (vv[e] - mean) * rstd * g0[e] + b0[e]; o1[e] = (vv[4 + e] - mean) * rstd * g1[e] + b1[e];
                p0[e] = uu[e] * (w00 * o0[e] + b00); p1[e] = uu[4 + e] * (w00 * o1[e] + b00); }
            float* gv = P.out + OGV + ((size_t)l * MS + bs) * DV + c; *(f32x4*)gv = o0; *(f32x4*)(gv + 4) = o1;
            *(v4u*)(WSP(bf16, WS_P) + (size_t)row * DV + c) = pack8(p0, p1); }
    }
}

#define NEG_INF (-__builtin_inff())
__device__ __forceinline__ bf16x8 ld_v2x8(const GAS bf16* p) {
    const bf16x4 lo = *(const GAS bf16x4*)p, hi = *(const GAS bf16x4*)(p + 16);
    return __builtin_shufflevector(lo, hi, 0, 1, 2, 3, 4, 5, 6, 7);
}
struct SampleAcc { float acc[4][8]; float m, l; };
__device__ __forceinline__ float sample_compute(const f32x4 k0, const f32x4 k1, const f32x4 v0, const f32x4 v1, bool valid, float dist, const float (&qv)[4][8], float slope2_own, int lane, SampleAcc& A) {
    const int j8 = lane & 7;
    float part[4];
#pragma unroll
    for (int h = 0; h < 4; ++h) { float a = (qv[h][0] * k0[0] + qv[h][1] * k0[1]) + (qv[h][2] * k0[2] + qv[h][3] * k0[3]) + (qv[h][4] * k1[0] + qv[h][5] * k1[1]) + (qv[h][6] * k1[2] + qv[h][7] * k1[3]);
        a += dppf<DPP_X1>(a); a += dppf<DPP_X2>(a); a += dppf<DPP_HM>(a); part[h] = a; }
    const int hown = j8 & 3;
    const float sown = hown == 0 ? part[0] : hown == 1 ? part[1] : hown == 2 ? part[2] : part[3];
    const float s2 = valid ? (sown - slope2_own * dist) : NEG_INF;
    float tm = fmaxf(s2, dppf<DPP_X8>(s2)); tm = xmax_16_32(tm);
    const float mnew = fmaxf(A.m, tm), msafe = (mnew == NEG_INF) ? 0.f : mnew, alpha = fexp2(A.m - msafe), p = fexp2(s2 - msafe);
    A.m = mnew; A.l = A.l * alpha + p;
    const float ph[4] = {dppf<0x00>(p), dppf<0x55>(p), dppf<0xAA>(p), dppf<0xFF>(p)}, ah[4] = {dppf<0x00>(alpha), dppf<0x55>(alpha), dppf<0xAA>(alpha), dppf<0xFF>(alpha)};
#pragma unroll
    for (int h = 0; h < 4; ++h)
#pragma unroll
        for (int e = 0; e < 4; ++e) { A.acc[h][e] = A.acc[h][e] * ah[h] + ph[h] * v0[e]; A.acc[h][4 + e] = A.acc[h][4 + e] * ah[h] + ph[h] * v1[e]; }
    return s2;
}
__device__ __forceinline__ float sample_step8(const float* krow, const float* vrow, bool valid, float dist, const float (&qv)[4][8], float slope2_own, int lane, SampleAcc& A) {
    const int j8 = lane & 7;
    const f32x4 k0 = *(const f32x4*)(krow + 8 * j8), k1 = *(const f32x4*)(krow + 8 * j8 + 4), v0 = *(const f32x4*)(vrow + 8 * j8), v1 = *(const f32x4*)(vrow + 8 * j8 + 4);
    return sample_compute(k0, k1, v0, v1, valid, dist, qv, slope2_own, lane, A);
}
__device__ __forceinline__ void sample_batch4(const float* kbase, const float* vbase, int rstride, int r0, int rlimit, int rclamp, float dist0, float ddist,
                                              const float (&qv)[4][8], float slope2_own, int lane, SampleAcc& A, LAS float* sraw) {
    const int j8 = lane & 7;
    f32x4 kk[4][2], vv[4][2];
#pragma unroll
    for (int s = 0; s < 4; ++s) { int r = r0 + 8 * s; r = r < rlimit ? r : rclamp; const float* kr = kbase + (size_t)r * rstride + 8 * j8; const float* vr = vbase + (size_t)r * rstride + 8 * j8;
        kk[s][0] = *(const f32x4*)kr; kk[s][1] = *(const f32x4*)(kr + 4); vv[s][0] = *(const f32x4*)vr; vv[s][1] = *(const f32x4*)(vr + 4); }
#pragma unroll
    for (int s = 0; s < 4; ++s) { const float s2 = sample_compute(kk[s][0], kk[s][1], vv[s][0], vv[s][1], r0 + 8 * s < rlimit, dist0 - ddist * (float)s, qv, slope2_own, lane, A);
        if (sraw) sraw[s * 64 + lane] = s2; }
}
__device__ __forceinline__ void sample_reset(SampleAcc& A) {
    A.m = NEG_INF; A.l = 0.f;
#pragma unroll
    for (int h = 0; h < 4; ++h)
#pragma unroll
        for (int i = 0; i < 8; ++i) A.acc[h][i] = 0.f;
}
__device__ __forceinline__ void sample_finish(SampleAcc& A, const float* gates_bg, int br, LAS float* wl, int lane, bool first) {
    float lt = A.l; lt += dppf<DPP_X8>(lt); lt = xsum_16_32(lt);
    float sc[4];
#pragma unroll
    for (int h = 0; h < 4; ++h) { const float lh = __shfl(lt, h); sc[h] = lh > 0.f ? gates_bg[h * 3 + br] / lh : 0.f; }
#pragma unroll
    for (int h = 0; h < 4; ++h)
#pragma unroll
        for (int i = 0; i < 8; ++i) { float a = A.acc[h][i]; a += dppf<DPP_X8>(a); a = xsum_16_32(a); A.acc[h][i] = a * sc[h]; }
    if (lane < 8) {
#pragma unroll
        for (int h = 0; h < 4; ++h)
#pragma unroll
            for (int i = 0; i < 8; ++i) { LAS float* p = wl + h * 64 + 8 * lane + i; *p = first ? A.acc[h][i] : (*p + A.acc[h][i]); }
    }
}
__device__ __forceinline__ void attn_sample_unit(const Ptrs& P, int bs, int g, LAS float* wl, int lane_in) {
    int lane = lane_in; asm volatile("" : "+v"(lane));
    const int kq = lane >> 3, j8 = lane & 7, row = MP + bs;
    const bf16* Q = WSP(bf16, WS_Q) + (size_t)row * DM + (4 * g) * 64; const float* GT = WSP(float, WS_GATES) + (size_t)row * 48 + g * 12;
    float qv[4][8];
#pragma unroll
    for (int h = 0; h < 4; ++h) unpack8(*(const v4u*)(Q + h * 64 + 8 * j8), qv[h]);
    const float slope2_own = fexp2(-0.5f * (float)(4 * g + (j8 & 3) + 1)) * LOG2E;
    SampleAcc A;
    LAS float* pimp = wl + 256;
    LAS float* sraw = wl + 512;
    const float* KCS = WSP(float, WS_KCS) + (size_t)(bs * 4 + g) * 128 * 64; const float* VCS = WSP(float, WS_VCS) + (size_t)(bs * 4 + g) * 128 * 64;
    sample_reset(A);
#pragma unroll 1
    for (int bt = 0; bt < 4; ++bt) sample_batch4(KCS, VCS, 64, 32 * bt + kq, 127, 126, (float)(PAST - (16 * (32 * bt + kq) + 31)), 128.f, qv, slope2_own, lane, A, sraw + bt * 256);
    { float lt = A.l; lt += dppf<DPP_X8>(lt); lt = xsum_16_32(lt);
      const float il = lt > 0.f ? 1.0f / lt : 0.f, mm = A.m == NEG_INF ? 0.f : A.m;
#pragma unroll 1
      for (int it = 0; it < 16; ++it) { float p = fexp2(sraw[it * 64 + lane] - mm) * il; p += dppf<DPP_X1>(p); p += dppf<DPP_X2>(p); if (j8 == 0) pimp[8 * it + kq] = p; } }
    sample_finish(A, GT, 0, wl, lane, true);
    unsigned long long selmask;
    { float v = -1.f;
      if (lane < 33) { float sacc = 0.f;
#pragma unroll
          for (int e = -1; e < 4; ++e) { const int n = 4 * lane + e; if (n >= 0 && n < 127) sacc += pimp[n]; }
          v = (lane == 0 || lane >= 31) ? sacc + 1e4f : sacc; }
      int rank = 0;
#pragma unroll 1
      for (int i = 0; i < 33; ++i) { const float vi = __builtin_bit_cast(float, __builtin_amdgcn_readlane(__builtin_bit_cast(int, v), i)); rank += (vi > v || (vi == v && i < lane)) ? 1 : 0; }
      selmask = __ballot(lane < 33 && rank < 16); }
    sample_reset(A);
#pragma unroll 1
    for (int j = 0; j < 32; ++j) {
        if (!((selmask >> j) & 1ull)) continue;
        const int page = P.page_table[bs * NPAGES + (j >> 1)];
        const float* kb = P.cache_kv + ((size_t)page * 128 * 4 + 2) * 256 + g * 64;
#pragma unroll 1
        for (int bb = 0; bb < 2; ++bb) { const int r0 = ((64 * j) & 127) + 32 * bb + kq;
            sample_batch4(kb, kb + 256, 1024, r0, 1 << 30, 0, (float)(PAST - (64 * j + 32 * bb + kq)), 8.f, qv, slope2_own, lane, A, nullptr); }
    }
    { const float* kr = P.out + OKV_S + ((size_t)bs * 4 + 2) * 256 + g * 64;
      (void)sample_step8(kr, kr + 256, kq == 0, 0.f, qv, slope2_own, lane, A); }
    sample_finish(A, GT, 1, wl, lane, false);
    sample_reset(A);
    { const float* kb = P.state_win + (size_t)bs * 512 * 512 + g * 64;
#pragma unroll 1
      for (int bt = 0; bt < 16; ++bt) sample_batch4(kb, kb + 256, 512, 32 * bt + kq, 1 << 30, 0, (float)(512 - (32 * bt + kq)), 8.f, qv, slope2_own, lane, A, nullptr); }
    { const float* kr = P.out + OWIN_S + ((size_t)bs * 512 + 511) * 512 + g * 64;
      (void)sample_step8(kr, kr + 256, kq == 0, 0.f, qv, slope2_own, lane, A); }
    sample_finish(A, GT, 2, wl, lane, false);
    { const f32x4 v = *(const LAS f32x4*)(wl + 4 * lane); v2u w; w.x = pk2(v[0], v[1]); w.y = pk2(v[2], v[3]);
      *(v2u*)(WSP(bf16, WS_O) + (size_t)row * DM + 256 * g + 4 * lane) = w; }
}

__device__ __forceinline__ void ldK(bf16x8 (&kf)[2][2], const GAS bf16* Kp, int k0, unsigned koff) {
#pragma unroll
    for (int kt = 0; kt < 2; ++kt)
#pragma unroll
        for (int ks = 0; ks < 2; ++ks) kf[kt][ks] = *(const GAS bf16x8*)((const GAS char*)(Kp + (size_t)k0 * 64 + kt * 256 + ks * 32) + koff);
}
__device__ __forceinline__ void ldV(bf16x8 (&vf)[4], const GAS bf16* Vp, int VP, int k0, unsigned voff) {
#pragma unroll
    for (int dt = 0; dt < 4; ++dt) vf[dt] = *(const GAS bf16x8*)((const GAS char*)(Vp + (size_t)(k0 >> 5) * 2048 + dt * 512) + voff);
}
template <int MODE, int GEN>
__device__ __forceinline__ void att_run(const GAS bf16* Kp, const GAS bf16* Vp, int VP, unsigned koff, unsigned voff, int n, int base, const LAS int* list,
                                        int KA, int KB, int W, unsigned M0, unsigned M1, unsigned M2, unsigned M3, int t, int fr, int fq, int lane,
                                        LAS float* wl, const float (&slope2)[4], f32x4 (&o)[4][4], float (&m)[4], float (&l)[4]) {
    if (n <= 0) return;
    bf16x8 kf[2][2], vf[4];
    int k0 = GEN == 0 ? 0 : (GEN == 1 ? base : list[0]);
    ldK(kf, Kp, k0, koff);
    if (MODE != 1) ldV(vf, Vp, VP, k0, voff);
    float carry = 0.f;
#pragma unroll 1
    for (int i = 0; i < n; ++i) {
        const int inx = (i + 1 < n) ? i + 1 : i;
        const int k0n = GEN == 0 ? 32 * inx : (GEN == 1 ? base - 32 * inx : list[inx]);
        f32x4 s[2][4];
        {
            unsigned qa = (unsigned)lane * 16u; asm volatile("" : "+v"(qa));
            const LAS char* qb = (const LAS char*)wl + qa;
#pragma unroll
            for (int h = 0; h < 4; ++h) {
                const bf16x8 q0 = *(const LAS bf16x8*)(qb + (h * 2 + 0) * 1024), q1 = *(const LAS bf16x8*)(qb + (h * 2 + 1) * 1024);
#pragma unroll
                for (int kt = 0; kt < 2; ++kt) { f32x4 a = (f32x4){0.f, 0.f, 0.f, 0.f};
                    a = __builtin_amdgcn_mfma_f32_16x16x32_bf16(kf[kt][0], q0, a, 0, 0, 0);
                    a = __builtin_amdgcn_mfma_f32_16x16x32_bf16(kf[kt][1], q1, a, 0, 0, 0); s[kt][h] = a; }
            }
        }
        ldK(kf, Kp, k0n, koff);
        bool extra = true;
        if (GEN == 2) { const int j = k0 >> 6, f = j & 3; const unsigned Mw = f == 0 ? M0 : f == 1 ? M1 : f == 2 ? M2 : M3; extra = (Mw >> (j >> 2)) & 1u; }
        f32x2 dp[2][2];
#pragma unroll
        for (int kt = 0; kt < 2; ++kt)
#pragma unroll
            for (int e = 0; e < 4; ++e) { const int nn = k0 + 8 * fq + 4 * kt + e, d = t - (KA * nn + KB); const float dv = (extra && (unsigned)d <= (unsigned)W) ? (float)d : __builtin_inff();
                if (e & 1) dp[kt][e >> 1].y = dv; else dp[kt][e >> 1].x = dv; }
        f32x2 sp[2][4][2];
#pragma unroll
        for (int h = 0; h < 4; ++h)
#pragma unroll
            for (int kt = 0; kt < 2; ++kt) { const f32x2 nsl = (f32x2){-slope2[h], -slope2[h]};
                sp[kt][h][0] = (f32x2){s[kt][h][0], s[kt][h][1]} + dp[kt][0] * nsl; sp[kt][h][1] = (f32x2){s[kt][h][2], s[kt][h][3]} + dp[kt][1] * nsl; }
        if (MODE == 2) {
#pragma unroll
            for (int h = 0; h < 4; ++h) { const f32x2 mm = (f32x2){m[h], m[h]}, ll = (f32x2){l[h], l[h]};
#pragma unroll
                for (int kt = 0; kt < 2; ++kt)
#pragma unroll
                    for (int pr = 0; pr < 2; ++pr) { const f32x2 a = sp[kt][h][pr] - mm; f32x2 p; p.x = fexp2(a.x); p.y = fexp2(a.y); sp[kt][h][pr] = p * ll; } }
            f32x2 as0[2], as1[2];
#pragma unroll
            for (int pr = 0; pr < 2; ++pr) { as0[pr] = (sp[0][0][pr] + sp[0][1][pr]) + (sp[0][2][pr] + sp[0][3][pr]); as1[pr] = (sp[1][0][pr] + sp[1][1][pr]) + (sp[1][2][pr] + sp[1][3][pr]); }
            const float r1 = __shfl(as1[1].y, (lane + 48) & 63);
            const float y0 = fq > 0 ? r1 : carry, y1 = as0[1].y; carry = r1;
            wl[2048 + fr * 128 + 8 * i + 2 * fq]     = ((as0[0].x + as0[0].y) + (as0[1].x + as0[1].y)) + y0;
            wl[2048 + fr * 128 + 8 * i + 2 * fq + 1] = ((as1[0].x + as1[0].y) + (as1[1].x + as1[1].y)) + y1;
        } else {
            float tl[4]; bool grow = false;
#pragma unroll
            for (int h = 0; h < 4; ++h) {
                const f32x2 mx = __builtin_elementwise_max(__builtin_elementwise_max(sp[0][h][0], sp[0][h][1]), __builtin_elementwise_max(sp[1][h][0], sp[1][h][1]));
                tl[h] = fmaxf(mx.x, mx.y); grow = grow || (tl[h] > m[h] + 8.0f);
            }
            if (__any(grow)) {
#pragma unroll
                for (int h = 0; h < 4; ++h) { const float tm = xmax_16_32(tl[h]);
                    const float mn = fmaxf(m[h], tm), ms = (mn == NEG_INF) ? 0.f : mn, alpha = fexp2(m[h] - ms); l[h] *= alpha; m[h] = mn;
                    if (MODE == 0) {
#pragma unroll
                        for (int dt = 0; dt < 4; ++dt) o[dt][h] = o[dt][h] * alpha; } }
            }
#pragma unroll
            for (int h = 0; h < 4; ++h) { const float ms = (m[h] == NEG_INF) ? 0.f : m[h]; const f32x2 mm = (f32x2){ms, ms}; f32x2 ps = (f32x2){0.f, 0.f};
#pragma unroll
                for (int kt = 0; kt < 2; ++kt)
#pragma unroll
                    for (int pr = 0; pr < 2; ++pr) { const f32x2 a = sp[kt][h][pr] - mm; f32x2 p; p.x = fexp2(a.x); p.y = fexp2(a.y); sp[kt][h][pr] = p; ps = ps + p; }
                l[h] += ps.x + ps.y; }
        }
#pragma unroll
        for (int h = 0; h < 4; ++h)
#pragma unroll
            for (int kt = 0; kt < 2; ++kt) s[kt][h] = (f32x4){sp[kt][h][0].x, sp[kt][h][0].y, sp[kt][h][1].x, sp[kt][h][1].y};
        if (MODE != 1) {
            bf16x8 pf[4];
#pragma unroll
            for (int h = 0; h < 4; ++h) { const v4u w = pack8(s[0][h], s[1][h]); pf[h] = __builtin_bit_cast(bf16x8, w); }
#pragma unroll
            for (int dt = 0; dt < 4; ++dt)
#pragma unroll
                for (int h = 0; h < 4; ++h) o[dt][h] = __builtin_amdgcn_mfma_f32_16x16x32_bf16(vf[dt], pf[h], o[dt][h], 0, 0, 0);
            ldV(vf, Vp, VP, k0n, voff);
        }
        k0 = k0n;
    }
}
#if defined(PROBE_MODE) && PROBE_MODE == 4
#define SEC_ON(s) (PROBE_A == (s) && (int)blockIdx.x == PROBE_BLK && threadIdx.x == 0)
#define SEC_T0(s) do { if (SEC_ON(s)) { volatile LAS unsigned* pm_ = (volatile LAS unsigned*)(unsigned)MISC_OFF; pm_[17] = (unsigned)__builtin_amdgcn_s_memrealtime(); } } while (0)
#define SEC_T1(s) do { if (SEC_ON(s)) { volatile LAS unsigned* pm_ = (volatile LAS unsigned*)(unsigned)MISC_OFF; pm_[16] = pm_[16] + ((unsigned)__builtin_amdgcn_s_memrealtime() - pm_[17]); } } while (0)
#define SEC_CNT(s, n) do { if (SEC_ON(s)) { volatile LAS unsigned* pm_ = (volatile LAS unsigned*)(unsigned)MISC_OFF; pm_[16] = pm_[16] + (unsigned)(n); } } while (0)
#else
#define SEC_T0(s) do { } while (0)
#define SEC_T1(s) do { } while (0)
#define SEC_CNT(s, n) do { } while (0)
#endif
__device__ __forceinline__ void attn_prompt_unit2(const Ptrs& P, int bg, int tt, LAS float* wl, int lane_in) {
    int lane = lane_in; asm volatile("" : "+v"(lane));
    const int fr = lane & 15, fq = lane >> 4, b = bg >> 2, g = bg & 3, t0 = 16 * tt, t = t0 + fr, row = b * SEQ + t;
    const float* GT = WSP(float, WS_GATES) + (size_t)row * 48 + g * 12;
    const GAS bf16* KC = (const GAS bf16*)WSP(bf16, WS_KC) + (size_t)bg * 512 * 64; const GAS bf16* VCT = (const GAS bf16*)WSP(bf16, WS_VCT) + (size_t)bg * 64 * 512;
    const GAS bf16* SK = (const GAS bf16*)WSP(bf16, WS_SK) + (size_t)bg * SEQ * 64; const GAS bf16* SVT = (const GAS bf16*)WSP(bf16, WS_SVT) + (size_t)bg * 64 * SEQ;
    const GAS bf16* WK = (const GAS bf16*)WSP(bf16, WS_WK) + (size_t)bg * SEQ * 64; const GAS bf16* WVT = (const GAS bf16*)WSP(bf16, WS_WVT) + (size_t)bg * 64 * SEQ;
    GAS float* OA = (GAS float*)WSP(float, WS_OACC) + (size_t)row * DM + 256 * g + 4 * fq;
    float slope2[4];
    { const GAS bf16* Q = (const GAS bf16*)WSP(bf16, WS_Q) + (size_t)row * DM + (4 * g) * 64 + 8 * fq;
#pragma unroll
      for (int h = 0; h < 4; ++h) { slope2[h] = fexp2(-0.5f * (float)(4 * g + h + 1)) * LOG2E;
#pragma unroll
          for (int ks = 0; ks < 2; ++ks) *(LAS v4u*)((LAS char*)wl + (h * 2 + ks) * 1024 + lane * 16) = *(const GAS v4u*)(Q + h * 64 + 32 * ks); } }
    f32x4 o[4][4]; float m[4], l[4];
    const int BIG = 1 << 30;
    const unsigned koff = (unsigned)((8 * (fr >> 2) + (fr & 3)) * 64 + 8 * fq) * 2u, voffc = (unsigned)(fr * 32 + 8 * fq) * 2u, voffs = voffc;
    const int nst = (tt >> 5) + 1;
    SEC_T0(1);
#pragma unroll
    for (int h = 0; h < 4; ++h) { m[h] = NEG_INF; l[h] = 0.f; }
    att_run<1, 0>(KC, VCT, 512, koff, voffc, nst, 0, nullptr, 16, 31, BIG, 0u, 0u, 0u, 0u, t, fr, fq, lane, wl, slope2, o, m, l);
#pragma unroll
    for (int h = 0; h < 4; ++h) { const float lt = xsum_16_32(l[h]); l[h] = lt > 0.f ? 1.0f / lt : 0.f; if (m[h] == NEG_INF) m[h] = 0.f;
#pragma unroll
        for (int dt = 0; dt < 4; ++dt) o[dt][h] = (f32x4){0.f, 0.f, 0.f, 0.f}; }
    att_run<2, 0>(KC, VCT, 512, koff, voffc, nst, 0, nullptr, 16, 31, BIG, 0u, 0u, 0u, 0u, t, fr, fq, lane, wl, slope2, o, m, l);
#pragma unroll
    for (int h = 0; h < 4; ++h) { const float gc = GT[h * 3 + 0];
#pragma unroll
        for (int dt = 0; dt < 4; ++dt) *(GAS f32x4*)(OA + h * 64 + 16 * dt) = o[dt][h] * gc; }
    SEC_T1(1);
    SEC_T0(2);
    const int qblk = t0 >> 6;
    unsigned M0, M1, M2, M3;
    {
        float cv[32];
#pragma unroll
        for (int q = 0; q < 32; ++q) { const int j = 4 * q + fq; const float x = wl[2048 + fr * 128 + j];
            const bool forced = (j == 0) | (j == qblk) | (j == qblk - 1); cv[q] = (j <= qblk) ? (forced ? x + 1e4f : x) : -1.f; }
        unsigned mask = 0u;
#pragma unroll 1
        for (int r = 0; r < 16; ++r) {
            float bv = cv[0]; int bq = 0;
#pragma unroll
            for (int q = 1; q < 32; ++q) if (cv[q] > bv) { bv = cv[q]; bq = q; }
            int bj = 4 * bq + fq;
            { float va, vb; int ia, ib; xpair16(bv, va, vb); xpair16i(bj, ia, ib); const bool tb = vb > va || (vb == va && ib < ia); bv = tb ? vb : va; bj = tb ? ib : ia; }
            { float va, vb; int ia, ib; xpair32(bv, va, vb); xpair32i(bj, ia, ib); const bool tb = vb > va || (vb == va && ib < ia); bv = tb ? vb : va; bj = tb ? ib : ia; }
            const bool mine = (bv >= 0.f) && ((bj & 3) == fq); const int wq = bj >> 2;
#pragma unroll
            for (int q = 0; q < 32; ++q) if (mine && q == wq) cv[q] = -2.f;
            if (mine) mask |= 1u << wq;
        }
        M0 = __shfl(mask, fr); M1 = __shfl(mask, fr + 16); M2 = __shfl(mask, fr + 32); M3 = __shfl(mask, fr + 48);
    }
    int nlist = 0;
    {
        unsigned U0 = M0, U1 = M1, U2 = M2, U3 = M3;
        U0 |= dppu<DPP_X1>(U0); U1 |= dppu<DPP_X1>(U1); U2 |= dppu<DPP_X1>(U2); U3 |= dppu<DPP_X1>(U3);
        U0 |= dppu<DPP_X2>(U0); U1 |= dppu<DPP_X2>(U1); U2 |= dppu<DPP_X2>(U2); U3 |= dppu<DPP_X2>(U3);
        U0 |= dppu<DPP_HM>(U0); U1 |= dppu<DPP_HM>(U1); U2 |= dppu<DPP_HM>(U2); U3 |= dppu<DPP_HM>(U3);
        U0 |= dppu<DPP_RM>(U0); U1 |= dppu<DPP_RM>(U1); U2 |= dppu<DPP_RM>(U2); U3 |= dppu<DPP_RM>(U3);
        U0 = __builtin_amdgcn_readfirstlane(U0); U1 = __builtin_amdgcn_readfirstlane(U1); U2 = __builtin_amdgcn_readfirstlane(U2); U3 = __builtin_amdgcn_readfirstlane(U3);
        LAS int* lst = (LAS int*)(wl + 2048);
#pragma unroll 1
        for (int j = qblk; j >= 0; --j) { const int f = j & 3; const unsigned Uw = f == 0 ? U0 : f == 1 ? U1 : f == 2 ? U2 : U3;
            if ((Uw >> (j >> 2)) & 1u) { if (lane == 0) { lst[nlist] = 64 * j + 32; lst[nlist + 1] = 64 * j; } nlist += 2; } }
    }
    SEC_T1(2); SEC_CNT(5, nlist); SEC_T0(3);
#pragma unroll
    for (int h = 0; h < 4; ++h) { m[h] = NEG_INF; l[h] = 0.f;
#pragma unroll
        for (int dt = 0; dt < 4; ++dt) o[dt][h] = (f32x4){0.f, 0.f, 0.f, 0.f}; }
    att_run<0, 2>(SK, SVT, SEQ, koff, voffs, nlist, 0, (const LAS int*)(wl + 2048), 1, 0, BIG, M0, M1, M2, M3, t, fr, fq, lane, wl, slope2, o, m, l);
    asm volatile("s_waitcnt vmcnt(0)" ::: "memory");
#pragma unroll
    for (int h = 0; h < 4; ++h) { const float lt = xsum_16_32(l[h]); const float sc = lt > 0.f ? GT[h * 3 + 1] / lt : 0.f;
#pragma unroll
        for (int dt = 0; dt < 4; ++dt) { GAS f32x4* p = (GAS f32x4*)(OA + h * 64 + 16 * dt); *p = *p + o[dt][h] * sc; } }
    SEC_T1(3); SEC_T0(4);
#pragma unroll
    for (int h = 0; h < 4; ++h) { m[h] = NEG_INF; l[h] = 0.f;
#pragma unroll
        for (int dt = 0; dt < 4; ++dt) o[dt][h] = (f32x4){0.f, 0.f, 0.f, 0.f}; }
    { const int kend = (t0 > 512 ? (t0 - 512) : 0) & ~31, ktop = t0 & ~31;
      att_run<0, 1>(WK, WVT, SEQ, koff, voffs, ((ktop - kend) >> 5) + 1, ktop, nullptr, 1, 0, 512, 0u, 0u, 0u, 0u, t, fr, fq, lane, wl, slope2, o, m, l); }
    asm volatile("s_waitcnt vmcnt(0)" ::: "memory");
    GAS bf16* O = (GAS bf16*)WSP(bf16, WS_O) + (size_t)row * DM + 256 * g + 4 * fq;
#pragma unroll
    for (int h = 0; h < 4; ++h) { const float lt = xsum_16_32(l[h]); const float sc = lt > 0.f ? GT[h * 3 + 2] / lt : 0.f;
#pragma unroll
        for (int dt = 0; dt < 4; ++dt) { const f32x4 v = *(const GAS f32x4*)(OA + h * 64 + 16 * dt) + o[dt][h] * sc;
            v2u w; w.x = pk2(v[0], v[1]); w.y = pk2(v[2], v[3]); *(GAS v2u*)(O + h * 64 + 16 * dt) = w; } }
    SEC_T1(4);
}

#define ATTN_UNIT attn_prompt_unit2
#ifdef PROBE_MODE
#ifndef PROBE_BLK
#define PROBE_BLK 0
#endif
#ifndef PROBE_MULT
#define PROBE_MULT 8
#endif
#define PROBE_SEL(p) ((p) >= PROBE_A && (p) <= PROBE_B)
#endif
struct Args { const void* in[31]; float* out; unsigned char* ws; int ph_lo, ph_hi; };
constexpr int N_PHASES = 2 + 1 + 12 + 2 * 1 + 2 * 1 + 12 + 1;

__global__ void __launch_bounds__(NWAVES * 64, 2) yoco_fwd(Args args) {
    extern __shared__ __attribute__((aligned(16))) unsigned char lds_raw[];
    LAS unsigned char* lds = (LAS unsigned char*)lds_raw;
    const int tid0 = threadIdx.x, wave = __builtin_amdgcn_readfirstlane(tid0 >> 6);
    const int G = gridDim.x; const int bx = blockIdx.x; const int vcu = (G % 8 == 0) ? (bx % 8) * (G / 8) + bx / 8 : bx;
    const int gw0 = vcu * NWAVES + wave, NGW = G * NWAVES;

    for (int u = tid0; u < (LDS_BYTES - LDSCTL_OFF) / 4; u += NWAVES * 64) ((LAS unsigned*)(lds + LDSCTL_OFF))[u] = 0u;
    __syncthreads();
    volatile LAS unsigned* MISC = (volatile LAS unsigned*)(lds + MISC_OFF);
    unsigned* barw = (unsigned*)(args.ws + WS_CTL) + CW_BAR;
    XcdBarrier bar; bar.bar = barw; bar.x = 0; bar.st = nullptr;
    const int lo = args.ph_lo, hi = args.ph_hi;
    if (hi - lo > 1) bar = xcd_barrier_post(barw, MISC + 8);
    int pid = 0;
#define IN_PH() (lo <= pid && pid < hi)
#define NIN() NormIn{P.ws, sl > 0 ? sl - 1 : 0, sl, sl > 0 ? 1 : 0}
#define LOADP() int tid = tid0; asm volatile("" : "+v"(tid)); const int lane = tid & 63; int gw = gw0; asm volatile("" : "+s"(gw)); (void)lane; (void)gw; Ptrs P; load_ptrs(P); const f16* X = WSP(f16, WS_X); bf16* H = WSP(bf16, WS_H); const float* MOD = WSP(float, WS_MOD); (void)X; (void)H; (void)MOD
#ifdef PROBE_MODE
#define PRB_ON() ((int)blockIdx.x == PROBE_BLK && tid0 == 0)
#define PRB_NOW() ((unsigned)__builtin_amdgcn_s_memrealtime())
#define END_PH() do { if (PRB_ON()) { const unsigned tm_ = PRB_NOW(); if ((PROBE_MODE & 1) && PROBE_SEL(pid)) MISC[16] = MISC[16] + (tm_ - MISC[17]); MISC[17] = tm_; } \
    if (lo <= pid && pid + 1 < hi) xcd_barrier(bar); \
    if (PRB_ON()) { const unsigned te_ = PRB_NOW(); if ((PROBE_MODE & 2) && PROBE_SEL(pid)) MISC[16] = MISC[16] + (te_ - MISC[17]); MISC[17] = te_; } ++pid; } while (0)
#else
#define END_PH() do { if (lo <= pid && pid + 1 < hi) xcd_barrier(bar); ++pid; } while (0)
#endif


#ifdef PROBE_MODE
    if (PRB_ON()) { MISC[16] = 0u; MISC[17] = PRB_NOW(); }
#endif
    if (IN_PH()) { LOADP(); prologue_phase(P, lds, gw, NGW, wave, lane, tid); }
    END_PH();
    if (IN_PH()) { LOADP();
        run_gemm(lds, WSP(bf16, WS_SC), WSP(bf16, WS_WMOD), 256, NMOD, DM, FMod{WSP(float, WS_MOD), P.ada_b, P.kv_ada_b, P.final_ada_b, WSP(bf16, WS_SHB)});
        run_gemm(lds, WSP(bf16, WS_ACMP), WSP(bf16, WS_WC1), 65536, 512, 1024, FBf16{WSP(bf16, WS_TS), 512});
        run_gemm(lds, WSP(bf16, WS_ACMP) + (size_t)65536 * 1024, WSP(bf16, WS_WC1) + (size_t)512 * 1024, 65536, 512, 1024, FBf16{WSP(bf16, WS_TS) + (size_t)65536 * 512, 512});
    }
    END_PH();

    for (int sl = 0; sl < 12; ++sl) {
        const int l = sl / 3, sub = sl - 3 * l;
        if (sl == 0) {
            if (IN_PH()) { LOADP();
                norm_phase<false>(X, P.norm_g, MOD, 0, DM, H, nullptr, gw, NGW, lane);
                { pg8::Gemm g{WSP(bf16, WS_SHB), WSP(bf16, WS_WGU), 13 * 256, 0, DM}; int cb = (int)blockIdx.x; asm volatile("" : "+s"(cb)); ShiftOrder S{(int)gridDim.x, cb}; Epi8<FB2> E{FB2{WSP(float, WS_B2)}};
                  pg8::gemm_phase<Epi8<FB2>, ShiftOrder, true, true>(lds, g, S, E); }
                load_cbias_lds(WSP(float, WS_CBIAS), lds, tid);
                for (int u = gw; u < 2 * 512 * 8; u += NGW) { const int kv = u >> 12, r = u & 4095, bg = r >> 3, rt = r & 7;
                    cmp_finish_unit<2>(WSP(bf16, WS_TS) + (size_t)kv * 65536 * 512, (const LAS float*)lds + kv * 256, WSP(bf16, WS_WC2) + kv * 64 * 256,
                                       kv == 0 ? (void*)WSP(float, WS_KCS) : (void*)WSP(float, WS_VCS), 128, bg, rt, lane); }
                __syncthreads();
            }
            END_PH();
        }
        if (sub != 1) {
            const int s = sub >> 1;
            if (IN_PH()) { LOADP();
                if (sl == 6) {
                    run_gemm2(lds, WSP(bf16, WS_HKV), WSP(bf16, WS_WKV), NKVP, NKVP, DM, FKv{P.out, WSP(bf16, WS_KCIN), NormIn{P.ws, 5, 12, 1}}, 0, 0);
                    run_gemm2(lds, H, WSP(bf16, WS_WGU) + (size_t)(l * 2 + s) * 5632 * 1024, 5632, 5632, DM, FSwiglu{WSP(bf16, WS_HID), NIN()}, (int)gridDim.x / 2, 0);
                } else
                run_gemm2(lds, H, WSP(bf16, WS_WGU) + (size_t)(l * 2 + s) * 5632 * 1024, 5632, 5632, DM, FSwiglu{WSP(bf16, WS_HID), NIN()}); }
            END_PH();
        } else if (l < 2) {
            if (IN_PH()) { LOADP(); run_gemm2(lds, H, WSP(bf16, WS_WUV) + (size_t)l * 6144 * 1024, 6144, 6144, DM, FGelu{WSP(bf16, WS_Z), NIN(), WSP(float, WS_CTL) + CW_VS + (size_t)l * RT * 2}); }
            END_PH();
            if (IN_PH()) { LOADP(); spatial2_phase(P, l, lds, wave, lane, tid, gw, NGW); }
            END_PH();
        } else {
            if (IN_PH()) { LOADP();
                if (sl == 7) {
                    load_cbias_lds(WSP(float, WS_CBIAS), lds, tid);
                    for (int u = gw; u < 2 * 8 * 32; u += NGW) { const int kv = u >> 8, r = u & 255, bg = r >> 5, rt = r & 31;
                        if (kv == 0) cmp_finish_unit<0>(WSP(bf16, WS_TK), (const LAS float*)lds, WSP(bf16, WS_WC2), (void*)WSP(bf16, WS_KC), 512, bg, rt, lane);
                        else cmp_finish_unit<1>(WSP(bf16, WS_TV), (const LAS float*)lds + 256, WSP(bf16, WS_WC2) + 64 * 256, (void*)WSP(bf16, WS_VCT), 512, bg, rt, lane); }
                    __syncthreads();
                }
                run_gemm2(lds, H, WSP(bf16, WS_WQG) + (size_t)(l - 2) * NQG * 1024, NQG, 1072, DM, FQg{WSP(bf16, WS_Q), WSP(float, WS_GATES), NIN()}); }
            END_PH();
            if (IN_PH()) { LOADP(); LAS float* wl = (LAS float*)(lds + (gw & 7) * 16384);
                {
                    int r = 0;
                    for (;;) {
                        const int q = ((int)(xb_xcc_id() & 7u) + r) & 7;
                        unsigned idx = 0u; if (lane == 0) idx = __hip_atomic_fetch_add((unsigned*)(P.ws + WS_CTL) + CW_QUEUE + 64 * (8 * (l - 2) + q), 1u, __ATOMIC_RELAXED, __HIP_MEMORY_SCOPE_AGENT);
                        idx = (unsigned)__builtin_amdgcn_readfirstlane((int)idx);
                        if (idx >= 64u + 512u) { if (++r == 8) break; continue; }
                        if (idx < 64u) { const int id = q * 64 + (int)idx; attn_sample_unit(P, id >> 2, id & 3, wl, lane); }
                        else ATTN_UNIT(P, q, 511 - ((int)idx - 64), wl, lane);
                    }
                }
            }
            END_PH();
        }
        if (IN_PH()) { LOADP();
            const bf16* A2 = sub != 1 ? WSP(bf16, WS_HID) : (l < 2 ? WSP(bf16, WS_P) : WSP(bf16, WS_O));
            const bf16* B2 = sub != 1 ? WSP(bf16, WS_WDN) + (size_t)(l * 2 + (sub >> 1)) * 1024 * DFF : (l < 2 ? WSP(bf16, WS_WOUT) + (size_t)l * 1024 * DV : WSP(bf16, WS_WO) + (size_t)(l - 2) * 1024 * 1024);
            const int K2 = sub != 1 ? DFF : (l < 2 ? DV : DM);
            if (sl == 6) {
                run_gemm(lds, WSP(bf16, WS_KCIN), WSP(bf16, WS_WC1), 4096, 512, 1024, FBf16{WSP(bf16, WS_TK), 512}, 64);
                run_gemm(lds, WSP(bf16, WS_VCIN), WSP(bf16, WS_WC1) + (size_t)512 * 1024, 4096, 512, 1024, FBf16{WSP(bf16, WS_TV), 512}, 32);
            }
            const int sn = sl + 1, ln = sn / 3, subn = sn - 3 * ln;
            const bool more = sl < 11;
            run_gemm2r(lds, A2, B2, K2, FResid{P.ws, l * 9216 + (sub * 3 + 2) * DM, sub != 1 ? 0.5f : 1.0f, more ? sn : -1, ln * 9216 + (subn * 3 + 1) * DM, sl == 5 ? 12 : -1, MODKV + DM, more ? sl : -1});
        }
        END_PH();
    }
    if (IN_PH()) { LOADP(); norm_phase<true>(X, P.final_g, MOD, MODFIN, MODFIN + DM, nullptr, P.out, gw, NGW, lane); }
#ifdef PROBE_MODE
    if (PRB_ON()) { const unsigned tm_ = PRB_NOW(); if ((PROBE_MODE & 1) && PROBE_SEL(pid)) MISC[16] = MISC[16] + (tm_ - MISC[17]);
        const unsigned want = MISC[16] * (unsigned)PROBE_MULT; const unsigned t0_ = PRB_NOW(); while (PRB_NOW() - t0_ < want) __builtin_amdgcn_s_sleep(32); }
#endif
    ++pid;
#undef IN_PH
#undef END_PH
}

extern "C" void kernel_launch(void* const* d_in, const int* in_sizes, int n_in, void* d_out, int out_size, void* d_ws, size_t ws_size, hipStream_t stream) {
    static int grid = 0;
    if (grid == 0) {
        if (n_in != 31 || (size_t)out_size != OUT_TOTAL || ws_size < WS_END) { fprintf(stderr, "kernel_launch: unexpected shapes (n_in %d, out %d, ws %zu need %zu); nothing launched\n", n_in, out_size, ws_size, (size_t)WS_END); grid = -1; return; }
        int dev = 0, cus = 0, per_cu = 0;
        if (hipGetDevice(&dev) != hipSuccess || hipDeviceGetAttribute(&cus, hipDeviceAttributeMultiprocessorCount, dev) != hipSuccess) { grid = -1; return; }
        if (hipFuncSetAttribute((const void*)yoco_fwd, hipFuncAttributeMaxDynamicSharedMemorySize, LDS_BYTES) != hipSuccess) { fprintf(stderr, "kernel_launch: hipFuncSetAttribute failed\n"); grid = -1; return; }
        if (hipOccupancyMaxActiveBlocksPerMultiprocessor(&per_cu, (const void*)yoco_fwd, NWAVES * 64, LDS_BYTES) != hipSuccess || per_cu < 1) { fprintf(stderr, "kernel_launch: occupancy query says %d blocks per CU\n", per_cu); }
        (void)hipGetLastError();
        grid = cus;
    }
    if (grid < 0) return;
    if (hipMemsetAsync((char*)d_ws + WS_CTL, 0, CTL_ZERO_BYTES, stream) != hipSuccess) return;
    Args a{};
    for (int i = 0; i < 31; ++i) a.in[i] = d_in[i];
    a.out = (float*)d_out; a.ws = (unsigned char*)d_ws;
#if ONE_LAUNCH
    a.ph_lo = 0; a.ph_hi = N_PHASES;
    hipLaunchKernelGGL(yoco_fwd, dim3(grid), dim3(NWAVES * 64), LDS_BYTES, stream, a);
#else
    for (int p = 0; p < N_PHASES; ++p) { a.ph_lo = p; a.ph_hi = p + 1; hipLaunchKernelGGL(yoco_fwd, dim3(grid), dim3(NWAVES * 64), LDS_BYTES, stream, a); }
#endif
}
```

```cpp
#include <hip/hip_runtime.h>
#include <cstdio>
#include <cstdint>
#include <cmath>
namespace pg8 {
#define PG8_LAS __attribute__((address_space(3)))
typedef unsigned short bf16_t;
typedef short bf16x8 __attribute__((ext_vector_type(8)));
typedef float f32x4 __attribute__((ext_vector_type(4)));
typedef unsigned u32x4 __attribute__((ext_vector_type(4)));
constexpr int BM = 256, BK = 64, HALF = 128, HTB = HALF * BK * 2  , STAGE_BYTES = 8 * HTB, NXCD = 8, WGM = 8;

__host__ __device__ __forceinline__ int lds_byte(int r, int c) { const int st = (r >> 4) * 2 + (c >> 5), rr = r & 15, cc = c & 31, ob = rr * 64 + cc * 2; return st * 1024 + (ob ^ (((ob >> 9) & 1) << 5)); }
__host__ __device__ __forceinline__ void stage_rc(int b, int& R, int& C) { const int st = b / 1024, sb = b % 1024, swz = sb ^ (((sb >> 9) & 1) << 5); R = (st >> 1) * 16 + swz / 64; C = (st & 1) * 32 + (swz % 64) / 2; }
__host__ __device__ __forceinline__ int perm32(int rho) { const int n = rho >> 4, i = rho & 15; return 8 * (i >> 2) + 4 * n + (i & 3); }

struct Unit { int pm, pn; };
struct Gemm { const bf16_t* A; const bf16_t* Bt; int M, N, K; };

struct StaticOrder {
    int nM, nN, nwg, G, c;
    __host__ __device__ void init(int M, int N, int G_, int c_) { nM = M / BM; nN = N / BM; nwg = nM * nN; G = G_; c = c_; }
    __host__ __device__ bool next(int i, Unit& u) const {
        const long L = (long)i * G + c; if (L >= nwg) return false;
        int wgid = (int)L; { const int q = nwg / NXCD, r = nwg % NXCD, xcd = wgid % NXCD, off = wgid / NXCD; wgid = (xcd < r ? xcd * (q + 1) : r * (q + 1) + (xcd - r) * q) + off; }
        const int nig = WGM * nN, gid = wgid / nig, fm = gid * WGM, gsz = (nM - fm) < WGM ? (nM - fm) : WGM;
        u.pm = fm + ((wgid % nig) % gsz); u.pn = (wgid % nig) / gsz; return true;
    }
    __device__ __forceinline__ void a_ready(const Unit&) const {}
    __device__ __forceinline__ void done(const Unit&) const {}
};

__device__ __forceinline__ unsigned cvt_pk_bf16(float lo, float hi) { unsigned r; asm volatile("v_cvt_pk_bf16_f32 %0, %1, %2" : "=v"(r) : "v"(lo), "v"(hi)); return r; }
typedef float f32x2 __attribute__((ext_vector_type(2)));
template <class Epi, class Sched, bool ALIGN_EPI = false, bool SP2 = false>
__device__ __forceinline__ void gemm_phase(PG8_LAS unsigned char* lds, const Gemm g, const Sched& S, const Epi& E) {
    int tid_raw = threadIdx.x; asm volatile("" : "+v"(tid_raw));
    const int tid = tid_raw, wid = __builtin_amdgcn_readfirstlane(tid >> 6), lane = tid & 63, wr = wid >> 2, wc = wid & 3, fr = lane & 15, fq = lane >> 4;
    const int K = g.K, nt = K / BK;
    unsigned voffA[2], voffB[2];
#pragma unroll
    for (int i = 0; i < 2; ++i) { int R, C; stage_rc(tid * 16 + i * 8192, R, C); const int Rb = Epi::PERM ? ((R & ~31) + perm32(R & 31)) : R;
        voffA[i] = (unsigned)(R * K + C) * 2u; voffB[i] = (unsigned)(Rb * K + C) * 2u; }
    const size_t kstep = (size_t)(BK * 2);
    const size_t hstep = (size_t)HALF * K * 2;
    const size_t tstep = 2 * hstep;
    const unsigned ldsw = (unsigned)wid * 1024u;
    const int aoff = lds_byte(wr * 64 + fr, fq * 8), boff = lds_byte(wc * 32 + fr, fq * 8);
#define PG8_SA(b, h) (((b) * 2 + (h)) * HTB)
#define PG8_SB(b, h) ((4 + (b) * 2 + (h)) * HTB)
#define PG8_STAGE(bufoff, gbase, voff) do { _Pragma("unroll") for (int _i = 0; _i < 2; ++_i) \
        __builtin_amdgcn_global_load_lds((const unsigned*)((const char*)(gbase) + (voff)[_i]), (PG8_LAS unsigned*)(lds + (bufoff) + ldsw + _i * 8192), 16, 0, 0); } while (0)
#define PG8_LDA(dst, b, h) do { _Pragma("unroll") for (int m = 0; m < 4; ++m) _Pragma("unroll") for (int k = 0; k < 2; ++k) dst[m][k] = *(const PG8_LAS bf16x8*)(lds + PG8_SA(b, h) + aoff + m * 2048 + k * 1024); } while (0)
#define PG8_LDB(dst, b, h) do { _Pragma("unroll") for (int n = 0; n < 2; ++n) _Pragma("unroll") for (int k = 0; k < 2; ++k) dst[n][k] = *(const PG8_LAS bf16x8*)(lds + PG8_SB(b, h) + boff + n * 2048 + k * 1024); } while (0)
#define PG8_MMA(ai, bj, At, Bt) do { __builtin_amdgcn_s_setprio(1); _Pragma("unroll") for (int m = 0; m < 4; ++m) _Pragma("unroll") for (int n = 0; n < 2; ++n) _Pragma("unroll") for (int k = 0; k < 2; ++k) \
        acc[ai][bj][m][n] = __builtin_amdgcn_mfma_f32_16x16x32_bf16(Bt[n][k], At[m][k], acc[ai][bj][m][n], 0, 0, 0); __builtin_amdgcn_s_setprio(0); } while (0)
#define PG8_WAIT_V(n) asm volatile("s_waitcnt vmcnt(" #n ")" ::: "memory")
#define PG8_WAIT_L(n) asm volatile("s_waitcnt lgkmcnt(" #n ")" ::: "memory")
#define PG8_BAR __builtin_amdgcn_s_barrier()
#define PG8_SCHED __builtin_amdgcn_sched_barrier(0)
    Unit cur, nxt; int ui = 0;
    if (!S.next(0, cur)) return;
    f32x4 acc[2][2][4][2];
#pragma unroll
    for (int a = 0; a < 2; ++a)
#pragma unroll
        for (int b = 0; b < 2; ++b)
#pragma unroll
            for (int m = 0; m < 4; ++m)
#pragma unroll
                for (int n = 0; n < 2; ++n) acc[a][b][m][n] = (f32x4){0.f, 0.f, 0.f, 0.f};
    bf16x8 At[4][2], B0[2][2], B1[2][2];
    const char* cA = (const char*)g.A + (size_t)cur.pm * tstep; const char* cB = (const char*)g.Bt + (size_t)cur.pn * tstep;
    S.a_ready(cur);
    if constexpr (SP2) {
        PG8_STAGE(PG8_SB(0, 0), cB, voffB); PG8_STAGE(PG8_SB(0, 1), cB + hstep, voffB); PG8_STAGE(PG8_SA(0, 0), cA, voffA); PG8_STAGE(PG8_SA(0, 1), cA + hstep, voffA);
        if (wr == 1) PG8_BAR;
        PG8_WAIT_V(2); PG8_BAR;
        PG8_STAGE(PG8_SB(1, 0), cB + kstep, voffB); PG8_STAGE(PG8_SA(1, 0), cA + kstep, voffA); PG8_STAGE(PG8_SB(1, 1), cB + hstep + kstep, voffB);
        PG8_WAIT_V(6); PG8_BAR;
    } else {
        PG8_STAGE(PG8_SB(0, 0), cB, voffB); PG8_STAGE(PG8_SA(0, 0), cA, voffA); PG8_STAGE(PG8_SB(0, 1), cB + hstep, voffB); PG8_STAGE(PG8_SA(0, 1), cA + hstep, voffA);
        if (wr == 1) PG8_BAR;
        PG8_WAIT_V(4); PG8_BAR;
        PG8_STAGE(PG8_SB(1, 0), cB + kstep, voffB); PG8_STAGE(PG8_SA(1, 0), cA + kstep, voffA); PG8_STAGE(PG8_SB(1, 1), cB + hstep + kstep, voffB);
        PG8_WAIT_V(6); PG8_BAR;
    }
    for (;;) {
        const bool has_next = S.next(ui + 1, nxt);
        const char* nA = has_next ? (const char*)g.A + (size_t)nxt.pm * tstep : cA; const char* nB = has_next ? (const char*)g.Bt + (size_t)nxt.pn * tstep : cB;
        for (int t = 0; t < nt; t += 2) {
            const bool last = (t == nt - 2);
            const char* a1 = cA + (size_t)(t + 1) * kstep;
            const char* a2 = last ? nA : cA + (size_t)(t + 2) * kstep; const char* b2 = last ? nB : cB + (size_t)(t + 2) * kstep;
            const char* a3 = a2 + kstep; const char* b3 = b2 + kstep;
            if (last && has_next) S.a_ready(nxt);
            if constexpr (SP2) {
            PG8_LDB(B0, 0, 0); PG8_LDB(B1, 0, 1); PG8_SCHED; PG8_LDA(At, 0, 0); PG8_STAGE(PG8_SA(1, 1), a1 + hstep, voffA);
            PG8_WAIT_V(8); PG8_WAIT_L(0); PG8_BAR; PG8_MMA(0, 0, At, B0); PG8_MMA(0, 1, At, B1); PG8_BAR; PG8_SCHED;
            PG8_LDA(At, 0, 1); PG8_STAGE(PG8_SB(0, 0), b2, voffB); PG8_STAGE(PG8_SB(0, 1), b2 + hstep, voffB); PG8_STAGE(PG8_SA(0, 0), a2, voffA);
            PG8_WAIT_V(8); PG8_WAIT_L(0); PG8_BAR; PG8_MMA(1, 0, At, B0); PG8_MMA(1, 1, At, B1); PG8_BAR; PG8_SCHED;
            PG8_LDB(B0, 1, 0); PG8_LDB(B1, 1, 1); PG8_SCHED; PG8_LDA(At, 1, 0); PG8_STAGE(PG8_SA(0, 1), a2 + hstep, voffA);
            PG8_WAIT_V(8); PG8_WAIT_L(0); PG8_BAR; PG8_MMA(0, 0, At, B0); PG8_MMA(0, 1, At, B1); PG8_BAR; PG8_SCHED;
            PG8_LDA(At, 1, 1); PG8_STAGE(PG8_SB(1, 0), b3, voffB); PG8_STAGE(PG8_SB(1, 1), b3 + hstep, voffB); PG8_STAGE(PG8_SA(1, 0), a3, voffA);
            PG8_WAIT_V(8); PG8_WAIT_L(0); PG8_BAR; PG8_MMA(1, 0, At, B0); PG8_MMA(1, 1, At, B1); PG8_BAR; PG8_SCHED;
            } else {
            PG8_LDB(B0, 0, 0); PG8_SCHED; PG8_LDA(At, 0, 0); PG8_STAGE(PG8_SA(1, 1), a1 + hstep, voffA);
            PG8_WAIT_L(8); PG8_BAR; PG8_WAIT_L(0); PG8_MMA(0, 0, At, B0); PG8_BAR; PG8_SCHED;
            PG8_LDB(B1, 0, 1); PG8_STAGE(PG8_SB(0, 0), b2, voffB);
            PG8_BAR; PG8_WAIT_L(0); PG8_MMA(0, 1, At, B1); PG8_BAR;
            PG8_LDA(At, 0, 1); PG8_STAGE(PG8_SA(0, 0), a2, voffA);
            PG8_BAR; PG8_WAIT_L(0); PG8_MMA(1, 0, At, B0); PG8_BAR; PG8_SCHED;
            PG8_STAGE(PG8_SB(0, 1), b2 + hstep, voffB);
            PG8_WAIT_V(6); PG8_BAR; PG8_MMA(1, 1, At, B1); PG8_BAR;
            PG8_LDB(B0, 1, 0); PG8_SCHED; PG8_LDA(At, 1, 0); PG8_STAGE(PG8_SA(0, 1), a2 + hstep, voffA);
            PG8_WAIT_L(8); PG8_BAR; PG8_WAIT_L(0); PG8_MMA(0, 0, At, B0); PG8_BAR; PG8_SCHED;
            PG8_LDB(B1, 1, 1); PG8_STAGE(PG8_SB(1, 0), b3, voffB);
            PG8_BAR; PG8_WAIT_L(0); PG8_MMA(0, 1, At, B1); PG8_BAR;
            PG8_LDA(At, 1, 1); PG8_STAGE(PG8_SA(1, 0), a3, voffA);
            PG8_BAR; PG8_WAIT_L(0); PG8_MMA(1, 0, At, B0); PG8_BAR; PG8_SCHED;
            PG8_STAGE(PG8_SB(1, 1), b3 + hstep, voffB);
            PG8_WAIT_V(6); PG8_BAR; PG8_MMA(1, 1, At, B1); PG8_BAR;
            }
        }
        if constexpr (ALIGN_EPI) { if (wr == 0) PG8_BAR; }
        if constexpr (!Epi::AFTER_DRAIN) { E(acc, cur, wr, wc, fr, fq); S.done(cur); }
        if (!has_next) break;
#pragma unroll
        for (int a = 0; a < 2; ++a)
#pragma unroll
            for (int b = 0; b < 2; ++b)
#pragma unroll
                for (int m = 0; m < 4; ++m)
#pragma unroll
                    for (int n = 0; n < 2; ++n) acc[a][b][m][n] = (f32x4){0.f, 0.f, 0.f, 0.f};
        cur = nxt; cA = nA; cB = nB; ++ui;
        if constexpr (ALIGN_EPI) { if (wr == 1) PG8_BAR; }
    }
    PG8_WAIT_V(0);
    if constexpr (!ALIGN_EPI) { if (wr == 0) PG8_BAR; }
    PG8_BAR;
    if constexpr (Epi::AFTER_DRAIN) { E.fused(acc, cur, wr, wc, fr, fq, lds, wid, lane); S.done(cur); }
#undef PG8_SA
#undef PG8_SB
#undef PG8_STAGE
#undef PG8_LDA
#undef PG8_LDB
#undef PG8_MMA
#undef PG8_WAIT_V
#undef PG8_WAIT_L
#undef PG8_BAR
#undef PG8_SCHED
}
}
#define LAS __attribute__((address_space(3)))
#define XB_TMO      128
#define XB_XCNT(j)  (256  + 64 * (j))
#define XB_XSUB(j)  (1280 + 64 * (j))
#define XB_XGEN(j)  (2304 + 64 * (j))
#define XB_TOP      3328
#define XB_TOPGEN   3392
#define XCD_BAR_WORDS 3456
#define XB_SPIN_CAP (1u << 18)

__device__ __forceinline__ unsigned xb_ld(unsigned* p)              { return __hip_atomic_load(p, __ATOMIC_RELAXED, __HIP_MEMORY_SCOPE_AGENT); }
__device__ __forceinline__ unsigned xb_add(unsigned* p, unsigned v) { return __hip_atomic_fetch_add(p, v, __ATOMIC_RELAXED, __HIP_MEMORY_SCOPE_AGENT); }
__device__ __forceinline__ unsigned xb_xcc_id() { return (unsigned)__builtin_amdgcn_s_getreg((3 << 11) | 20) & 0xFu; }
#define XB_SPIN(cond, bar) do { unsigned _sp = 0; while (cond) { __builtin_amdgcn_s_sleep(1); \
    if ((++_sp & 255u) == 0u) { if (xb_ld(&(bar)[XB_TMO])) break; if (_sp > XB_SPIN_CAP) { atomicAdd(&(bar)[XB_TMO], 1u); break; } } } } while (0)

struct XcdBarrier {
    unsigned* bar; unsigned x;
    volatile LAS unsigned* st;
};

__device__ __forceinline__ XcdBarrier xcd_barrier_post(unsigned* bar, volatile LAS unsigned* st) {
    XcdBarrier b; b.bar = bar; b.x = xb_xcc_id(); b.st = st;
    if (threadIdx.x == 0) (void)xb_add(&bar[XB_XCNT(b.x)], 1u);
    return b;
}
__device__ __forceinline__ void xcd_barrier_complete(unsigned* bar, unsigned x, unsigned& nloc, unsigned& nx) {
    const unsigned G = gridDim.x * gridDim.y * gridDim.z;
    unsigned sum, cnt, mine, sp = 0u;
    for (;;) {
        sum = 0u; cnt = 0u; mine = 0u;
#pragma unroll
        for (unsigned j = 0; j < 16; ++j) { const unsigned c = xb_ld(&bar[XB_XCNT(j)]); sum += c; cnt += (c > 0u) ? 1u : 0u; mine = (j == x) ? c : mine; }
        if (sum == G) break;
        __builtin_amdgcn_s_sleep(1);
        if ((++sp & 255u) == 0u) { if (xb_ld(&bar[XB_TMO])) break; if (sp > XB_SPIN_CAP) { atomicAdd(&bar[XB_TMO], 1u); break; } }
    }
    nloc = mine > 0u ? mine : 1u; nx = cnt > 0u ? cnt : 1u;
}

__device__ __forceinline__ void xcd_barrier(const XcdBarrier& b) {
    asm volatile("s_waitcnt vmcnt(0)" ::: "memory");
    __syncthreads();
    if (threadIdx.x == 0) {
        unsigned* bar = b.bar;
        __builtin_amdgcn_s_waitcnt(0);
        unsigned nloc = b.st[0], nx = b.st[1];
        if (nloc == 0u) { xcd_barrier_complete(bar, b.x, nloc, nx); b.st[0] = nloc; b.st[1] = nx; }
        const unsigned old = xb_add(&bar[XB_XSUB(b.x)], 1u);
        const unsigned gen = old / nloc;
        if (old + 1u == (gen + 1u) * nloc) {
            __builtin_amdgcn_fence(__ATOMIC_RELEASE, "agent");
            asm volatile("s_waitcnt vmcnt(0)" ::: "memory");
            const unsigned og = xb_add(&bar[XB_TOP], 1u);
            const unsigned tg = og / nx;
            if (og + 1u == (tg + 1u) * nx) xb_add(&bar[XB_TOPGEN], 1u);
            else XB_SPIN(xb_ld(&bar[XB_TOPGEN]) == tg, bar);
            __builtin_amdgcn_fence(__ATOMIC_ACQUIRE, "agent");
            xb_add(&bar[XB_XGEN(b.x)], 1u);
            asm volatile("s_waitcnt vmcnt(0)" ::: "memory");
        } else {
            XB_SPIN(xb_ld(&bar[XB_XGEN(b.x)]) == gen, bar);
            __builtin_amdgcn_fence(__ATOMIC_ACQUIRE, "agent");
            asm volatile("s_waitcnt vmcnt(0)" ::: "memory");
        }
    }
    __syncthreads();
}

constexpr int DM = 1024, SEQ = 8192, MP = 16384, MS = 128, MR = MP + MS, RT = 16640;
constexpr int DFF = 2816, DV = 3072, NGA = 8, CGW = 384, NQG = 1280, NKVP = 1536;
constexpr int NMOD = 40960;
constexpr int MODKV = 36864, MODFIN = 38912;
constexpr int NPAGES = 16, PAST = 2048;
constexpr float LOG2E = 1.4426950408889634f;
#ifndef ONE_LAUNCH
#define ONE_LAUNCH 1
#endif

constexpr size_t OY_P = 0, OY_S = 16777216, OKV_P = 16908288, OKV_S = 33685504, OWIN_P = 33816576, OWIN_S = 34340864, OGV = 67895296, OUT_TOTAL = 68681728;

constexpr size_t al(size_t x) { return (x + 0xFFFFFull) & ~0xFFFFFull; }
constexpr size_t WS_CTL = 0, CTL_ZERO_BYTES = 2u << 20;
constexpr size_t WS_WMOD = al(CTL_ZERO_BYTES);
constexpr size_t WS_WGU = al(WS_WMOD + (size_t)NMOD * DM * 2);
constexpr size_t WS_WDN = al(WS_WGU + (size_t)8 * 5632 * DM * 2);
constexpr size_t WS_WUV = al(WS_WDN + (size_t)8 * DM * DFF * 2);
constexpr size_t WS_WOUT = al(WS_WUV + (size_t)2 * 6144 * DM * 2);
constexpr size_t WS_WQG = al(WS_WOUT + (size_t)2 * DM * DV * 2);
constexpr size_t WS_WO = al(WS_WQG + (size_t)2 * NQG * DM * 2);
constexpr size_t WS_WKV = al(WS_WO + (size_t)2 * DM * DM * 2);
constexpr size_t WS_WC1 = al(WS_WKV + (size_t)NKVP * DM * 2);
constexpr size_t WS_WC2 = al(WS_WC1 + (size_t)2 * 512 * 1024 * 2);
constexpr size_t WS_WSP = al(WS_WC2 + (size_t)2 * 64 * 256 * 2);
constexpr size_t WS_CBIAS = al(WS_WSP + (size_t)2 * 8 * 128 * 128 * 2);
constexpr size_t WS_X = al(WS_CBIAS + 4096);
constexpr size_t WS_H = al(WS_X + (size_t)RT * DM * 2);
constexpr size_t WS_HID = al(WS_H + (size_t)RT * DM * 2);
constexpr size_t WS_Z = al(WS_HID + (size_t)RT * DFF * 2);
constexpr size_t WS_VT = al(WS_Z + (size_t)RT * 6144 * 2);
constexpr size_t WS_P = al(WS_VT + (size_t)128 * DV * 128 * 2);
constexpr size_t WS_Q = al(WS_P + (size_t)RT * DV * 2);
constexpr size_t WS_GATES = al(WS_Q + (size_t)RT * DM * 2);
constexpr size_t WS_O = al(WS_GATES + (size_t)RT * 48 * 4);
constexpr size_t KVB = (size_t)8 * SEQ * 64 * 2;
constexpr size_t WS_KCIN = al(WS_O + (size_t)RT * DM * 2);
constexpr size_t WS_VCIN = WS_KCIN + KVB, WS_SK = WS_VCIN + KVB, WS_SVT = WS_SK + KVB, WS_WK = WS_SVT + KVB, WS_WVT = WS_WK + KVB;
constexpr size_t WS_MOD = al(WS_WVT + KVB);
constexpr size_t WS_SC = al(WS_MOD + (size_t)256 * NMOD * 4);
constexpr size_t WS_TK = al(WS_SC + (size_t)256 * DM * 2);
constexpr size_t WS_TV = al(WS_TK + (size_t)4096 * 512 * 2);
constexpr size_t WS_KC = al(WS_TV + (size_t)4096 * 512 * 2);
constexpr size_t WS_VCT = al(WS_KC + (size_t)8 * 512 * 64 * 2);
constexpr size_t WS_ACMP = al(WS_VCT + (size_t)8 * 64 * 512 * 2);
constexpr size_t WS_TS = al(WS_ACMP + (size_t)2 * 65536 * 1024 * 2);
constexpr size_t WS_KCS = al(WS_TS + (size_t)2 * 65536 * 512 * 2);
constexpr size_t WS_VCS = al(WS_KCS + (size_t)512 * 128 * 64 * 4);
constexpr size_t WS_OACC = al(WS_VCS + (size_t)512 * 128 * 64 * 4);
constexpr size_t WS_HKV = al(WS_OACC + (size_t)MP * DM * 4);
constexpr size_t WS_SHB = al(WS_HKV + (size_t)RT * DM * 2);
constexpr size_t WS_B2 = al(WS_SHB + (size_t)13 * 256 * 1024 * 2);
constexpr size_t WS_NG = al(WS_B2 + (size_t)13 * 256 * 6144 * 4);
constexpr size_t WS_SSP = al(WS_NG + (size_t)13 * 1024 * 4);
constexpr size_t WS_SSPS = al(WS_SSP + (size_t)11 * MP * 16 * 4);
constexpr size_t WS_END = al(WS_SSPS + (size_t)11 * MS * 32 * 4);

constexpr int CW_BAR = 4096, CW_QUEUE = 8192, CW_SS = 32768, CW_VS = CW_SS + 11 * 16640;
static_assert((size_t)(CW_VS + 2 * 16640 * 2) * 4 <= CTL_ZERO_BYTES, "SS / VS accumulators inside the memset region");

constexpr int RING_BYTES = 131072, LDSCTL_OFF = RING_BYTES, MISC_OFF = LDSCTL_OFF + 320, LDS_BYTES = 147456;
constexpr int NWAVES = 8;

#define GAS __attribute__((address_space(1)))
typedef unsigned short bf16;
typedef unsigned v4u __attribute__((ext_vector_type(4)));
typedef unsigned v2u __attribute__((ext_vector_type(2)));
typedef float f32x4 __attribute__((ext_vector_type(4)));
typedef short bf16x8 __attribute__((ext_vector_type(8)));
typedef short bf16x4 __attribute__((ext_vector_type(4)));
typedef float f32x2 __attribute__((ext_vector_type(2)));
typedef _Float16 f16x4 __attribute__((ext_vector_type(4)));
typedef _Float16 f16x8 __attribute__((ext_vector_type(8)));
typedef _Float16 f16;

__device__ __forceinline__ float bf2f(unsigned b) { return __uint_as_float(b << 16); }
__device__ __forceinline__ float bflo(unsigned w) { return __uint_as_float(w << 16); }
__device__ __forceinline__ float bfhi(unsigned w) { return __uint_as_float(w & 0xffff0000u); }
__device__ __forceinline__ unsigned pk2(float lo, float hi) { return pg8::cvt_pk_bf16(lo, hi); }
__device__ __forceinline__ float frcp(float x) { return __builtin_amdgcn_rcpf(x); }
__device__ __forceinline__ float fexp2(float x) { return __builtin_amdgcn_exp2f(x); }
__device__ __forceinline__ float sigmoid_f(float x) { return frcp(1.f + fexp2(-LOG2E * x)); }
__device__ __forceinline__ float silu_f(float x) { return x * sigmoid_f(x); }
__device__ __forceinline__ float gelu_tanh_f(float x) { const float u = x + 0.044715f * x * x * x; return x * frcp(1.f + fexp2(-2.302208198f * u)); }
__device__ __forceinline__ int row_b(int r) { return r < SEQ ? 0 : (r < MP ? 1 : 2 + ((r - MP) < MS ? (r - MP) : (MS - 1))); }
template <int CTRL> __device__ __forceinline__ float dppf(float x) { return __builtin_bit_cast(float, __builtin_amdgcn_mov_dpp(__builtin_bit_cast(int, x), CTRL, 0xF, 0xF, true)); }
template <int CTRL> __device__ __forceinline__ unsigned dppu(unsigned x) { return (unsigned)__builtin_amdgcn_mov_dpp((int)x, CTRL, 0xF, 0xF, true); }
#define DPP_X1 0xB1
#define DPP_X2 0x4E
#define DPP_HM 0x141
#define DPP_RM 0x140
#define DPP_X8 0x128
__device__ __forceinline__ void xpair16(float x, float& a, float& b) { auto r = __builtin_amdgcn_permlane16_swap(__float_as_uint(x), __float_as_uint(x), false, false); a = __uint_as_float(r[0]); b = __uint_as_float(r[1]); }
__device__ __forceinline__ void xpair32(float x, float& a, float& b) { auto r = __builtin_amdgcn_permlane32_swap(__float_as_uint(x), __float_as_uint(x), false, false); a = __uint_as_float(r[0]); b = __uint_as_float(r[1]); }
__device__ __forceinline__ void xpair16i(int x, int& a, int& b) { auto r = __builtin_amdgcn_permlane16_swap((unsigned)x, (unsigned)x, false, false); a = (int)r[0]; b = (int)r[1]; }
__device__ __forceinline__ void xpair32i(int x, int& a, int& b) { auto r = __builtin_amdgcn_permlane32_swap((unsigned)x, (unsigned)x, false, false); a = (int)r[0]; b = (int)r[1]; }
__device__ __forceinline__ float xsum_16_32(float x) { float a, b; xpair16(x, a, b); x = a + b; xpair32(x, a, b); return a + b; }
__device__ __forceinline__ float xmax_16_32(float x) { float a, b; xpair16(x, a, b); x = fmaxf(a, b); xpair32(x, a, b); return fmaxf(a, b); }
__device__ __forceinline__ float wave_sum(float v) { v += dppf<DPP_X1>(v); v += dppf<DPP_X2>(v); v += dppf<DPP_HM>(v); v += dppf<DPP_RM>(v); return xsum_16_32(v); }
__device__ __forceinline__ v4u pack8(const f32x4 a, const f32x4 b) { v4u w; w.x = pk2(a[0], a[1]); w.y = pk2(a[2], a[3]); w.z = pk2(b[0], b[1]); w.w = pk2(b[2], b[3]); return w; }
__device__ __forceinline__ void unpack8(const v4u w, float (&f)[8]) { f[0] = bflo(w.x); f[1] = bfhi(w.x); f[2] = bflo(w.y); f[3] = bfhi(w.y); f[4] = bflo(w.z); f[5] = bfhi(w.z); f[6] = bflo(w.w); f[7] = bfhi(w.w); }

template <class F> struct Epi8 {
    static constexpr bool PERM = true, AFTER_DRAIN = false; F f;
    __device__ __forceinline__ void operator()(const pg8::f32x4 (&acc)[2][2][4][2], const pg8::Unit& u, int wr, int wc, int fr, int fq) const {
        const int row0 = u.pm * pg8::BM + wr * 64 + fr, col0 = u.pn * pg8::BM + wc * 32 + 8 * fq;
        typename F::Pre pre; f.prep(pre, row0, col0, false);
#pragma unroll
        for (int ai = 0; ai < 2; ++ai)
#pragma unroll
            for (int mh = 0; mh < 2; ++mh) {
                typename F::Ld ld[2][2];
#pragma unroll
                for (int m2 = 0; m2 < 2; ++m2)
#pragma unroll
                    for (int bj = 0; bj < 2; ++bj) f.fetch(ld[m2][bj], row0 + ai * pg8::HALF + (2 * mh + m2) * 16, col0 + bj * pg8::HALF);
#pragma unroll
                for (int m2 = 0; m2 < 2; ++m2) { const int m = 2 * mh + m2, row = row0 + ai * pg8::HALF + m * 16;
                    f32x2 part = (f32x2){0.f, 0.f};
#pragma unroll
                    for (int bj = 0; bj < 2; ++bj) part = part + f(pre, ld[m2][bj], ai * 4 + m, bj, row, col0 + bj * pg8::HALF, acc[ai][bj][m][0], acc[ai][bj][m][1]);
                    f.row_done(row, part, fq); }
            }
    }
};
struct NoLd {};
struct NoPre {};
struct NormPre { float rs[8]; f32x4 b[2][2]; };
struct NormIn { unsigned char* ws; int ssi, inst, on;
    __device__ __forceinline__ void prep(NormPre& p, int row0, int col0, bool skinny) const {
        if (!on) return;
        const float* SS = (const float*)(ws + WS_CTL) + CW_SS + (size_t)ssi * RT; const float* b = (const float*)(ws + WS_B2) + ((size_t)inst * 256 + row_b(row0)) * 6144 + col0;
        if (skinny) { p.rs[0] = SS[row0]; p.b[0][0] = *(const f32x4*)b; p.b[0][1] = *(const f32x4*)(b + 4); p.rs[0] = __builtin_amdgcn_rsqf(p.rs[0] * (1.0f / DM) + 1e-6f); }
        else {
#pragma unroll
            for (int i = 0; i < 8; ++i) p.rs[i] = SS[row0 + (i >> 2) * 128 + (i & 3) * 16];
#pragma unroll
            for (int bj = 0; bj < 2; ++bj) { p.b[bj][0] = *(const f32x4*)(b + 128 * bj); p.b[bj][1] = *(const f32x4*)(b + 128 * bj + 4); }
#pragma unroll
            for (int i = 0; i < 8; ++i) p.rs[i] = __builtin_amdgcn_rsqf(p.rs[i] * (1.0f / DM) + 1e-6f);
        }
    }
    __device__ __forceinline__ void apply(const NormPre& p, int ri, int bj, f32x4& v0, f32x4& v1) const { if (on) { v0 = v0 * p.rs[ri] + p.b[bj][0]; v1 = v1 * p.rs[ri] + p.b[bj][1]; } }
};
struct FSwiglu {
    typedef NormPre Pre; typedef NoLd Ld; __device__ __forceinline__ void fetch(Ld&, int, int) const {} bf16* HID; NormIn ni;
    __device__ __forceinline__ void prep(Pre& p, int row0, int col0, bool sk) const { ni.prep(p, row0, col0, sk); }
    __device__ __forceinline__ f32x2 operator()(const Pre& p, const Ld&, int ri, int bj, int row, int col0, f32x4 g, f32x4 u) const {
        ni.apply(p, ri, bj, g, u);
        v2u w; w.x = pk2(silu_f(g[0]) * u[0], silu_f(g[1]) * u[1]); w.y = pk2(silu_f(g[2]) * u[2], silu_f(g[3]) * u[3]);
        *(v2u*)(HID + (size_t)row * DFF + (col0 >> 1)) = w; return (f32x2){0.f, 0.f};
    }
    __device__ __forceinline__ void row_done(int, f32x2, int) const {}
};
struct ResidPre { f32x4 gate[2][2], hm[2][2]; };
struct FResid {
    typedef ResidPre Pre; struct Ld { f32x4 x0, x1; };
    unsigned char* ws; int gcol; float coef; int n1, sc1, n2, sc2, ssi;
    __device__ __forceinline__ void fetch(Ld& d, int row, int col0) const { const f16x8 h = *(const f16x8*)((const f16*)(ws + WS_X) + (size_t)row * DM + col0); const f16x4 lo = __builtin_shufflevector(h, h, 0, 1, 2, 3), hi = __builtin_shufflevector(h, h, 4, 5, 6, 7);
        d.x0 = __builtin_convertvector(lo, f32x4); d.x1 = __builtin_convertvector(hi, f32x4); }
    __device__ __forceinline__ void prep(Pre& p, int row0, int col0, bool skinny) const {
        const float* mrow = (const float*)(ws + WS_MOD) + (size_t)row_b(row0) * NMOD + col0;
#pragma unroll
        for (int bj = 0; bj < 2; ++bj) { if (skinny && bj) break;
            p.gate[bj][0] = *(const f32x4*)(mrow + gcol + 128 * bj) * coef; p.gate[bj][1] = *(const f32x4*)(mrow + gcol + 128 * bj + 4) * coef;
            if (n1 >= 0) { const float* g1 = (const float*)(ws + WS_NG) + n1 * DM + col0 + 128 * bj;
                p.hm[bj][0] = *(const f32x4*)g1 * (*(const f32x4*)(mrow + sc1 + 128 * bj) + 1.0f); p.hm[bj][1] = *(const f32x4*)(g1 + 4) * (*(const f32x4*)(mrow + sc1 + 128 * bj + 4) + 1.0f); } }
    }
    __device__ __forceinline__ f32x2 operator()(const Pre& p, const Ld& d, int ri, int bj, int row, int col0, f32x4 v0, f32x4 v1) const {
        const f32x4 x0 = d.x0 + p.gate[bj][0] * v0, x1 = d.x1 + p.gate[bj][1] * v1;
        { const f16x4 lo = __builtin_convertvector(x0, f16x4), hi = __builtin_convertvector(x1, f16x4); *(f16x8*)((f16*)(ws + WS_X) + (size_t)row * DM + col0) = __builtin_shufflevector(lo, hi, 0, 1, 2, 3, 4, 5, 6, 7); }
        if (n1 >= 0) *(v4u*)((bf16*)(ws + WS_H) + (size_t)row * DM + col0) = pack8(x0 * p.hm[bj][0], x1 * p.hm[bj][1]);
        if (n2 >= 0) { const float* mrow = (const float*)(ws + WS_MOD) + (size_t)row_b(row) * NMOD + col0; const float* g2 = (const float*)(ws + WS_NG) + n2 * DM + col0;
            const f32x4 a0 = *(const f32x4*)g2, a1 = *(const f32x4*)(g2 + 4), s0 = *(const f32x4*)(mrow + sc2), s1 = *(const f32x4*)(mrow + sc2 + 4);
            *(v4u*)((bf16*)(ws + WS_HKV) + (size_t)row * DM + col0) = pack8(x0 * a0 * (s0 + 1.0f), x1 * a1 * (s1 + 1.0f)); }
        return (f32x2){((x0[0] * x0[0] + x0[1] * x0[1]) + (x0[2] * x0[2] + x0[3] * x0[3])) + ((x1[0] * x1[0] + x1[1] * x1[1]) + (x1[2] * x1[2] + x1[3] * x1[3])), 0.f};
    }
    __device__ __forceinline__ void row_done(int row, f32x2 part2, int fq) const {
        float part = part2[0];
        if (ssi >= 0) { part = xsum_16_32(part); if (fq == 0) atomicAdd((float*)(ws + WS_CTL) + CW_SS + (size_t)ssi * RT + row, part); }
    }
};
struct FGelu {
    typedef NormPre Pre; typedef NoLd Ld; __device__ __forceinline__ void fetch(Ld&, int, int) const {} bf16* Z; NormIn ni; float* VS;
    __device__ __forceinline__ void prep(Pre& p, int row0, int col0, bool sk) const { ni.prep(p, row0, col0, sk); }
    __device__ __forceinline__ f32x2 operator()(const Pre& p, const Ld&, int ri, int bj, int row, int col0, f32x4 v0, f32x4 v1) const {
        ni.apply(p, ri, bj, v0, v1);
        f32x4 a, b;
#pragma unroll
        for (int i = 0; i < 4; ++i) { a[i] = gelu_tanh_f(v0[i]); b[i] = gelu_tanh_f(v1[i]); }
        *(v4u*)(Z + (size_t)row * 6144 + col0) = pack8(a, b);
        if (col0 < DV) return (f32x2){0.f, 0.f};
        const f32x4 s = a + b, q = a * a + b * b; return (f32x2){(s[0] + s[1]) + (s[2] + s[3]), (q[0] + q[1]) + (q[2] + q[3])};
    }
    __device__ __forceinline__ void row_done(int row, f32x2 part, int fq) const {
        float s = part[0], q = part[1];
        s = xsum_16_32(s); q = xsum_16_32(q);
        if (fq == 0 && q != 0.f) { atomicAdd(VS + 2 * (size_t)row, s); atomicAdd(VS + 2 * (size_t)row + 1, q); }
    }
};
struct FQg {
    typedef NormPre Pre; typedef NoLd Ld; __device__ __forceinline__ void fetch(Ld&, int, int) const {} bf16* Q; float* GATES; NormIn ni;
    __device__ __forceinline__ void prep(Pre& p, int row0, int col0, bool sk) const { ni.prep(p, row0, col0, sk); }
    __device__ __forceinline__ f32x2 operator()(const Pre& p, const Ld&, int ri, int bj, int row, int col0, f32x4 v0, f32x4 v1) const {
        ni.apply(p, ri, bj, v0, v1);
        if (col0 < DM) { *(v4u*)(Q + (size_t)row * DM + col0) = pack8(v0 * (0.125f * LOG2E), v1 * (0.125f * LOG2E)); }
        else if (col0 < DM + 48) { f32x4 a, b;
#pragma unroll
            for (int i = 0; i < 4; ++i) { a[i] = sigmoid_f(v0[i]); b[i] = sigmoid_f(v1[i]); }
            float* gp = GATES + (size_t)row * 48 + (col0 - DM); *(f32x4*)gp = a; *(f32x4*)(gp + 4) = b; }
        return (f32x2){0.f, 0.f};
    }
    __device__ __forceinline__ void row_done(int, f32x2, int) const {}
};
struct FKv {
    typedef NormPre Pre; typedef NoLd Ld; __device__ __forceinline__ void fetch(Ld&, int, int) const {} float* out; bf16 *KCIN; NormIn ni;
    __device__ __forceinline__ void prep(Pre& p, int row0, int col0, bool sk) const { ni.prep(p, row0, col0, sk); }
    __device__ __forceinline__ f32x2 operator()(const Pre& p, const Ld&, int ri, int bj, int row, int col0, f32x4 v0, f32x4 v1) const {
        ni.apply(p, ri, bj, v0, v1);
        const int slot = col0 >> 8, g = (col0 >> 6) & 3, d0 = col0 & 63;
        if (row < MP) {
            const int b = row >> 13, t = row & (SEQ - 1);
            if (slot < 4) { float* q = out + OKV_P + (size_t)row * DM + col0; *(f32x4*)q = v0; *(f32x4*)(q + 4) = v1; }
            else if (t >= SEQ - 512) { float* q = out + OWIN_P + ((size_t)(b * 512 + (t - (SEQ - 512))) * 2 + (slot - 4)) * 256 + g * 64 + d0; *(f32x4*)q = v0; *(f32x4*)(q + 4) = v1; }
            const int bg = b * 4 + g;
            if (slot == 3 || slot == 5) {
                bf16* base = KCIN + (size_t)slot * (KVB / 2) + (((size_t)bg * (SEQ / 32) + (t >> 5)) * 64 + d0) * 32 + (t & 31);
#pragma unroll
                for (int i = 0; i < 4; ++i) { base[i * 32] = (bf16)(pk2(v0[i], 0.f) & 0xffffu); base[(i + 4) * 32] = (bf16)(pk2(v1[i], 0.f) & 0xffffu); }
            } else {
                bf16* base = KCIN + (size_t)slot * (KVB / 2) + ((size_t)bg * SEQ + t) * 64 + d0;
                *(v4u*)base = pack8(v0, v1);
            }
        } else {
            const int bs = row - MP;
            if (slot < 4) { float* q = out + OKV_S + (size_t)bs * DM + col0; *(f32x4*)q = v0; *(f32x4*)(q + 4) = v1; }
            else { float* q = out + OWIN_S + ((size_t)bs * 512 + 511) * 512 + (slot - 4) * 256 + g * 64 + d0; *(f32x4*)q = v0; *(f32x4*)(q + 4) = v1; }
        }
        return (f32x2){0.f, 0.f};
    }
    __device__ __forceinline__ void row_done(int, f32x2, int) const {}
};
constexpr int SH_NINST = 13;
struct FMod {
    typedef NoPre Pre; typedef NoLd Ld; __device__ __forceinline__ void fetch(Ld&, int, int) const {} float* MOD; const float *b0, *b1, *b2; bf16* SHB;
    __device__ __forceinline__ void prep(Pre&, int, int, bool) const {}
    __device__ __forceinline__ f32x2 operator()(const Pre&, const Ld&, int, int, int row, int col0, f32x4 v0, f32x4 v1) const {
        const float* bp = col0 < MODKV ? b0 + col0 : (col0 < MODFIN ? b1 + (col0 - MODKV) : b2 + (col0 - MODFIN));
        v0 = v0 + *(const f32x4*)bp; v1 = v1 + *(const f32x4*)(bp + 4);
        float* p = MOD + (size_t)row * NMOD + col0; *(f32x4*)p = v0; *(f32x4*)(p + 4) = v1;
        int inst = -1, k = 0;
        if (col0 < MODKV) { const int l = col0 / 9216, r = col0 - l * 9216, sub = r / 3072, rr = r - sub * 3072; if (rr < DM) { inst = l * 3 + sub; k = rr; } }
        else if (col0 < MODKV + DM) { inst = 12; k = col0 - MODKV; }
        if (inst >= 0) *(v4u*)(SHB + ((size_t)inst * 256 + row) * DM + k) = pack8(v0, v1);
        return (f32x2){0.f, 0.f};
    }
    __device__ __forceinline__ void row_done(int, f32x2, int) const {}
};
struct FBf16 {
    typedef NoPre Pre; typedef NoLd Ld; __device__ __forceinline__ void fetch(Ld&, int, int) const {} bf16* T; int ld;
    __device__ __forceinline__ void prep(Pre&, int, int, bool) const {}
    __device__ __forceinline__ f32x2 operator()(const Pre&, const Ld&, int, int, int row, int col0, f32x4 v0, f32x4 v1) const { *(v4u*)(T + (size_t)row * ld + col0) = pack8(v0, v1); return (f32x2){0.f, 0.f}; }
    __device__ __forceinline__ void row_done(int, f32x2, int) const {}
};
constexpr int TILEB = 256 * 1024 * 2;
constexpr int PN_UV = (int)((WS_WUV - WS_WGU) / TILEB), PN_QG = (int)((WS_WQG - WS_WGU) / TILEB), PN_KV = (int)((WS_WKV - WS_WGU) / TILEB);
static_assert((WS_WUV - WS_WGU) % TILEB == 0 && (WS_WQG - WS_WGU) % TILEB == 0 && (WS_WKV - WS_WGU) % TILEB == 0, "weight copies on 256-row tile boundaries");
struct ShiftOrder {
    int G, c;
    __device__ __forceinline__ bool next(int i, pg8::Unit& u) const {
        const int L = i * G + c; if (L >= 240) return false;
        if (L < 176) { const int f = L / 22, t = L - f * 22; u.pm = (f >> 1) * 3 + 2 * (f & 1); u.pn = f * 22 + t; }
        else if (L < 224) { const int q = L - 176, l = q / 24, t = q - l * 24; u.pm = l * 3 + 1; u.pn = PN_UV + l * 24 + t; }
        else if (L < 234) { const int q = L - 224, j = q / 5, t = q - j * 5; u.pm = (2 + j) * 3 + 1; u.pn = PN_QG + j * 5 + t; }
        else { u.pm = 12; u.pn = PN_KV + (L - 234); }
        return true;
    }
    __device__ __forceinline__ void a_ready(const pg8::Unit&) const {}
    __device__ __forceinline__ void done(const pg8::Unit&) const {}
};
struct FB2 {
    typedef NoPre Pre; typedef NoLd Ld; __device__ __forceinline__ void fetch(Ld&, int, int) const {} float* B2;
    __device__ __forceinline__ void prep(Pre&, int, int, bool) const {}
    __device__ __forceinline__ f32x2 operator()(const Pre&, const Ld&, int, int, int row, int col0, f32x4 v0, f32x4 v1) const {
        const int inst = row >> 8, b = row & 255, pn = col0 >> 8;
        int t;
        if (pn < 176) t = pn % 22; else if (pn < PN_QG) t = (pn - PN_UV) % 24; else if (pn < PN_KV) t = (pn - PN_QG) % 5; else t = pn - PN_KV;
        float* p = B2 + ((size_t)inst * 256 + b) * 6144 + t * 256 + (col0 & 255); *(f32x4*)p = v0; *(f32x4*)(p + 4) = v1; return (f32x2){0.f, 0.f};
    }
    __device__ __forceinline__ void row_done(int, f32x2, int) const {}
};

template <class F> __device__ __forceinline__ void run_gemm(LAS unsigned char* lds, const bf16* A, const bf16* Bt, int M, int N, int K, const F& f, int rot = 0) {
    int cblk = ((int)blockIdx.x + rot) % (int)gridDim.x; asm volatile("" : "+s"(cblk));
    pg8::Gemm g{A, Bt, M, N, K}; pg8::StaticOrder S; S.init(M, N, (int)gridDim.x, cblk);
    Epi8<F> E{f};
    pg8::gemm_phase<Epi8<F>, pg8::StaticOrder, true, true>(lds, g, S, E);
}

template <int RTU, int SB, class F> __device__ __forceinline__ void skinny_gemm(LAS unsigned char* lds, const bf16* A, const bf16* Bt, int ncol32, int K, int rem, const F& f) {
    int tid_raw = threadIdx.x; asm volatile("" : "+v"(tid_raw));
    const int lane = tid_raw & 63, wave = __builtin_amdgcn_readfirstlane(tid_raw >> 6), fr = lane & 15, fq = lane >> 4;
    constexpr int NR = 8 / RTU;
    const int kper = K >> 3, nsteps = kper >> 5, nunits = NR * ncol32;
    int cblk = (int)blockIdx.x; asm volatile("" : "+s"(cblk));
    const int nl = (int)gridDim.x - rem;
    LAS f32x4* red = (LAS f32x4*)lds;
    if (cblk < rem) return;
    for (int u = cblk - rem; u < nunits; u += nl) {
        const int n0 = 32 * (u / NR), r0 = MP + 16 * RTU * (u % NR);
        f32x4 acc[RTU][2];
#pragma unroll
        for (int rt = 0; rt < RTU; ++rt) { acc[rt][0] = (f32x4){0.f, 0.f, 0.f, 0.f}; acc[rt][1] = (f32x4){0.f, 0.f, 0.f, 0.f}; }
        const bf16* bp = Bt + (size_t)(n0 + 8 * (fr >> 2) + (fr & 3)) * K + wave * kper + 8 * fq;
        const bf16* ap = A + (size_t)(r0 + fr) * K + wave * kper + 8 * fq;
        const int row = r0 + 16 * (wave < RTU ? wave : 0) + fr;
        typename F::Pre pre; typename F::Ld ld;
        if (wave < RTU) { f.fetch(ld, row, n0 + 8 * fq); f.prep(pre, row, n0 + 8 * fq, true); }
#pragma unroll 1
        for (int ks0 = 0; ks0 < nsteps; ks0 += SB) {
            bf16x8 bb[SB][2], aa[SB][RTU];
#pragma unroll
            for (int s = 0; s < SB; ++s) { const int ks = (ks0 + s < nsteps) ? ks0 + s : nsteps - 1;
                bb[s][0] = *(const bf16x8*)(bp + 32 * ks); bb[s][1] = *(const bf16x8*)(bp + (size_t)4 * K + 32 * ks);
#pragma unroll
                for (int rt = 0; rt < RTU; ++rt) aa[s][rt] = *(const bf16x8*)(ap + (size_t)(16 * rt) * K + 32 * ks); }
#pragma unroll
            for (int s = 0; s < SB; ++s) if (ks0 + s < nsteps) {
#pragma unroll
                for (int rt = 0; rt < RTU; ++rt) { acc[rt][0] = __builtin_amdgcn_mfma_f32_16x16x32_bf16(bb[s][0], aa[s][rt], acc[rt][0], 0, 0, 0); acc[rt][1] = __builtin_amdgcn_mfma_f32_16x16x32_bf16(bb[s][1], aa[s][rt], acc[rt][1], 0, 0, 0); } }
        }
#pragma unroll
        for (int rt = 0; rt < RTU; ++rt) { red[((wave * RTU + rt) * 2 + 0) * 64 + lane] = acc[rt][0]; red[((wave * RTU + rt) * 2 + 1) * 64 + lane] = acc[rt][1]; }
        __syncthreads();
        if (wave < RTU) {
            f32x4 s0 = (f32x4){0.f, 0.f, 0.f, 0.f}, s1 = (f32x4){0.f, 0.f, 0.f, 0.f};
#pragma unroll
            for (int w2 = 0; w2 < 8; ++w2) { s0 = s0 + red[((w2 * RTU + wave) * 2 + 0) * 64 + lane]; s1 = s1 + red[((w2 * RTU + wave) * 2 + 1) * 64 + lane]; }
            const f32x2 part = f(pre, ld, 0, 0, row, n0 + 8 * fq, s0, s1); f.row_done(row, part, fq);
        }
        __syncthreads();
    }
}
template <class F> __device__ __forceinline__ void run_gemm2(LAS unsigned char* lds, const bf16* A, const bf16* Bt, int N, int Nreal, int K, const F& f, int rot = 0, int rem = -1) {
    run_gemm(lds, A, Bt, MP, N, K, f, rot);
    skinny_gemm<4, 6>(lds, A, Bt, (Nreal + 31) >> 5, K, rem >= 0 ? rem : ((MP / 256) * (N / 256)) % (int)gridDim.x, f);
}
template <class F> __device__ __forceinline__ void run_gemm2r(LAS unsigned char* lds, const bf16* A, const bf16* Bt, int K, const F& f) {
    run_gemm(lds, A, Bt, MP, DM, K, f, 0);
    skinny_gemm<1, 12>(lds, A, Bt, DM / 32, K, 0, f);
}

template <bool FINAL>
__device__ __forceinline__ void norm_phase(const f16* X, const float* gvec, const float* MOD, int shift_col, int scale_col, bf16* H, float* out, int gw, int NGW, int lane) {
    f32x4 gv[4];
#pragma unroll
    for (int j = 0; j < 4; ++j) gv[j] = *(const f32x4*)(gvec + 4 * lane + 256 * j);
    for (int r0 = gw; r0 < MR; r0 += 4 * NGW) {
        f16x4 raw[4][4];
#pragma unroll
        for (int q = 0; q < 4; ++q) { const int rq = r0 + q * NGW, rc = rq < MR ? rq : MR - 1; const f16x4* xr = (const f16x4*)(X + (size_t)rc * DM) + lane;
#pragma unroll
            for (int j = 0; j < 4; ++j) raw[q][j] = xr[64 * j]; }
#pragma unroll
        for (int q = 0; q < 4; ++q) { const int r = r0 + q * NGW;
            if (r < MR) {
                const float* mrow = MOD + (size_t)row_b(r) * NMOD;
                f32x4 sh[4], sc[4];
#pragma unroll
                for (int j = 0; j < 4; ++j) { const int c = 4 * lane + 256 * j; sh[j] = *(const f32x4*)(mrow + shift_col + c); sc[j] = *(const f32x4*)(mrow + scale_col + c); }
                f32x4 v[4]; float ss = 0.f;
#pragma unroll
                for (int j = 0; j < 4; ++j) { v[j] = __builtin_convertvector(raw[q][j], f32x4); ss += (v[j][0] * v[j][0] + v[j][1] * v[j][1]) + (v[j][2] * v[j][2] + v[j][3] * v[j][3]); }
                ss = wave_sum(ss);
                const float rstd = 1.0f / sqrtf(ss * (1.0f / DM) + 1e-6f);
#pragma unroll
                for (int j = 0; j < 4; ++j) { const int c = 4 * lane + 256 * j;
                    const f32x4 y = (v[j] * rstd) * gv[j] * (sc[j] + 1.0f) + sh[j];
                    if (FINAL) { float* o = (r < MP) ? out + OY_P + (size_t)r * DM + c : out + OY_S + (size_t)(r - MP) * DM + c; *(f32x4*)o = y; }
                    else { v2u w; w.x = pk2(y[0], y[1]); w.y = pk2(y[2], y[3]); *(v2u*)(H + (size_t)r * DM + c) = w; }
                }
            }
        }
    }
}

__device__ __forceinline__ void transpose_item(const float* W, int N, int ldw, bf16* WT, int ldt, int mode, int row_off, LAS float* scr, int item, int lane) {
    const int nblk = (N + 31) >> 5, kb = item / nblk, nb = item - kb * nblk, k0 = 64 * kb, n0 = 32 * nb;
    const int nn = n0 + (lane & 31); const bool okn = nn < N;
    float tv[32];
#pragma unroll
    for (int i = 0; i < 32; ++i) { const int kk = 2 * i + (lane >> 5); tv[i] = okn ? __builtin_nontemporal_load(W + (size_t)(k0 + kk) * ldw + nn) : 0.f; }
#pragma unroll
    for (int i = 0; i < 32; ++i) { const int kk = 2 * i + (lane >> 5); scr[kk * 33 + (lane & 31)] = tv[i]; }
    asm volatile("s_waitcnt lgkmcnt(0)" ::: "memory");
    const int c = lane & 7;
#pragma unroll
    for (int j = 0; j < 4; ++j) { const int n = (lane >> 3) + 8 * j; const LAS float* s = scr + (8 * c) * 33 + n;
        v4u o; o.x = pk2(s[0 * 33], s[1 * 33]); o.y = pk2(s[2 * 33], s[3 * 33]); o.z = pk2(s[4 * 33], s[5 * 33]); o.w = pk2(s[6 * 33], s[7 * 33]);
        const int ng = n0 + n;
        const int drow = mode == 0 ? row_off + ng : (8 * (ng >> 2) + (ng & 3) + (mode == 2 ? 4 : 0));
        if (ng < N) *(v4u*)(WT + (size_t)drow * ldt + k0 + 8 * c) = o; }
    asm volatile("s_waitcnt lgkmcnt(0)" ::: "memory");
}
struct TDesc { const float* src; int K, N, ldw; bf16* dst; int ldt, mode, row_off; };
struct Ptrs {
    const float *x_prompt, *x_sample, *cache_kv, *state_win; const int* page_table; const float *c_prompt, *c_sample, *ada_w, *ada_b, *norm_g, *w_gate, *w_up, *w_down,
        *w_uv, *ln_g, *ln_b, *w_sp, *b_sp, *w_out, *w_qg, *w_o, *kv_norm_g, *kv_ada_w, *kv_ada_b, *kv_w, *cmp_w1, *cmp_w2, *cmp_pe, *final_g, *final_ada_w, *final_ada_b;
    float* out; unsigned char* ws;
};
#define WSP(T, off) ((T*)(P.ws + (off)))
typedef const __attribute__((address_space(4))) unsigned long long* kptr_t;
__device__ __forceinline__ void load_ptrs(Ptrs& P) {
    kptr_t k = (kptr_t)__builtin_amdgcn_kernarg_segment_ptr();
    asm volatile("" : "+s"(k));
    P.x_prompt = (const float*)(GAS const float*)k[0]; P.x_sample = (const float*)(GAS const float*)k[1]; P.cache_kv = (const float*)(GAS const float*)k[2]; P.state_win = (const float*)(GAS const float*)k[3];
    P.page_table = (const int*)(GAS const int*)k[4]; P.c_prompt = (const float*)(GAS const float*)k[5]; P.c_sample = (const float*)(GAS const float*)k[6]; P.ada_w = (const float*)(GAS const float*)k[7];
    P.ada_b = (const float*)(GAS const float*)k[8]; P.norm_g = (const float*)(GAS const float*)k[9]; P.w_gate = (const float*)(GAS const float*)k[10]; P.w_up = (const float*)(GAS const float*)k[11];
    P.w_down = (const float*)(GAS const float*)k[12]; P.w_uv = (const float*)(GAS const float*)k[13]; P.ln_g = (const float*)(GAS const float*)k[14]; P.ln_b = (const float*)(GAS const float*)k[15];
    P.w_sp = (const float*)(GAS const float*)k[16]; P.b_sp = (const float*)(GAS const float*)k[17]; P.w_out = (const float*)(GAS const float*)k[18]; P.w_qg = (const float*)(GAS const float*)k[19];
    P.w_o = (const float*)(GAS const float*)k[20]; P.kv_norm_g = (const float*)(GAS const float*)k[21]; P.kv_ada_w = (const float*)(GAS const float*)k[22]; P.kv_ada_b = (const float*)(GAS const float*)k[23];
    P.kv_w = (const float*)(GAS const float*)k[24]; P.cmp_w1 = (const float*)(GAS const float*)k[25]; P.cmp_w2 = (const float*)(GAS const float*)k[26]; P.cmp_pe = (const float*)(GAS const float*)k[27];
    P.final_g = (const float*)(GAS const float*)k[28]; P.final_ada_w = (const float*)(GAS const float*)k[29]; P.final_ada_b = (const float*)(GAS const float*)k[30];
    P.out = (float*)(GAS float*)k[31]; P.ws = (unsigned char*)(GAS unsigned char*)k[32];
}
__device__ __forceinline__ void get_tdesc(const Ptrs& P, int id, TDesc& d) {
    d.mode = 0; d.row_off = 0; d.K = 1024; d.ldt = 1024;
    if (id < 4) { d.src = P.ada_w + (size_t)id * 1024 * 9216; d.N = 9216; d.dst = WSP(bf16, WS_WMOD); d.row_off = id * 9216; }
    else if (id == 4) { d.src = P.kv_ada_w; d.N = 2048; d.dst = WSP(bf16, WS_WMOD); d.row_off = MODKV; }
    else if (id == 5) { d.src = P.final_ada_w; d.N = 2048; d.dst = WSP(bf16, WS_WMOD); d.row_off = MODFIN; }
    else if (id < 14) { const int i = id - 6; d.src = P.w_gate + (size_t)i * 1024 * DFF; d.N = DFF; d.dst = WSP(bf16, WS_WGU) + (size_t)i * 5632 * 1024; d.mode = 1; }
    else if (id < 22) { const int i = id - 14; d.src = P.w_up + (size_t)i * 1024 * DFF; d.N = DFF; d.dst = WSP(bf16, WS_WGU) + (size_t)i * 5632 * 1024; d.mode = 2; }
    else if (id < 30) { const int i = id - 22; d.src = P.w_down + (size_t)i * DFF * 1024; d.K = DFF; d.N = 1024; d.dst = WSP(bf16, WS_WDN) + (size_t)i * 1024 * DFF; d.ldt = DFF; }
    else if (id < 32) { const int i = id - 30; d.src = P.w_uv + (size_t)i * 1024 * 6144; d.N = 6144; d.dst = WSP(bf16, WS_WUV) + (size_t)i * 6144 * 1024; }
    else if (id < 34) { const int i = id - 32; d.src = P.w_out + (size_t)i * DV * 1024; d.K = DV; d.N = 1024; d.dst = WSP(bf16, WS_WOUT) + (size_t)i * 1024 * DV; d.ldt = DV; }
    else if (id < 36) { const int i = id - 34; d.src = P.w_qg + (size_t)i * 1024 * 1072; d.N = 1072; d.dst = WSP(bf16, WS_WQG) + (size_t)i * NQG * 1024; }
    else if (id < 38) { const int i = id - 36; d.src = P.w_o + (size_t)i * 1024 * 1024; d.N = 1024; d.dst = WSP(bf16, WS_WO) + (size_t)i * 1024 * 1024; }
    else if (id == 38) { d.src = P.kv_w; d.N = NKVP; d.dst = WSP(bf16, WS_WKV); }
    else if (id < 43) { const int i = id - 39, kv = i >> 1, r = i & 1; d.src = P.cmp_w1 + (size_t)kv * 2048 * 256 + (size_t)r * 1024 * 256; d.N = 256; d.dst = WSP(bf16, WS_WC1) + (size_t)kv * 512 * 1024; d.row_off = r * 256; }
    else { const int kv = id - 43; d.src = P.cmp_w2 + (size_t)kv * 256 * 64; d.K = 256; d.N = 64; d.dst = WSP(bf16, WS_WC2) + (size_t)kv * 64 * 256; d.ldt = 256; }
    d.ldw = d.N;
}
constexpr int N_TMAT = 45;

__device__ __forceinline__ void prologue_phase(const Ptrs& P, LAS unsigned char* lds, int gw, int NGW, int wave, int lane, int tid) {
    if (blockIdx.x < 8) {
        const int kv = blockIdx.x >> 2, hb = blockIdx.x & 3; const float* pe = P.cmp_pe + kv * 2048; const float* w1 = P.cmp_w1 + (size_t)kv * 2048 * 256 + hb * 64 + lane;
        float acc = 0.f;
#pragma unroll 8
        for (int k = wave * 256; k < wave * 256 + 256; ++k) acc += pe[k] * w1[(size_t)k * 256];
        LAS float* red = (LAS float*)lds;
        red[wave * 64 + lane] = acc;
        __syncthreads();
        if (wave == 0) { float s = 0.f;
#pragma unroll
            for (int w = 0; w < 8; ++w) s += red[w * 64 + lane];
            WSP(float, WS_CBIAS)[kv * 256 + hb * 64 + lane] = s; }
        __syncthreads();
    }
    { LAS float* scr = (LAS float*)(lds + wave * 16384); int off = 0;
      for (int id = 0; id < N_TMAT; ++id) { TDesc d; get_tdesc(P, id, d);
          const int nitems = (d.K >> 6) * ((d.N + 31) >> 5);
          for (int it = (gw + NGW - (off % NGW)) % NGW; it < nitems; it += NGW) transpose_item(d.src, d.N, d.ldw, d.dst, d.ldt, d.mode, d.row_off, scr, it, lane);
          off += nitems; } }
    for (int r = gw; r < RT; r += NGW) { f16x4* xo = (f16x4*)(WSP(f16, WS_X) + (size_t)r * DM) + lane;
        const f32x4* xi = r < MP ? (const f32x4*)(P.x_prompt + (size_t)r * DM) + lane : (const f32x4*)(P.x_sample + (size_t)((r < MR ? r : MR - 1) - MP) * DM) + lane;
#pragma unroll
        for (int j = 0; j < 4; ++j) { f32x4 v = xi[64 * j]; if (r >= MR) v = (f32x4){0.f, 0.f, 0.f, 0.f}; xo[64 * j] = __builtin_convertvector(v, f16x4); } }
    for (int r = gw; r < 256; r += NGW) { const float* ci = r < 2 ? P.c_prompt + (size_t)r * DM : P.c_sample + (size_t)((r < 130 ? r : 129) - 2) * DM;
#pragma unroll
        for (int j = 0; j < 4; ++j) { const int c = 4 * lane + 256 * j; f32x4 v = *(const f32x4*)(ci + c); v2u w; w.x = pk2(silu_f(v[0]), silu_f(v[1])); w.y = pk2(silu_f(v[2]), silu_f(v[3])); if (r >= 130) { w.x = 0u; w.y = 0u; }
            *(v2u*)(WSP(bf16, WS_SC) + (size_t)r * DM + c) = w; } }
    for (int it0 = gw * 8; it0 < MS * PAST; it0 += NGW * 8) { const int bs = it0 >> 11, pos0 = it0 & (PAST - 1); const int page = P.page_table[bs * NPAGES + (pos0 >> 7)];
        const float* src = P.cache_kv + ((size_t)page * 128 + (pos0 & 127)) * 1024 + 8 * lane;
        f32x4 a[8], b[8];
#pragma unroll
        for (int q = 0; q < 8; ++q) { a[q] = __builtin_nontemporal_load((const f32x4*)(src + (size_t)q * 1024)); b[q] = __builtin_nontemporal_load((const f32x4*)(src + (size_t)q * 1024 + 4)); }
        const int slot = lane >> 5, g = (lane >> 3) & 3, d0 = (lane & 7) * 8;
        bf16* dst = WSP(bf16, WS_ACMP) + (size_t)slot * 65536 * 1024 + ((size_t)(bs * 4 + g) * 128 + (pos0 >> 4)) * 1024 + (pos0 & 15) * 64 + d0;
#pragma unroll
        for (int q = 0; q < 8; ++q) *(v4u*)(dst + q * 64) = pack8(a[q], b[q]); }
    for (int i = gw * 64 + lane; i < 13 * DM; i += NGW * 64) WSP(float, WS_NG)[i] = i < 12 * DM ? P.norm_g[i] : P.kv_norm_g[i - 12 * DM];
    for (int i = gw * 64 + lane; i < 2 * 8 * 128 * 128; i += NGW * 64) { const int t = (i >> 7) & 127, s = i & 127; WSP(bf16, WS_WSP)[i] = (bf16)(pk2(s <= t ? P.w_sp[i] : 0.f, 0.f) & 0xffffu); }
    for (int it = gw; it < MS * 64; it += NGW) { const int bs = it >> 6, j0 = (it & 63) * 8;
        const float* src = P.state_win + ((size_t)bs * 512 + j0 + 1) * 512 + 4 * lane; float* dst = P.out + OWIN_S + ((size_t)bs * 512 + j0) * 512 + 4 * lane;
        f32x4 v[16];
#pragma unroll
        for (int q = 0; q < 16; ++q) { const int j = j0 + (q >> 1); v[q] = (j < 511) ? __builtin_nontemporal_load((const f32x4*)(src + (size_t)(q >> 1) * 512 + (q & 1) * 256)) : (f32x4){0.f, 0.f, 0.f, 0.f}; }
#pragma unroll
        for (int q = 0; q < 16; ++q) { const int j = j0 + (q >> 1); if (j < 511) __builtin_nontemporal_store(v[q], (f32x4*)(dst + (size_t)(q >> 1) * 512 + (q & 1) * 256)); } }
}

__device__ __forceinline__ void load_cbias_lds(const float* cb, LAS unsigned char* lds, int tid) {
    __syncthreads();
    if (tid < 128) *(LAS f32x4*)(lds + tid * 16) = *(const f32x4*)(cb + tid * 4);
    __syncthreads();
}
template <int MODE>
__device__ __forceinline__ void cmp_finish_unit(const bf16* T, const LAS float* cbias, const bf16* W2T, void* outp, int C, int bg, int rt, int lane) {
    const int fr = lane & 15, fq = lane >> 4, NB = C - 1, i0 = 16 * rt;
    const int ib = i0 + fr, ic = ib < NB ? ib : NB - 1;
    const bf16* ta = T + ((size_t)bg * C + ic) * 512 + 8 * fq; const bf16* tb = ta + 512 + 256;
    v4u ra[8], rb[8];
#pragma unroll
    for (int ks = 0; ks < 8; ++ks) { ra[ks] = *(const v4u*)(ta + 32 * ks); rb[ks] = *(const v4u*)(tb + 32 * ks); }
    asm volatile("" ::: "memory");
    bf16x8 hf[8];
#pragma unroll
    for (int ks = 0; ks < 8; ++ks) { float a[8], b[8]; unpack8(ra[ks], a); unpack8(rb[ks], b);
        const f32x4 c0 = *(const LAS f32x4*)(cbias + 32 * ks + 8 * fq), c1 = *(const LAS f32x4*)(cbias + 32 * ks + 8 * fq + 4);
        f32x4 h0, h1;
#pragma unroll
        for (int e = 0; e < 4; ++e) { h0[e] = gelu_tanh_f(c0[e] + a[e] + b[e]); h1[e] = gelu_tanh_f(c1[e] + a[e + 4] + b[e + 4]); }
        const v4u w = pack8(h0, h1); hf[ks] = __builtin_bit_cast(bf16x8, w); }
    f32x4 acc[4];
#pragma unroll
    for (int np = 0; np < 2; ++np) {
        bf16x8 wf[2][8];
#pragma unroll
        for (int n2 = 0; n2 < 2; ++n2)
#pragma unroll
            for (int ks = 0; ks < 8; ++ks) wf[n2][ks] = *(const bf16x8*)(W2T + (size_t)(16 * (2 * np + n2) + fr) * 256 + 32 * ks + 8 * fq);
        asm volatile("" ::: "memory");
#pragma unroll
        for (int n2 = 0; n2 < 2; ++n2) { const int nt = 2 * np + n2; acc[nt] = (f32x4){0.f, 0.f, 0.f, 0.f};
#pragma unroll
            for (int ks = 0; ks < 8; ++ks) {
                if (MODE == 1) acc[nt] = __builtin_amdgcn_mfma_f32_16x16x32_bf16(hf[ks], wf[n2][ks], acc[nt], 0, 0, 0);
                else acc[nt] = __builtin_amdgcn_mfma_f32_16x16x32_bf16(wf[n2][ks], hf[ks], acc[nt], 0, 0, 0); } }
    }
#pragma unroll
    for (int nt = 0; nt < 4; ++nt) {
        if (MODE == 0) { f32x4 v = acc[nt]; if (ib >= NB) v = (f32x4){0.f, 0.f, 0.f, 0.f}; v2u w; w.x = pk2(v[0], v[1]); w.y = pk2(v[2], v[3]);
            *(v2u*)((bf16*)outp + ((size_t)bg * 512 + ib) * 64 + 16 * nt + 4 * fq) = w; }
        else if (MODE == 1) { f32x4 v = acc[nt];
#pragma unroll
            for (int e = 0; e < 4; ++e) if (i0 + 4 * fq + e >= NB) v[e] = 0.f;
            v2u w; w.x = pk2(v[0], v[1]); w.y = pk2(v[2], v[3]);
            *(v2u*)((bf16*)outp + (((size_t)bg * 16 + (i0 >> 5)) * 64 + 16 * nt + fr) * 32 + (i0 & 31) + 4 * fq) = w; }
        else { f32x4 v = acc[nt]; if (ib >= NB) v = (f32x4){0.f, 0.f, 0.f, 0.f};
            *(f32x4*)((float*)outp + ((size_t)bg * 128 + ib) * 64 + 16 * nt + 4 * fq) = v; }
    }
}

struct SpRegs { f32x4 st; v4u za[2], zb[2]; bf16x8 wf[4]; v4u uv[4]; float bt; };
__device__ __forceinline__ void sp_load(SpRegs& R, const Ptrs& P, int l, int u, int wave, int lane) {
    const bf16* Z = WSP(bf16, WS_Z); const bf16* WS = WSP(bf16, WS_WSP); const float* VS = WSP(float, WS_CTL) + CW_VS + (size_t)l * RT * 2;
    const int fr = lane & 15, fq = lane >> 4, nks = (wave >> 1) + 1, n = u / 24, cb = u - n * 24, g = cb / 3;
    R.st = *(const f32x4*)(VS + 2 * (n * 128 + 2 * lane));
#pragma unroll
    for (int q = 0; q < 2; ++q) { const int cc = cb * 128 + 8 * (wave + 8 * q); const bf16* z0 = Z + (size_t)(n * 128 + 2 * lane) * 6144 + DV + cc; R.za[q] = *(const v4u*)z0; R.zb[q] = *(const v4u*)(z0 + 6144); }
    const bf16* wp = WS + ((size_t)(l * 8 + g) * 128 + 16 * wave + fr) * 128 + 8 * fq;
#pragma unroll
    for (int ks = 0; ks < 4; ++ks) R.wf[ks] = *(const bf16x8*)(wp + 32 * (ks < nks ? ks : 0));
    const int t = 16 * wave + fr, row = n * 128 + t; R.bt = P.b_sp[(l * 8 + g) * 128 + t];
#pragma unroll
    for (int mm = 0; mm < 4; ++mm) R.uv[mm] = *(const v4u*)(Z + (size_t)row * 6144 + cb * 128 + 32 * mm + 8 * fq);
}
__device__ __forceinline__ void sp_compute(const SpRegs& R, const Ptrs& P, int l, int u, LAS unsigned* tile, int wave, int lane) {
    bf16* PO = WSP(bf16, WS_P); const float* lg = P.ln_g + l * DV; const float* lb = P.ln_b + l * DV;
    const int fr = lane & 15, fq = lane >> 4, nks = (wave >> 1) + 1, n = u / 24, cb = u - n * 24;
    const float m0 = R.st[0] * (1.0f / DV), m1 = R.st[2] * (1.0f / DV); float v0 = R.st[1] * (1.0f / DV) - m0 * m0, v1 = R.st[3] * (1.0f / DV) - m1 * m1; v0 = v0 > 0.f ? v0 : 0.f; v1 = v1 > 0.f ? v1 : 0.f;
    const float r0 = 1.0f / sqrtf(v0 + 1e-6f), r1 = 1.0f / sqrtf(v1 + 1e-6f);
#pragma unroll
    for (int q = 0; q < 2; ++q) { const int ccg = wave + 8 * q, cc = cb * 128 + 8 * ccg; float a[8], b[8]; unpack8(R.za[q], a); unpack8(R.zb[q], b);
        const f32x4 g0 = *(const f32x4*)(lg + cc), g1 = *(const f32x4*)(lg + cc + 4), b0 = *(const f32x4*)(lb + cc), b1 = *(const f32x4*)(lb + cc + 4);
#pragma unroll
        for (int e = 0; e < 8; ++e) { const float gg = e < 4 ? g0[e] : g1[e - 4], bb = e < 4 ? b0[e] : b1[e - 4];
            tile[(8 * ccg + e) * 68 + lane] = pk2((a[e] - m0) * r0 * gg + bb, (b[e] - m1) * r1 * gg + bb); } }
    __syncthreads();
    f32x4 acc[8];
#pragma unroll
    for (int j = 0; j < 8; ++j) acc[j] = (f32x4){0.f, 0.f, 0.f, 0.f};
    const LAS char* vp = (const LAS char*)tile + (8 * (fr >> 2) + (fr & 3)) * 272 + 16 * fq;
#pragma unroll
    for (int ks = 0; ks < 4; ++ks) if (ks < nks) {
#pragma unroll
        for (int j = 0; j < 8; ++j) { const bf16x8 vf = *(const LAS bf16x8*)(vp + (32 * (j >> 1) + 4 * (j & 1)) * 272 + 64 * ks);
            acc[j] = __builtin_amdgcn_mfma_f32_16x16x32_bf16(vf, R.wf[ks], acc[j], 0, 0, 0); }
    }
    const int row = n * 128 + 16 * wave + fr;
#pragma unroll
    for (int mm = 0; mm < 4; ++mm) { const int c = cb * 128 + 32 * mm + 8 * fq; float uu[8]; unpack8(R.uv[mm], uu);
        f32x4 p0, p1;
#pragma unroll
        for (int e = 0; e < 4; ++e) { p0[e] = uu[e] * (acc[2 * mm][e] + R.bt); p1[e] = uu[4 + e] * (acc[2 * mm + 1][e] + R.bt); }
        *(v4u*)(PO + (size_t)row * DV + c) = pack8(p0, p1); }
}
__device__ __forceinline__ void spatial2_phase(const Ptrs& P, int l, LAS unsigned char* lds, int wave, int lane, int tid, int gw, int NGW) {
    const bf16* Z = WSP(bf16, WS_Z);
    const float* VS = WSP(float, WS_CTL) + CW_VS + (size_t)l * RT * 2;
    const float* lg = P.ln_g + l * DV; const float* lb = P.ln_b + l * DV;
    { const int NU = 128 * 24, G_ = (int)gridDim.x; int u = (int)blockIdx.x;
      LAS unsigned* t0 = (LAS unsigned*)lds; LAS unsigned* t1 = (LAS unsigned*)(lds + 34816);
      SpRegs A, B;
      if (u < NU) sp_load(A, P, l, u, wave, lane);
      while (u < NU) {
          int un = u + G_; if (un < NU) sp_load(B, P, l, un, wave, lane);
          sp_compute(A, P, l, u, t0, wave, lane);
          u = un; if (u >= NU) break;
          un = u + G_; if (un < NU) sp_load(A, P, l, un, wave, lane);
          sp_compute(B, P, l, u, t1, wave, lane);
          u = un;
      } }
    __syncthreads();
    for (int bs = gw; bs < MS; bs += NGW) {
        const int row = MP + bs; const bf16* zr = Z + (size_t)row * 6144 + 8 * lane;
        const float mean = VS[2 * row] * (1.0f / DV); float var = VS[2 * row + 1] * (1.0f / DV) - mean * mean; var = var > 0.f ? var : 0.f; const float rstd = 1.0f / sqrtf(var + 1e-6f);
#pragma unroll
        for (int j = 0; j < 6; ++j) { const int c = 512 * j + 8 * lane, g = c / CGW;
            const float w00 = P.w_sp[(size_t)(l * 8 + g) * 128 * 128], b00 = P.b_sp[(l * 8 + g) * 128];
            const f32x4 g0 = *(const f32x4*)(lg + c), g1 = *(const f32x4*)(lg + c + 4), b0 = *(const f32x4*)(lb + c), b1 = *(const f32x4*)(lb + c + 4);
            float vv[8], uu[8]; unpack8(*(const v4u*)(zr + DV + 512 * j), vv); unpack8(*(const v4u*)(zr + 512 * j), uu);
            f32x4 o0, o1, p0, p1;
#pragma unroll
            for (int e = 0; e < 4; ++e) { o0[e] = (vv[e] - mean) * rstd * g0[e] + b0[e]; o1[e] = (vv[4 + e] - mean) * rstd * g1[e] + b1[e];
                p0[e] = uu[e] * (w00 * o0[e] + b00); p1[e] = uu[4 + e] * (w00 * o1[e] + b00); }
            float* gv = P.out + OGV + ((size_t)l * MS + bs) * DV + c; *(f32x4*)gv = o0; *(f32x4*)(gv + 4) = o1;
            *(v4u*)(WSP(bf16, WS_P) + (size_t)row * DV + c) = pack8(p0, p1); }
    }
}

#define NEG_INF (-__builtin_inff())
__device__ __forceinline__ bf16x8 ld_v2x8(const GAS bf16* p) {
    const bf16x4 lo = *(const GAS bf16x4*)p, hi = *(const GAS bf16x4*)(p + 16);
    return __builtin_shufflevector(lo, hi, 0, 1, 2, 3, 4, 5, 6, 7);
}
struct SampleAcc { float acc[4][8]; float m, l; };
__device__ __forceinline__ float sample_compute(const f32x4 k0, const f32x4 k1, const f32x4 v0, const f32x4 v1, bool valid, float dist, const float (&qv)[4][8], float slope2_own, int lane, SampleAcc& A) {
    const int j8 = lane & 7;
    float part[4];
#pragma unroll
    for (int h = 0; h < 4; ++h) { float a = (qv[h][0] * k0[0] + qv[h][1] * k0[1]) + (qv[h][2] * k0[2] + qv[h][3] * k0[3]) + (qv[h][4] * k1[0] + qv[h][5] * k1[1]) + (qv[h][6] * k1[2] + qv[h][7] * k1[3]);
        a += dppf<DPP_X1>(a); a += dppf<DPP_X2>(a); a += dppf<DPP_HM>(a); part[h] = a; }
    const int hown = j8 & 3;
    const float sown = hown == 0 ? part[0] : hown == 1 ? part[1] : hown == 2 ? part[2] : part[3];
    const float s2 = valid ? (sown - slope2_own * dist) : NEG_INF;
    float tm = fmaxf(s2, dppf<DPP_X8>(s2)); tm = xmax_16_32(tm);
    const float mnew = fmaxf(A.m, tm), msafe = (mnew == NEG_INF) ? 0.f : mnew, alpha = fexp2(A.m - msafe), p = fexp2(s2 - msafe);
    A.m = mnew; A.l = A.l * alpha + p;
    const float ph[4] = {dppf<0x00>(p), dppf<0x55>(p), dppf<0xAA>(p), dppf<0xFF>(p)}, ah[4] = {dppf<0x00>(alpha), dppf<0x55>(alpha), dppf<0xAA>(alpha), dppf<0xFF>(alpha)};
#pragma unroll
    for (int h = 0; h < 4; ++h)
#pragma unroll
        for (int e = 0; e < 4; ++e) { A.acc[h][e] = A.acc[h][e] * ah[h] + ph[h] * v0[e]; A.acc[h][4 + e] = A.acc[h][4 + e] * ah[h] + ph[h] * v1[e]; }
    return s2;
}
__device__ __forceinline__ float sample_step8(const float* krow, const float* vrow, bool valid, float dist, const float (&qv)[4][8], float slope2_own, int lane, SampleAcc& A) {
    const int j8 = lane & 7;
    const f32x4 k0 = *(const f32x4*)(krow + 8 * j8), k1 = *(const f32x4*)(krow + 8 * j8 + 4), v0 = *(const f32x4*)(vrow + 8 * j8), v1 = *(const f32x4*)(vrow + 8 * j8 + 4);
    return sample_compute(k0, k1, v0, v1, valid, dist, qv, slope2_own, lane, A);
}
__device__ __forceinline__ void sample_batch4(const float* kbase, const float* vbase, int rstride, int r0, int rlimit, int rclamp, float dist0, float ddist,
                                              const float (&qv)[4][8], float slope2_own, int lane, SampleAcc& A, LAS float* sraw) {
    const int j8 = lane & 7;
    f32x4 kk[4][2], vv[4][2];
#pragma unroll
    for (int s = 0; s < 4; ++s) { int r = r0 + 8 * s; r = r < rlimit ? r : rclamp; const float* kr = kbase + (size_t)r * rstride + 8 * j8; const float* vr = vbase + (size_t)r * rstride + 8 * j8;
        kk[s][0] = *(const f32x4*)kr; kk[s][1] = *(const f32x4*)(kr + 4); vv[s][0] = *(const f32x4*)vr; vv[s][1] = *(const f32x4*)(vr + 4); }
#pragma unroll
    for (int s = 0; s < 4; ++s) { const float s2 = sample_compute(kk[s][0], kk[s][1], vv[s][0], vv[s][1], r0 + 8 * s < rlimit, dist0 - ddist * (float)s, qv, slope2_own, lane, A);
        if (sraw) sraw[s * 64 + lane] = s2; }
}
__device__ __forceinline__ void sample_reset(SampleAcc& A) {
    A.m = NEG_INF; A.l = 0.f;
#pragma unroll
    for (int h = 0; h < 4; ++h)
#pragma unroll
        for (int i = 0; i < 8; ++i) A.acc[h][i] = 0.f;
}
__device__ __forceinline__ void sample_finish(SampleAcc& A, const float* gates_bg, int br, LAS float* wl, int lane, bool first) {
    float lt = A.l; lt += dppf<DPP_X8>(lt); lt = xsum_16_32(lt);
    float sc[4];
#pragma unroll
    for (int h = 0; h < 4; ++h) { const float lh = __shfl(lt, h); sc[h] = lh > 0.f ? gates_bg[h * 3 + br] / lh : 0.f; }
#pragma unroll
    for (int h = 0; h < 4; ++h)
#pragma unroll
        for (int i = 0; i < 8; ++i) { float a = A.acc[h][i]; a += dppf<DPP_X8>(a); a = xsum_16_32(a); A.acc[h][i] = a * sc[h]; }
    if (lane < 8) {
#pragma unroll
        for (int h = 0; h < 4; ++h)
#pragma unroll
            for (int i = 0; i < 8; ++i) { LAS float* p = wl + h * 64 + 8 * lane + i; *p = first ? A.acc[h][i] : (*p + A.acc[h][i]); }
    }
}
__device__ __forceinline__ void attn_sample_unit(const Ptrs& P, int bs, int g, LAS float* wl, int lane_in) {
    int lane = lane_in; asm volatile("" : "+v"(lane));
    const int kq = lane >> 3, j8 = lane & 7, row = MP + bs;
    const bf16* Q = WSP(bf16, WS_Q) + (size_t)row * DM + (4 * g) * 64; const float* GT = WSP(float, WS_GATES) + (size_t)row * 48 + g * 12;
    float qv[4][8];
#pragma unroll
    for (int h = 0; h < 4; ++h) unpack8(*(const v4u*)(Q + h * 64 + 8 * j8), qv[h]);
    const float slope2_own = fexp2(-0.5f * (float)(4 * g + (j8 & 3) + 1)) * LOG2E;
    SampleAcc A;
    LAS float* pimp = wl + 256;
    LAS float* sraw = wl + 512;
    const float* KCS = WSP(float, WS_KCS) + (size_t)(bs * 4 + g) * 128 * 64; const float* VCS = WSP(float, WS_VCS) + (size_t)(bs * 4 + g) * 128 * 64;
    sample_reset(A);
#pragma unroll 1
    for (int bt = 0; bt < 4; ++bt) sample_batch4(KCS, VCS, 64, 32 * bt + kq, 127, 126, (float)(PAST - (16 * (32 * bt + kq) + 31)), 128.f, qv, slope2_own, lane, A, sraw + bt * 256);
    { float lt = A.l; lt += dppf<DPP_X8>(lt); lt = xsum_16_32(lt);
      const float il = lt > 0.f ? 1.0f / lt : 0.f, mm = A.m == NEG_INF ? 0.f : A.m;
#pragma unroll 1
      for (int it = 0; it < 16; ++it) { float p = fexp2(sraw[it * 64 + lane] - mm) * il; p += dppf<DPP_X1>(p); p += dppf<DPP_X2>(p); if (j8 == 0) pimp[8 * it + kq] = p; } }
    sample_finish(A, GT, 0, wl, lane, true);
    unsigned long long selmask;
    { float v = -1.f;
      if (lane < 33) { float sacc = 0.f;
#pragma unroll
          for (int e = -1; e < 4; ++e) { const int n = 4 * lane + e; if (n >= 0 && n < 127) sacc += pimp[n]; }
          v = (lane == 0 || lane >= 31) ? sacc + 1e4f : sacc; }
      int rank = 0;
#pragma unroll 1
      for (int i = 0; i < 33; ++i) { const float vi = __builtin_bit_cast(float, __builtin_amdgcn_readlane(__builtin_bit_cast(int, v), i)); rank += (vi > v || (vi == v && i < lane)) ? 1 : 0; }
      selmask = __ballot(lane < 33 && rank < 16); }
    sample_reset(A);
#pragma unroll 1
    for (int j = 0; j < 32; ++j) {
        if (!((selmask >> j) & 1ull)) continue;
        const int page = P.page_table[bs * NPAGES + (j >> 1)];
        const float* kb = P.cache_kv + ((size_t)page * 128 * 4 + 2) * 256 + g * 64;
#pragma unroll 1
        for (int bb = 0; bb < 2; ++bb) { const int r0 = ((64 * j) & 127) + 32 * bb + kq;
            sample_batch4(kb, kb + 256, 1024, r0, 1 << 30, 0, (float)(PAST - (64 * j + 32 * bb + kq)), 8.f, qv, slope2_own, lane, A, nullptr); }
    }
    { const float* kr = P.out + OKV_S + ((size_t)bs * 4 + 2) * 256 + g * 64;
      (void)sample_step8(kr, kr + 256, kq == 0, 0.f, qv, slope2_own, lane, A); }
    sample_finish(A, GT, 1, wl, lane, false);
    sample_reset(A);
    { const float* kb = P.state_win + (size_t)bs * 512 * 512 + g * 64;
#pragma unroll 1
      for (int bt = 0; bt < 16; ++bt) sample_batch4(kb, kb + 256, 512, 32 * bt + kq, 1 << 30, 0, (float)(512 - (32 * bt + kq)), 8.f, qv, slope2_own, lane, A, nullptr); }
    { const float* kr = P.out + OWIN_S + ((size_t)bs * 512 + 511) * 512 + g * 64;
      (void)sample_step8(kr, kr + 256, kq == 0, 0.f, qv, slope2_own, lane, A); }
    sample_finish(A, GT, 2, wl, lane, false);
    { const f32x4 v = *(const LAS f32x4*)(wl + 4 * lane); v2u w; w.x = pk2(v[0], v[1]); w.y = pk2(v[2], v[3]);
      *(v2u*)(WSP(bf16, WS_O) + (size_t)row * DM + 256 * g + 4 * lane) = w; }
}

__device__ __forceinline__ void ldK(bf16x8 (&kf)[2][2], const GAS bf16* Kp, int k0, unsigned koff) {
#pragma unroll
    for (int kt = 0; kt < 2; ++kt)
#pragma unroll
        for (int ks = 0; ks < 2; ++ks) kf[kt][ks] = *(const GAS bf16x8*)((const GAS char*)(Kp + (size_t)k0 * 64 + kt * 256 + ks * 32) + koff);
}
__device__ __forceinline__ void ldV(bf16x8 (&vf)[4], const GAS bf16* Vp, int VP, int k0, unsigned voff) {
#pragma unroll
    for (int dt = 0; dt < 4; ++dt) vf[dt] = *(const GAS bf16x8*)((const GAS char*)(Vp + (size_t)(k0 >> 5) * 2048 + dt * 512) + voff);
}
template <int MODE, int GEN>
__device__ __forceinline__ void att_run(const GAS bf16* Kp, const GAS bf16* Vp, int VP, unsigned koff, unsigned voff, int n, int base, const LAS int* list,
                                        int KA, int KB, int W, unsigned M0, unsigned M1, unsigned M2, unsigned M3, int t, int fr, int fq, int lane,
                                        LAS float* wl, const float (&slope2)[4], f32x4 (&o)[4][4], float (&m)[4], float (&l)[4]) {
    if (n <= 0) return;
    bf16x8 kf[2][2], vf[4];
    int k0 = GEN == 0 ? 0 : (GEN == 1 ? base : list[0]);
    ldK(kf, Kp, k0, koff);
    if (MODE != 1) ldV(vf, Vp, VP, k0, voff);
    float carry = 0.f;
#pragma unroll 1
    for (int i = 0; i < n; ++i) {
        const int inx = (i + 1 < n) ? i + 1 : i;
        const int k0n = GEN == 0 ? 32 * inx : (GEN == 1 ? base - 32 * inx : list[inx]);
        f32x4 s[2][4];
        {
            unsigned qa = (unsigned)lane * 16u; asm volatile("" : "+v"(qa));
            const LAS char* qb = (const LAS char*)wl + qa;
#pragma unroll
            for (int h = 0; h < 4; ++h) {
                const bf16x8 q0 = *(const LAS bf16x8*)(qb + (h * 2 + 0) * 1024), q1 = *(const LAS bf16x8*)(qb + (h * 2 + 1) * 1024);
#pragma unroll
                for (int kt = 0; kt < 2; ++kt) { f32x4 a = (f32x4){0.f, 0.f, 0.f, 0.f};
                    a = __builtin_amdgcn_mfma_f32_16x16x32_bf16(kf[kt][0], q0, a, 0, 0, 0);
                    a = __builtin_amdgcn_mfma_f32_16x16x32_bf16(kf[kt][1], q1, a, 0, 0, 0); s[kt][h] = a; }
            }
        }
        ldK(kf, Kp, k0n, koff);
        bool extra = true;
        if (GEN == 2) { const int j = k0 >> 6, f = j & 3; const unsigned Mw = f == 0 ? M0 : f == 1 ? M1 : f == 2 ? M2 : M3; extra = (Mw >> (j >> 2)) & 1u; }
        f32x2 dp[2][2];
#pragma unroll
        for (int kt = 0; kt < 2; ++kt)
#pragma unroll
            for (int e = 0; e < 4; ++e) { const int nn = k0 + 8 * fq + 4 * kt + e, d = t - (KA * nn + KB); const float dv = (extra && (unsigned)d <= (unsigned)W) ? (float)d : __builtin_inff();
                if (e & 1) dp[kt][e >> 1].y = dv; else dp[kt][e >> 1].x = dv; }
        f32x2 sp[2][4][2];
#pragma unroll
        for (int h = 0; h < 4; ++h)
#pragma unroll
            for (int kt = 0; kt < 2; ++kt) { const f32x2 nsl = (f32x2){-slope2[h], -slope2[h]};
                sp[kt][h][0] = (f32x2){s[kt][h][0], s[kt][h][1]} + dp[kt][0] * nsl; sp[kt][h][1] = (f32x2){s[kt][h][2], s[kt][h][3]} + dp[kt][1] * nsl; }
        if (MODE == 2) {
#pragma unroll
            for (int h = 0; h < 4; ++h) { const f32x2 mm = (f32x2){m[h], m[h]}, ll = (f32x2){l[h], l[h]};
#pragma unroll
                for (int kt = 0; kt < 2; ++kt)
#pragma unroll
                    for (int pr = 0; pr < 2; ++pr) { const f32x2 a = sp[kt][h][pr] - mm; f32x2 p; p.x = fexp2(a.x); p.y = fexp2(a.y); sp[kt][h][pr] = p * ll; } }
            f32x2 as0[2], as1[2];
#pragma unroll
            for (int pr = 0; pr < 2; ++pr) { as0[pr] = (sp[0][0][pr] + sp[0][1][pr]) + (sp[0][2][pr] + sp[0][3][pr]); as1[pr] = (sp[1][0][pr] + sp[1][1][pr]) + (sp[1][2][pr] + sp[1][3][pr]); }
            const float r1 = __shfl(as1[1].y, (lane + 48) & 63);
            const float y0 = fq > 0 ? r1 : carry, y1 = as0[1].y; carry = r1;
            wl[2048 + fr * 128 + 8 * i + 2 * fq]     = ((as0[0].x + as0[0].y) + (as0[1].x + as0[1].y)) + y0;
            wl[2048 + fr * 128 + 8 * i + 2 * fq + 1] = ((as1[0].x + as1[0].y) + (as1[1].x + as1[1].y)) + y1;
        } else {
            float tl[4]; bool grow = false;
#pragma unroll
            for (int h = 0; h < 4; ++h) {
                const f32x2 mx = __builtin_elementwise_max(__builtin_elementwise_max(sp[0][h][0], sp[0][h][1]), __builtin_elementwise_max(sp[1][h][0], sp[1][h][1]));
                tl[h] = fmaxf(mx.x, mx.y); grow = grow || (tl[h] > m[h] + 8.0f);
            }
            if (__any(grow)) {
#pragma unroll
                for (int h = 0; h < 4; ++h) { const float tm = xmax_16_32(tl[h]);
                    const float mn = fmaxf(m[h], tm), ms = (mn == NEG_INF) ? 0.f : mn, alpha = fexp2(m[h] - ms); l[h] *= alpha; m[h] = mn;
                    if (MODE == 0) {
#pragma unroll
                        for (int dt = 0; dt < 4; ++dt) o[dt][h] = o[dt][h] * alpha; } }
            }
#pragma unroll
            for (int h = 0; h < 4; ++h) { const float ms = (m[h] == NEG_INF) ? 0.f : m[h]; const f32x2 mm = (f32x2){ms, ms}; f32x2 ps = (f32x2){0.f, 0.f};
#pragma unroll
                for (int kt = 0; kt < 2; ++kt)
#pragma unroll
                    for (int pr = 0; pr < 2; ++pr) { const f32x2 a = sp[kt][h][pr] - mm; f32x2 p; p.x = fexp2(a.x); p.y = fexp2(a.y); sp[kt][h][pr] = p; ps = ps + p; }
                l[h] += ps.x + ps.y; }
        }
#pragma unroll
        for (int h = 0; h < 4; ++h)
#pragma unroll
            for (int kt = 0; kt < 2; ++kt) s[kt][h] = (f32x4){sp[kt][h][0].x, sp[kt][h][0].y, sp[kt][h][1].x, sp[kt][h][1].y};
        if (MODE != 1) {
            bf16x8 pf[4];
#pragma unroll
            for (int h = 0; h < 4; ++h) { const v4u w = pack8(s[0][h], s[1][h]); pf[h] = __builtin_bit_cast(bf16x8, w); }
#pragma unroll
            for (int dt = 0; dt < 4; ++dt)
#pragma unroll
                for (int h = 0; h < 4; ++h) o[dt][h] = __builtin_amdgcn_mfma_f32_16x16x32_bf16(vf[dt], pf[h], o[dt][h], 0, 0, 0);
            ldV(vf, Vp, VP, k0n, voff);
        }
        k0 = k0n;
    }
}
#if defined(PROBE_MODE) && PROBE_MODE == 4
#define SEC_ON(s) (PROBE_A == (s) && (int)blockIdx.x == PROBE_BLK && threadIdx.x == 0)
#define SEC_T0(s) do { if (SEC_ON(s)) { volatile LAS unsigned* pm_ = (volatile LAS unsigned*)(unsigned)MISC_OFF; pm_[17] = (unsigned)__builtin_amdgcn_s_memrealtime(); } } while (0)
#define SEC_T1(s) do { if (SEC_ON(s)) { volatile LAS unsigned* pm_ = (volatile LAS unsigned*)(unsigned)MISC_OFF; pm_[16] = pm_[16] + ((unsigned)__builtin_amdgcn_s_memrealtime() - pm_[17]); } } while (0)
#define SEC_CNT(s, n) do { if (SEC_ON(s)) { volatile LAS unsigned* pm_ = (volatile LAS unsigned*)(unsigned)MISC_OFF; pm_[16] = pm_[16] + (unsigned)(n); } } while (0)
#else
#define SEC_T0(s) do { } while (0)
#define SEC_T1(s) do { } while (0)
#define SEC_CNT(s, n) do { } while (0)
#endif
__device__ __forceinline__ void attn_prompt_unit2(const Ptrs& P, int bg, int tt, LAS float* wl, int lane_in) {
    int lane = lane_in; asm volatile("" : "+v"(lane));
    const int fr = lane & 15, fq = lane >> 4, b = bg >> 2, g = bg & 3, t0 = 16 * tt, t = t0 + fr, row = b * SEQ + t;
    const float* GT = WSP(float, WS_GATES) + (size_t)row * 48 + g * 12;
    const GAS bf16* KC = (const GAS bf16*)WSP(bf16, WS_KC) + (size_t)bg * 512 * 64; const GAS bf16* VCT = (const GAS bf16*)WSP(bf16, WS_VCT) + (size_t)bg * 64 * 512;
    const GAS bf16* SK = (const GAS bf16*)WSP(bf16, WS_SK) + (size_t)bg * SEQ * 64; const GAS bf16* SVT = (const GAS bf16*)WSP(bf16, WS_SVT) + (size_t)bg * 64 * SEQ;
    const GAS bf16* WK = (const GAS bf16*)WSP(bf16, WS_WK) + (size_t)bg * SEQ * 64; const GAS bf16* WVT = (const GAS bf16*)WSP(bf16, WS_WVT) + (size_t)bg * 64 * SEQ;
    GAS float* OA = (GAS float*)WSP(float, WS_OACC) + (size_t)row * DM + 256 * g + 4 * fq;
    float slope2[4];
    { const GAS bf16* Q = (const GAS bf16*)WSP(bf16, WS_Q) + (size_t)row * DM + (4 * g) * 64 + 8 * fq;
#pragma unroll
      for (int h = 0; h < 4; ++h) { slope2[h] = fexp2(-0.5f * (float)(4 * g + h + 1)) * LOG2E;
#pragma unroll
          for (int ks = 0; ks < 2; ++ks) *(LAS v4u*)((LAS char*)wl + (h * 2 + ks) * 1024 + lane * 16) = *(const GAS v4u*)(Q + h * 64 + 32 * ks); } }
    f32x4 o[4][4]; float m[4], l[4];
    const int BIG = 1 << 30;
    const unsigned koff = (unsigned)((8 * (fr >> 2) + (fr & 3)) * 64 + 8 * fq) * 2u, voffc = (unsigned)(fr * 32 + 8 * fq) * 2u, voffs = voffc;
    const int nst = (tt >> 5) + 1;
    SEC_T0(1);
#pragma unroll
    for (int h = 0; h < 4; ++h) { m[h] = NEG_INF; l[h] = 0.f; }
    att_run<1, 0>(KC, VCT, 512, koff, voffc, nst, 0, nullptr, 16, 31, BIG, 0u, 0u, 0u, 0u, t, fr, fq, lane, wl, slope2, o, m, l);
#pragma unroll
    for (int h = 0; h < 4; ++h) { const float lt = xsum_16_32(l[h]); l[h] = lt > 0.f ? 1.0f / lt : 0.f; if (m[h] == NEG_INF) m[h] = 0.f;
#pragma unroll
        for (int dt = 0; dt < 4; ++dt) o[dt][h] = (f32x4){0.f, 0.f, 0.f, 0.f}; }
    att_run<2, 0>(KC, VCT, 512, koff, voffc, nst, 0, nullptr, 16, 31, BIG, 0u, 0u, 0u, 0u, t, fr, fq, lane, wl, slope2, o, m, l);
#pragma unroll
    for (int h = 0; h < 4; ++h) { const float gc = GT[h * 3 + 0];
#pragma unroll
        for (int dt = 0; dt < 4; ++dt) *(GAS f32x4*)(OA + h * 64 + 16 * dt) = o[dt][h] * gc; }
    SEC_T1(1);
    SEC_T0(2);
    const int qblk = t0 >> 6;
    unsigned M0, M1, M2, M3;
    {
        float cv[32];
#pragma unroll
        for (int q = 0; q < 32; ++q) { const int j = 4 * q + fq; const float x = wl[2048 + fr * 128 + j];
            const bool forced = (j == 0) | (j == qblk) | (j == qblk - 1); cv[q] = (j <= qblk) ? (forced ? x + 1e4f : x) : -1.f; }
        unsigned mask = 0u;
#pragma unroll 1
        for (int r = 0; r < 16; ++r) {
            float bv = cv[0]; int bq = 0;
#pragma unroll
            for (int q = 1; q < 32; ++q) if (cv[q] > bv) { bv = cv[q]; bq = q; }
            int bj = 4 * bq + fq;
            { float va, vb; int ia, ib; xpair16(bv, va, vb); xpair16i(bj, ia, ib); const bool tb = vb > va || (vb == va && ib < ia); bv = tb ? vb : va; bj = tb ? ib : ia; }
            { float va, vb; int ia, ib; xpair32(bv, va, vb); xpair32i(bj, ia, ib); const bool tb = vb > va || (vb == va && ib < ia); bv = tb ? vb : va; bj = tb ? ib : ia; }
            const bool mine = (bv >= 0.f) && ((bj & 3) == fq); const int wq = bj >> 2;
#pragma unroll
            for (int q = 0; q < 32; ++q) if (mine && q == wq) cv[q] = -2.f;
            if (mine) mask |= 1u << wq;
        }
        M0 = __shfl(mask, fr); M1 = __shfl(mask, fr + 16); M2 = __shfl(mask, fr + 32); M3 = __shfl(mask, fr + 48);
    }
    int nlist = 0;
    {
        unsigned U0 = M0, U1 = M1, U2 = M2, U3 = M3;
        U0 |= dppu<DPP_X1>(U0); U1 |= dppu<DPP_X1>(U1); U2 |= dppu<DPP_X1>(U2); U3 |= dppu<DPP_X1>(U3);
        U0 |= dppu<DPP_X2>(U0); U1 |= dppu<DPP_X2>(U1); U2 |= dppu<DPP_X2>(U2); U3 |= dppu<DPP_X2>(U3);
        U0 |= dppu<DPP_HM>(U0); U1 |= dppu<DPP_HM>(U1); U2 |= dppu<DPP_HM>(U2); U3 |= dppu<DPP_HM>(U3);
        U0 |= dppu<DPP_RM>(U0); U1 |= dppu<DPP_RM>(U1); U2 |= dppu<DPP_RM>(U2); U3 |= dppu<DPP_RM>(U3);
        U0 = __builtin_amdgcn_readfirstlane(U0); U1 = __builtin_amdgcn_readfirstlane(U1); U2 = __builtin_amdgcn_readfirstlane(U2); U3 = __builtin_amdgcn_readfirstlane(U3);
        LAS int* lst = (LAS int*)(wl + 2048);
#pragma unroll 1
        for (int j = qblk; j >= 0; --j) { const int f = j & 3; const unsigned Uw = f == 0 ? U0 : f == 1 ? U1 : f == 2 ? U2 : U3;
            if ((Uw >> (j >> 2)) & 1u) { if (lane == 0) { lst[nlist] = 64 * j + 32; lst[nlist + 1] = 64 * j; } nlist += 2; } }
    }
    SEC_T1(2); SEC_CNT(5, nlist); SEC_T0(3);
#pragma unroll
    for (int h = 0; h < 4; ++h) { m[h] = NEG_INF; l[h] = 0.f;
#pragma unroll
        for (int dt = 0; dt < 4; ++dt) o[dt][h] = (f32x4){0.f, 0.f, 0.f, 0.f}; }
    att_run<0, 2>(SK, SVT, SEQ, koff, voffs, nlist, 0, (const LAS int*)(wl + 2048), 1, 0, BIG, M0, M1, M2, M3, t, fr, fq, lane, wl, slope2, o, m, l);
    asm volatile("s_waitcnt vmcnt(0)" ::: "memory");
#pragma unroll
    for (int h = 0; h < 4; ++h) { const float lt = xsum_16_32(l[h]); const float sc = lt > 0.f ? GT[h * 3 + 1] / lt : 0.f;
#pragma unroll
        for (int dt = 0; dt < 4; ++dt) { GAS f32x4* p = (GAS f32x4*)(OA + h * 64 + 16 * dt); *p = *p + o[dt][h] * sc; } }
    SEC_T1(3); SEC_T0(4);
#pragma unroll
    for (int h = 0; h < 4; ++h) { m[h] = NEG_INF; l[h] = 0.f;
#pragma unroll
        for (int dt = 0; dt < 4; ++dt) o[dt][h] = (f32x4){0.f, 0.f, 0.f, 0.f}; }
    { const int kend = (t0 > 512 ? (t0 - 512) : 0) & ~31, ktop = t0 & ~31;
      att_run<0, 1>(WK, WVT, SEQ, koff, voffs, ((ktop - kend) >> 5) + 1, ktop, nullptr, 1, 0, 512, 0u, 0u, 0u, 0u, t, fr, fq, lane, wl, slope2, o, m, l); }
    asm volatile("s_waitcnt vmcnt(0)" ::: "memory");
    GAS bf16* O = (GAS bf16*)WSP(bf16, WS_O) + (size_t)row * DM + 256 * g + 4 * fq;
#pragma unroll
    for (int h = 0; h < 4; ++h) { const float lt = xsum_16_32(l[h]); const float sc = lt > 0.f ? GT[h * 3 + 2] / lt : 0.f;
#pragma unroll
        for (int dt = 0; dt < 4; ++dt) { const f32x4 v = *(const GAS f32x4*)(OA + h * 64 + 16 * dt) + o[dt][h] * sc;
            v2u w; w.x = pk2(v[0], v[1]); w.y = pk2(v[2], v[3]); *(GAS v2u*)(O + h * 64 + 16 * dt) = w; } }
    SEC_T1(4);
}

#define ATTN_UNIT attn_prompt_unit2
#ifdef PROBE_MODE
#ifndef PROBE_BLK
#define PROBE_BLK 0
#endif
#ifndef PROBE_MULT
#define PROBE_MULT 8
#endif
#define PROBE_SEL(p) ((p) >= PROBE_A && (p) <= PROBE_B)
#endif
struct Args { const void* in[31]; float* out; unsigned char* ws; int ph_lo, ph_hi; };
constexpr int N_PHASES = 2 + 1 + 12 + 2 * 1 + 2 * 1 + 12 + 1;

__global__ void __launch_bounds__(NWAVES * 64, 2) yoco_fwd(Args args) {
    extern __shared__ __attribute__((aligned(16))) unsigned char lds_raw[];
    LAS unsigned char* lds = (LAS unsigned char*)lds_raw;
    const int tid0 = threadIdx.x, wave = __builtin_amdgcn_readfirstlane(tid0 >> 6);
    const int G = gridDim.x; const int bx = blockIdx.x; const int vcu = (G % 8 == 0) ? (bx % 8) * (G / 8) + bx / 8 : bx;
    const int gw0 = vcu * NWAVES + wave, NGW = G * NWAVES;

    for (int u = tid0; u < (LDS_BYTES - LDSCTL_OFF) / 4; u += NWAVES * 64) ((LAS unsigned*)(lds + LDSCTL_OFF))[u] = 0u;
    __syncthreads();
    volatile LAS unsigned* MISC = (volatile LAS unsigned*)(lds + MISC_OFF);
    unsigned* barw = (unsigned*)(args.ws + WS_CTL) + CW_BAR;
    XcdBarrier bar; bar.bar = barw; bar.x = 0; bar.st = nullptr;
    const int lo = args.ph_lo, hi = args.ph_hi;
    if (hi - lo > 1) bar = xcd_barrier_post(barw, MISC + 8);
    int pid = 0;
#define IN_PH() (lo <= pid && pid < hi)
#define NIN() NormIn{P.ws, sl > 0 ? sl - 1 : 0, sl, sl > 0 ? 1 : 0}
#define LOADP() int tid = tid0; asm volatile("" : "+v"(tid)); const int lane = tid & 63; int gw = gw0; asm volatile("" : "+s"(gw)); (void)lane; (void)gw; Ptrs P; load_ptrs(P); const f16* X = WSP(f16, WS_X); bf16* H = WSP(bf16, WS_H); const float* MOD = WSP(float, WS_MOD); (void)X; (void)H; (void)MOD
#ifdef PROBE_MODE
#define PRB_ON() ((int)blockIdx.x == PROBE_BLK && tid0 == 0)
#define PRB_NOW() ((unsigned)__builtin_amdgcn_s_memrealtime())
#define END_PH() do { if (PRB_ON()) { const unsigned tm_ = PRB_NOW(); if ((PROBE_MODE & 1) && PROBE_SEL(pid)) MISC[16] = MISC[16] + (tm_ - MISC[17]); MISC[17] = tm_; } \
    if (lo <= pid && pid + 1 < hi) xcd_barrier(bar); \
    if (PRB_ON()) { const unsigned te_ = PRB_NOW(); if ((PROBE_MODE & 2) && PROBE_SEL(pid)) MISC[16] = MISC[16] + (te_ - MISC[17]); MISC[17] = te_; } ++pid; } while (0)
#else
#define END_PH() do { if (lo <= pid && pid + 1 < hi) xcd_barrier(bar); ++pid; } while (0)
#endif


#ifdef PROBE_MODE
    if (PRB_ON()) { MISC[16] = 0u; MISC[17] = PRB_NOW(); }
#endif
    if (IN_PH()) { LOADP(); prologue_phase(P, lds, gw, NGW, wave, lane, tid); }
    END_PH();
    if (IN_PH()) { LOADP();
        run_gemm(lds, WSP(bf16, WS_SC), WSP(bf16, WS_WMOD), 256, NMOD, DM, FMod{WSP(float, WS_MOD), P.ada_b, P.kv_ada_b, P.final_ada_b, WSP(bf16, WS_SHB)});
        run_gemm(lds, WSP(bf16, WS_ACMP), WSP(bf16, WS_WC1), 65536, 512, 1024, FBf16{WSP(bf16, WS_TS), 512});
        run_gemm(lds, WSP(bf16, WS_ACMP) + (size_t)65536 * 1024, WSP(bf16, WS_WC1) + (size_t)512 * 1024, 65536, 512, 1024, FBf16{WSP(bf16, WS_TS) + (size_t)65536 * 512, 512});
    }
    END_PH();

    for (int sl = 0; sl < 12; ++sl) {
        const int l = sl / 3, sub = sl - 3 * l;
        if (sl == 0) {
            if (IN_PH()) { LOADP();
                norm_phase<false>(X, P.norm_g, MOD, 0, DM, H, nullptr, gw, NGW, lane);
                { pg8::Gemm g{WSP(bf16, WS_SHB), WSP(bf16, WS_WGU), 13 * 256, 0, DM}; int cb = (int)blockIdx.x; asm volatile("" : "+s"(cb)); ShiftOrder S{(int)gridDim.x, cb}; Epi8<FB2> E{FB2{WSP(float, WS_B2)}};
                  pg8::gemm_phase<Epi8<FB2>, ShiftOrder, true, true>(lds, g, S, E); }
                load_cbias_lds(WSP(float, WS_CBIAS), lds, tid);
                if (wave >= 4) __builtin_amdgcn_s_setprio(1);
                for (int u = gw; u < 2 * 512 * 8; u += NGW) { const int kv = u >> 12, r = u & 4095, bg = r >> 3, rt = r & 7;
                    cmp_finish_unit<2>(WSP(bf16, WS_TS) + (size_t)kv * 65536 * 512, (const LAS float*)lds + kv * 256, WSP(bf16, WS_WC2) + kv * 64 * 256,
                                       kv == 0 ? (void*)WSP(float, WS_KCS) : (void*)WSP(float, WS_VCS), 128, bg, rt, lane); }
                __builtin_amdgcn_s_setprio(0);
                __syncthreads();
            }
            END_PH();
        }
        if (sub != 1) {
            const int s = sub >> 1;
            if (IN_PH()) { LOADP();
                if (sl == 6) {
                    run_gemm2(lds, WSP(bf16, WS_HKV), WSP(bf16, WS_WKV), NKVP, NKVP, DM, FKv{P.out, WSP(bf16, WS_KCIN), NormIn{P.ws, 5, 12, 1}}, 0, 0);
                    run_gemm2(lds, H, WSP(bf16, WS_WGU) + (size_t)(l * 2 + s) * 5632 * 1024, 5632, 5632, DM, FSwiglu{WSP(bf16, WS_HID), NIN()}, (int)gridDim.x / 2, 0);
                } else
                run_gemm2(lds, H, WSP(bf16, WS_WGU) + (size_t)(l * 2 + s) * 5632 * 1024, 5632, 5632, DM, FSwiglu{WSP(bf16, WS_HID), NIN()}); }
            END_PH();
        } else if (l < 2) {
            if (IN_PH()) { LOADP(); run_gemm2(lds, H, WSP(bf16, WS_WUV) + (size_t)l * 6144 * 1024, 6144, 6144, DM, FGelu{WSP(bf16, WS_Z), NIN(), WSP(float, WS_CTL) + CW_VS + (size_t)l * RT * 2}); }
            END_PH();
            if (IN_PH()) { LOADP(); spatial2_phase(P, l, lds, wave, lane, tid, gw, NGW); }
            END_PH();
        } else {
            if (IN_PH()) { LOADP();
                if (sl == 7) {
                    load_cbias_lds(WSP(float, WS_CBIAS), lds, tid);
                    for (int u = gw; u < 2 * 8 * 32; u += NGW) { const int kv = u >> 8, r = u & 255, bg = r >> 5, rt = r & 31;
                        if (kv == 0) cmp_finish_unit<0>(WSP(bf16, WS_TK), (const LAS float*)lds, WSP(bf16, WS_WC2), (void*)WSP(bf16, WS_KC), 512, bg, rt, lane);
                        else cmp_finish_unit<1>(WSP(bf16, WS_TV), (const LAS float*)lds + 256, WSP(bf16, WS_WC2) + 64 * 256, (void*)WSP(bf16, WS_VCT), 512, bg, rt, lane); }
                    __syncthreads();
                }
                run_gemm2(lds, H, WSP(bf16, WS_WQG) + (size_t)(l - 2) * NQG * 1024, NQG, 1072, DM, FQg{WSP(bf16, WS_Q), WSP(float, WS_GATES), NIN()}); }
            END_PH();
            if (IN_PH()) { LOADP(); LAS float* wl = (LAS float*)(lds + (gw & 7) * 16384);
                {
                    int r = 0;
                    for (;;) {
                        const int q = ((int)(xb_xcc_id() & 7u) + r) & 7;
                        unsigned idx = 0u; if (lane == 0) idx = __hip_atomic_fetch_add((unsigned*)(P.ws + WS_CTL) + CW_QUEUE + 64 * (8 * (l - 2) + q), 1u, __ATOMIC_RELAXED, __HIP_MEMORY_SCOPE_AGENT);
                        idx = (unsigned)__builtin_amdgcn_readfirstlane((int)idx);
                        if (idx >= 64u + 512u) { if (++r == 8) break; continue; }
                        if (idx < 64u) { const int id = q * 64 + (int)idx; attn_sample_unit(P, id >> 2, id & 3, wl, lane); }
                        else ATTN_UNIT(P, q, 511 - ((int)idx - 64), wl, lane);
                    }
                }
            }
            END_PH();
        }
        if (IN_PH()) { LOADP();
            const bf16* A2 = sub != 1 ? WSP(bf16, WS_HID) : (l < 2 ? WSP(bf16, WS_P) : WSP(bf16, WS_O));
            const bf16* B2 = sub != 1 ? WSP(bf16, WS_WDN) + (size_t)(l * 2 + (sub >> 1)) * 1024 * DFF : (l < 2 ? WSP(bf16, WS_WOUT) + (size_t)l * 1024 * DV : WSP(bf16, WS_WO) + (size_t)(l - 2) * 1024 * 1024);
            const int K2 = sub != 1 ? DFF : (l < 2 ? DV : DM);
            if (sl == 6) {
                run_gemm(lds, WSP(bf16, WS_KCIN), WSP(bf16, WS_WC1), 4096, 512, 1024, FBf16{WSP(bf16, WS_TK), 512}, 64);
                run_gemm(lds, WSP(bf16, WS_VCIN), WSP(bf16, WS_WC1) + (size_t)512 * 1024, 4096, 512, 1024, FBf16{WSP(bf16, WS_TV), 512}, 32);
            }
            const int sn = sl + 1, ln = sn / 3, subn = sn - 3 * ln;
            const bool more = sl < 11;
            run_gemm2r(lds, A2, B2, K2, FResid{P.ws, l * 9216 + (sub * 3 + 2) * DM, sub != 1 ? 0.5f : 1.0f, more ? sn : -1, ln * 9216 + (subn * 3 + 1) * DM, sl == 5 ? 12 : -1, MODKV + DM, more ? sl : -1});
        }
        END_PH();
    }
    if (IN_PH()) { LOADP(); norm_phase<true>(X, P.final_g, MOD, MODFIN, MODFIN + DM, nullptr, P.out, gw, NGW, lane); }
#ifdef PROBE_MODE
    if (PRB_ON()) { const unsigned tm_ = PRB_NOW(); if ((PROBE_MODE & 1) && PROBE_SEL(pid)) MISC[16] = MISC[16] + (tm_ - MISC[17]);
        const unsigned want = MISC[16] * (unsigned)PROBE_MULT; const unsigned t0_ = PRB_NOW(); while (PRB_NOW() - t0_ < want) __builtin_amdgcn_s_sleep(32); }
#endif
    ++pid;
#undef IN_PH
#undef END_PH
}

extern "C" void kernel_launch(void* const* d_in, const int* in_sizes, int n_in, void* d_out, int out_size, void* d_ws, size_t ws_size, hipStream_t stream) {
    static int grid = 0;
    if (grid == 0) {
        if (n_in != 31 || (size_t)out_size != OUT_TOTAL || ws_size < WS_END) { fprintf(stderr, "kernel_launch: unexpected shapes (n_in %d, out %d, ws %zu need %zu); nothing launched\n", n_in, out_size, ws_size, (size_t)WS_END); grid = -1; return; }
        int dev = 0, cus = 0, per_cu = 0;
        if (hipGetDevice(&dev) != hipSuccess || hipDeviceGetAttribute(&cus, hipDeviceAttributeMultiprocessorCount, dev) != hipSuccess) { grid = -1; return; }
        if (hipFuncSetAttribute((const void*)yoco_fwd, hipFuncAttributeMaxDynamicSharedMemorySize, LDS_BYTES) != hipSuccess) { fprintf(stderr, "kernel_launch: hipFuncSetAttribute failed\n"); grid = -1; return; }
        if (hipOccupancyMaxActiveBlocksPerMultiprocessor(&per_cu, (const void*)yoco_fwd, NWAVES * 64, LDS_BYTES) != hipSuccess || per_cu < 1) { fprintf(stderr, "kernel_launch: occupancy query says %d blocks per CU\n", per_cu); }
        (void)hipGetLastError();
        grid = cus;
    }
    if (grid < 0) return;
    if (hipMemsetAsync((char*)d_ws + WS_CTL, 0, CTL_ZERO_BYTES, stream) != hipSuccess) return;
    Args a{};
    for (int i = 0; i < 31; ++i) a.in[i] = d_in[i];
    a.out = (float*)d_out; a.ws = (unsigned char*)d_ws;
#if ONE_LAUNCH
    a.ph_lo = 0; a.ph_hi = N_PHASES;
    hipLaunchKernelGGL(yoco_fwd, dim3(grid), dim3(NWAVES * 64), LDS_BYTES, stream, a);
#else
    for (int p = 0; p < N_PHASES; ++p) { a.ph_lo = p; a.ph_hi = p + 1; hipLaunchKernelGGL(yoco_fwd, dim3(grid), dim3(NWAVES * 64), LDS_BYTES, stream, a); }
#endif
}
```

```cpp
#include <hip/hip_runtime.h>
#include <cstdio>
#include <cstdint>
#include <cmath>
namespace pg8 {
#define PG8_LAS __attribute__((address_space(3)))
typedef unsigned short bf16_t;
typedef short bf16x8 __attribute__((ext_vector_type(8)));
typedef float f32x4 __attribute__((ext_vector_type(4)));
typedef unsigned u32x4 __attribute__((ext_vector_type(4)));
constexpr int BM = 256, BK = 64, HALF = 128, HTB = HALF * BK * 2  , STAGE_BYTES = 8 * HTB, NXCD = 8, WGM = 8;

__host__ __device__ __forceinline__ int lds_byte(int r, int c) { const int st = (r >> 4) * 2 + (c >> 5), rr = r & 15, cc = c & 31, ob = rr * 64 + cc * 2; return st * 1024 + (ob ^ (((ob >> 9) & 1) << 5)); }
__host__ __device__ __forceinline__ void stage_rc(int b, int& R, int& C) { const int st = b / 1024, sb = b % 1024, swz = sb ^ (((sb >> 9) & 1) << 5); R = (st >> 1) * 16 + swz / 64; C = (st & 1) * 32 + (swz % 64) / 2; }
__host__ __device__ __forceinline__ int perm32(int rho) { const int n = rho >> 4, i = rho & 15; return 8 * (i >> 2) + 4 * n + (i & 3); }

struct Unit { int pm, pn; };
struct Gemm { const bf16_t* A; const bf16_t* Bt; int M, N, K; };

struct StaticOrder {
    int nM, nN, nwg, G, c;
    __host__ __device__ void init(int M, int N, int G_, int c_) { nM = M / BM; nN = N / BM; nwg = nM * nN; G = G_; c = c_; }
    __host__ __device__ bool next(int i, Unit& u) const {
        const long L = (long)i * G + c; if (L >= nwg) return false;
        int wgid = (int)L; { const int q = nwg / NXCD, r = nwg % NXCD, xcd = wgid % NXCD, off = wgid / NXCD; wgid = (xcd < r ? xcd * (q + 1) : r * (q + 1) + (xcd - r) * q) + off; }
        const int nig = WGM * nN, gid = wgid / nig, fm = gid * WGM, gsz = (nM - fm) < WGM ? (nM - fm) : WGM;
        u.pm = fm + ((wgid % nig) % gsz); u.pn = (wgid % nig) / gsz; return true;
    }
    __device__ __forceinline__ void a_ready(const Unit&) const {}
    __device__ __forceinline__ void done(const Unit&) const {}
};

__device__ __forceinline__ unsigned cvt_pk_bf16(float lo, float hi) { unsigned r; asm volatile("v_cvt_pk_bf16_f32 %0, %1, %2" : "=v"(r) : "v"(lo), "v"(hi)); return r; }
typedef float f32x2 __attribute__((ext_vector_type(2)));
template <class Epi, class Sched, bool ALIGN_EPI = false, bool SP2 = false>
__device__ __forceinline__ void gemm_phase(PG8_LAS unsigned char* lds, const Gemm g, const Sched& S, const Epi& E) {
    int tid_raw = threadIdx.x; asm volatile("" : "+v"(tid_raw));
    const int tid = tid_raw, wid = __builtin_amdgcn_readfirstlane(tid >> 6), lane = tid & 63, wr = wid >> 2, wc = wid & 3, fr = lane & 15, fq = lane >> 4;
    const int K = g.K, nt = K / BK;
    unsigned voffA[2], voffB[2];
#pragma unroll
    for (int i = 0; i < 2; ++i) { int R, C; stage_rc(tid * 16 + i * 8192, R, C); const int Rb = Epi::PERM ? ((R & ~31) + perm32(R & 31)) : R;
        voffA[i] = (unsigned)(R * K + C) * 2u; voffB[i] = (unsigned)(Rb * K + C) * 2u; }
    const size_t kstep = (size_t)(BK * 2);
    const size_t hstep = (size_t)HALF * K * 2;
    const size_t tstep = 2 * hstep;
    const unsigned ldsw = (unsigned)wid * 1024u;
    const int aoff = lds_byte(wr * 64 + fr, fq * 8), boff = lds_byte(wc * 32 + fr, fq * 8);
#define PG8_SA(b, h) (((b) * 2 + (h)) * HTB)
#define PG8_SB(b, h) ((4 + (b) * 2 + (h)) * HTB)
#define PG8_STAGE(bufoff, gbase, voff) do { _Pragma("unroll") for (int _i = 0; _i < 2; ++_i) \
        __builtin_amdgcn_global_load_lds((const unsigned*)((const char*)(gbase) + (voff)[_i]), (PG8_LAS unsigned*)(lds + (bufoff) + ldsw + _i * 8192), 16, 0, 0); } while (0)
#define PG8_LDA(dst, b, h) do { _Pragma("unroll") for (int m = 0; m < 4; ++m) _Pragma("unroll") for (int k = 0; k < 2; ++k) dst[m][k] = *(const PG8_LAS bf16x8*)(lds + PG8_SA(b, h) + aoff + m * 2048 + k * 1024); } while (0)
#define PG8_LDB(dst, b, h) do { _Pragma("unroll") for (int n = 0; n < 2; ++n) _Pragma("unroll") for (int k = 0; k < 2; ++k) dst[n][k] = *(const PG8_LAS bf16x8*)(lds + PG8_SB(b, h) + boff + n * 2048 + k * 1024); } while (0)
#define PG8_MMA(ai, bj, At, Bt) do { __builtin_amdgcn_s_setprio(1); _Pragma("unroll") for (int m = 0; m < 4; ++m) _Pragma("unroll") for (int n = 0; n < 2; ++n) _Pragma("unroll") for (int k = 0; k < 2; ++k) \
        acc[ai][bj][m][n] = __builtin_amdgcn_mfma_f32_16x16x32_bf16(Bt[n][k], At[m][k], acc[ai][bj][m][n], 0, 0, 0); __builtin_amdgcn_s_setprio(0); } while (0)
#define PG8_WAIT_V(n) asm volatile("s_waitcnt vmcnt(" #n ")" ::: "memory")
#define PG8_WAIT_L(n) asm volatile("s_waitcnt lgkmcnt(" #n ")" ::: "memory")
#define PG8_BAR __builtin_amdgcn_s_barrier()
#define PG8_SCHED __builtin_amdgcn_sched_barrier(0)
    Unit cur, nxt; int ui = 0;
    if (!S.next(0, cur)) return;
    f32x4 acc[2][2][4][2];
#pragma unroll
    for (int a = 0; a < 2; ++a)
#pragma unroll
        for (int b = 0; b < 2; ++b)
#pragma unroll
            for (int m = 0; m < 4; ++m)
#pragma unroll
                for (int n = 0; n < 2; ++n) acc[a][b][m][n] = (f32x4){0.f, 0.f, 0.f, 0.f};
    bf16x8 At[4][2], B0[2][2], B1[2][2];
    const char* cA = (const char*)g.A + (size_t)cur.pm * tstep; const char* cB = (const char*)g.Bt + (size_t)cur.pn * tstep;
    S.a_ready(cur);
    if constexpr (SP2) {
        PG8_STAGE(PG8_SB(0, 0), cB, voffB); PG8_STAGE(PG8_SB(0, 1), cB + hstep, voffB); PG8_STAGE(PG8_SA(0, 0), cA, voffA); PG8_STAGE(PG8_SA(0, 1), cA + hstep, voffA);
        if (wr == 1) PG8_BAR;
        PG8_WAIT_V(2); PG8_BAR;
        PG8_STAGE(PG8_SB(1, 0), cB + kstep, voffB); PG8_STAGE(PG8_SA(1, 0), cA + kstep, voffA); PG8_STAGE(PG8_SB(1, 1), cB + hstep + kstep, voffB);
        PG8_WAIT_V(6); PG8_BAR;
    } else {
        PG8_STAGE(PG8_SB(0, 0), cB, voffB); PG8_STAGE(PG8_SA(0, 0), cA, voffA); PG8_STAGE(PG8_SB(0, 1), cB + hstep, voffB); PG8_STAGE(PG8_SA(0, 1), cA + hstep, voffA);
        if (wr == 1) PG8_BAR;
        PG8_WAIT_V(4); PG8_BAR;
        PG8_STAGE(PG8_SB(1, 0), cB + kstep, voffB); PG8_STAGE(PG8_SA(1, 0), cA + kstep, voffA); PG8_STAGE(PG8_SB(1, 1), cB + hstep + kstep, voffB);
        PG8_WAIT_V(6); PG8_BAR;
    }
    for (;;) {
        const bool has_next = S.next(ui + 1, nxt);
        const char* nA = has_next ? (const char*)g.A + (size_t)nxt.pm * tstep : cA; const char* nB = has_next ? (const char*)g.Bt + (size_t)nxt.pn * tstep : cB;
        for (int t = 0; t < nt; t += 2) {
            const bool last = (t == nt - 2);
            const char* a1 = cA + (size_t)(t + 1) * kstep;
            const char* a2 = last ? nA : cA + (size_t)(t + 2) * kstep; const char* b2 = last ? nB : cB + (size_t)(t + 2) * kstep;
            const char* a3 = a2 + kstep; const char* b3 = b2 + kstep;
            if (last && has_next) S.a_ready(nxt);
            if constexpr (SP2) {
            PG8_LDB(B0, 0, 0); PG8_LDB(B1, 0, 1); PG8_SCHED; PG8_LDA(At, 0, 0); PG8_STAGE(PG8_SA(1, 1), a1 + hstep, voffA);
            PG8_WAIT_V(8); PG8_WAIT_L(0); PG8_BAR; PG8_MMA(0, 0, At, B0); PG8_MMA(0, 1, At, B1); PG8_BAR; PG8_SCHED;
            PG8_LDA(At, 0, 1); PG8_STAGE(PG8_SB(0, 0), b2, voffB); PG8_STAGE(PG8_SB(0, 1), b2 + hstep, voffB); PG8_STAGE(PG8_SA(0, 0), a2, voffA);
            PG8_WAIT_V(8); PG8_WAIT_L(0); PG8_BAR; PG8_MMA(1, 0, At, B0); PG8_MMA(1, 1, At, B1); PG8_BAR; PG8_SCHED;
            PG8_LDB(B0, 1, 0); PG8_LDB(B1, 1, 1); PG8_SCHED; PG8_LDA(At, 1, 0); PG8_STAGE(PG8_SA(0, 1), a2 + hstep, voffA);
            PG8_WAIT_V(8); PG8_WAIT_L(0); PG8_BAR; PG8_MMA(0, 0, At, B0); PG8_MMA(0, 1, At, B1); PG8_BAR; PG8_SCHED;
            PG8_LDA(At, 1, 1); PG8_STAGE(PG8_SB(1, 0), b3, voffB); PG8_STAGE(PG8_SB(1, 1), b3 + hstep, voffB); PG8_STAGE(PG8_SA(1, 0), a3, voffA);
            PG8_WAIT_V(8); PG8_WAIT_L(0); PG8_BAR; PG8_MMA(1, 0, At, B0); PG8_MMA(1, 1, At, B1); PG8_BAR; PG8_SCHED;
            } else {
            PG8_LDB(B0, 0, 0); PG8_SCHED; PG8_LDA(At, 0, 0); PG8_STAGE(PG8_SA(1, 1), a1 + hstep, voffA);
            PG8_WAIT_L(8); PG8_BAR; PG8_WAIT_L(0); PG8_MMA(0, 0, At, B0); PG8_BAR; PG8_SCHED;
            PG8_LDB(B1, 0, 1); PG8_STAGE(PG8_SB(0, 0), b2, voffB);
            PG8_BAR; PG8_WAIT_L(0); PG8_MMA(0, 1, At, B1); PG8_BAR;
            PG8_LDA(At, 0, 1); PG8_STAGE(PG8_SA(0, 0), a2, voffA);
            PG8_BAR; PG8_WAIT_L(0); PG8_MMA(1, 0, At, B0); PG8_BAR; PG8_SCHED;
            PG8_STAGE(PG8_SB(0, 1), b2 + hstep, voffB);
            PG8_WAIT_V(6); PG8_BAR; PG8_MMA(1, 1, At, B1); PG8_BAR;
            PG8_LDB(B0, 1, 0); PG8_SCHED; PG8_LDA(At, 1, 0); PG8_STAGE(PG8_SA(0, 1), a2 + hstep, voffA);
            PG8_WAIT_L(8); PG8_BAR; PG8_WAIT_L(0); PG8_MMA(0, 0, At, B0); PG8_BAR; PG8_SCHED;
            PG8_LDB(B1, 1, 1); PG8_STAGE(PG8_SB(1, 0), b3, voffB);
            PG8_BAR; PG8_WAIT_L(0); PG8_MMA(0, 1, At, B1); PG8_BAR;
            PG8_LDA(At, 1, 1); PG8_STAGE(PG8_SA(1, 0), a3, voffA);
            PG8_BAR; PG8_WAIT_L(0); PG8_MMA(1, 0, At, B0); PG8_BAR; PG8_SCHED;
            PG8_STAGE(PG8_SB(1, 1), b3 + hstep, voffB);
            PG8_WAIT_V(6); PG8_BAR; PG8_MMA(1, 1, At, B1); PG8_BAR;
            }
        }
        if constexpr (ALIGN_EPI) { if (wr == 0) PG8_BAR; }
        if constexpr (!Epi::AFTER_DRAIN) { E(acc, cur, wr, wc, fr, fq); S.done(cur); }
        if (!has_next) break;
#pragma unroll
        for (int a = 0; a < 2; ++a)
#pragma unroll
            for (int b = 0; b < 2; ++b)
#pragma unroll
                for (int m = 0; m < 4; ++m)
#pragma unroll
                    for (int n = 0; n < 2; ++n) acc[a][b][m][n] = (f32x4){0.f, 0.f, 0.f, 0.f};
        cur = nxt; cA = nA; cB = nB; ++ui;
        if constexpr (ALIGN_EPI) { if (wr == 1) PG8_BAR; }
    }
    PG8_WAIT_V(0);
    if constexpr (!ALIGN_EPI) { if (wr == 0) PG8_BAR; }
    PG8_BAR;
    if constexpr (Epi::AFTER_DRAIN) { E.fused(acc, cur, wr, wc, fr, fq, lds, wid, lane); S.done(cur); }
#undef PG8_SA
#undef PG8_SB
#undef PG8_STAGE
#undef PG8_LDA
#undef PG8_LDB
#undef PG8_MMA
#undef PG8_WAIT_V
#undef PG8_WAIT_L
#undef PG8_BAR
#undef PG8_SCHED
}
}
#define LAS __attribute__((address_space(3)))
#define XB_TMO      128
#define XB_XCNT(j)  (256  + 64 * (j))
#define XB_XSUB(j)  (1280 + 64 * (j))
#define XB_XGEN(j)  (2304 + 64 * (j))
#define XB_TOP      3328
#define XB_TOPGEN   3392
#define XCD_BAR_WORDS 3456
#define XB_SPIN_CAP (1u << 18)

__device__ __forceinline__ unsigned xb_ld(unsigned* p)              { return __hip_atomic_load(p, __ATOMIC_RELAXED, __HIP_MEMORY_SCOPE_AGENT); }
__device__ __forceinline__ unsigned xb_add(unsigned* p, unsigned v) { return __hip_atomic_fetch_add(p, v, __ATOMIC_RELAXED, __HIP_MEMORY_SCOPE_AGENT); }
__device__ __forceinline__ unsigned xb_xcc_id() { return (unsigned)__builtin_amdgcn_s_getreg((3 << 11) | 20) & 0xFu; }
#define XB_SPIN(cond, bar) do { unsigned _sp = 0; while (cond) { __builtin_amdgcn_s_sleep(1); \
    if ((++_sp & 255u) == 0u) { if (xb_ld(&(bar)[XB_TMO])) break; if (_sp > XB_SPIN_CAP) { atomicAdd(&(bar)[XB_TMO], 1u); break; } } } } while (0)

struct XcdBarrier {
    unsigned* bar; unsigned x;
    volatile LAS unsigned* st;
};

__device__ __forceinline__ XcdBarrier xcd_barrier_post(unsigned* bar, volatile LAS unsigned* st) {
    XcdBarrier b; b.bar = bar; b.x = xb_xcc_id(); b.st = st;
    if (threadIdx.x == 0) (void)xb_add(&bar[XB_XCNT(b.x)], 1u);
    return b;
}
__device__ __forceinline__ void xcd_barrier_complete(unsigned* bar, unsigned x, unsigned& nloc, unsigned& nx) {
    const unsigned G = gridDim.x * gridDim.y * gridDim.z;
    unsigned sum, cnt, mine, sp = 0u;
    for (;;) {
        sum = 0u; cnt = 0u; mine = 0u;
#pragma unroll
        for (unsigned j = 0; j < 16; ++j) { const unsigned c = xb_ld(&bar[XB_XCNT(j)]); sum += c; cnt += (c > 0u) ? 1u : 0u; mine = (j == x) ? c : mine; }
        if (sum == G) break;
        __builtin_amdgcn_s_sleep(1);
        if ((++sp & 255u) == 0u) { if (xb_ld(&bar[XB_TMO])) break; if (sp > XB_SPIN_CAP) { atomicAdd(&bar[XB_TMO], 1u); break; } }
    }
    nloc = mine > 0u ? mine : 1u; nx = cnt > 0u ? cnt : 1u;
}

__device__ __forceinline__ void xcd_barrier(const XcdBarrier& b) {
    asm volatile("s_waitcnt vmcnt(0)" ::: "memory");
    __syncthreads();
    if (threadIdx.x == 0) {
        unsigned* bar = b.bar;
        __builtin_amdgcn_s_waitcnt(0);
        unsigned nloc = b.st[0], nx = b.st[1];
        if (nloc == 0u) { xcd_barrier_complete(bar, b.x, nloc, nx); b.st[0] = nloc; b.st[1] = nx; }
        const unsigned old = xb_add(&bar[XB_XSUB(b.x)], 1u);
        const unsigned gen = old / nloc;
        if (old + 1u == (gen + 1u) * nloc) {
            __builtin_amdgcn_fence(__ATOMIC_RELEASE, "agent");
            asm volatile("s_waitcnt vmcnt(0)" ::: "memory");
            const unsigned og = xb_add(&bar[XB_TOP], 1u);
            const unsigned tg = og / nx;
            if (og + 1u == (tg + 1u) * nx) xb_add(&bar[XB_TOPGEN], 1u);
            else XB_SPIN(xb_ld(&bar[XB_TOPGEN]) == tg, bar);
            __builtin_amdgcn_fence(__ATOMIC_ACQUIRE, "agent");
            xb_add(&bar[XB_XGEN(b.x)], 1u);
            asm volatile("s_waitcnt vmcnt(0)" ::: "memory");
        } else {
            XB_SPIN(xb_ld(&bar[XB_XGEN(b.x)]) == gen, bar);
            __builtin_amdgcn_fence(__ATOMIC_ACQUIRE, "agent");
            asm volatile("s_waitcnt vmcnt(0)" ::: "memory");
        }
    }
    __syncthreads();
}

constexpr int DM = 1024, SEQ = 8192, MP = 16384, MS = 128, MR = MP + MS, RT = 16640;
constexpr int DFF = 2816, DV = 3072, NGA = 8, CGW = 384, NQG = 1280, NKVP = 1536;
constexpr int NMOD = 40960;
constexpr int MODKV = 36864, MODFIN = 38912;
constexpr int NPAGES = 16, PAST = 2048;
constexpr float LOG2E = 1.4426950408889634f;
#ifndef ONE_LAUNCH
#define ONE_LAUNCH 1
#endif

constexpr size_t OY_P = 0, OY_S = 16777216, OKV_P = 16908288, OKV_S = 33685504, OWIN_P = 33816576, OWIN_S = 34340864, OGV = 67895296, OUT_TOTAL = 68681728;

constexpr size_t al(size_t x) { return (x + 0xFFFFFull) & ~0xFFFFFull; }
constexpr size_t WS_CTL = 0, CTL_ZERO_BYTES = 2u << 20;
constexpr size_t WS_WMOD = al(CTL_ZERO_BYTES);
constexpr size_t WS_WGU = al(WS_WMOD + (size_t)NMOD * DM * 2);
constexpr size_t WS_WDN = al(WS_WGU + (size_t)8 * 5632 * DM * 2);
constexpr size_t WS_WUV = al(WS_WDN + (size_t)8 * DM * DFF * 2);
constexpr size_t WS_WOUT = al(WS_WUV + (size_t)2 * 6144 * DM * 2);
constexpr size_t WS_WQG = al(WS_WOUT + (size_t)2 * DM * DV * 2);
constexpr size_t WS_WO = al(WS_WQG + (size_t)2 * NQG * DM * 2);
constexpr size_t WS_WKV = al(WS_WO + (size_t)2 * DM * DM * 2);
constexpr size_t WS_WC1 = al(WS_WKV + (size_t)NKVP * DM * 2);
constexpr size_t WS_WC2 = al(WS_WC1 + (size_t)2 * 512 * 1024 * 2);
constexpr size_t WS_WSP = al(WS_WC2 + (size_t)2 * 64 * 256 * 2);
constexpr size_t WS_CBIAS = al(WS_WSP + (size_t)2 * 8 * 128 * 128 * 2);
constexpr size_t WS_X = al(WS_CBIAS + 4096);
constexpr size_t WS_H = al(WS_X + (size_t)RT * DM * 2);
constexpr size_t WS_HID = al(WS_H + (size_t)RT * DM * 2);
constexpr size_t WS_Z = al(WS_HID + (size_t)RT * DFF * 2);
constexpr size_t WS_VT = al(WS_Z + (size_t)RT * 6144 * 2);
constexpr size_t WS_P = al(WS_VT + (size_t)128 * DV * 128 * 2);
constexpr size_t WS_Q = al(WS_P + (size_t)RT * DV * 2);
constexpr size_t WS_GATES = al(WS_Q + (size_t)RT * DM * 2);
constexpr size_t WS_O = al(WS_GATES + (size_t)RT * 48 * 4);
constexpr size_t KVB = (size_t)8 * SEQ * 64 * 2;
constexpr size_t WS_KCIN = al(WS_O + (size_t)RT * DM * 2);
constexpr size_t WS_VCIN = WS_KCIN + KVB, WS_SK = WS_VCIN + KVB, WS_SVT = WS_SK + KVB, WS_WK = WS_SVT + KVB, WS_WVT = WS_WK + KVB;
constexpr size_t WS_MOD = al(WS_WVT + KVB);
constexpr size_t WS_SC = al(WS_MOD + (size_t)256 * NMOD * 4);
constexpr size_t WS_TK = al(WS_SC + (size_t)256 * DM * 2);
constexpr size_t WS_TV = al(WS_TK + (size_t)4096 * 512 * 2);
constexpr size_t WS_KC = al(WS_TV + (size_t)4096 * 512 * 2);
constexpr size_t WS_VCT = al(WS_KC + (size_t)8 * 512 * 64 * 2);
constexpr size_t WS_ACMP = al(WS_VCT + (size_t)8 * 64 * 512 * 2);
constexpr size_t WS_TS = al(WS_ACMP + (size_t)2 * 65536 * 1024 * 2);
constexpr size_t WS_KCS = al(WS_TS + (size_t)2 * 65536 * 512 * 2);
constexpr size_t WS_VCS = al(WS_KCS + (size_t)512 * 128 * 64 * 4);
constexpr size_t WS_OACC = al(WS_VCS + (size_t)512 * 128 * 64 * 4);
constexpr size_t WS_HKV = al(WS_OACC + (size_t)MP * DM * 4);
constexpr size_t WS_SHB = al(WS_HKV + (size_t)RT * DM * 2);
constexpr size_t WS_B2 = al(WS_SHB + (size_t)13 * 256 * 1024 * 2);
constexpr size_t WS_NG = al(WS_B2 + (size_t)13 * 256 * 6144 * 4);
constexpr size_t WS_SSP = al(WS_NG + (size_t)13 * 1024 * 4);
constexpr size_t WS_SSPS = al(WS_SSP + (size_t)11 * MP * 16 * 4);
constexpr size_t WS_END = al(WS_SSPS + (size_t)11 * MS * 32 * 4);

constexpr int CW_BAR = 4096, CW_QUEUE = 8192, CW_SS = 32768, CW_VS = CW_SS + 11 * 16640;
static_assert((size_t)(CW_VS + 2 * 16640 * 2) * 4 <= CTL_ZERO_BYTES, "SS / VS accumulators inside the memset region");

constexpr int RING_BYTES = 131072, LDSCTL_OFF = RING_BYTES, MISC_OFF = LDSCTL_OFF + 320, LDS_BYTES = 147456;
constexpr int NWAVES = 8;

#define GAS __attribute__((address_space(1)))
typedef unsigned short bf16;
typedef unsigned v4u __attribute__((ext_vector_type(4)));
typedef unsigned v2u __attribute__((ext_vector_type(2)));
typedef float f32x4 __attribute__((ext_vector_type(4)));
typedef short bf16x8 __attribute__((ext_vector_type(8)));
typedef short bf16x4 __attribute__((ext_vector_type(4)));
typedef float f32x2 __attribute__((ext_vector_type(2)));
typedef _Float16 f16x4 __attribute__((ext_vector_type(4)));
typedef _Float16 f16x8 __attribute__((ext_vector_type(8)));
typedef _Float16 f16;

__device__ __forceinline__ float bf2f(unsigned b) { return __uint_as_float(b << 16); }
__device__ __forceinline__ float bflo(unsigned w) { return __uint_as_float(w << 16); }
__device__ __forceinline__ float bfhi(unsigned w) { return __uint_as_float(w & 0xffff0000u); }
__device__ __forceinline__ unsigned pk2(float lo, float hi) { return pg8::cvt_pk_bf16(lo, hi); }
__device__ __forceinline__ float frcp(float x) { return __builtin_amdgcn_rcpf(x); }
__device__ __forceinline__ float fexp2(float x) { return __builtin_amdgcn_exp2f(x); }
__device__ __forceinline__ float sigmoid_f(float x) { return frcp(1.f + fexp2(-LOG2E * x)); }
__device__ __forceinline__ float silu_f(float x) { return x * sigmoid_f(x); }
__device__ __forceinline__ float gelu_tanh_f(float x) { const float u = x + 0.044715f * x * x * x; return x * frcp(1.f + fexp2(-2.302208198f * u)); }
__device__ __forceinline__ int row_b(int r) { return r < SEQ ? 0 : (r < MP ? 1 : 2 + ((r - MP) < MS ? (r - MP) : (MS - 1))); }
template <int CTRL> __device__ __forceinline__ float dppf(float x) { return __builtin_bit_cast(float, __builtin_amdgcn_mov_dpp(__builtin_bit_cast(int, x), CTRL, 0xF, 0xF, true)); }
template <int CTRL> __device__ __forceinline__ unsigned dppu(unsigned x) { return (unsigned)__builtin_amdgcn_mov_dpp((int)x, CTRL, 0xF, 0xF, true); }
#define DPP_X1 0xB1
#define DPP_X2 0x4E
#define DPP_HM 0x141
#define DPP_RM 0x140
#define DPP_X8 0x128
__device__ __forceinline__ void xpair16(float x, float& a, float& b) { auto r = __builtin_amdgcn_permlane16_swap(__float_as_uint(x), __float_as_uint(x), false, false); a = __uint_as_float(r[0]); b = __uint_as_float(r[1]); }
__device__ __forceinline__ void xpair32(float x, float& a, float& b) { auto r = __builtin_amdgcn_permlane32_swap(__float_as_uint(x), __float_as_uint(x), false, false); a = __uint_as_float(r[0]); b = __uint_as_float(r[1]); }
__device__ __forceinline__ void xpair16i(int x, int& a, int& b) { auto r = __builtin_amdgcn_permlane16_swap((unsigned)x, (unsigned)x, false, false); a = (int)r[0]; b = (int)r[1]; }
__device__ __forceinline__ void xpair32i(int x, int& a, int& b) { auto r = __builtin_amdgcn_permlane32_swap((unsigned)x, (unsigned)x, false, false); a = (int)r[0]; b = (int)r[1]; }
__device__ __forceinline__ float xsum_16_32(float x) { float a, b; xpair16(x, a, b); x = a + b; xpair32(x, a, b); return a + b; }
__device__ __forceinline__ float xmax_16_32(float x) { float a, b; xpair16(x, a, b); x = fmaxf(a, b); xpair32(x, a, b); return fmaxf(a, b); }
__device__ __forceinline__ float wave_sum(float v) { v += dppf<DPP_X1>(v); v += dppf<DPP_X2>(v); v += dppf<DPP_HM>(v); v += dppf<DPP_RM>(v); return xsum_16_32(v); }
__device__ __forceinline__ v4u pack8(const f32x4 a, const f32x4 b) { v4u w; w.x = pk2(a[0], a[1]); w.y = pk2(a[2], a[3]); w.z = pk2(b[0], b[1]); w.w = pk2(b[2], b[3]); return w; }
__device__ __forceinline__ void unpack8(const v4u w, float (&f)[8]) { f[0] = bflo(w.x); f[1] = bfhi(w.x); f[2] = bflo(w.y); f[3] = bfhi(w.y); f[4] = bflo(w.z); f[5] = bfhi(w.z); f[6] = bflo(w.w); f[7] = bfhi(w.w); }

template <class F> struct Epi8 {
    static constexpr bool PERM = true, AFTER_DRAIN = false; F f;
    __device__ __forceinline__ void operator()(const pg8::f32x4 (&acc)[2][2][4][2], const pg8::Unit& u, int wr, int wc, int fr, int fq) const {
        const int row0 = u.pm * pg8::BM + wr * 64 + fr, col0 = u.pn * pg8::BM + wc * 32 + 8 * fq;
        typename F::Pre pre; f.prep(pre, row0, col0, false);
#pragma unroll
        for (int ai = 0; ai < 2; ++ai)
#pragma unroll
            for (int mh = 0; mh < 2; ++mh) {
                typename F::Ld ld[2][2];
#pragma unroll
                for (int m2 = 0; m2 < 2; ++m2)
#pragma unroll
                    for (int bj = 0; bj < 2; ++bj) f.fetch(ld[m2][bj], row0 + ai * pg8::HALF + (2 * mh + m2) * 16, col0 + bj * pg8::HALF);
#pragma unroll
                for (int m2 = 0; m2 < 2; ++m2) { const int m = 2 * mh + m2, row = row0 + ai * pg8::HALF + m * 16;
                    f32x2 part = (f32x2){0.f, 0.f};
#pragma unroll
                    for (int bj = 0; bj < 2; ++bj) part = part + f(pre, ld[m2][bj], ai * 4 + m, bj, row, col0 + bj * pg8::HALF, acc[ai][bj][m][0], acc[ai][bj][m][1]);
                    f.row_done(row, part, fq); }
            }
    }
};
struct NoLd {};
struct NoPre {};
struct NormPre { float rs[8]; f32x4 b[2][2]; };
struct NormIn { unsigned char* ws; int ssi, inst, on;
    __device__ __forceinline__ void prep(NormPre& p, int row0, int col0, bool skinny) const {
        if (!on) return;
        const float* SS = (const float*)(ws + WS_CTL) + CW_SS + (size_t)ssi * RT; const float* b = (const float*)(ws + WS_B2) + ((size_t)inst * 256 + row_b(row0)) * 6144 + col0;
        if (skinny) { p.rs[0] = SS[row0]; p.b[0][0] = *(const f32x4*)b; p.b[0][1] = *(const f32x4*)(b + 4); p.rs[0] = __builtin_amdgcn_rsqf(p.rs[0] * (1.0f / DM) + 1e-6f); }
        else {
#pragma unroll
            for (int i = 0; i < 8; ++i) p.rs[i] = SS[row0 + (i >> 2) * 128 + (i & 3) * 16];
#pragma unroll
            for (int bj = 0; bj < 2; ++bj) { p.b[bj][0] = *(const f32x4*)(b + 128 * bj); p.b[bj][1] = *(const f32x4*)(b + 128 * bj + 4); }
#pragma unroll
            for (int i = 0; i < 8; ++i) p.rs[i] = __builtin_amdgcn_rsqf(p.rs[i] * (1.0f / DM) + 1e-6f);
        }
    }
    __device__ __forceinline__ void apply(const NormPre& p, int ri, int bj, f32x4& v0, f32x4& v1) const { if (on) { v0 = v0 * p.rs[ri] + p.b[bj][0]; v1 = v1 * p.rs[ri] + p.b[bj][1]; } }
};
struct FSwiglu {
    typedef NormPre Pre; typedef NoLd Ld; __device__ __forceinline__ void fetch(Ld&, int, int) const {} bf16* HID; NormIn ni;
    __device__ __forceinline__ void prep(Pre& p, int row0, int col0, bool sk) const { ni.prep(p, row0, col0, sk); }
    __device__ __forceinline__ f32x2 operator()(const Pre& p, const Ld&, int ri, int bj, int row, int col0, f32x4 g, f32x4 u) const {
        ni.apply(p, ri, bj, g, u);
        v2u w; w.x = pk2(silu_f(g[0]) * u[0], silu_f(g[1]) * u[1]); w.y = pk2(silu_f(g[2]) * u[2], silu_f(g[3]) * u[3]);
        *(v2u*)(HID + (size_t)row * DFF + (col0 >> 1)) = w; return (f32x2){0.f, 0.f};
    }
    __device__ __forceinline__ void row_done(int, f32x2, int) const {}
};
struct ResidPre { f32x4 gate[2][2], hm[2][2]; };
struct FResid {
    typedef ResidPre Pre; struct Ld { f32x4 x0, x1; };
    unsigned char* ws; int gcol; float coef; int n1, sc1, n2, sc2, ssi;
    __device__ __forceinline__ void fetch(Ld& d, int row, int col0) const { const f16x8 h = *(const f16x8*)((const f16*)(ws + WS_X) + (size_t)row * DM + col0); const f16x4 lo = __builtin_shufflevector(h, h, 0, 1, 2, 3), hi = __builtin_shufflevector(h, h, 4, 5, 6, 7);
        d.x0 = __builtin_convertvector(lo, f32x4); d.x1 = __builtin_convertvector(hi, f32x4); }
    __device__ __forceinline__ void prep(Pre& p, int row0, int col0, bool skinny) const {
        const float* mrow = (const float*)(ws + WS_MOD) + (size_t)row_b(row0) * NMOD + col0;
#pragma unroll
        for (int bj = 0; bj < 2; ++bj) { if (skinny && bj) break;
            p.gate[bj][0] = *(const f32x4*)(mrow + gcol + 128 * bj) * coef; p.gate[bj][1] = *(const f32x4*)(mrow + gcol + 128 * bj + 4) * coef;
            if (n1 >= 0) { const float* g1 = (const float*)(ws + WS_NG) + n1 * DM + col0 + 128 * bj;
                p.hm[bj][0] = *(const f32x4*)g1 * (*(const f32x4*)(mrow + sc1 + 128 * bj) + 1.0f); p.hm[bj][1] = *(const f32x4*)(g1 + 4) * (*(const f32x4*)(mrow + sc1 + 128 * bj + 4) + 1.0f); } }
    }
    __device__ __forceinline__ f32x2 operator()(const Pre& p, const Ld& d, int ri, int bj, int row, int col0, f32x4 v0, f32x4 v1) const {
        const f32x4 x0 = d.x0 + p.gate[bj][0] * v0, x1 = d.x1 + p.gate[bj][1] * v1;
        { const f16x4 lo = __builtin_convertvector(x0, f16x4), hi = __builtin_convertvector(x1, f16x4); *(f16x8*)((f16*)(ws + WS_X) + (size_t)row * DM + col0) = __builtin_shufflevector(lo, hi, 0, 1, 2, 3, 4, 5, 6, 7); }
        if (n1 >= 0) *(v4u*)((bf16*)(ws + WS_H) + (size_t)row * DM + col0) = pack8(x0 * p.hm[bj][0], x1 * p.hm[bj][1]);
        if (n2 >= 0) { const float* mrow = (const float*)(ws + WS_MOD) + (size_t)row_b(row) * NMOD + col0; const float* g2 = (const float*)(ws + WS_NG) + n2 * DM + col0;
            const f32x4 a0 = *(const f32x4*)g2, a1 = *(const f32x4*)(g2 + 4), s0 = *(const f32x4*)(mrow + sc2), s1 = *(const f32x4*)(mrow + sc2 + 4);
            *(v4u*)((bf16*)(ws + WS_HKV) + (size_t)row * DM + col0) = pack8(x0 * a0 * (s0 + 1.0f), x1 * a1 * (s1 + 1.0f)); }
        return (f32x2){((x0[0] * x0[0] + x0[1] * x0[1]) + (x0[2] * x0[2] + x0[3] * x0[3])) + ((x1[0] * x1[0] + x1[1] * x1[1]) + (x1[2] * x1[2] + x1[3] * x1[3])), 0.f};
    }
    __device__ __forceinline__ void row_done(int row, f32x2 part2, int fq) const {
        float part = part2[0];
        if (ssi >= 0) { part = xsum_16_32(part); if (fq == 0) atomicAdd((float*)(ws + WS_CTL) + CW_SS + (size_t)ssi * RT + row, part); }
    }
};
struct FGelu {
    typedef NormPre Pre; typedef NoLd Ld; __device__ __forceinline__ void fetch(Ld&, int, int) const {} bf16* Z; NormIn ni; float* VS;
    __device__ __forceinline__ void prep(Pre& p, int row0, int col0, bool sk) const { ni.prep(p, row0, col0, sk); }
    __device__ __forceinline__ f32x2 operator()(const Pre& p, const Ld&, int ri, int bj, int row, int col0, f32x4 v0, f32x4 v1) const {
        ni.apply(p, ri, bj, v0, v1);
        f32x4 a, b;
#pragma unroll
        for (int i = 0; i < 4; ++i) { a[i] = gelu_tanh_f(v0[i]); b[i] = gelu_tanh_f(v1[i]); }
        *(v4u*)(Z + (size_t)row * 6144 + col0) = pack8(a, b);
        if (col0 < DV) return (f32x2){0.f, 0.f};
        const f32x4 s = a + b, q = a * a + b * b; return (f32x2){(s[0] + s[1]) + (s[2] + s[3]), (q[0] + q[1]) + (q[2] + q[3])};
    }
    __device__ __forceinline__ void row_done(int row, f32x2 part, int fq) const {
        float s = part[0], q = part[1];
        s = xsum_16_32(s); q = xsum_16_32(q);
        if (fq == 0 && q != 0.f) { atomicAdd(VS + 2 * (size_t)row, s); atomicAdd(VS + 2 * (size_t)row + 1, q); }
    }
};
struct FQg {
    typedef NormPre Pre; typedef NoLd Ld; __device__ __forceinline__ void fetch(Ld&, int, int) const {} bf16* Q; float* GATES; NormIn ni;
    __device__ __forceinline__ void prep(Pre& p, int row0, int col0, bool sk) const { ni.prep(p, row0, col0, sk); }
    __device__ __forceinline__ f32x2 operator()(const Pre& p, const Ld&, int ri, int bj, int row, int col0, f32x4 v0, f32x4 v1) const {
        ni.apply(p, ri, bj, v0, v1);
        if (col0 < DM) { *(v4u*)(Q + (size_t)row * DM + col0) = pack8(v0 * (0.125f * LOG2E), v1 * (0.125f * LOG2E)); }
        else if (col0 < DM + 48) { f32x4 a, b;
#pragma unroll
            for (int i = 0; i < 4; ++i) { a[i] = sigmoid_f(v0[i]); b[i] = sigmoid_f(v1[i]); }
            float* gp = GATES + (size_t)row * 48 + (col0 - DM); *(f32x4*)gp = a; *(f32x4*)(gp + 4) = b; }
        return (f32x2){0.f, 0.f};
    }
    __device__ __forceinline__ void row_done(int, f32x2, int) const {}
};
struct FKv {
    typedef NormPre Pre; typedef NoLd Ld; __device__ __forceinline__ void fetch(Ld&, int, int) const {} float* out; bf16 *KCIN; NormIn ni;
    __device__ __forceinline__ void prep(Pre& p, int row0, int col0, bool sk) const { ni.prep(p, row0, col0, sk); }
    __device__ __forceinline__ f32x2 operator()(const Pre& p, const Ld&, int ri, int bj, int row, int col0, f32x4 v0, f32x4 v1) const {
        ni.apply(p, ri, bj, v0, v1);
        const int slot = col0 >> 8, g = (col0 >> 6) & 3, d0 = col0 & 63;
        if (row < MP) {
            const int b = row >> 13, t = row & (SEQ - 1);
            if (slot < 4) { float* q = out + OKV_P + (size_t)row * DM + col0; *(f32x4*)q = v0; *(f32x4*)(q + 4) = v1; }
            else if (t >= SEQ - 512) { float* q = out + OWIN_P + ((size_t)(b * 512 + (t - (SEQ - 512))) * 2 + (slot - 4)) * 256 + g * 64 + d0; *(f32x4*)q = v0; *(f32x4*)(q + 4) = v1; }
            const int bg = b * 4 + g;
            if (slot == 3 || slot == 5) {
                bf16* base = KCIN + (size_t)slot * (KVB / 2) + (((size_t)bg * (SEQ / 32) + (t >> 5)) * 64 + d0) * 32 + (t & 31);
#pragma unroll
                for (int i = 0; i < 4; ++i) { base[i * 32] = (bf16)(pk2(v0[i], 0.f) & 0xffffu); base[(i + 4) * 32] = (bf16)(pk2(v1[i], 0.f) & 0xffffu); }
            } else {
                bf16* base = KCIN + (size_t)slot * (KVB / 2) + ((size_t)bg * SEQ + t) * 64 + d0;
                *(v4u*)base = pack8(v0, v1);
            }
        } else {
            const int bs = row - MP;
            if (slot < 4) { float* q = out + OKV_S + (size_t)bs * DM + col0; *(f32x4*)q = v0; *(f32x4*)(q + 4) = v1; }
            else { float* q = out + OWIN_S + ((size_t)bs * 512 + 511) * 512 + (slot - 4) * 256 + g * 64 + d0; *(f32x4*)q = v0; *(f32x4*)(q + 4) = v1; }
        }
        return (f32x2){0.f, 0.f};
    }
    __device__ __forceinline__ void row_done(int, f32x2, int) const {}
};
constexpr int SH_NINST = 13;
struct FMod {
    typedef NoPre Pre; typedef NoLd Ld; __device__ __forceinline__ void fetch(Ld&, int, int) const {} float* MOD; const float *b0, *b1, *b2; bf16* SHB;
    __device__ __forceinline__ void prep(Pre&, int, int, bool) const {}
    __device__ __forceinline__ f32x2 operator()(const Pre&, const Ld&, int, int, int row, int col0, f32x4 v0, f32x4 v1) const {
        const float* bp = col0 < MODKV ? b0 + col0 : (col0 < MODFIN ? b1 + (col0 - MODKV) : b2 + (col0 - MODFIN));
        v0 = v0 + *(const f32x4*)bp; v1 = v1 + *(const f32x4*)(bp + 4);
        float* p = MOD + (size_t)row * NMOD + col0; *(f32x4*)p = v0; *(f32x4*)(p + 4) = v1;
        int inst = -1, k = 0;
        if (col0 < MODKV) { const int l = col0 / 9216, r = col0 - l * 9216, sub = r / 3072, rr = r - sub * 3072; if (rr < DM) { inst = l * 3 + sub; k = rr; } }
        else if (col0 < MODKV + DM) { inst = 12; k = col0 - MODKV; }
        if (inst >= 0) *(v4u*)(SHB + ((size_t)inst * 256 + row) * DM + k) = pack8(v0, v1);
        return (f32x2){0.f, 0.f};
    }
    __device__ __forceinline__ void row_done(int, f32x2, int) const {}
};
struct FBf16 {
    typedef NoPre Pre; typedef NoLd Ld; __device__ __forceinline__ void fetch(Ld&, int, int) const {} bf16* T; int ld;
    __device__ __forceinline__ void prep(Pre&, int, int, bool) const {}
    __device__ __forceinline__ f32x2 operator()(const Pre&, const Ld&, int, int, int row, int col0, f32x4 v0, f32x4 v1) const { *(v4u*)(T + (size_t)row * ld + col0) = pack8(v0, v1); return (f32x2){0.f, 0.f}; }
    __device__ __forceinline__ void row_done(int, f32x2, int) const {}
};
constexpr int TILEB = 256 * 1024 * 2;
constexpr int PN_UV = (int)((WS_WUV - WS_WGU) / TILEB), PN_QG = (int)((WS_WQG - WS_WGU) / TILEB), PN_KV = (int)((WS_WKV - WS_WGU) / TILEB);
static_assert((WS_WUV - WS_WGU) % TILEB == 0 && (WS_WQG - WS_WGU) % TILEB == 0 && (WS_WKV - WS_WGU) % TILEB == 0, "weight copies on 256-row tile boundaries");
struct ShiftOrder {
    int G, c;
    __device__ __forceinline__ bool next(int i, pg8::Unit& u) const {
        const int L = i * G + c; if (L >= 240) return false;
        if (L < 176) { const int f = L / 22, t = L - f * 22; u.pm = (f >> 1) * 3 + 2 * (f & 1); u.pn = f * 22 + t; }
        else if (L < 224) { const int q = L - 176, l = q / 24, t = q - l * 24; u.pm = l * 3 + 1; u.pn = PN_UV + l * 24 + t; }
        else if (L < 234) { const int q = L - 224, j = q / 5, t = q - j * 5; u.pm = (2 + j) * 3 + 1; u.pn = PN_QG + j * 5 + t; }
        else { u.pm = 12; u.pn = PN_KV + (L - 234); }
        return true;
    }
    __device__ __forceinline__ void a_ready(const pg8::Unit&) const {}
    __device__ __forceinline__ void done(const pg8::Unit&) const {}
};
struct FB2 {
    typedef NoPre Pre; typedef NoLd Ld; __device__ __forceinline__ void fetch(Ld&, int, int) const {} float* B2;
    __device__ __forceinline__ void prep(Pre&, int, int, bool) const {}
    __device__ __forceinline__ f32x2 operator()(const Pre&, const Ld&, int, int, int row, int col0, f32x4 v0, f32x4 v1) const {
        const int inst = row >> 8, b = row & 255, pn = col0 >> 8;
        int t;
        if (pn < 176) t = pn % 22; else if (pn < PN_QG) t = (pn - PN_UV) % 24; else if (pn < PN_KV) t = (pn - PN_QG) % 5; else t = pn - PN_KV;
        float* p = B2 + ((size_t)inst * 256 + b) * 6144 + t * 256 + (col0 & 255); *(f32x4*)p = v0; *(f32x4*)(p + 4) = v1; return (f32x2){0.f, 0.f};
    }
    __device__ __forceinline__ void row_done(int, f32x2, int) const {}
};

template <class F> __device__ __forceinline__ void run_gemm(LAS unsigned char* lds, const bf16* A, const bf16* Bt, int M, int N, int K, const F& f, int rot = 0) {
    int cblk = ((int)blockIdx.x + rot) % (int)gridDim.x; asm volatile("" : "+s"(cblk));
    pg8::Gemm g{A, Bt, M, N, K}; pg8::StaticOrder S; S.init(M, N, (int)gridDim.x, cblk);
    Epi8<F> E{f};
    pg8::gemm_phase<Epi8<F>, pg8::StaticOrder, true, true>(lds, g, S, E);
}

template <int RTU, int SB, class F> __device__ __forceinline__ void skinny_gemm(LAS unsigned char* lds, const bf16* A, const bf16* Bt, int ncol32, int K, int rem, const F& f) {
    int tid_raw = threadIdx.x; asm volatile("" : "+v"(tid_raw));
    const int lane = tid_raw & 63, wave = __builtin_amdgcn_readfirstlane(tid_raw >> 6), fr = lane & 15, fq = lane >> 4;
    constexpr int NR = 8 / RTU;
    const int kper = K >> 3, nsteps = kper >> 5, nunits = NR * ncol32;
    int cblk = (int)blockIdx.x; asm volatile("" : "+s"(cblk));
    const int nl = (int)gridDim.x - rem;
    LAS f32x4* red = (LAS f32x4*)lds;
    if (cblk < rem) return;
    for (int u = cblk - rem; u < nunits; u += nl) {
        const int n0 = 32 * (u / NR), r0 = MP + 16 * RTU * (u % NR);
        f32x4 acc[RTU][2];
#pragma unroll
        for (int rt = 0; rt < RTU; ++rt) { acc[rt][0] = (f32x4){0.f, 0.f, 0.f, 0.f}; acc[rt][1] = (f32x4){0.f, 0.f, 0.f, 0.f}; }
        const bf16* bp = Bt + (size_t)(n0 + 8 * (fr >> 2) + (fr & 3)) * K + wave * kper + 8 * fq;
        const bf16* ap = A + (size_t)(r0 + fr) * K + wave * kper + 8 * fq;
        const int row = r0 + 16 * (wave < RTU ? wave : 0) + fr;
        typename F::Pre pre; typename F::Ld ld;
        if (wave < RTU) { f.fetch(ld, row, n0 + 8 * fq); f.prep(pre, row, n0 + 8 * fq, true); }
#pragma unroll 1
        for (int ks0 = 0; ks0 < nsteps; ks0 += SB) {
            bf16x8 bb[SB][2], aa[SB][RTU];
#pragma unroll
            for (int s = 0; s < SB; ++s) { const int ks = (ks0 + s < nsteps) ? ks0 + s : nsteps - 1;
                bb[s][0] = *(const bf16x8*)(bp + 32 * ks); bb[s][1] = *(const bf16x8*)(bp + (size_t)4 * K + 32 * ks);
#pragma unroll
                for (int rt = 0; rt < RTU; ++rt) aa[s][rt] = *(const bf16x8*)(ap + (size_t)(16 * rt) * K + 32 * ks); }
#pragma unroll
            for (int s = 0; s < SB; ++s) if (ks0 + s < nsteps) {
#pragma unroll
                for (int rt = 0; rt < RTU; ++rt) { acc[rt][0] = __builtin_amdgcn_mfma_f32_16x16x32_bf16(bb[s][0], aa[s][rt], acc[rt][0], 0, 0, 0); acc[rt][1] = __builtin_amdgcn_mfma_f32_16x16x32_bf16(bb[s][1], aa[s][rt], acc[rt][1], 0, 0, 0); } }
        }
#pragma unroll
        for (int rt = 0; rt < RTU; ++rt) { red[((wave * RTU + rt) * 2 + 0) * 64 + lane] = acc[rt][0]; red[((wave * RTU + rt) * 2 + 1) * 64 + lane] = acc[rt][1]; }
        __syncthreads();
        if (wave < RTU) {
            f32x4 s0 = (f32x4){0.f, 0.f, 0.f, 0.f}, s1 = (f32x4){0.f, 0.f, 0.f, 0.f};
#pragma unroll
            for (int w2 = 0; w2 < 8; ++w2) { s0 = s0 + red[((w2 * RTU + wave) * 2 + 0) * 64 + lane]; s1 = s1 + red[((w2 * RTU + wave) * 2 + 1) * 64 + lane]; }
            const f32x2 part = f(pre, ld, 0, 0, row, n0 + 8 * fq, s0, s1); f.row_done(row, part, fq);
        }
        __syncthreads();
    }
}
template <class F> __device__ __forceinline__ void run_gemm2(LAS unsigned char* lds, const bf16* A, const bf16* Bt, int N, int Nreal, int K, const F& f, int rot = 0, int rem = -1) {
    run_gemm(lds, A, Bt, MP, N, K, f, rot);
    skinny_gemm<4, 6>(lds, A, Bt, (Nreal + 31) >> 5, K, rem >= 0 ? rem : ((MP / 256) * (N / 256)) % (int)gridDim.x, f);
}
template <class F> __device__ __forceinline__ void run_gemm2r(LAS unsigned char* lds, const bf16* A, const bf16* Bt, int K, const F& f) {
    run_gemm(lds, A, Bt, MP, DM, K, f, 0);
    skinny_gemm<1, 12>(lds, A, Bt, DM / 32, K, 0, f);
}

template <bool FINAL>
__device__ __forceinline__ void norm_phase(const f16* X, const float* gvec, const float* MOD, int shift_col, int scale_col, bf16* H, float* out, int gw, int NGW, int lane) {
    f32x4 gv[4];
#pragma unroll
    for (int j = 0; j < 4; ++j) gv[j] = *(const f32x4*)(gvec + 4 * lane + 256 * j);
    for (int r0 = gw; r0 < MR; r0 += 4 * NGW) {
        f16x4 raw[4][4];
#pragma unroll
        for (int q = 0; q < 4; ++q) { const int rq = r0 + q * NGW, rc = rq < MR ? rq : MR - 1; const f16x4* xr = (const f16x4*)(X + (size_t)rc * DM) + lane;
#pragma unroll
            for (int j = 0; j < 4; ++j) raw[q][j] = xr[64 * j]; }
#pragma unroll
        for (int q = 0; q < 4; ++q) { const int r = r0 + q * NGW;
            if (r < MR) {
                const float* mrow = MOD + (size_t)row_b(r) * NMOD;
                f32x4 sh[4], sc[4];
#pragma unroll
                for (int j = 0; j < 4; ++j) { const int c = 4 * lane + 256 * j; sh[j] = *(const f32x4*)(mrow + shift_col + c); sc[j] = *(const f32x4*)(mrow + scale_col + c); }
                f32x4 v[4]; float ss = 0.f;
#pragma unroll
                for (int j = 0; j < 4; ++j) { v[j] = __builtin_convertvector(raw[q][j], f32x4); ss += (v[j][0] * v[j][0] + v[j][1] * v[j][1]) + (v[j][2] * v[j][2] + v[j][3] * v[j][3]); }
                ss = wave_sum(ss);
                const float rstd = 1.0f / sqrtf(ss * (1.0f / DM) + 1e-6f);
#pragma unroll
                for (int j = 0; j < 4; ++j) { const int c = 4 * lane + 256 * j;
                    const f32x4 y = (v[j] * rstd) * gv[j] * (sc[j] + 1.0f) + sh[j];
                    if (FINAL) { float* o = (r < MP) ? out + OY_P + (size_t)r * DM + c : out + OY_S + (size_t)(r - MP) * DM + c; *(f32x4*)o = y; }
                    else { v2u w; w.x = pk2(y[0], y[1]); w.y = pk2(y[2], y[3]); *(v2u*)(H + (size_t)r * DM + c) = w; }
                }
            }
        }
    }
}

__device__ __forceinline__ void transpose_item(const float* W, int N, int ldw, bf16* WT, int ldt, int mode, int row_off, LAS float* scr, int item, int lane) {
    const int nblk = (N + 31) >> 5, kb = item / nblk, nb = item - kb * nblk, k0 = 64 * kb, n0 = 32 * nb;
    const int nn = n0 + (lane & 31); const bool okn = nn < N;
    float tv[32];
#pragma unroll
    for (int i = 0; i < 32; ++i) { const int kk = 2 * i + (lane >> 5); tv[i] = okn ? __builtin_nontemporal_load(W + (size_t)(k0 + kk) * ldw + nn) : 0.f; }
#pragma unroll
    for (int i = 0; i < 32; ++i) { const int kk = 2 * i + (lane >> 5); scr[kk * 33 + (lane & 31)] = tv[i]; }
    asm volatile("s_waitcnt lgkmcnt(0)" ::: "memory");
    const int c = lane & 7;
#pragma unroll
    for (int j = 0; j < 4; ++j) { const int n = (lane >> 3) + 8 * j; const LAS float* s = scr + (8 * c) * 33 + n;
        v4u o; o.x = pk2(s[0 * 33], s[1 * 33]); o.y = pk2(s[2 * 33], s[3 * 33]); o.z = pk2(s[4 * 33], s[5 * 33]); o.w = pk2(s[6 * 33], s[7 * 33]);
        const int ng = n0 + n;
        const int drow = mode == 0 ? row_off + ng : (8 * (ng >> 2) + (ng & 3) + (mode == 2 ? 4 : 0));
        if (ng < N) *(v4u*)(WT + (size_t)drow * ldt + k0 + 8 * c) = o; }
    asm volatile("s_waitcnt lgkmcnt(0)" ::: "memory");
}
struct TDesc { const float* src; int K, N, ldw; bf16* dst; int ldt, mode, row_off; };
struct Ptrs {
    const float *x_prompt, *x_sample, *cache_kv, *state_win; const int* page_table; const float *c_prompt, *c_sample, *ada_w, *ada_b, *norm_g, *w_gate, *w_up, *w_down,
        *w_uv, *ln_g, *ln_b, *w_sp, *b_sp, *w_out, *w_qg, *w_o, *kv_norm_g, *kv_ada_w, *kv_ada_b, *kv_w, *cmp_w1, *cmp_w2, *cmp_pe, *final_g, *final_ada_w, *final_ada_b;
    float* out; unsigned char* ws;
};
#define WSP(T, off) ((T*)(P.ws + (off)))
typedef const __attribute__((address_space(4))) unsigned long long* kptr_t;
__device__ __forceinline__ void load_ptrs(Ptrs& P) {
    kptr_t k = (kptr_t)__builtin_amdgcn_kernarg_segment_ptr();
    asm volatile("" : "+s"(k));
    P.x_prompt = (const float*)(GAS const float*)k[0]; P.x_sample = (const float*)(GAS const float*)k[1]; P.cache_kv = (const float*)(GAS const float*)k[2]; P.state_win = (const float*)(GAS const float*)k[3];
    P.page_table = (const int*)(GAS const int*)k[4]; P.c_prompt = (const float*)(GAS const float*)k[5]; P.c_sample = (const float*)(GAS const float*)k[6]; P.ada_w = (const float*)(GAS const float*)k[7];
    P.ada_b = (const float*)(GAS const float*)k[8]; P.norm_g = (const float*)(GAS const float*)k[9]; P.w_gate = (const float*)(GAS const float*)k[10]; P.w_up = (const float*)(GAS const float*)k[11];
    P.w_down = (const float*)(GAS const float*)k[12]; P.w_uv = (const float*)(GAS const float*)k[13]; P.ln_g = (const float*)(GAS const float*)k[14]; P.ln_b = (const float*)(GAS const float*)k[15];
    P.w_sp = (const float*)(GAS const float*)k[16]; P.b_sp = (const float*)(GAS const float*)k[17]; P.w_out = (const float*)(GAS const float*)k[18]; P.w_qg = (const float*)(GAS const float*)k[19];
    P.w_o = (const float*)(GAS const float*)k[20]; P.kv_norm_g = (const float*)(GAS const float*)k[21]; P.kv_ada_w = (const float*)(GAS const float*)k[22]; P.kv_ada_b = (const float*)(GAS const float*)k[23];
    P.kv_w = (const float*)(GAS const float*)k[24]; P.cmp_w1 = (const float*)(GAS const float*)k[25]; P.cmp_w2 = (const float*)(GAS const float*)k[26]; P.cmp_pe = (const float*)(GAS const float*)k[27];
    P.final_g = (const float*)(GAS const float*)k[28]; P.final_ada_w = (const float*)(GAS const float*)k[29]; P.final_ada_b = (const float*)(GAS const float*)k[30];
    P.out = (float*)(GAS float*)k[31]; P.ws = (unsigned char*)(GAS unsigned char*)k[32];
}
__device__ __forceinline__ void get_tdesc(const Ptrs& P, int id, TDesc& d) {
    d.mode = 0; d.row_off = 0; d.K = 1024; d.ldt = 1024;
    if (id < 4) { d.src = P.ada_w + (size_t)id * 1024 * 9216; d.N = 9216; d.dst = WSP(bf16, WS_WMOD); d.row_off = id * 9216; }
    else if (id == 4) { d.src = P.kv_ada_w; d.N = 2048; d.dst = WSP(bf16, WS_WMOD); d.row_off = MODKV; }
    else if (id == 5) { d.src = P.final_ada_w; d.N = 2048; d.dst = WSP(bf16, WS_WMOD); d.row_off = MODFIN; }
    else if (id < 14) { const int i = id - 6; d.src = P.w_gate + (size_t)i * 1024 * DFF; d.N = DFF; d.dst = WSP(bf16, WS_WGU) + (size_t)i * 5632 * 1024; d.mode = 1; }
    else if (id < 22) { const int i = id - 14; d.src = P.w_up + (size_t)i * 1024 * DFF; d.N = DFF; d.dst = WSP(bf16, WS_WGU) + (size_t)i * 5632 * 1024; d.mode = 2; }
    else if (id < 30) { const int i = id - 22; d.src = P.w_down + (size_t)i * DFF * 1024; d.K = DFF; d.N = 1024; d.dst = WSP(bf16, WS_WDN) + (size_t)i * 1024 * DFF; d.ldt = DFF; }
    else if (id < 32) { const int i = id - 30; d.src = P.w_uv + (size_t)i * 1024 * 6144; d.N = 6144; d.dst = WSP(bf16, WS_WUV) + (size_t)i * 6144 * 1024; }
    else if (id < 34) { const int i = id - 32; d.src = P.w_out + (size_t)i * DV * 1024; d.K = DV; d.N = 1024; d.dst = WSP(bf16, WS_WOUT) + (size_t)i * 1024 * DV; d.ldt = DV; }
    else if (id < 36) { const int i = id - 34; d.src = P.w_qg + (size_t)i * 1024 * 1072; d.N = 1072; d.dst = WSP(bf16, WS_WQG) + (size_t)i * NQG * 1024; }
    else if (id < 38) { const int i = id - 36; d.src = P.w_o + (size_t)i * 1024 * 1024; d.N = 1024; d.dst = WSP(bf16, WS_WO) + (size_t)i * 1024 * 1024; }
    else if (id == 38) { d.src = P.kv_w; d.N = NKVP; d.dst = WSP(bf16, WS_WKV); }
    else if (id < 43) { const int i = id - 39, kv = i >> 1, r = i & 1; d.src = P.cmp_w1 + (size_t)kv * 2048 * 256 + (size_t)r * 1024 * 256; d.N = 256; d.dst = WSP(bf16, WS_WC1) + (size_t)kv * 512 * 1024; d.row_off = r * 256; }
    else { const int kv = id - 43; d.src = P.cmp_w2 + (size_t)kv * 256 * 64; d.K = 256; d.N = 64; d.dst = WSP(bf16, WS_WC2) + (size_t)kv * 64 * 256; d.ldt = 256; }
    d.ldw = d.N;
}
constexpr int N_TMAT = 45;

__device__ __forceinline__ void prologue_phase(const Ptrs& P, LAS unsigned char* lds, int gw, int NGW, int wave, int lane, int tid) {
    if (blockIdx.x < 8) {
        const int kv = blockIdx.x >> 2, hb = blockIdx.x & 3; const float* pe = P.cmp_pe + kv * 2048; const float* w1 = P.cmp_w1 + (size_t)kv * 2048 * 256 + hb * 64 + lane;
        float acc = 0.f;
#pragma unroll 8
        for (int k = wave * 256; k < wave * 256 + 256; ++k) acc += pe[k] * w1[(size_t)k * 256];
        LAS float* red = (LAS float*)lds;
        red[wave * 64 + lane] = acc;
        __syncthreads();
        if (wave == 0) { float s = 0.f;
#pragma unroll
            for (int w = 0; w < 8; ++w) s += red[w * 64 + lane];
            WSP(float, WS_CBIAS)[kv * 256 + hb * 64 + lane] = s; }
        __syncthreads();
    }
    { LAS float* scr = (LAS float*)(lds + wave * 16384); int off = 0;
      for (int id = 0; id < N_TMAT; ++id) { TDesc d; get_tdesc(P, id, d);
          const int nitems = (d.K >> 6) * ((d.N + 31) >> 5);
          for (int it = (gw + NGW - (off % NGW)) % NGW; it < nitems; it += NGW) transpose_item(d.src, d.N, d.ldw, d.dst, d.ldt, d.mode, d.row_off, scr, it, lane);
          off += nitems; } }
    for (int r = gw; r < RT; r += NGW) { f16x4* xo = (f16x4*)(WSP(f16, WS_X) + (size_t)r * DM) + lane;
        const f32x4* xi = r < MP ? (const f32x4*)(P.x_prompt + (size_t)r * DM) + lane : (const f32x4*)(P.x_sample + (size_t)((r < MR ? r : MR - 1) - MP) * DM) + lane;
#pragma unroll
        for (int j = 0; j < 4; ++j) { f32x4 v = xi[64 * j]; if (r >= MR) v = (f32x4){0.f, 0.f, 0.f, 0.f}; xo[64 * j] = __builtin_convertvector(v, f16x4); } }
    for (int r = gw; r < 256; r += NGW) { const float* ci = r < 2 ? P.c_prompt + (size_t)r * DM : P.c_sample + (size_t)((r < 130 ? r : 129) - 2) * DM;
#pragma unroll
        for (int j = 0; j < 4; ++j) { const int c = 4 * lane + 256 * j; f32x4 v = *(const f32x4*)(ci + c); v2u w; w.x = pk2(silu_f(v[0]), silu_f(v[1])); w.y = pk2(silu_f(v[2]), silu_f(v[3])); if (r >= 130) { w.x = 0u; w.y = 0u; }
            *(v2u*)(WSP(bf16, WS_SC) + (size_t)r * DM + c) = w; } }
    for (int it0 = gw * 8; it0 < MS * PAST; it0 += NGW * 8) { const int bs = it0 >> 11, pos0 = it0 & (PAST - 1); const int page = P.page_table[bs * NPAGES + (pos0 >> 7)];
        const float* src = P.cache_kv + ((size_t)page * 128 + (pos0 & 127)) * 1024 + 8 * lane;
        f32x4 a[8], b[8];
#pragma unroll
        for (int q = 0; q < 8; ++q) { a[q] = __builtin_nontemporal_load((const f32x4*)(src + (size_t)q * 1024)); b[q] = __builtin_nontemporal_load((const f32x4*)(src + (size_t)q * 1024 + 4)); }
        const int slot = lane >> 5, g = (lane >> 3) & 3, d0 = (lane & 7) * 8;
        bf16* dst = WSP(bf16, WS_ACMP) + (size_t)slot * 65536 * 1024 + ((size_t)(bs * 4 + g) * 128 + (pos0 >> 4)) * 1024 + (pos0 & 15) * 64 + d0;
#pragma unroll
        for (int q = 0; q < 8; ++q) *(v4u*)(dst + q * 64) = pack8(a[q], b[q]); }
    for (int i = gw * 64 + lane; i < 13 * DM; i += NGW * 64) WSP(float, WS_NG)[i] = i < 12 * DM ? P.norm_g[i] : P.kv_norm_g[i - 12 * DM];
    for (int i = gw * 64 + lane; i < 2 * 8 * 128 * 128; i += NGW * 64) { const int t = (i >> 7) & 127, s = i & 127; WSP(bf16, WS_WSP)[i] = (bf16)(pk2(s <= t ? P.w_sp[i] : 0.f, 0.f) & 0xffffu); }
    for (int it = gw; it < MS * 64; it += NGW) { const int bs = it >> 6, j0 = (it & 63) * 8;
        const float* src = P.state_win + ((size_t)bs * 512 + j0 + 1) * 512 + 4 * lane; float* dst = P.out + OWIN_S + ((size_t)bs * 512 + j0) * 512 + 4 * lane;
        f32x4 v[16];
#pragma unroll
        for (int q = 0; q < 16; ++q) { const int j = j0 + (q >> 1); v[q] = (j < 511) ? __builtin_nontemporal_load((const f32x4*)(src + (size_t)(q >> 1) * 512 + (q & 1) * 256)) : (f32x4){0.f, 0.f, 0.f, 0.f}; }
#pragma unroll
        for (int q = 0; q < 16; ++q) { const int j = j0 + (q >> 1); if (j < 511) __builtin_nontemporal_store(v[q], (f32x4*)(dst + (size_t)(q >> 1) * 512 + (q & 1) * 256)); } }
}

__device__ __forceinline__ void load_cbias_lds(const float* cb, LAS unsigned char* lds, int tid) {
    __syncthreads();
    if (tid < 128) *(LAS f32x4*)(lds + tid * 16) = *(const f32x4*)(cb + tid * 4);
    __syncthreads();
}
template <int MODE>
__device__ __forceinline__ void cmp_finish_unit(const bf16* T, const LAS float* cbias, const bf16* W2T, void* outp, int C, int bg, int rt, int lane) {
    const int fr = lane & 15, fq = lane >> 4, NB = C - 1, i0 = 16 * rt;
    const int ib = i0 + fr, ic = ib < NB ? ib : NB - 1;
    const bf16* ta = T + ((size_t)bg * C + ic) * 512 + 8 * fq; const bf16* tb = ta + 512 + 256;
    v4u ra[8], rb[8];
#pragma unroll
    for (int ks = 0; ks < 8; ++ks) { ra[ks] = *(const v4u*)(ta + 32 * ks); rb[ks] = *(const v4u*)(tb + 32 * ks); }
    asm volatile("" ::: "memory");
    bf16x8 hf[8];
#pragma unroll
    for (int ks = 0; ks < 8; ++ks) { float a[8], b[8]; unpack8(ra[ks], a); unpack8(rb[ks], b);
        const f32x4 c0 = *(const LAS f32x4*)(cbias + 32 * ks + 8 * fq), c1 = *(const LAS f32x4*)(cbias + 32 * ks + 8 * fq + 4);
        f32x4 h0, h1;
#pragma unroll
        for (int e = 0; e < 4; ++e) { h0[e] = gelu_tanh_f(c0[e] + a[e] + b[e]); h1[e] = gelu_tanh_f(c1[e] + a[e + 4] + b[e + 4]); }
        const v4u w = pack8(h0, h1); hf[ks] = __builtin_bit_cast(bf16x8, w); }
    f32x4 acc[4];
#pragma unroll
    for (int np = 0; np < 2; ++np) {
        bf16x8 wf[2][8];
#pragma unroll
        for (int n2 = 0; n2 < 2; ++n2)
#pragma unroll
            for (int ks = 0; ks < 8; ++ks) wf[n2][ks] = *(const bf16x8*)(W2T + (size_t)(16 * (2 * np + n2) + fr) * 256 + 32 * ks + 8 * fq);
        asm volatile("" ::: "memory");
#pragma unroll
        for (int n2 = 0; n2 < 2; ++n2) { const int nt = 2 * np + n2; acc[nt] = (f32x4){0.f, 0.f, 0.f, 0.f};
#pragma unroll
            for (int ks = 0; ks < 8; ++ks) {
                if (MODE == 1) acc[nt] = __builtin_amdgcn_mfma_f32_16x16x32_bf16(hf[ks], wf[n2][ks], acc[nt], 0, 0, 0);
                else acc[nt] = __builtin_amdgcn_mfma_f32_16x16x32_bf16(wf[n2][ks], hf[ks], acc[nt], 0, 0, 0); } }
    }
#pragma unroll
    for (int nt = 0; nt < 4; ++nt) {
        if (MODE == 0) { f32x4 v = acc[nt]; if (ib >= NB) v = (f32x4){0.f, 0.f, 0.f, 0.f}; v2u w; w.x = pk2(v[0], v[1]); w.y = pk2(v[2], v[3]);
            *(v2u*)((bf16*)outp + ((size_t)bg * 512 + ib) * 64 + 16 * nt + 4 * fq) = w; }
        else if (MODE == 1) { f32x4 v = acc[nt];
#pragma unroll
            for (int e = 0; e < 4; ++e) if (i0 + 4 * fq + e >= NB) v[e] = 0.f;
            v2u w; w.x = pk2(v[0], v[1]); w.y = pk2(v[2], v[3]);
            *(v2u*)((bf16*)outp + (((size_t)bg * 16 + (i0 >> 5)) * 64 + 16 * nt + fr) * 32 + (i0 & 31) + 4 * fq) = w; }
        else { f32x4 v = acc[nt]; if (ib >= NB) v = (f32x4){0.f, 0.f, 0.f, 0.f};
            *(f32x4*)((float*)outp + ((size_t)bg * 128 + ib) * 64 + 16 * nt + 4 * fq) = v; }
    }
}

struct SpRegs { f32x4 st; v4u za[2], zb[2]; bf16x8 wf[4]; v4u uv[4]; float bt; };
__device__ __forceinline__ void sp_load(SpRegs& R, const Ptrs& P, int l, int u, int wave, int lane) {
    const bf16* Z = WSP(bf16, WS_Z); const bf16* WS = WSP(bf16, WS_WSP); const float* VS = WSP(float, WS_CTL) + CW_VS + (size_t)l * RT * 2;
    const int fr = lane & 15, fq = lane >> 4, nks = (wave >> 1) + 1, n = u / 24, cb = u - n * 24, g = cb / 3;
    R.st = *(const f32x4*)(VS + 2 * (n * 128 + 2 * lane));
#pragma unroll
    for (int q = 0; q < 2; ++q) { const int cc = cb * 128 + 8 * (wave + 8 * q); const bf16* z0 = Z + (size_t)(n * 128 + 2 * lane) * 6144 + DV + cc; R.za[q] = *(const v4u*)z0; R.zb[q] = *(const v4u*)(z0 + 6144); }
    const bf16* wp = WS + ((size_t)(l * 8 + g) * 128 + 16 * wave + fr) * 128 + 8 * fq;
#pragma unroll
    for (int ks = 0; ks < 4; ++ks) R.wf[ks] = *(const bf16x8*)(wp + 32 * (ks < nks ? ks : 0));
    const int t = 16 * wave + fr, row = n * 128 + t; R.bt = P.b_sp[(l * 8 + g) * 128 + t];
#pragma unroll
    for (int mm = 0; mm < 4; ++mm) R.uv[mm] = *(const v4u*)(Z + (size_t)row * 6144 + cb * 128 + 32 * mm + 8 * fq);
}
__device__ __forceinline__ void sp_compute(const SpRegs& R, const Ptrs& P, int l, int u, LAS unsigned* tile, int wave, int lane) {
    bf16* PO = WSP(bf16, WS_P); const float* lg = P.ln_g + l * DV; const float* lb = P.ln_b + l * DV;
    const int fr = lane & 15, fq = lane >> 4, nks = (wave >> 1) + 1, n = u / 24, cb = u - n * 24;
    const float m0 = R.st[0] * (1.0f / DV), m1 = R.st[2] * (1.0f / DV); float v0 = R.st[1] * (1.0f / DV) - m0 * m0, v1 = R.st[3] * (1.0f / DV) - m1 * m1; v0 = v0 > 0.f ? v0 : 0.f; v1 = v1 > 0.f ? v1 : 0.f;
    const float r0 = 1.0f / sqrtf(v0 + 1e-6f), r1 = 1.0f / sqrtf(v1 + 1e-6f);
#pragma unroll
    for (int q = 0; q < 2; ++q) { const int ccg = wave + 8 * q, cc = cb * 128 + 8 * ccg; float a[8], b[8]; unpack8(R.za[q], a); unpack8(R.zb[q], b);
        const f32x4 g0 = *(const f32x4*)(lg + cc), g1 = *(const f32x4*)(lg + cc + 4), b0 = *(const f32x4*)(lb + cc), b1 = *(const f32x4*)(lb + cc + 4);
#pragma unroll
        for (int e = 0; e < 8; ++e) { const float gg = e < 4 ? g0[e] : g1[e - 4], bb = e < 4 ? b0[e] : b1[e - 4];
            tile[(8 * ccg + e) * 68 + lane] = pk2((a[e] - m0) * r0 * gg + bb, (b[e] - m1) * r1 * gg + bb); } }
    __syncthreads();
    f32x4 acc[8];
#pragma unroll
    for (int j = 0; j < 8; ++j) acc[j] = (f32x4){0.f, 0.f, 0.f, 0.f};
    const LAS char* vp = (const LAS char*)tile + (8 * (fr >> 2) + (fr & 3)) * 272 + 16 * fq;
#pragma unroll
    for (int ks = 0; ks < 4; ++ks) if (ks < nks) {
#pragma unroll
        for (int j = 0; j < 8; ++j) { const bf16x8 vf = *(const LAS bf16x8*)(vp + (32 * (j >> 1) + 4 * (j & 1)) * 272 + 64 * ks);
            acc[j] = __builtin_amdgcn_mfma_f32_16x16x32_bf16(vf, R.wf[ks], acc[j], 0, 0, 0); }
    }
    const int row = n * 128 + 16 * wave + fr;
#pragma unroll
    for (int mm = 0; mm < 4; ++mm) { const int c = cb * 128 + 32 * mm + 8 * fq; float uu[8]; unpack8(R.uv[mm], uu);
        f32x4 p0, p1;
#pragma unroll
        for (int e = 0; e < 4; ++e) { p0[e] = uu[e] * (acc[2 * mm][e] + R.bt); p1[e] = uu[4 + e] * (acc[2 * mm + 1][e] + R.bt); }
        *(v4u*)(PO + (size_t)row * DV + c) = pack8(p0, p1); }
}
__device__ __forceinline__ void spatial2_phase(const Ptrs& P, int l, LAS unsigned char* lds, int wave, int lane, int tid, int gw, int NGW) {
    const bf16* Z = WSP(bf16, WS_Z);
    const float* VS = WSP(float, WS_CTL) + CW_VS + (size_t)l * RT * 2;
    const float* lg = P.ln_g + l * DV; const float* lb = P.ln_b + l * DV;
    { const int NU = 128 * 24, G_ = (int)gridDim.x; int u = (int)blockIdx.x;
      LAS unsigned* t0 = (LAS unsigned*)lds; LAS unsigned* t1 = (LAS unsigned*)(lds + 34816);
      SpRegs A, B;
      if (u < NU) sp_load(A, P, l, u, wave, lane);
      while (u < NU) {
          int un = u + G_; if (un < NU) sp_load(B, P, l, un, wave, lane);
          sp_compute(A, P, l, u, t0, wave, lane);
          u = un; if (u >= NU) break;
          un = u + G_; if (un < NU) sp_load(A, P, l, un, wave, lane);
          sp_compute(B, P, l, u, t1, wave, lane);
          u = un;
      } }
    __syncthreads();
    for (int bs = gw; bs < MS; bs += NGW) {
        const int row = MP + bs; const bf16* zr = Z + (size_t)row * 6144 + 8 * lane;
        const float mean = VS[2 * row] * (1.0f / DV); float var = VS[2 * row + 1] * (1.0f / DV) - mean * mean; var = var > 0.f ? var : 0.f; const float rstd = 1.0f / sqrtf(var + 1e-6f);
#pragma unroll
        for (int j = 0; j < 6; ++j) { const int c = 512 * j + 8 * lane, g = c / CGW;
            const float w00 = P.w_sp[(size_t)(l * 8 + g) * 128 * 128], b00 = P.b_sp[(l * 8 + g) * 128];
            const f32x4 g0 = *(const f32x4*)(lg + c), g1 = *(const f32x4*)(lg + c + 4), b0 = *(const f32x4*)(lb + c), b1 = *(const f32x4*)(lb + c + 4);
            float vv[8], uu[8]; unpack8(*(const v4u*)(zr + DV + 512 * j), vv); unpack8(*(const v4u*)(zr + 512 * j), uu);
            f32x4 o0, o1, p0, p1;
#pragma unroll
            for (int e = 0; e < 4; ++e) { o0[e] = (vv[e] - mean) * rstd * g0[e] + b0[e]; o1[e] = (vv[4 + e] - mean) * rstd * g1[e] + b1[e];
                p0[e] = uu[e] * (w00 * o0[e] + b00); p1[e] = uu[4 + e] * (w00 * o1[e] + b00); }
            float* gv = P.out + OGV + ((size_t)l * MS + bs) * DV + c; *(f32x4*)gv = o0; *(f32x4*)(gv + 4) = o1;
            *(v4u*)(WSP(bf16, WS_P) + (size_t)row * DV + c) = pack8(p0, p1); }
    }
}

#define NEG_INF (-__builtin_inff())
__device__ __forceinline__ bf16x8 ld_v2x8(const GAS bf16* p) {
    const bf16x4 lo = *(const GAS bf16x4*)p, hi = *(const GAS bf16x4*)(p + 16);
    return __builtin_shufflevector(lo, hi, 0, 1, 2, 3, 4, 5, 6, 7);
}
struct SampleAcc { float acc[4][8]; float m, l; };
__device__ __forceinline__ float sample_compute(const f32x4 k0, const f32x4 k1, const f32x4 v0, const f32x4 v1, bool valid, float dist, const float (&qv)[4][8], float slope2_own, int lane, SampleAcc& A) {
    const int j8 = lane & 7;
    float part[4];
#pragma unroll
    for (int h = 0; h < 4; ++h) { float a = (qv[h][0] * k0[0] + qv[h][1] * k0[1]) + (qv[h][2] * k0[2] + qv[h][3] * k0[3]) + (qv[h][4] * k1[0] + qv[h][5] * k1[1]) + (qv[h][6] * k1[2] + qv[h][7] * k1[3]);
        a += dppf<DPP_X1>(a); a += dppf<DPP_X2>(a); a += dppf<DPP_HM>(a); part[h] = a; }
    const int hown = j8 & 3;
    const float sown = hown == 0 ? part[0] : hown == 1 ? part[1] : hown == 2 ? part[2] : part[3];
    const float s2 = valid ? (sown - slope2_own * dist) : NEG_INF;
    float tm = fmaxf(s2, dppf<DPP_X8>(s2)); tm = xmax_16_32(tm);
    const float mnew = fmaxf(A.m, tm), msafe = (mnew == NEG_INF) ? 0.f : mnew, alpha = fexp2(A.m - msafe), p = fexp2(s2 - msafe);
    A.m = mnew; A.l = A.l * alpha + p;
    const float ph[4] = {dppf<0x00>(p), dppf<0x55>(p), dppf<0xAA>(p), dppf<0xFF>(p)}, ah[4] = {dppf<0x00>(alpha), dppf<0x55>(alpha), dppf<0xAA>(alpha), dppf<0xFF>(alpha)};
#pragma unroll
    for (int h = 0; h < 4; ++h)
#pragma unroll
        for (int e = 0; e < 4; ++e) { A.acc[h][e] = A.acc[h][e] * ah[h] + ph[h] * v0[e]; A.acc[h][4 + e] = A.acc[h][4 + e] * ah[h] + ph[h] * v1[e]; }
    return s2;
}
__device__ __forceinline__ float sample_step8(const float* krow, const float* vrow, bool valid, float dist, const float (&qv)[4][8], float slope2_own, int lane, SampleAcc& A) {
    const int j8 = lane & 7;
    const f32x4 k0 = *(const f32x4*)(krow + 8 * j8), k1 = *(const f32x4*)(krow + 8 * j8 + 4), v0 = *(const f32x4*)(vrow + 8 * j8), v1 = *(const f32x4*)(vrow + 8 * j8 + 4);
    return sample_compute(k0, k1, v0, v1, valid, dist, qv, slope2_own, lane, A);
}
__device__ __forceinline__ void sample_batch4(const float* kbase, const float* vbase, int rstride, int r0, int rlimit, int rclamp, float dist0, float ddist,
                                              const float (&qv)[4][8], float slope2_own, int lane, SampleAcc& A, LAS float* sraw) {
    const int j8 = lane & 7;
    f32x4 kk[4][2], vv[4][2];
#pragma unroll
    for (int s = 0; s < 4; ++s) { int r = r0 + 8 * s; r = r < rlimit ? r : rclamp; const float* kr = kbase + (size_t)r * rstride + 8 * j8; const float* vr = vbase + (size_t)r * rstride + 8 * j8;
        kk[s][0] = *(const f32x4*)kr; kk[s][1] = *(const f32x4*)(kr + 4); vv[s][0] = *(const f32x4*)vr; vv[s][1] = *(const f32x4*)(vr + 4); }
#pragma unroll
    for (int s = 0; s < 4; ++s) { const float s2 = sample_compute(kk[s][0], kk[s][1], vv[s][0], vv[s][1], r0 + 8 * s < rlimit, dist0 - ddist * (float)s, qv, slope2_own, lane, A);
        if (sraw) sraw[s * 64 + lane] = s2; }
}
__device__ __forceinline__ void sample_reset(SampleAcc& A) {
    A.m = NEG_INF; A.l = 0.f;
#pragma unroll
    for (int h = 0; h < 4; ++h)
#pragma unroll
        for (int i = 0; i < 8; ++i) A.acc[h][i] = 0.f;
}
__device__ __forceinline__ void sample_finish(SampleAcc& A, const float* gates_bg, int br, LAS float* wl, int lane, bool first) {
    float lt = A.l; lt += dppf<DPP_X8>(lt); lt = xsum_16_32(lt);
    float sc[4];
#pragma unroll
    for (int h = 0; h < 4; ++h) { const float lh = __shfl(lt, h); sc[h] = lh > 0.f ? gates_bg[h * 3 + br] / lh : 0.f; }
#pragma unroll
    for (int h = 0; h < 4; ++h)
#pragma unroll
        for (int i = 0; i < 8; ++i) { float a = A.acc[h][i]; a += dppf<DPP_X8>(a); a = xsum_16_32(a); A.acc[h][i] = a * sc[h]; }
    if (lane < 8) {
#pragma unroll
        for (int h = 0; h < 4; ++h)
#pragma unroll
            for (int i = 0; i < 8; ++i) { LAS float* p = wl + h * 64 + 8 * lane + i; *p = first ? A.acc[h][i] : (*p + A.acc[h][i]); }
    }
}
__device__ __forceinline__ void attn_sample_unit(const Ptrs& P, int bs, int g, LAS float* wl, int lane_in) {
    int lane = lane_in; asm volatile("" : "+v"(lane));
    const int kq = lane >> 3, j8 = lane & 7, row = MP + bs;
    const bf16* Q = WSP(bf16, WS_Q) + (size_t)row * DM + (4 * g) * 64; const float* GT = WSP(float, WS_GATES) + (size_t)row * 48 + g * 12;
    float qv[4][8];
#pragma unroll
    for (int h = 0; h < 4; ++h) unpack8(*(const v4u*)(Q + h * 64 + 8 * j8), qv[h]);
    const float slope2_own = fexp2(-0.5f * (float)(4 * g + (j8 & 3) + 1)) * LOG2E;
    SampleAcc A;
    LAS float* pimp = wl + 256;
    LAS float* sraw = wl + 512;
    const float* KCS = WSP(float, WS_KCS) + (size_t)(bs * 4 + g) * 128 * 64; const float* VCS = WSP(float, WS_VCS) + (size_t)(bs * 4 + g) * 128 * 64;
    sample_reset(A);
#pragma unroll 1
    for (int bt = 0; bt < 4; ++bt) sample_batch4(KCS, VCS, 64, 32 * bt + kq, 127, 126, (float)(PAST - (16 * (32 * bt + kq) + 31)), 128.f, qv, slope2_own, lane, A, sraw + bt * 256);
    { float lt = A.l; lt += dppf<DPP_X8>(lt); lt = xsum_16_32(lt);
      const float il = lt > 0.f ? 1.0f / lt : 0.f, mm = A.m == NEG_INF ? 0.f : A.m;
#pragma unroll 1
      for (int it = 0; it < 16; ++it) { float p = fexp2(sraw[it * 64 + lane] - mm) * il; p += dppf<DPP_X1>(p); p += dppf<DPP_X2>(p); if (j8 == 0) pimp[8 * it + kq] = p; } }
    sample_finish(A, GT, 0, wl, lane, true);
    unsigned long long selmask;
    { float v = -1.f;
      if (lane < 33) { float sacc = 0.f;
#pragma unroll
          for (int e = -1; e < 4; ++e) { const int n = 4 * lane + e; if (n >= 0 && n < 127) sacc += pimp[n]; }
          v = (lane == 0 || lane >= 31) ? sacc + 1e4f : sacc; }
      int rank = 0;
#pragma unroll 1
      for (int i = 0; i < 33; ++i) { const float vi = __builtin_bit_cast(float, __builtin_amdgcn_readlane(__builtin_bit_cast(int, v), i)); rank += (vi > v || (vi == v && i < lane)) ? 1 : 0; }
      selmask = __ballot(lane < 33 && rank < 16); }
    sample_reset(A);
#pragma unroll 1
    for (int j = 0; j < 32; ++j) {
        if (!((selmask >> j) & 1ull)) continue;
        const int page = P.page_table[bs * NPAGES + (j >> 1)];
        const float* kb = P.cache_kv + ((size_t)page * 128 * 4 + 2) * 256 + g * 64;
#pragma unroll 1
        for (int bb = 0; bb < 2; ++bb) { const int r0 = ((64 * j) & 127) + 32 * bb + kq;
            sample_batch4(kb, kb + 256, 1024, r0, 1 << 30, 0, (float)(PAST - (64 * j + 32 * bb + kq)), 8.f, qv, slope2_own, lane, A, nullptr); }
    }
    { const float* kr = P.out + OKV_S + ((size_t)bs * 4 + 2) * 256 + g * 64;
      (void)sample_step8(kr, kr + 256, kq == 0, 0.f, qv, slope2_own, lane, A); }
    sample_finish(A, GT, 1, wl, lane, false);
    sample_reset(A);
    { const float* kb = P.state_win + (size_t)bs * 512 * 512 + g * 64;
#pragma unroll 1
      for (int bt = 0; bt < 16; ++bt) sample_batch4(kb, kb + 256, 512, 32 * bt + kq, 1 << 30, 0, (float)(512 - (32 * bt + kq)), 8.f, qv, slope2_own, lane, A, nullptr); }
    { const float* kr = P.out + OWIN_S + ((size_t)bs * 512 + 511) * 512 + g * 64;
      (void)sample_step8(kr, kr + 256, kq == 0, 0.f, qv, slope2_own, lane, A); }
    sample_finish(A, GT, 2, wl, lane, false);
    { const f32x4 v = *(const LAS f32x4*)(wl + 4 * lane); v2u w; w.x = pk2(v[0], v[1]); w.y = pk2(v[2], v[3]);
      *(v2u*)(WSP(bf16, WS_O) + (size_t)row * DM + 256 * g + 4 * lane) = w; }
}

__device__ __forceinline__ void ldK(bf16x8 (&kf)[2][2], const GAS bf16* Kp, int k0, unsigned koff) {
#pragma unroll
    for (int kt = 0; kt < 2; ++kt)
#pragma unroll
        for (int ks = 0; ks < 2; ++ks) kf[kt][ks] = *(const GAS bf16x8*)((const GAS char*)(Kp + (size_t)k0 * 64 + kt * 256 + ks * 32) + koff);
}
__device__ __forceinline__ void ldV(bf16x8 (&vf)[4], const GAS bf16* Vp, int VP, int k0, unsigned voff) {
#pragma unroll
    for (int dt = 0; dt < 4; ++dt) vf[dt] = *(const GAS bf16x8*)((const GAS char*)(Vp + (size_t)(k0 >> 5) * 2048 + dt * 512) + voff);
}
template <int MODE, int GEN, int NXT>
__device__ __forceinline__ void att_run(bf16x8 (&kf)[2][2], bf16x8 (&vf)[4], const GAS bf16* Kp, const GAS bf16* Vp, const GAS bf16* Kn, const GAS bf16* Vn, int k0x,
                                        int VP, unsigned koff, unsigned voff, int n, int base, const LAS int* list,
                                        int KA, int KB, int W, unsigned M0, unsigned M1, unsigned M2, unsigned M3, int t, int fr, int fq, int lane,
                                        LAS float* wl, const float (&slope2)[4], f32x4 (&o)[4][4], float (&m)[4], float (&l)[4]) {
    if (n <= 0) { if (NXT) { ldK(kf, Kn, k0x, koff); ldV(vf, Vn, VP, k0x, voff); } return; }
    int k0 = GEN == 0 ? 0 : (GEN == 1 ? base : list[0]);
    float carry = 0.f;
#pragma unroll 1
    for (int i = 0; i < n; ++i) {
        const bool last = i + 1 >= n;
        const int inx = last ? i : i + 1;
        const int k0n = (NXT && last) ? k0x : (GEN == 0 ? 32 * inx : (GEN == 1 ? base - 32 * inx : list[inx]));
        const GAS bf16* Kq = (NXT && last) ? Kn : Kp; const GAS bf16* Vq = (NXT && last) ? Vn : Vp;
        f32x4 s[2][4];
        {
            unsigned qa = (unsigned)lane * 16u; asm volatile("" : "+v"(qa));
            const LAS char* qb = (const LAS char*)wl + qa;
#pragma unroll
            for (int h = 0; h < 4; ++h) {
                const bf16x8 q0 = *(const LAS bf16x8*)(qb + (h * 2 + 0) * 1024), q1 = *(const LAS bf16x8*)(qb + (h * 2 + 1) * 1024);
#pragma unroll
                for (int kt = 0; kt < 2; ++kt) { f32x4 a = (f32x4){0.f, 0.f, 0.f, 0.f};
                    a = __builtin_amdgcn_mfma_f32_16x16x32_bf16(kf[kt][0], q0, a, 0, 0, 0);
                    a = __builtin_amdgcn_mfma_f32_16x16x32_bf16(kf[kt][1], q1, a, 0, 0, 0); s[kt][h] = a; }
            }
        }
        if (NXT || !last) ldK(kf, Kq, k0n, koff);
        bool extra = true;
        if (GEN == 2) { const int j = k0 >> 6, f = j & 3; const unsigned Mw = f == 0 ? M0 : f == 1 ? M1 : f == 2 ? M2 : M3; extra = (Mw >> (j >> 2)) & 1u; }
        f32x2 dp[2][2];
#pragma unroll
        for (int kt = 0; kt < 2; ++kt)
#pragma unroll
            for (int e = 0; e < 4; ++e) { const int nn = k0 + 8 * fq + 4 * kt + e, d = t - (KA * nn + KB); const float dv = (extra && (unsigned)d <= (unsigned)W) ? (float)d : __builtin_inff();
                if (e & 1) dp[kt][e >> 1].y = dv; else dp[kt][e >> 1].x = dv; }
        f32x2 sp[2][4][2];
#pragma unroll
        for (int h = 0; h < 4; ++h)
#pragma unroll
            for (int kt = 0; kt < 2; ++kt) { const f32x2 nsl = (f32x2){-slope2[h], -slope2[h]};
                sp[kt][h][0] = (f32x2){s[kt][h][0], s[kt][h][1]} + dp[kt][0] * nsl; sp[kt][h][1] = (f32x2){s[kt][h][2], s[kt][h][3]} + dp[kt][1] * nsl; }
        if (MODE == 2) {
#pragma unroll
            for (int h = 0; h < 4; ++h) { const f32x2 mm = (f32x2){m[h], m[h]}, ll = (f32x2){l[h], l[h]};
#pragma unroll
                for (int kt = 0; kt < 2; ++kt)
#pragma unroll
                    for (int pr = 0; pr < 2; ++pr) { const f32x2 a = sp[kt][h][pr] - mm; f32x2 p; p.x = fexp2(a.x); p.y = fexp2(a.y); sp[kt][h][pr] = p * ll; } }
            f32x2 as0[2], as1[2];
#pragma unroll
            for (int pr = 0; pr < 2; ++pr) { as0[pr] = (sp[0][0][pr] + sp[0][1][pr]) + (sp[0][2][pr] + sp[0][3][pr]); as1[pr] = (sp[1][0][pr] + sp[1][1][pr]) + (sp[1][2][pr] + sp[1][3][pr]); }
            const float r1 = __shfl(as1[1].y, (lane + 48) & 63);
            const float y0 = fq > 0 ? r1 : carry, y1 = as0[1].y; carry = r1;
            wl[2048 + fr * 128 + 8 * i + 2 * fq]     = ((as0[0].x + as0[0].y) + (as0[1].x + as0[1].y)) + y0;
            wl[2048 + fr * 128 + 8 * i + 2 * fq + 1] = ((as1[0].x + as1[0].y) + (as1[1].x + as1[1].y)) + y1;
        } else {
            float tl[4]; bool grow = false;
#pragma unroll
            for (int h = 0; h < 4; ++h) {
                const f32x2 mx = __builtin_elementwise_max(__builtin_elementwise_max(sp[0][h][0], sp[0][h][1]), __builtin_elementwise_max(sp[1][h][0], sp[1][h][1]));
                tl[h] = fmaxf(mx.x, mx.y); grow = grow || (tl[h] > m[h] + 8.0f);
            }
            if (__any(grow)) {
#pragma unroll
                for (int h = 0; h < 4; ++h) { const float tm = xmax_16_32(tl[h]);
                    const float mn = fmaxf(m[h], tm), ms = (mn == NEG_INF) ? 0.f : mn, alpha = fexp2(m[h] - ms); l[h] *= alpha; m[h] = mn;
                    if (MODE == 0) {
#pragma unroll
                        for (int dt = 0; dt < 4; ++dt) o[dt][h] = o[dt][h] * alpha; } }
            }
#pragma unroll
            for (int h = 0; h < 4; ++h) { const float ms = (m[h] == NEG_INF) ? 0.f : m[h]; const f32x2 mm = (f32x2){ms, ms}; f32x2 ps = (f32x2){0.f, 0.f};
#pragma unroll
                for (int kt = 0; kt < 2; ++kt)
#pragma unroll
                    for (int pr = 0; pr < 2; ++pr) { const f32x2 a = sp[kt][h][pr] - mm; f32x2 p; p.x = fexp2(a.x); p.y = fexp2(a.y); sp[kt][h][pr] = p; ps = ps + p; }
                l[h] += ps.x + ps.y; }
        }
#pragma unroll
        for (int h = 0; h < 4; ++h)
#pragma unroll
            for (int kt = 0; kt < 2; ++kt) s[kt][h] = (f32x4){sp[kt][h][0].x, sp[kt][h][0].y, sp[kt][h][1].x, sp[kt][h][1].y};
        if (MODE != 1) {
            bf16x8 pf[4];
#pragma unroll
            for (int h = 0; h < 4; ++h) { const v4u w = pack8(s[0][h], s[1][h]); pf[h] = __builtin_bit_cast(bf16x8, w); }
#pragma unroll
            for (int dt = 0; dt < 4; ++dt)
#pragma unroll
                for (int h = 0; h < 4; ++h) o[dt][h] = __builtin_amdgcn_mfma_f32_16x16x32_bf16(vf[dt], pf[h], o[dt][h], 0, 0, 0);
            if (NXT || !last) ldV(vf, Vq, VP, k0n, voff);
        } else if (NXT && last) ldV(vf, Vq, VP, k0n, voff);
        k0 = k0n;
    }
}
#if defined(PROBE_MODE) && PROBE_MODE == 4
#define SEC_ON(s) (PROBE_A == (s) && (int)blockIdx.x == PROBE_BLK && threadIdx.x == 0)
#define SEC_T0(s) do { if (SEC_ON(s)) { volatile LAS unsigned* pm_ = (volatile LAS unsigned*)(unsigned)MISC_OFF; pm_[17] = (unsigned)__builtin_amdgcn_s_memrealtime(); } } while (0)
#define SEC_T1(s) do { if (SEC_ON(s)) { volatile LAS unsigned* pm_ = (volatile LAS unsigned*)(unsigned)MISC_OFF; pm_[16] = pm_[16] + ((unsigned)__builtin_amdgcn_s_memrealtime() - pm_[17]); } } while (0)
#define SEC_CNT(s, n) do { if (SEC_ON(s)) { volatile LAS unsigned* pm_ = (volatile LAS unsigned*)(unsigned)MISC_OFF; pm_[16] = pm_[16] + (unsigned)(n); } } while (0)
#else
#define SEC_T0(s) do { } while (0)
#define SEC_T1(s) do { } while (0)
#define SEC_CNT(s, n) do { } while (0)
#endif
__device__ __forceinline__ void attn_prompt_unit2(const Ptrs& P, int bg, int tt, LAS float* wl, int lane_in) {
    int lane = lane_in; asm volatile("" : "+v"(lane));
    const int fr = lane & 15, fq = lane >> 4, b = bg >> 2, g = bg & 3, t0 = 16 * tt, t = t0 + fr, row = b * SEQ + t;
    const float* GT = WSP(float, WS_GATES) + (size_t)row * 48 + g * 12;
    const GAS bf16* KC = (const GAS bf16*)WSP(bf16, WS_KC) + (size_t)bg * 512 * 64; const GAS bf16* VCT = (const GAS bf16*)WSP(bf16, WS_VCT) + (size_t)bg * 64 * 512;
    const GAS bf16* SK = (const GAS bf16*)WSP(bf16, WS_SK) + (size_t)bg * SEQ * 64; const GAS bf16* SVT = (const GAS bf16*)WSP(bf16, WS_SVT) + (size_t)bg * 64 * SEQ;
    const GAS bf16* WK = (const GAS bf16*)WSP(bf16, WS_WK) + (size_t)bg * SEQ * 64; const GAS bf16* WVT = (const GAS bf16*)WSP(bf16, WS_WVT) + (size_t)bg * 64 * SEQ;
    GAS float* OA = (GAS float*)WSP(float, WS_OACC) + (size_t)row * DM + 256 * g + 4 * fq;
    const unsigned koff = (unsigned)((8 * (fr >> 2) + (fr & 3)) * 64 + 8 * fq) * 2u, voffc = (unsigned)(fr * 32 + 8 * fq) * 2u, voffs = voffc;
    bf16x8 kf[2][2], vf[4];
    ldK(kf, KC, 0, koff);
    float slope2[4];
    { const GAS bf16* Q = (const GAS bf16*)WSP(bf16, WS_Q) + (size_t)row * DM + (4 * g) * 64 + 8 * fq;
#pragma unroll
      for (int h = 0; h < 4; ++h) { slope2[h] = fexp2(-0.5f * (float)(4 * g + h + 1)) * LOG2E;
#pragma unroll
          for (int ks = 0; ks < 2; ++ks) *(LAS v4u*)((LAS char*)wl + (h * 2 + ks) * 1024 + lane * 16) = *(const GAS v4u*)(Q + h * 64 + 32 * ks); } }
    f32x4 o[4][4]; float m[4], l[4];
    const int BIG = 1 << 30;
    const int nst = (tt >> 5) + 1;
    SEC_T0(1);
#pragma unroll
    for (int h = 0; h < 4; ++h) { m[h] = NEG_INF; l[h] = 0.f; }
    att_run<1, 0, 1>(kf, vf, KC, VCT, KC, VCT, 0, 512, koff, voffc, nst, 0, nullptr, 16, 31, BIG, 0u, 0u, 0u, 0u, t, fr, fq, lane, wl, slope2, o, m, l);
#pragma unroll
    for (int h = 0; h < 4; ++h) { const float lt = xsum_16_32(l[h]); l[h] = lt > 0.f ? 1.0f / lt : 0.f; if (m[h] == NEG_INF) m[h] = 0.f;
#pragma unroll
        for (int dt = 0; dt < 4; ++dt) o[dt][h] = (f32x4){0.f, 0.f, 0.f, 0.f}; }
    att_run<2, 0, 1>(kf, vf, KC, VCT, SK, SVT, 64 * (t0 >> 6) + 32, 512, koff, voffc, nst, 0, nullptr, 16, 31, BIG, 0u, 0u, 0u, 0u, t, fr, fq, lane, wl, slope2, o, m, l);
#pragma unroll
    for (int h = 0; h < 4; ++h) { const float gc = GT[h * 3 + 0];
#pragma unroll
        for (int dt = 0; dt < 4; ++dt) *(GAS f32x4*)(OA + h * 64 + 16 * dt) = o[dt][h] * gc; }
    SEC_T1(1);
    SEC_T0(2);
    const int qblk = t0 >> 6;
    unsigned M0, M1, M2, M3;
    {
        float cv[32];
#pragma unroll
        for (int q = 0; q < 32; ++q) { const int j = 4 * q + fq; const float x = wl[2048 + fr * 128 + j];
            const bool forced = (j == 0) | (j == qblk) | (j == qblk - 1); cv[q] = (j <= qblk) ? (forced ? x + 1e4f : x) : -1.f; }
        unsigned mask = 0u;
#pragma unroll 1
        for (int r = 0; r < 16; ++r) {
            float bv = cv[0]; int bq = 0;
#pragma unroll
            for (int q = 1; q < 32; ++q) if (cv[q] > bv) { bv = cv[q]; bq = q; }
            int bj = 4 * bq + fq;
            { float va, vb; int ia, ib; xpair16(bv, va, vb); xpair16i(bj, ia, ib); const bool tb = vb > va || (vb == va && ib < ia); bv = tb ? vb : va; bj = tb ? ib : ia; }
            { float va, vb; int ia, ib; xpair32(bv, va, vb); xpair32i(bj, ia, ib); const bool tb = vb > va || (vb == va && ib < ia); bv = tb ? vb : va; bj = tb ? ib : ia; }
            const bool mine = (bv >= 0.f) && ((bj & 3) == fq); const int wq = bj >> 2;
#pragma unroll
            for (int q = 0; q < 32; ++q) if (mine && q == wq) cv[q] = -2.f;
            if (mine) mask |= 1u << wq;
        }
        M0 = __shfl(mask, fr); M1 = __shfl(mask, fr + 16); M2 = __shfl(mask, fr + 32); M3 = __shfl(mask, fr + 48);
    }
    int nlist = 0;
    {
        unsigned U0 = M0, U1 = M1, U2 = M2, U3 = M3;
        U0 |= dppu<DPP_X1>(U0); U1 |= dppu<DPP_X1>(U1); U2 |= dppu<DPP_X1>(U2); U3 |= dppu<DPP_X1>(U3);
        U0 |= dppu<DPP_X2>(U0); U1 |= dppu<DPP_X2>(U1); U2 |= dppu<DPP_X2>(U2); U3 |= dppu<DPP_X2>(U3);
        U0 |= dppu<DPP_HM>(U0); U1 |= dppu<DPP_HM>(U1); U2 |= dppu<DPP_HM>(U2); U3 |= dppu<DPP_HM>(U3);
        U0 |= dppu<DPP_RM>(U0); U1 |= dppu<DPP_RM>(U1); U2 |= dppu<DPP_RM>(U2); U3 |= dppu<DPP_RM>(U3);
        U0 = __builtin_amdgcn_readfirstlane(U0); U1 = __builtin_amdgcn_readfirstlane(U1); U2 = __builtin_amdgcn_readfirstlane(U2); U3 = __builtin_amdgcn_readfirstlane(U3);
        LAS int* lst = (LAS int*)(wl + 2048);
#pragma unroll 1
        for (int j = qblk; j >= 0; --j) { const int f = j & 3; const unsigned Uw = f == 0 ? U0 : f == 1 ? U1 : f == 2 ? U2 : U3;
            if ((Uw >> (j >> 2)) & 1u) { if (lane == 0) { lst[nlist] = 64 * j + 32; lst[nlist + 1] = 64 * j; } nlist += 2; } }
    }
    SEC_T1(2); SEC_CNT(5, nlist); SEC_T0(3);
#pragma unroll
    for (int h = 0; h < 4; ++h) { m[h] = NEG_INF; l[h] = 0.f;
#pragma unroll
        for (int dt = 0; dt < 4; ++dt) o[dt][h] = (f32x4){0.f, 0.f, 0.f, 0.f}; }
    att_run<0, 2, 1>(kf, vf, SK, SVT, WK, WVT, t0 & ~31, SEQ, koff, voffs, nlist, 0, (const LAS int*)(wl + 2048), 1, 0, BIG, M0, M1, M2, M3, t, fr, fq, lane, wl, slope2, o, m, l);
    asm volatile("s_waitcnt vmcnt(0)" ::: "memory");
#pragma unroll
    for (int h = 0; h < 4; ++h) { const float lt = xsum_16_32(l[h]); const float sc = lt > 0.f ? GT[h * 3 + 1] / lt : 0.f;
#pragma unroll
        for (int dt = 0; dt < 4; ++dt) { GAS f32x4* p = (GAS f32x4*)(OA + h * 64 + 16 * dt); *p = *p + o[dt][h] * sc; } }
    SEC_T1(3); SEC_T0(4);
#pragma unroll
    for (int h = 0; h < 4; ++h) { m[h] = NEG_INF; l[h] = 0.f;
#pragma unroll
        for (int dt = 0; dt < 4; ++dt) o[dt][h] = (f32x4){0.f, 0.f, 0.f, 0.f}; }
    { const int kend = (t0 > 512 ? (t0 - 512) : 0) & ~31, ktop = t0 & ~31;
      att_run<0, 1, 0>(kf, vf, WK, WVT, WK, WVT, 0, SEQ, koff, voffs, ((ktop - kend) >> 5) + 1, ktop, nullptr, 1, 0, 512, 0u, 0u, 0u, 0u, t, fr, fq, lane, wl, slope2, o, m, l); }
    asm volatile("s_waitcnt vmcnt(0)" ::: "memory");
    GAS bf16* O = (GAS bf16*)WSP(bf16, WS_O) + (size_t)row * DM + 256 * g + 4 * fq;
#pragma unroll
    for (int h = 0; h < 4; ++h) { const float lt = xsum_16_32(l[h]); const float sc = lt > 0.f ? GT[h * 3 + 2] / lt : 0.f;
#pragma unroll
        for (int dt = 0; dt < 4; ++dt) { const f32x4 v = *(const GAS f32x4*)(OA + h * 64 + 16 * dt) + o[dt][h] * sc;
            v2u w; w.x = pk2(v[0], v[1]); w.y = pk2(v[2], v[3]); *(GAS v2u*)(O + h * 64 + 16 * dt) = w; } }
    SEC_T1(4);
}

#define ATTN_UNIT attn_prompt_unit2
#ifdef PROBE_MODE
#ifndef PROBE_BLK
#define PROBE_BLK 0
#endif
#ifndef PROBE_MULT
#define PROBE_MULT 8
#endif
#define PROBE_SEL(p) ((p) >= PROBE_A && (p) <= PROBE_B)
#endif
struct Args { const void* in[31]; float* out; unsigned char* ws; int ph_lo, ph_hi; };
constexpr int N_PHASES = 2 + 1 + 12 + 2 * 1 + 2 * 1 + 12 + 1;

__global__ void __launch_bounds__(NWAVES * 64, 2) yoco_fwd(Args args) {
    extern __shared__ __attribute__((aligned(16))) unsigned char lds_raw[];
    LAS unsigned char* lds = (LAS unsigned char*)lds_raw;
    const int tid0 = threadIdx.x, wave = __builtin_amdgcn_readfirstlane(tid0 >> 6);
    const int G = gridDim.x; const int bx = blockIdx.x; const int vcu = (G % 8 == 0) ? (bx % 8) * (G / 8) + bx / 8 : bx;
    const int gw0 = vcu * NWAVES + wave, NGW = G * NWAVES;

    for (int u = tid0; u < (LDS_BYTES - LDSCTL_OFF) / 4; u += NWAVES * 64) ((LAS unsigned*)(lds + LDSCTL_OFF))[u] = 0u;
    __syncthreads();
    volatile LAS unsigned* MISC = (volatile LAS unsigned*)(lds + MISC_OFF);
    unsigned* barw = (unsigned*)(args.ws + WS_CTL) + CW_BAR;
    XcdBarrier bar; bar.bar = barw; bar.x = 0; bar.st = nullptr;
    const int lo = args.ph_lo, hi = args.ph_hi;
    if (hi - lo > 1) bar = xcd_barrier_post(barw, MISC + 8);
    int pid = 0;
#define IN_PH() (lo <= pid && pid < hi)
#define NIN() NormIn{P.ws, sl > 0 ? sl - 1 : 0, sl, sl > 0 ? 1 : 0}
#define LOADP() int tid = tid0; asm volatile("" : "+v"(tid)); const int lane = tid & 63; int gw = gw0; asm volatile("" : "+s"(gw)); (void)lane; (void)gw; Ptrs P; load_ptrs(P); const f16* X = WSP(f16, WS_X); bf16* H = WSP(bf16, WS_H); const float* MOD = WSP(float, WS_MOD); (void)X; (void)H; (void)MOD
#ifdef PROBE_MODE
#define PRB_ON() ((int)blockIdx.x == PROBE_BLK && tid0 == 0)
#define PRB_NOW() ((unsigned)__builtin_amdgcn_s_memrealtime())
#define END_PH() do { if (PRB_ON()) { const unsigned tm_ = PRB_NOW(); if ((PROBE_MODE & 1) && PROBE_SEL(pid)) MISC[16] = MISC[16] + (tm_ - MISC[17]); MISC[17] = tm_; } \
    if (lo <= pid && pid + 1 < hi) xcd_barrier(bar); \
    if (PRB_ON()) { const unsigned te_ = PRB_NOW(); if ((PROBE_MODE & 2) && PROBE_SEL(pid)) MISC[16] = MISC[16] + (te_ - MISC[17]); MISC[17] = te_; } ++pid; } while (0)
#else
#define END_PH() do { if (lo <= pid && pid + 1 < hi) xcd_barrier(bar); ++pid; } while (0)
#endif


#ifdef PROBE_MODE
    if (PRB_ON()) { MISC[16] = 0u; MISC[17] = PRB_NOW(); }
#endif
    if (IN_PH()) { LOADP(); prologue_phase(P, lds, gw, NGW, wave, lane, tid); }
    END_PH();
    if (IN_PH()) { LOADP();
        run_gemm(lds, WSP(bf16, WS_SC), WSP(bf16, WS_WMOD), 256, NMOD, DM, FMod{WSP(float, WS_MOD), P.ada_b, P.kv_ada_b, P.final_ada_b, WSP(bf16, WS_SHB)});
        run_gemm(lds, WSP(bf16, WS_ACMP), WSP(bf16, WS_WC1), 65536, 512, 1024, FBf16{WSP(bf16, WS_TS), 512});
        run_gemm(lds, WSP(bf16, WS_ACMP) + (size_t)65536 * 1024, WSP(bf16, WS_WC1) + (size_t)512 * 1024, 65536, 512, 1024, FBf16{WSP(bf16, WS_TS) + (size_t)65536 * 512, 512});
    }
    END_PH();

    for (int sl = 0; sl < 12; ++sl) {
        const int l = sl / 3, sub = sl - 3 * l;
        if (sl == 0) {
            if (IN_PH()) { LOADP();
                norm_phase<false>(X, P.norm_g, MOD, 0, DM, H, nullptr, gw, NGW, lane);
                { pg8::Gemm g{WSP(bf16, WS_SHB), WSP(bf16, WS_WGU), 13 * 256, 0, DM}; int cb = (int)blockIdx.x; asm volatile("" : "+s"(cb)); ShiftOrder S{(int)gridDim.x, cb}; Epi8<FB2> E{FB2{WSP(float, WS_B2)}};
                  pg8::gemm_phase<Epi8<FB2>, ShiftOrder, true, true>(lds, g, S, E); }
                load_cbias_lds(WSP(float, WS_CBIAS), lds, tid);
                if (wave >= 4) __builtin_amdgcn_s_setprio(1);
                for (int u = gw; u < 2 * 512 * 8; u += NGW) { const int kv = u >> 12, r = u & 4095, bg = r >> 3, rt = r & 7;
                    cmp_finish_unit<2>(WSP(bf16, WS_TS) + (size_t)kv * 65536 * 512, (const LAS float*)lds + kv * 256, WSP(bf16, WS_WC2) + kv * 64 * 256,
                                       kv == 0 ? (void*)WSP(float, WS_KCS) : (void*)WSP(float, WS_VCS), 128, bg, rt, lane); }
                __builtin_amdgcn_s_setprio(0);
                __syncthreads();
            }
            END_PH();
        }
        if (sub != 1) {
            const int s = sub >> 1;
            if (IN_PH()) { LOADP();
                if (sl == 6) {
                    run_gemm2(lds, WSP(bf16, WS_HKV), WSP(bf16, WS_WKV), NKVP, NKVP, DM, FKv{P.out, WSP(bf16, WS_KCIN), NormIn{P.ws, 5, 12, 1}}, 0, 0);
                    run_gemm2(lds, H, WSP(bf16, WS_WGU) + (size_t)(l * 2 + s) * 5632 * 1024, 5632, 5632, DM, FSwiglu{WSP(bf16, WS_HID), NIN()}, (int)gridDim.x / 2, 0);
                } else
                run_gemm2(lds, H, WSP(bf16, WS_WGU) + (size_t)(l * 2 + s) * 5632 * 1024, 5632, 5632, DM, FSwiglu{WSP(bf16, WS_HID), NIN()}); }
            END_PH();
        } else if (l < 2) {
            if (IN_PH()) { LOADP(); run_gemm2(lds, H, WSP(bf16, WS_WUV) + (size_t)l * 6144 * 1024, 6144, 6144, DM, FGelu{WSP(bf16, WS_Z), NIN(), WSP(float, WS_CTL) + CW_VS + (size_t)l * RT * 2}); }
            END_PH();
            if (IN_PH()) { LOADP(); spatial2_phase(P, l, lds, wave, lane, tid, gw, NGW); }
            END_PH();
        } else {
            if (IN_PH()) { LOADP();
                if (sl == 7) {
                    load_cbias_lds(WSP(float, WS_CBIAS), lds, tid);
                    for (int u = gw; u < 2 * 8 * 32; u += NGW) { const int kv = u >> 8, r = u & 255, bg = r >> 5, rt = r & 31;
                        if (kv == 0) cmp_finish_unit<0>(WSP(bf16, WS_TK), (const LAS float*)lds, WSP(bf16, WS_WC2), (void*)WSP(bf16, WS_KC), 512, bg, rt, lane);
                        else cmp_finish_unit<1>(WSP(bf16, WS_TV), (const LAS float*)lds + 256, WSP(bf16, WS_WC2) + 64 * 256, (void*)WSP(bf16, WS_VCT), 512, bg, rt, lane); }
                    __syncthreads();
                }
                run_gemm2(lds, H, WSP(bf16, WS_WQG) + (size_t)(l - 2) * NQG * 1024, NQG, 1072, DM, FQg{WSP(bf16, WS_Q), WSP(float, WS_GATES), NIN()}); }
            END_PH();
            if (IN_PH()) { LOADP(); LAS float* wl = (LAS float*)(lds + (gw & 7) * 16384);
                {
                    int r = 0;
                    for (;;) {
                        const int q = ((int)(xb_xcc_id() & 7u) + r) & 7;
                        unsigned idx = 0u; if (lane == 0) idx = __hip_atomic_fetch_add((unsigned*)(P.ws + WS_CTL) + CW_QUEUE + 64 * (8 * (l - 2) + q), 1u, __ATOMIC_RELAXED, __HIP_MEMORY_SCOPE_AGENT);
                        idx = (unsigned)__builtin_amdgcn_readfirstlane((int)idx);
                        if (idx >= 64u + 512u) { if (++r == 8) break; continue; }
                        if (idx < 64u) { const int id = q * 64 + (int)idx; attn_sample_unit(P, id >> 2, id & 3, wl, lane); }
                        else ATTN_UNIT(P, q, 511 - ((int)idx - 64), wl, lane);
                    }
                }
            }
            END_PH();
        }
        if (IN_PH()) { LOADP();
            const bf16* A2 = sub != 1 ? WSP(bf16, WS_HID) : (l < 2 ? WSP(bf16, WS_P) : WSP(bf16, WS_O));
            const bf16* B2 = sub != 1 ? WSP(bf16, WS_WDN) + (size_t)(l * 2 + (sub >> 1)) * 1024 * DFF : (l < 2 ? WSP(bf16, WS_WOUT) + (size_t)l * 1024 * DV : WSP(bf16, WS_WO) + (size_t)(l - 2) * 1024 * 1024);
            const int K2 = sub != 1 ? DFF : (l < 2 ? DV : DM);
            if (sl == 6) {
                run_gemm(lds, WSP(bf16, WS_KCIN), WSP(bf16, WS_WC1), 4096, 512, 1024, FBf16{WSP(bf16, WS_TK), 512}, 64);
                run_gemm(lds, WSP(bf16, WS_VCIN), WSP(bf16, WS_WC1) + (size_t)512 * 1024, 4096, 512, 1024, FBf16{WSP(bf16, WS_TV), 512}, 32);
            }
            const int sn = sl + 1, ln = sn / 3, subn = sn - 3 * ln;
            const bool more = sl < 11;
            run_gemm2r(lds, A2, B2, K2, FResid{P.ws, l * 9216 + (sub * 3 + 2) * DM, sub != 1 ? 0.5f : 1.0f, more ? sn : -1, ln * 9216 + (subn * 3 + 1) * DM, sl == 5 ? 12 : -1, MODKV + DM, more ? sl : -1});
        }
        END_PH();
    }
    if (IN_PH()) { LOADP(); norm_phase<true>(X, P.final_g, MOD, MODFIN, MODFIN + DM, nullptr, P.out, gw, NGW, lane); }
#ifdef PROBE_MODE
    if (PRB_ON()) { const unsigned tm_ = PRB_NOW(); if ((PROBE_MODE & 1) && PROBE_SEL(pid)) MISC[16] = MISC[16] + (tm_ - MISC[17]);
        const unsigned want = MISC[16] * (unsigned)PROBE_MULT; const unsigned t0_ = PRB_NOW(); while (PRB_NOW() - t0_ < want) __builtin_amdgcn_s_sleep(32); }
#endif
    ++pid;
#undef IN_PH
#undef END_PH
}

extern "C" void kernel_launch(void* const* d_in, const int* in_sizes, int n_in, void* d_out, int out_size, void* d_ws, size_t ws_size, hipStream_t stream) {
    static int grid = 0;
    if (grid == 0) {
        if (n_in != 31 || (size_t)out_size != OUT_TOTAL || ws_size < WS_END) { fprintf(stderr, "kernel_launch: unexpected shapes (n_in %d, out %d, ws %zu need %zu); nothing launched\n", n_in, out_size, ws_size, (size_t)WS_END); grid = -1; return; }
        int dev = 0, cus = 0, per_cu = 0;
        if (hipGetDevice(&dev) != hipSuccess || hipDeviceGetAttribute(&cus, hipDeviceAttributeMultiprocessorCount, dev) != hipSuccess) { grid = -1; return; }
        if (hipFuncSetAttribute((const void*)yoco_fwd, hipFuncAttributeMaxDynamicSharedMemorySize, LDS_BYTES) != hipSuccess) { fprintf(stderr, "kernel_launch: hipFuncSetAttribute failed\n"); grid = -1; return; }
        if (hipOccupancyMaxActiveBlocksPerMultiprocessor(&per_cu, (const void*)yoco_fwd, NWAVES * 64, LDS_BYTES) != hipSuccess || per_cu < 1) { fprintf(stderr, "kernel_launch: occupancy query says %d blocks per CU\n", per_cu); }
        (void)hipGetLastError();
        grid = cus;
    }
    if (grid < 0) return;
    if (hipMemsetAsync((char*)d_ws + WS_CTL, 0, CTL_ZERO_BYTES, stream) != hipSuccess) return;
    Args a{};
    for (int i = 0; i < 31; ++i) a.in[i] = d_in[i];
    a.out = (float*)d_out; a.ws = (unsigned char*)d_ws;
#if ONE_LAUNCH
    a.ph_lo = 0; a.ph_hi = N_PHASES;
    hipLaunchKernelGGL(yoco_fwd, dim3(grid), dim3(NWAVES * 64), LDS_BYTES, stream, a);
#else
    for (int p = 0; p < N_PHASES; ++p) { a.ph_lo = p; a.ph_hi = p + 1; hipLaunchKernelGGL(yoco_fwd, dim3(grid), dim3(NWAVES * 64), LDS_BYTES, stream, a); }
#endif
}
```
